# Optimizing an MI355X kernel written in HIP

```python
import math
import jax, jax.numpy as jnp
from jax import lax
import numpy as np

D_MODEL = 1024
BATCH = 4
SEQ = 8192
DEPTH = 2

GRID_W = 64
CTX_LEN = 256
Q_BLOCK = 128
ROPE_BASE = 10000.0
LN_EPS = 1e-6
RMS_EPS = 1e-6
DN_ALPHA = (2 * DEPTH) ** 0.25
DN_BETA = (8 * DEPTH) ** -0.25
FOURIER_GROUPS = 4
FOURIER_GROUP_DIM = D_MODEL // 8
FOURIER_WIDTH = FOURIER_GROUPS * FOURIER_GROUP_DIM
MLA_HEADS = 8
MLA_Q_LORA = D_MODEL // 4
MLA_KV_LORA = D_MODEL // 4
MLA_NOPE = 64
MLA_ROPE = 32
MLA_V = 64
MLA_SCALE = (MLA_NOPE + MLA_ROPE) ** -0.5
MLA_IN_WIDTH = FOURIER_WIDTH + MLA_Q_LORA + MLA_KV_LORA + MLA_ROPE
DIFF_HEADS = 8
DIFF_HEAD_DIM = 64
DIFF_QK_WIDTH = DIFF_HEADS * 2 * DIFF_HEAD_DIM
DIFF_V_WIDTH = DIFF_HEADS * 2 * DIFF_HEAD_DIM
DIFF_SCALE = DIFF_HEAD_DIM ** -0.5
FF_HIDDEN = int(math.ceil(8 * D_MODEL / 3 / 256)) * 256

kernel_name = "hybrid_fourier_mla_diffattn_prefix_dit"


def layer_norm(x, g=None, b=None):
    xf = x.astype(jnp.float32)
    mu = jnp.mean(xf, axis=-1, keepdims=True)
    var = jnp.mean(jnp.square(xf - mu), axis=-1, keepdims=True)
    y = (xf - mu) * lax.rsqrt(var + LN_EPS)
    if g is not None:
        y = y * g.astype(jnp.float32) + b.astype(jnp.float32)
    return y.astype(x.dtype)


def rms_norm(x, g):
    xf = x.astype(jnp.float32)
    y = xf * lax.rsqrt(jnp.mean(jnp.square(xf), axis=-1, keepdims=True) + RMS_EPS) * g.astype(jnp.float32)
    return y.astype(x.dtype)


def axial_rope(x, rows, cols):
    quarter = x.shape[-1] // 4
    inv = 1.0 / (ROPE_BASE ** (jnp.arange(quarter, dtype=jnp.float32) / quarter))
    bshape = (x.shape[1],) + (1,) * (x.ndim - 3) + (quarter,)
    xf = x.astype(jnp.float32)
    outs = []
    for pos, xh in ((rows, xf[..., :2 * quarter]), (cols, xf[..., 2 * quarter:])):
        ang = (pos.astype(jnp.float32)[:, None] * inv).reshape(bshape)
        cos, sin = jnp.cos(ang), jnp.sin(ang)
        x1, x2 = xh[..., :quarter], xh[..., quarter:]
        outs += [x1 * cos - x2 * sin, x1 * sin + x2 * cos]
    return jnp.concatenate(outs, axis=-1).astype(x.dtype)


def to_blocks(a):
    b, s = a.shape[0], a.shape[1]
    return jnp.moveaxis(a.reshape((b, s // Q_BLOCK, Q_BLOCK) + a.shape[2:]), 1, 0)


def from_blocks(o):
    nb, b, blk = o.shape[0], o.shape[1], o.shape[2]
    return jnp.moveaxis(o, 0, 1).reshape((b, nb * blk) + o.shape[3:])


def fourier_mix(u):
    b, n, _ = u.shape
    z = u.astype(jnp.float32).reshape(b, n, FOURIER_GROUPS, FOURIER_GROUP_DIM)
    z = jnp.fft.fft2(z, axes=(1, 3), norm='ortho').real
    return z.reshape(b, n, FOURIER_WIDTH).astype(u.dtype)


def mla_attend(qn, qr, kn, kr, v):
    s = jnp.einsum('bqhd,bkhd->bhqk', qn, kn) + jnp.einsum('bqhr,bkr->bhqk', qr, kr)
    p = jax.nn.softmax(s.astype(jnp.float32) * MLA_SCALE, axis=-1).astype(v.dtype)
    return jnp.einsum('bhqk,bkhd->bqhd', p, v)


def diff_attend(q, k, v, lam):
    s = jnp.einsum('bqhcd,bkhcd->bhcqk', q, k).astype(jnp.float32) * DIFF_SCALE
    p = jax.nn.softmax(s, axis=-1)
    a = (p[:, :, 0] - lam * p[:, :, 1]).astype(v.dtype)
    return jnp.einsum('bhqk,bkhe->bqhe', a, v)


def swiglu(h, w_gate, w_up, w_down):
    return (jax.nn.silu(h @ w_gate) * (h @ w_up)) @ w_down


def mixer_fourier_mla(h, hc, rows, cols, w_in, q_norm, w_uq, kv_norm, w_ukv, w_out, need_ctx):
    def project(z):
        b, n, _ = z.shape
        u = z @ w_in
        o1 = FOURIER_WIDTH
        o2 = o1 + MLA_Q_LORA
        o3 = o2 + MLA_KV_LORA
        f, cq, ckv, kr = u[..., :o1], u[..., o1:o2], u[..., o2:o3], u[..., o3:]
        q = (rms_norm(cq, q_norm) @ w_uq).reshape(b, n, MLA_HEADS, MLA_NOPE + MLA_ROPE)
        kv = (rms_norm(ckv, kv_norm) @ w_ukv).reshape(b, n, MLA_HEADS, MLA_NOPE + MLA_V)
        return f, q[..., :MLA_NOPE], q[..., MLA_NOPE:], kv[..., :MLA_NOPE], kv[..., MLA_NOPE:], kr

    b, s, _ = h.shape
    f, qn, qr, kn, v, kr = project(h)
    qr = axial_rope(qr, rows, cols)
    kr = axial_rope(kr, rows, cols)
    fc, qnc, qrc, knc, vc, krc = project(hc)
    kn_all = jnp.concatenate([knc, kn], axis=1)
    kr_all = jnp.concatenate([krc, kr], axis=1)
    v_all = jnp.concatenate([vc, v], axis=1)
    att = from_blocks(lax.map(lambda qb: mla_attend(qb[0], qb[1], kn_all, kr_all, v_all),
                              (to_blocks(qn), to_blocks(qr))))
    y = jnp.concatenate([fourier_mix(f), att.reshape(b, s, MLA_HEADS * MLA_V)], axis=-1) @ w_out
    yc = None
    if need_ctx:
        attc = mla_attend(qnc, qrc, knc, krc, vc)
        yc = jnp.concatenate([fourier_mix(fc), attc.reshape(b, hc.shape[1], MLA_HEADS * MLA_V)], axis=-1) @ w_out
    return y, yc


def mixer_diff(h, hc, rows, cols, w_in, lambda_q1, lambda_k1, lambda_q2, lambda_k2, subln, w_out,
               lambda_init, need_ctx):
    def project(z):
        b, n, _ = z.shape
        u = z @ w_in
        q = u[..., :DIFF_QK_WIDTH].reshape(b, n, DIFF_HEADS, 2, DIFF_HEAD_DIM)
        k = u[..., DIFF_QK_WIDTH:2 * DIFF_QK_WIDTH].reshape(b, n, DIFF_HEADS, 2, DIFF_HEAD_DIM)
        v = u[..., 2 * DIFF_QK_WIDTH:].reshape(b, n, DIFF_HEADS, 2 * DIFF_HEAD_DIM)
        return q, k, v

    def finish(o):
        b, n = o.shape[0], o.shape[1]
        o = rms_norm(o, subln) * (1.0 - lambda_init)
        return o.reshape(b, n, DIFF_V_WIDTH) @ w_out

    f32 = jnp.float32
    lam = (jnp.exp(jnp.sum(lambda_q1.astype(f32) * lambda_k1.astype(f32)))
           - jnp.exp(jnp.sum(lambda_q2.astype(f32) * lambda_k2.astype(f32))) + lambda_init)
    q, k, v = project(h)
    q = axial_rope(q, rows, cols)
    k = axial_rope(k, rows, cols)
    qc, kc, vc = project(hc)
    k_all = jnp.concatenate([kc, k], axis=1)
    v_all = jnp.concatenate([vc, v], axis=1)
    att = from_blocks(lax.map(lambda qb: diff_attend(qb, k_all, v_all, lam), to_blocks(q)))
    y = finish(att)
    yc = finish(diff_attend(qc, kc, vc, lam)) if need_ctx else None
    return y, yc


def setup_inputs(seed: int = 0) -> dict:
    key = jax.random.key(seed)
    ks = iter(jax.random.split(key, 48))

    def nrm(shape, scale):
        return jax.random.normal(next(ks), shape, jnp.float32) * scale

    def gain(n):
        return 1.0 + nrm((n,), 0.02)

    d = D_MODEL
    inp = {}
    inp['x'] = nrm((BATCH, SEQ, d), 1.0)
    inp['c'] = nrm((BATCH, d), 1.0)
    inp['ctx'] = nrm((BATCH, CTX_LEN, d), 1.0)
    inp['c_ctx'] = nrm((d,), 1.0)
    inp['l0_w_mod'] = nrm((d, 6 * d), 0.5 * d ** -0.5)
    inp['l0_b_mod'] = nrm((6 * d,), 0.02)
    inp['l0_w_in'] = nrm((d, MLA_IN_WIDTH), d ** -0.5)
    inp['l0_q_norm'] = gain(MLA_Q_LORA)
    inp['l0_w_uq'] = nrm((MLA_Q_LORA, MLA_HEADS * (MLA_NOPE + MLA_ROPE)), MLA_Q_LORA ** -0.5)
    inp['l0_kv_norm'] = gain(MLA_KV_LORA)
    inp['l0_w_ukv'] = nrm((MLA_KV_LORA, MLA_HEADS * (MLA_NOPE + MLA_V)), MLA_KV_LORA ** -0.5)
    inp['l0_w_out'] = nrm((FOURIER_WIDTH + MLA_HEADS * MLA_V, d), DN_BETA * (FOURIER_WIDTH + MLA_HEADS * MLA_V) ** -0.5)
    inp['l0_ln1_g'] = gain(d)
    inp['l0_ln1_b'] = nrm((d,), 0.02)
    inp['l0_w_gate'] = nrm((d, FF_HIDDEN), d ** -0.5)
    inp['l0_w_up'] = nrm((d, FF_HIDDEN), d ** -0.5)
    inp['l0_w_down'] = nrm((FF_HIDDEN, d), DN_BETA * FF_HIDDEN ** -0.5)
    inp['l0_ln2_g'] = gain(d)
    inp['l0_ln2_b'] = nrm((d,), 0.02)
    inp['l1_w_mod'] = nrm((d, 6 * d), 0.5 * d ** -0.5)
    inp['l1_b_mod'] = nrm((6 * d,), 0.02)
    inp['l1_w_in'] = nrm((d, 2 * DIFF_QK_WIDTH + DIFF_V_WIDTH), d ** -0.5)
    inp['l1_lambda_q1'] = nrm((DIFF_HEAD_DIM,), 0.1)
    inp['l1_lambda_k1'] = nrm((DIFF_HEAD_DIM,), 0.1)
    inp['l1_lambda_q2'] = nrm((DIFF_HEAD_DIM,), 0.1)
    inp['l1_lambda_k2'] = nrm((DIFF_HEAD_DIM,), 0.1)
    inp['l1_subln'] = gain(2 * DIFF_HEAD_DIM)
    inp['l1_w_out'] = nrm((DIFF_V_WIDTH, d), DN_BETA * DIFF_V_WIDTH ** -0.5)
    inp['l1_ln1_g'] = gain(d)
    inp['l1_ln1_b'] = nrm((d,), 0.02)
    inp['l1_w_gate'] = nrm((d, FF_HIDDEN), d ** -0.5)
    inp['l1_w_up'] = nrm((d, FF_HIDDEN), d ** -0.5)
    inp['l1_w_down'] = nrm((FF_HIDDEN, d), DN_BETA * FF_HIDDEN ** -0.5)
    inp['l1_ln2_g'] = gain(d)
    inp['l1_ln2_b'] = nrm((d,), 0.02)
    return inp


def reference(x, c, ctx, c_ctx,
              l0_w_mod, l0_b_mod, l0_w_in, l0_q_norm, l0_w_uq, l0_kv_norm, l0_w_ukv, l0_w_out,
              l0_ln1_g, l0_ln1_b, l0_w_gate, l0_w_up, l0_w_down, l0_ln2_g, l0_ln2_b,
              l1_w_mod, l1_b_mod, l1_w_in, l1_lambda_q1, l1_lambda_k1, l1_lambda_q2, l1_lambda_k2,
              l1_subln, l1_w_out, l1_ln1_g, l1_ln1_b, l1_w_gate, l1_w_up, l1_w_down, l1_ln2_g, l1_ln2_b):
    s = x.shape[1]
    ROWS = s // GRID_W
    rows = jnp.repeat(jnp.arange(ROWS, dtype=jnp.int32), GRID_W)
    cols = jnp.tile(jnp.arange(GRID_W, dtype=jnp.int32), ROWS)

    layers = [
        dict(w_mod=l0_w_mod, b_mod=l0_b_mod, ln1_g=l0_ln1_g, ln1_b=l0_ln1_b, w_gate=l0_w_gate,
             w_up=l0_w_up, w_down=l0_w_down, ln2_g=l0_ln2_g, ln2_b=l0_ln2_b,
             mix=(l0_w_in, l0_q_norm, l0_w_uq, l0_kv_norm, l0_w_ukv, l0_w_out)),
        dict(w_mod=l1_w_mod, b_mod=l1_b_mod, ln1_g=l1_ln1_g, ln1_b=l1_ln1_b, w_gate=l1_w_gate,
             w_up=l1_w_up, w_down=l1_w_down, ln2_g=l1_ln2_g, ln2_b=l1_ln2_b,
             mix=(l1_w_in, l1_lambda_q1, l1_lambda_k1, l1_lambda_q2, l1_lambda_k2, l1_subln, l1_w_out)),
    ]

    xc = ctx
    for i in range(DEPTH):
        p = layers[i]
        need_ctx = i < DEPTH - 1
        sh1, sc1, g1, sh2, sc2, g2 = jnp.split(jax.nn.silu(c)[:, None, :] @ p['w_mod'] + p['b_mod'], 6, axis=-1)
        csh1, csc1, cg1, csh2, csc2, cg2 = jnp.split(jax.nn.silu(c_ctx) @ p['w_mod'] + p['b_mod'], 6, axis=-1)
        h = layer_norm(x) * (1.0 + sc1) + sh1
        hc = layer_norm(xc) * (1.0 + csc1) + csh1
        if i % 2 == 0:
            y, yc = mixer_fourier_mla(h, hc, rows, cols, *p['mix'], need_ctx)
        else:
            lambda_init = 0.8 - 0.6 * math.exp(-0.3 * i)
            y, yc = mixer_diff(h, hc, rows, cols, *p['mix'], lambda_init, need_ctx)
        x = layer_norm(DN_ALPHA * x + g1 * y, p['ln1_g'], p['ln1_b'])
        h = layer_norm(x) * (1.0 + sc2) + sh2
        x = layer_norm(DN_ALPHA * x + g2 * swiglu(h, p['w_gate'], p['w_up'], p['w_down']), p['ln2_g'], p['ln2_b'])
        if need_ctx:
            xc = layer_norm(DN_ALPHA * xc + cg1 * yc, p['ln1_g'], p['ln1_b'])
            hc = layer_norm(xc) * (1.0 + csc2) + csh2
            xc = layer_norm(DN_ALPHA * xc + cg2 * swiglu(hc, p['w_gate'], p['w_up'], p['w_down']), p['ln2_g'], p['ln2_b'])
    return x
```

```cpp
#include <hip/hip_runtime.h>
#include <hip/hip_cooperative_groups.h>
#include <cstdio>
#include <cstdint>
namespace cg = cooperative_groups;

#ifndef MK_MULTI
#define MK_MULTI 0
#endif

#define DI __device__ __forceinline__
#define LAS __attribute__((address_space(3)))
typedef unsigned short bf16_t;
typedef short bf16x8 __attribute__((ext_vector_type(8)));
typedef float f32x4 __attribute__((ext_vector_type(4)));
typedef float f32x2 __attribute__((ext_vector_type(2)));
typedef float f32x16 __attribute__((ext_vector_type(16)));
typedef unsigned u32x4 __attribute__((ext_vector_type(4)));
typedef unsigned u32x2 __attribute__((ext_vector_type(2)));
typedef __bf16 bf16x2_t __attribute__((ext_vector_type(2)));

constexpr int DM = 1024, NB = 4, SEQ = 8192, CTX = 256, TPB = SEQ + CTX  , ROWS = NB * TPB  , FF = 2816;
constexpr int NRT = ROWS / 256;
constexpr float LN_EPS = 1e-6f, RMS_EPS = 1e-6f;
constexpr float DN_ALPHA = 1.41421356237f;
constexpr float LOG2E = 1.4426950408889634f;
constexpr float MLA_QSCALE = 0.10206207261596577f * LOG2E;
constexpr float DIFF_QSCALE = 0.125f * LOG2E;
constexpr float LAMBDA_INIT = 0.35550906f;

constexpr size_t MiB = 1u << 20;
constexpr size_t WS_MOD = 0;
constexpr size_t WS_TAB16 = 256 * 1024;
constexpr size_t WS_TAB8 = WS_TAB16 + 16384;
constexpr size_t WS_XC = 1 * MiB;
constexpr size_t WS_W = 5 * MiB;
constexpr size_t W_IN0 = WS_W;
constexpr size_t W_UQ = W_IN0 + 1280 * 1024 * 2;
constexpr size_t W_KN = W_UQ + 768 * 256 * 2;
constexpr size_t W_V0 = W_KN + 512 * 256 * 2;
constexpr size_t W_OUT0 = W_V0 + 512 * 256 * 2;
constexpr size_t W_GU0 = W_OUT0 + 1024 * 1024 * 2;
constexpr size_t W_D0 = W_GU0 + 5632 * 1024 * 2;
constexpr size_t W_QK1 = W_D0 + 1024 * 2816 * 2;
constexpr size_t W_V1 = W_QK1 + 2048 * 1024 * 2;
constexpr size_t W_OUT1 = W_V1 + 1024 * 1024 * 2;
constexpr size_t W_GU1 = W_OUT1 + 1024 * 1024 * 2;
constexpr size_t W_D1 = W_GU1 + 5632 * 1024 * 2;
constexpr size_t W_DC = W_D1 + 1024 * 2816 * 2;
constexpr size_t W_D256 = W_DC + 256 * 128 * 2;
constexpr size_t W_END = W_D256 + 256 * 512 * 2;
static_assert(W_END <= 56 * MiB, "weights region");
constexpr size_t WS_DN = 56 * MiB;
constexpr size_t WS_R2 = 184 * MiB;
constexpr size_t WS_R3 = 250 * MiB;
constexpr size_t WS_R4 = WS_R3 + (size_t)ROWS * 1280 * 2;
constexpr size_t WS_CQN = WS_R4, WS_CKVN = WS_R4 + (size_t)ROWS * 256 * 2;
constexpr size_t WS_R5 = WS_R4 + (size_t)ROWS * 512 * 2;
constexpr size_t WS_Q = WS_R5;
constexpr size_t WS_KN = WS_Q + (size_t)ROWS * 768 * 2;
constexpr size_t WS_KR = WS_KN + (size_t)ROWS * 512 * 2;
constexpr size_t WS_VT0 = WS_KR + (size_t)ROWS * 32 * 2;
constexpr size_t WS_END = WS_VT0 + (size_t)512 * ROWS * 2;
constexpr size_t WS_Y0 = WS_R5;
constexpr size_t WS_VT1 = WS_R3 + (size_t)ROWS * 2048 * 2;
static_assert(WS_END <= 512 * MiB, "workspace");
static_assert(WS_VT1 + (size_t)1024 * ROWS * 2 <= WS_END, "vt1");
static_assert(WS_R3 + (size_t)ROWS * FF * 2 <= WS_END, "hid");

DI int otid() { int t = threadIdx.x; asm volatile("" : "+v"(t)); return t; }
DI float wave_sum(float v) {
#pragma unroll
    for (int o = 1; o < 64; o <<= 1) v += __shfl_xor(v, o);
    return v;
}
DI unsigned cvtpk(float lo, float hi) { f32x2 v = {lo, hi}; bf16x2_t b = __builtin_convertvector(v, bf16x2_t); return __builtin_bit_cast(unsigned, b); }
DI float bf2f(unsigned short b) { return __uint_as_float(((unsigned)b) << 16); }
DI float bflo(unsigned w) { return __uint_as_float(w << 16); }
DI float bfhi(unsigned w) { return __uint_as_float(w & 0xffff0000u); }

namespace pg8 {
constexpr int BM = 256, BK = 64, HALF = 128, HTB = HALF * BK * 2, STAGE_BYTES = 8 * HTB, NXCD = 8, WGM = 8;
__host__ __device__ __forceinline__ int lds_byte(int r, int c) { const int st = (r >> 4) * 2 + (c >> 5), rr = r & 15, cc = c & 31, ob = rr * 64 + cc * 2; return st * 1024 + (ob ^ (((ob >> 9) & 1) << 5)); }
__host__ __device__ __forceinline__ void stage_rc(int b, int& R, int& C) { const int st = b / 1024, sb = b % 1024, swz = sb ^ (((sb >> 9) & 1) << 5); R = (st >> 1) * 16 + swz / 64; C = (st & 1) * 32 + (swz % 64) / 2; }
__host__ __device__ __forceinline__ int perm32(int rho) { const int n = rho >> 4, i = rho & 15; return 8 * (i >> 2) + 4 * n + (i & 3); }

struct Unit { int pm, pn, pb; };
struct Gemm {
    const bf16_t* A; const bf16_t* Bt; int nM, nN, nB, K, kseg;
    int a_rs, b_rs, a_seg, b_seg, a_bs, b_bs;
    int rot;
};
struct StaticOrder {
    int nM, nN, nwg, tot, G, c;
    DI void init(int nM_, int nN_, int nB_, int G_, int c_, int rot) { nM = nM_; nN = nN_; nwg = nM * nN; tot = nwg * nB_; G = G_; c = (c_ + G_ - (rot % G_)) % G_; }
    DI bool next(int i, Unit& u) const {
        const long L = (long)i * G + c; if (L >= tot) return false;
        u.pb = (int)(L / nwg); int wgid = (int)(L % nwg);
        { const int q = nwg / NXCD, r = nwg % NXCD, xcd = wgid % NXCD, off = wgid / NXCD; wgid = (xcd < r ? xcd * (q + 1) : r * (q + 1) + (xcd - r) * q) + off; }
        const int nig = WGM * nN, gid = wgid / nig, fm = gid * WGM, gsz = (nM - fm) < WGM ? (nM - fm) : WGM;
        u.pm = fm + ((wgid % nig) % gsz); u.pn = (wgid % nig) / gsz; return true;
    }
};

struct EpiStore {
    static constexpr bool PERM = true;
    bf16_t* O; int ldc, o_bs, ai_extra; float scale;
    DI void operator()(const f32x4 (&acc)[2][2][4][2], const Unit& u, int wr, int wc, int fr, int fq) const {
        const int row0 = u.pm * BM + wr * 64 + fr, col0 = u.pn * BM + wc * 32 + 8 * fq;
        bf16_t* base = O + (size_t)u.pb * o_bs;
#pragma unroll
        for (int ai = 0; ai < 2; ++ai)
#pragma unroll
            for (int m = 0; m < 4; ++m) { bf16_t* rowp = base + (size_t)(row0 + ai * HALF + m * 16) * ldc + (size_t)ai * ai_extra + col0;
#pragma unroll
                for (int bj = 0; bj < 2; ++bj) { const f32x4 v0 = acc[ai][bj][m][0] * scale, v1 = acc[ai][bj][m][1] * scale;
                    u32x4 w; w.x = cvtpk(v0[0], v0[1]); w.y = cvtpk(v0[2], v0[3]); w.z = cvtpk(v1[0], v1[1]); w.w = cvtpk(v1[2], v1[3]);
                    *(u32x4*)(rowp + bj * HALF) = w; } }
    }
};
struct EpiSwiglu {
    static constexpr bool PERM = true;
    bf16_t* O; int ldc;
    DI void operator()(const f32x4 (&acc)[2][2][4][2], const Unit& u, int wr, int wc, int fr, int fq) const {
        const int row0 = u.pm * BM + wr * 64 + fr, col0 = u.pn * HALF + wc * 32 + 8 * fq;
#pragma unroll
        for (int ai = 0; ai < 2; ++ai)
#pragma unroll
            for (int m = 0; m < 4; ++m) { bf16_t* rowp = O + (size_t)(row0 + ai * HALF + m * 16) * ldc + col0; float h[8];
#pragma unroll
                for (int n = 0; n < 2; ++n)
#pragma unroll
                    for (int i = 0; i < 4; ++i) { const float g = acc[ai][0][m][n][i], up = acc[ai][1][m][n][i];
                        h[n * 4 + i] = g * __builtin_amdgcn_rcpf(1.0f + __builtin_amdgcn_exp2f(-g * LOG2E)) * up; }
                u32x4 w; w.x = cvtpk(h[0], h[1]); w.y = cvtpk(h[2], h[3]); w.z = cvtpk(h[4], h[5]); w.w = cvtpk(h[6], h[7]);
                *(u32x4*)rowp = w; }
    }
};
template <int MODE> struct EpiRope {
    static constexpr bool PERM = false;
    bf16_t* O; int ldc; float qscale; int q_tiles, rope_from; const f32x2* tab;
    DI void operator()(const f32x4 (&acc)[2][2][4][2], const Unit& u, int wr, int wc, int fr, int fq) const {
        const float sc = u.pn < q_tiles ? qscale : 1.0f; const bool rope_tile = u.pn >= rope_from;
        const int col0 = u.pn * BM + wc * 32 + 4 * fq;
#pragma unroll
        for (int ai = 0; ai < 2; ++ai)
#pragma unroll
            for (int m = 0; m < 4; ++m) {
                const int row = u.pm * BM + ai * HALF + wr * 64 + m * 16 + fr; const int j = row % TPB; const int t = j - CTX;
                f32x4 cs0 = {1.f, 0.f, 1.f, 0.f}, cs1 = {1.f, 0.f, 1.f, 0.f};
                if (rope_tile && t >= 0) {
                    int pos, f0;
                    if (MODE == 16) { pos = (wc & 1) ? (t & 63) : (t >> 6); f0 = 4 * fq; } else { pos = (fq >> 1) ? (t & 63) : (t >> 6); f0 = 4 * (fq & 1); }
                    const f32x4* tp = (const f32x4*)(tab + pos * MODE + f0); cs0 = tp[0]; cs1 = tp[1];
                }
                const float c[4] = {cs0[0], cs0[2], cs1[0], cs1[2]}, s[4] = {cs0[1], cs0[3], cs1[1], cs1[3]};
                bf16_t* rowp = O + (size_t)row * ldc + col0;
#pragma unroll
                for (int bj = 0; bj < 2; ++bj) { const f32x4 x1 = acc[ai][bj][m][0] * sc, x2 = acc[ai][bj][m][1] * sc; float o1[4], o2[4];
#pragma unroll
                    for (int i = 0; i < 4; ++i) { o1[i] = x1[i] * c[i] - x2[i] * s[i]; o2[i] = x1[i] * s[i] + x2[i] * c[i]; }
                    u32x2 w1, w2; w1.x = cvtpk(o1[0], o1[1]); w1.y = cvtpk(o1[2], o1[3]); w2.x = cvtpk(o2[0], o2[1]); w2.y = cvtpk(o2[2], o2[3]);
                    *(u32x2*)(rowp + bj * HALF) = w1; *(u32x2*)(rowp + bj * HALF + 16) = w2; }
            }
    }
};

template <class Epi>
DI void gemm_phase(LAS unsigned char* lds, const Gemm g, const StaticOrder& S, const Epi& E) {
    const int tid = otid(), wid = __builtin_amdgcn_readfirstlane(tid >> 6), lane = tid & 63, wr = wid >> 2, wc = wid & 3, fr = lane & 15, fq = lane >> 4;
    const int nt = g.K / BK, kseg = g.kseg;
    unsigned voffA[2], voffB[2];
#pragma unroll
    for (int i = 0; i < 2; ++i) { int R, C; stage_rc(tid * 16 + i * 8192, R, C); const int Rb = Epi::PERM ? ((R & ~31) + perm32(R & 31)) : R;
        voffA[i] = (unsigned)(R * g.a_rs + C) * 2u; voffB[i] = (unsigned)(Rb * g.b_rs + C) * 2u; }
    const int kstep = BK * 2;
    const unsigned hstepA = (unsigned)HALF * g.a_rs * 2, hstepB = (unsigned)HALF * g.b_rs * 2;
    const unsigned tstepA = 2 * hstepA, tstepB = 2 * hstepB;
    const int segA = (g.a_seg - kseg * BK) * 2, segB = (g.b_seg - kseg * BK) * 2;
#define OFFA(t) ((t) * kstep + ((t) >= kseg ? segA : 0))
#define OFFB(t) ((t) * kstep + ((t) >= kseg ? segB : 0))
    const unsigned ldsw = (unsigned)wid * 1024u;
    const int aoff = lds_byte(wr * 64 + fr, fq * 8), boff = lds_byte(wc * 32 + fr, fq * 8);
#define PG8_SA(b, h) (((b) * 2 + (h)) * HTB)
#define PG8_SB(b, h) ((4 + (b) * 2 + (h)) * HTB)
#define PG8_STAGE(bufoff, gbase, voff) do { _Pragma("unroll") for (int _i = 0; _i < 2; ++_i) \
        __builtin_amdgcn_global_load_lds((const unsigned*)((const char*)(gbase) + (voff)[_i]), (LAS unsigned*)(lds + (bufoff) + ldsw + _i * 8192), 16, 0, 0); } while (0)
#define PG8_LDA(dst, b, h) do { _Pragma("unroll") for (int m = 0; m < 4; ++m) _Pragma("unroll") for (int k = 0; k < 2; ++k) dst[m][k] = *(const LAS bf16x8*)(lds + PG8_SA(b, h) + aoff + m * 2048 + k * 1024); } while (0)
#define PG8_LDB(dst, b, h) do { _Pragma("unroll") for (int n = 0; n < 2; ++n) _Pragma("unroll") for (int k = 0; k < 2; ++k) dst[n][k] = *(const LAS bf16x8*)(lds + PG8_SB(b, h) + boff + n * 2048 + k * 1024); } while (0)
#define PG8_MMA(ai, bj, At, Bt) do { __builtin_amdgcn_s_setprio(1); _Pragma("unroll") for (int m = 0; m < 4; ++m) _Pragma("unroll") for (int n = 0; n < 2; ++n) _Pragma("unroll") for (int k = 0; k < 2; ++k) \
        acc[ai][bj][m][n] = __builtin_amdgcn_mfma_f32_16x16x32_bf16(Bt[n][k], At[m][k], acc[ai][bj][m][n], 0, 0, 0); __builtin_amdgcn_s_setprio(0); } while (0)
#define PG8_WAIT_V(n) asm volatile("s_waitcnt vmcnt(" #n ")" ::: "memory")
#define PG8_WAIT_L(n) asm volatile("s_waitcnt lgkmcnt(" #n ")" ::: "memory")
#define PG8_BAR __builtin_amdgcn_s_barrier()
#define PG8_SCHED __builtin_amdgcn_sched_barrier(0)
    Unit cur, nxt; int ui = 0;
    if (!S.next(0, cur)) return;
    f32x4 acc[2][2][4][2];
#pragma unroll
    for (int a = 0; a < 2; ++a)
#pragma unroll
        for (int b = 0; b < 2; ++b)
#pragma unroll
            for (int m = 0; m < 4; ++m)
#pragma unroll
                for (int n = 0; n < 2; ++n) acc[a][b][m][n] = (f32x4){0.f, 0.f, 0.f, 0.f};
    bf16x8 At[4][2], B0[2][2], B1[2][2];
    const char* cA = (const char*)g.A + ((size_t)cur.pb * g.a_bs) * 2 + (size_t)cur.pm * tstepA;
    const char* cB = (const char*)g.Bt + ((size_t)cur.pb * g.b_bs) * 2 + (size_t)cur.pn * tstepB;
    {
        PG8_STAGE(PG8_SB(0, 0), cB, voffB); PG8_STAGE(PG8_SB(0, 1), cB + hstepB, voffB); PG8_STAGE(PG8_SA(0, 0), cA, voffA); PG8_STAGE(PG8_SA(0, 1), cA + hstepA, voffA);
        if (wr == 1) PG8_BAR;
        PG8_WAIT_V(2); PG8_BAR;
        PG8_STAGE(PG8_SB(1, 0), cB + OFFB(1), voffB); PG8_STAGE(PG8_SA(1, 0), cA + OFFA(1), voffA); PG8_STAGE(PG8_SB(1, 1), cB + hstepB + OFFB(1), voffB);
        PG8_WAIT_V(6); PG8_BAR;
    }
    for (;;) {
        const bool has_next = S.next(ui + 1, nxt);
        const char* nA = has_next ? (const char*)g.A + ((size_t)nxt.pb * g.a_bs) * 2 + (size_t)nxt.pm * tstepA : cA;
        const char* nB = has_next ? (const char*)g.Bt + ((size_t)nxt.pb * g.b_bs) * 2 + (size_t)nxt.pn * tstepB : cB;
        for (int t = 0; t < nt; t += 2) {
            const bool last = (t == nt - 2);
            const char* a1 = cA + OFFA(t + 1);
            const char* a2 = last ? nA : cA + OFFA(t + 2); const char* b2 = last ? nB : cB + OFFB(t + 2);
            const char* a3 = last ? nA + OFFA(1) : cA + OFFA(t + 3); const char* b3 = last ? nB + OFFB(1) : cB + OFFB(t + 3);
            PG8_LDB(B0, 0, 0); PG8_LDB(B1, 0, 1); PG8_SCHED; PG8_LDA(At, 0, 0); PG8_STAGE(PG8_SA(1, 1), a1 + hstepA, voffA);
            PG8_WAIT_V(8); PG8_WAIT_L(0); PG8_BAR; PG8_MMA(0, 0, At, B0); PG8_MMA(0, 1, At, B1); PG8_BAR; PG8_SCHED;
            PG8_LDA(At, 0, 1); PG8_STAGE(PG8_SB(0, 0), b2, voffB); PG8_STAGE(PG8_SB(0, 1), b2 + hstepB, voffB); PG8_STAGE(PG8_SA(0, 0), a2, voffA);
            PG8_WAIT_V(8); PG8_WAIT_L(0); PG8_BAR; PG8_MMA(1, 0, At, B0); PG8_MMA(1, 1, At, B1); PG8_BAR; PG8_SCHED;
            PG8_LDB(B0, 1, 0); PG8_LDB(B1, 1, 1); PG8_SCHED; PG8_LDA(At, 1, 0); PG8_STAGE(PG8_SA(0, 1), a2 + hstepA, voffA);
            PG8_WAIT_V(8); PG8_WAIT_L(0); PG8_BAR; PG8_MMA(0, 0, At, B0); PG8_MMA(0, 1, At, B1); PG8_BAR; PG8_SCHED;
            PG8_LDA(At, 1, 1); PG8_STAGE(PG8_SB(1, 0), b3, voffB); PG8_STAGE(PG8_SB(1, 1), b3 + hstepB, voffB); PG8_STAGE(PG8_SA(1, 0), a3, voffA);
            PG8_WAIT_V(8); PG8_WAIT_L(0); PG8_BAR; PG8_MMA(1, 0, At, B0); PG8_MMA(1, 1, At, B1); PG8_BAR; PG8_SCHED;
        }
        if (wr == 0) PG8_BAR;
        E(acc, cur, wr, wc, fr, fq);
        if (!has_next) break;
#pragma unroll
        for (int a = 0; a < 2; ++a)
#pragma unroll
            for (int b = 0; b < 2; ++b)
#pragma unroll
                for (int m = 0; m < 4; ++m)
#pragma unroll
                    for (int n = 0; n < 2; ++n) acc[a][b][m][n] = (f32x4){0.f, 0.f, 0.f, 0.f};
        cur = nxt; cA = nA; cB = nB; ++ui;
        if (wr == 1) PG8_BAR;
    }
    PG8_WAIT_V(0);
    PG8_BAR;
#undef OFFA
#undef OFFB
#undef PG8_SA
#undef PG8_SB
#undef PG8_STAGE
#undef PG8_LDA
#undef PG8_LDB
#undef PG8_MMA
#undef PG8_WAIT_V
#undef PG8_WAIT_L
#undef PG8_BAR
#undef PG8_SCHED
}
}

#define MFMA32(a, b, c) __builtin_amdgcn_mfma_f32_32x32x16_bf16((a), (b), (c), 0, 0, 0)
template <int D1, int D2, int DV>
DI void attn_core(f32x16 (&o)[DV / 32], float& l_out, LAS unsigned char* lds, const bf16_t* q1, const bf16_t* q2,
                  const bf16_t* k1, long ldk1, const bf16_t* k2, long ldk2, const bf16_t* vt, long ldv, int ntiles) {
    constexpr int DQK = D1 + D2, KROW = DQK * 2 + 16, VROW = 144, KT = 64 * KROW, VT = DV * VROW, BUF = KT + VT;
    constexpr int KCH = DQK / 8, NKC = 64 * KCH, NVC = DV * 8, KPT = (NKC + 511) / 512, VPT = NVC / 512;
    const int tid = otid(), lane = tid & 63, r = lane & 31, h = lane >> 5;
    bf16x8 qf[DQK / 16];
#pragma unroll
    for (int d0 = 0; d0 < DQK / 16; ++d0) qf[d0] = (16 * d0 < D1) ? *(const bf16x8*)(q1 + 16 * d0 + 8 * h) : *(const bf16x8*)(q2 + (16 * d0 - D1) + 8 * h);
    u32x4 kreg[KPT], vreg[VPT];
    auto gload = [&](int t) {
#pragma unroll
        for (int i = 0; i < KPT; ++i) { const int c = tid + i * 512; if (c < NKC) { const int row = c / KCH, cc = (c % KCH) * 8;
            kreg[i] = (cc < D1) ? *(const u32x4*)(k1 + (size_t)(t * 64 + row) * ldk1 + cc) : *(const u32x4*)(k2 + (size_t)(t * 64 + row) * ldk2 + (cc - D1)); } }
#pragma unroll
        for (int i = 0; i < VPT; ++i) { const int c = tid + i * 512; const int d = c >> 3, cc = (c & 7) * 8; vreg[i] = *(const u32x4*)(vt + (size_t)d * ldv + t * 64 + cc); }
    };
    auto sstore = [&](int b) {
        LAS unsigned char* kb = lds + b * BUF; LAS unsigned char* vb = kb + KT;
#pragma unroll
        for (int i = 0; i < KPT; ++i) { const int c = tid + i * 512; if (c < NKC) { const int row = c / KCH, cc = (c % KCH) * 8; *(LAS u32x4*)(kb + row * KROW + cc * 2) = kreg[i]; } }
#pragma unroll
        for (int i = 0; i < VPT; ++i) { const int c = tid + i * 512; const int d = c >> 3, cc = (c & 7) * 8; *(LAS u32x4*)(vb + d * VROW + cc * 2) = vreg[i]; }
    };
    const int pr = (r & ~12) | ((r & 4) << 1) | ((r & 8) >> 1);
    float mrun = -1e30f, lrun = 0.f;
#pragma unroll
    for (int b = 0; b < DV / 32; ++b)
#pragma unroll
        for (int i = 0; i < 16; ++i) o[b][i] = 0.f;
    gload(0); sstore(0); __syncthreads();
    for (int t = 0; t < ntiles; ++t) {
        if (t + 1 < ntiles) gload(t + 1);
        const LAS unsigned char* kb = lds + (t & 1) * BUF; const LAS unsigned char* vb = kb + KT;
        f32x16 p[2];
#pragma unroll
        for (int hf = 0; hf < 2; ++hf) {
#pragma unroll
            for (int i = 0; i < 16; ++i) p[hf][i] = 0.f;
#pragma unroll
            for (int d0 = 0; d0 < DQK / 16; ++d0) { const bf16x8 ka = *(const LAS bf16x8*)(kb + (32 * hf + pr) * KROW + (16 * d0 + 8 * h) * 2); p[hf] = MFMA32(ka, qf[d0], p[hf]); }
        }
        float tm = p[0][0];
#pragma unroll
        for (int i = 1; i < 16; ++i) tm = fmaxf(tm, p[0][i]);
#pragma unroll
        for (int i = 0; i < 16; ++i) tm = fmaxf(tm, p[1][i]);
        tm = fmaxf(tm, __shfl_xor(tm, 32));
        const float mnew = fmaxf(mrun, tm), alpha = __builtin_amdgcn_exp2f(mrun - mnew); mrun = mnew;
        float rs = 0.f;
#pragma unroll
        for (int hf = 0; hf < 2; ++hf)
#pragma unroll
            for (int i = 0; i < 16; ++i) { p[hf][i] = __builtin_amdgcn_exp2f(p[hf][i] - mnew); rs += p[hf][i]; }
        lrun = lrun * alpha + rs;
#pragma unroll
        for (int b = 0; b < DV / 32; ++b)
#pragma unroll
            for (int i = 0; i < 16; ++i) o[b][i] *= alpha;
        bf16x8 pf[4];
#pragma unroll
        for (int ks = 0; ks < 4; ++ks) { const int hf = ks >> 1, s8 = (ks & 1) * 8; u32x4 w;
            w.x = cvtpk(p[hf][s8 + 0], p[hf][s8 + 1]); w.y = cvtpk(p[hf][s8 + 2], p[hf][s8 + 3]); w.z = cvtpk(p[hf][s8 + 4], p[hf][s8 + 5]); w.w = cvtpk(p[hf][s8 + 6], p[hf][s8 + 7]);
            pf[ks] = __builtin_bit_cast(bf16x8, w); }
#pragma unroll
        for (int b = 0; b < DV / 32; ++b)
#pragma unroll
            for (int ks = 0; ks < 4; ++ks) { const bf16x8 va = *(const LAS bf16x8*)(vb + (32 * b + r) * VROW + (16 * ks + 8 * h) * 2); o[b] = MFMA32(va, pf[ks], o[b]); }
        if (t + 1 < ntiles) sstore((t + 1) & 1);
        __syncthreads();
    }
    l_out = lrun + __shfl_xor(lrun, 32);
}
constexpr int ATTN_LDS = 2 * (64 * (96 * 2 + 16) + 128 * 144);

struct Args {
    const float* in[35]; float* out; unsigned char* ws; int ph_lo, ph_hi;
};
enum { I_X = 0, I_C, I_CTX, I_CCTX,
       I0_WMOD, I0_BMOD, I0_WIN, I0_QN, I0_WUQ, I0_KVN, I0_WUKV, I0_WOUT, I0_LN1G, I0_LN1B, I0_WG, I0_WU, I0_WD, I0_LN2G, I0_LN2B,
       I1_WMOD, I1_BMOD, I1_WIN, I1_LQ1, I1_LK1, I1_LQ2, I1_LK2, I1_SUBLN, I1_WOUT, I1_LN1G, I1_LN1B, I1_WG, I1_WU, I1_WD, I1_LN2G, I1_LN2B };

DI bf16_t* tr_dst(int job, int n, unsigned char* ws) {
    switch (job) {
    case 0: return (bf16_t*)(ws + W_IN0) + (size_t)n * 1024;
    case 1: { const int hd = n / 96, d = n % 96; int row; if (d < 64) row = hd * 64 + d; else { const int e = d - 64, t = e >> 3, f = e & 7; row = 512 + hd * 32 + 16 * (t & 1) + 8 * (t >> 1) + f; }
              return (bf16_t*)(ws + W_UQ) + (size_t)row * 256; }
    case 2: { const int hd = n >> 7, d = n & 127; return d < 64 ? (bf16_t*)(ws + W_KN) + (size_t)(hd * 64 + d) * 256 : (bf16_t*)(ws + W_V0) + (size_t)(hd * 64 + d - 64) * 256; }
    case 3: return (bf16_t*)(ws + W_OUT0) + (size_t)n * 1024;
    case 4: return (bf16_t*)(ws + W_GU0) + (size_t)(256 * (n >> 7) + (n & 127)) * 1024;
    case 5: return (bf16_t*)(ws + W_GU0) + (size_t)(256 * (n >> 7) + 128 + (n & 127)) * 1024;
    case 6: return (bf16_t*)(ws + W_D0) + (size_t)n * 2816;
    case 7: return n < 2048 ? (bf16_t*)(ws + W_QK1) + (size_t)n * 1024 : (bf16_t*)(ws + W_V1) + (size_t)(n - 2048) * 1024;
    case 8: return (bf16_t*)(ws + W_OUT1) + (size_t)n * 1024;
    case 9: return (bf16_t*)(ws + W_GU1) + (size_t)(256 * (n >> 7) + (n & 127)) * 1024;
    case 10: return (bf16_t*)(ws + W_GU1) + (size_t)(256 * (n >> 7) + 128 + (n & 127)) * 1024;
    default: return (bf16_t*)(ws + W_D1) + (size_t)n * 2816;
    }
}
DI void transpose_item(const float* W, int K, int N, int job, unsigned char* ws, LAS float* scr, int item, int lane) {
    const int nblk = N / 32, kb = item / nblk, nb = item % nblk, k0 = 64 * kb, n0 = 32 * nb;
#pragma unroll 8
    for (int i = 0; i < 32; ++i) { const int kk = 2 * i + (lane >> 5); scr[kk * 33 + (lane & 31)] = W[(size_t)(k0 + kk) * N + n0 + (lane & 31)]; }
    asm volatile("s_waitcnt lgkmcnt(0)" ::: "memory");
    const int c = lane & 7;
#pragma unroll
    for (int j = 0; j < 4; ++j) { const int n = (lane >> 3) + 8 * j; const LAS float* s = scr + (8 * c) * 33 + n;
        u32x4 o; o.x = cvtpk(s[0 * 33], s[1 * 33]); o.y = cvtpk(s[2 * 33], s[3 * 33]); o.z = cvtpk(s[4 * 33], s[5 * 33]); o.w = cvtpk(s[6 * 33], s[7 * 33]);
        bf16_t* dst = tr_dst(job, n0 + n, ws); *(u32x4*)(dst + k0 + 8 * c) = o; }
    asm volatile("s_waitcnt lgkmcnt(0)" ::: "memory");
}

DI void prologue(const Args& a, LAS unsigned char* lds) {
    unsigned char* ws = a.ws;
    const int tid = otid(), lane = tid & 63, wave = tid >> 6;
    const int G = gridDim.x, gw = blockIdx.x * 8 + wave, NGW = G * 8;
    const long gt = (long)blockIdx.x * 512 + tid, NGT = (long)G * 512;
    {
        LAS float* scr = (LAS float*)(lds + wave * 16384);
        const int jin[12] = {I0_WIN, I0_WUQ, I0_WUKV, I0_WOUT, I0_WG, I0_WU, I0_WD, I1_WIN, I1_WOUT, I1_WG, I1_WU, I1_WD};
        const int jK[12] = {1024, 256, 256, 1024, 1024, 1024, 2816, 1024, 1024, 1024, 1024, 2816};
        const int jN[12] = {1056, 768, 1024, 1024, 2816, 2816, 1024, 3072, 1024, 2816, 2816, 1024};
        int base = 0;
#pragma unroll
        for (int j = 0; j < 12; ++j) { const int items = (jK[j] / 64) * (jN[j] / 32);
            for (int it = gw; it < items; it += NGW) transpose_item(a.in[jin[j]], jK[j], jN[j], j, ws, scr, it, lane);
            base += items; }
        u32x4 z = {0u, 0u, 0u, 0u};
        for (long i = gt; i < (1280 - 1056) * 1024 / 8; i += NGT) ((u32x4*)((bf16_t*)(ws + W_IN0) + (size_t)1056 * 1024))[i] = z;
    }
    {
        const float sc = 0.011048543456039806f;
        for (long i = gt; i < (long)4096 * 2048; i += NGT) { const int k = (int)(i >> 11), c8 = (int)(i & 2047) * 8; const int part = c8 >> 13, n0 = c8 & 8191; float v[8];
#pragma unroll
            for (int e = 0; e < 8; ++e) { const float ph = (float)((k * (n0 + e)) & 8191) * (1.0f / 8192.0f); v[e] = (part ? __builtin_amdgcn_sinf(ph) : __builtin_amdgcn_cosf(ph)) * sc; }
            u32x4 o; o.x = cvtpk(v[0], v[1]); o.y = cvtpk(v[2], v[3]); o.z = cvtpk(v[4], v[5]); o.w = cvtpk(v[6], v[7]);
            *(u32x4*)((bf16_t*)(ws + WS_DN) + (size_t)k * 16384 + c8) = o; }
        for (long i = gt; i < 256 * 512; i += NGT) { const int k = (int)(i >> 9), c = (int)(i & 511), part = c >> 8, n = c & 255; const float ph = (float)((k * n) & 255) * (1.0f / 256.0f);
            const float v = (part ? __builtin_amdgcn_sinf(ph) : __builtin_amdgcn_cosf(ph)) * 0.0625f; ((bf16_t*)(ws + W_D256))[i] = (bf16_t)(cvtpk(v, 0.f) & 0xffffu); }
        for (long i = gt; i < 256 * 128; i += NGT) { const int rr = (int)(i >> 7), c = (int)(i & 127), part = rr >> 7, l = rr & 127; const float ph = (float)((l * c) & 127) * (1.0f / 128.0f);
            const float v = (part ? -__builtin_amdgcn_sinf(ph) : __builtin_amdgcn_cosf(ph)) * 0.08838834764831845f; ((bf16_t*)(ws + W_DC))[i] = (bf16_t)(cvtpk(v, 0.f) & 0xffffu); }
        for (long i = gt; i < 128 * 16; i += NGT) { const int pos = (int)(i >> 4), f = (int)(i & 15); const float inv = 1.0f / powf(10000.0f, (float)f / 16.0f); const float ang = (float)pos * inv;
            ((f32x2*)(ws + WS_TAB16))[i] = (f32x2){cosf(ang), sinf(ang)}; }
        for (long i = gt; i < 128 * 8; i += NGT) { const int pos = (int)(i >> 3), f = (int)(i & 7); const float inv = 1.0f / powf(10000.0f, (float)f / 8.0f); const float ang = (float)pos * inv;
            ((f32x2*)(ws + WS_TAB8))[i] = (f32x2){cosf(ang), sinf(ang)}; }
    }
    {
        LAS float* red = (LAS float*)lds;
        for (int it = blockIdx.x; it < 2 * 96; it += G) {
            __syncthreads();
            const int layer = it / 96, n = (it % 96) * 64 + lane; const float* w = a.in[layer ? I1_WMOD : I0_WMOD]; const float* bm = a.in[layer ? I1_BMOD : I0_BMOD];
            float acc[5] = {0.f, 0.f, 0.f, 0.f, 0.f};
            for (int kk = 0; kk < 128; ++kk) { const int k = wave * 128 + kk; const float wv = w[(size_t)k * 6144 + n];
#pragma unroll
                for (int cls = 0; cls < 5; ++cls) { const float cv = cls < 4 ? a.in[I_C][cls * 1024 + k] : a.in[I_CCTX][k]; const float sl = cv / (1.0f + __expf(-cv)); acc[cls] += sl * wv; } }
#pragma unroll
            for (int cls = 0; cls < 5; ++cls) red[(wave * 5 + cls) * 64 + lane] = acc[cls];
            __syncthreads();
            if (tid < 320) { const int cls = tid >> 6, l = tid & 63; float s = 0.f;
#pragma unroll
                for (int w8 = 0; w8 < 8; ++w8) s += red[(w8 * 5 + cls) * 64 + l];
                const int nn = (it % 96) * 64 + l; ((float*)(ws + WS_MOD))[(size_t)(layer * 5 + cls) * 6144 + nn] = s + bm[nn]; }
        }
        __syncthreads();
    }
}

struct RowPass {
    const float* xl; const float* xc;
    float* ol; float* oc;
    const bf16_t* Y;
    const float* mod;
    int gate_off; const float* lng; const float* lnb;
    const float* mod2; int sc_off, sh_off;
    bf16_t* H;
};
DI void ln_stats(const f32x4 (&v)[4], float& mean, float& rstd) {
    float s = 0.f;
#pragma unroll
    for (int j = 0; j < 4; ++j) s += (v[j][0] + v[j][1]) + (v[j][2] + v[j][3]);
    mean = wave_sum(s) * (1.0f / DM); float q = 0.f;
#pragma unroll
    for (int j = 0; j < 4; ++j) { const f32x4 d = v[j] - mean; q += (d[0] * d[0] + d[1] * d[1]) + (d[2] * d[2] + d[3] * d[3]); }
    rstd = 1.0f / sqrtf(wave_sum(q) * (1.0f / DM) + LN_EPS);
}
DI void row_pass(const RowPass& P, int m, int lane) {
    const int b = m / TPB, j = m % TPB; const bool isctx = j < CTX; const int cls = isctx ? 4 : b;
    const size_t xoff = isctx ? (size_t)(b * CTX + j) * DM : (size_t)(b * SEQ + j - CTX) * DM;
    const float* xs = (isctx ? P.xc : P.xl) + xoff; float* xd = isctx ? P.oc : P.ol;
    f32x4 v[4];
#pragma unroll
    for (int jj = 0; jj < 4; ++jj) v[jj] = *(const f32x4*)(xs + 4 * lane + 256 * jj);
    if (P.Y) {
        const float* gate = P.mod + (size_t)cls * 6144 + P.gate_off;
#pragma unroll
        for (int jj = 0; jj < 4; ++jj) { const int c0 = 4 * lane + 256 * jj; const u32x2 yw = *(const u32x2*)(P.Y + (size_t)m * DM + c0); const f32x4 g = *(const f32x4*)(gate + c0);
            v[jj][0] = DN_ALPHA * v[jj][0] + g[0] * bflo(yw.x); v[jj][1] = DN_ALPHA * v[jj][1] + g[1] * bfhi(yw.x);
            v[jj][2] = DN_ALPHA * v[jj][2] + g[2] * bflo(yw.y); v[jj][3] = DN_ALPHA * v[jj][3] + g[3] * bfhi(yw.y); }
        float mean, rstd; ln_stats(v, mean, rstd);
#pragma unroll
        for (int jj = 0; jj < 4; ++jj) { const int c0 = 4 * lane + 256 * jj; const f32x4 g = *(const f32x4*)(P.lng + c0), bb = *(const f32x4*)(P.lnb + c0); v[jj] = (v[jj] - mean) * rstd * g + bb; }
        if (xd) {
#pragma unroll
            for (int jj = 0; jj < 4; ++jj) *(f32x4*)(xd + xoff + 4 * lane + 256 * jj) = v[jj];
        }
    }
    if (P.H) {
        float mean, rstd; ln_stats(v, mean, rstd);
        const float* sc = P.mod2 + (size_t)cls * 6144 + P.sc_off; const float* sh = P.mod2 + (size_t)cls * 6144 + P.sh_off;
#pragma unroll
        for (int jj = 0; jj < 4; ++jj) { const int c0 = 4 * lane + 256 * jj; const f32x4 s1 = *(const f32x4*)(sc + c0), s0 = *(const f32x4*)(sh + c0);
            const f32x4 hh = (v[jj] - mean) * rstd * (s1 + 1.0f) + s0; u32x2 w; w.x = cvtpk(hh[0], hh[1]); w.y = cvtpk(hh[2], hh[3]);
            *(u32x2*)(P.H + (size_t)m * DM + c0) = w; }
    }
}
DI void p3_row(const Args& a, int m, int lane) {
    unsigned char* ws = a.ws; const bf16_t* U = (const bf16_t*)(ws + WS_R3) + (size_t)m * 1280;
    const u32x2 qw = *(const u32x2*)(U + 512 + 4 * lane), kw = *(const u32x2*)(U + 768 + 4 * lane);
    float q[4] = {bflo(qw.x), bfhi(qw.x), bflo(qw.y), bfhi(qw.y)}, k[4] = {bflo(kw.x), bfhi(kw.x), bflo(kw.y), bfhi(kw.y)};
    const float qs = wave_sum(q[0] * q[0] + q[1] * q[1] + q[2] * q[2] + q[3] * q[3]), ks = wave_sum(k[0] * k[0] + k[1] * k[1] + k[2] * k[2] + k[3] * k[3]);
    const float qr = 1.0f / sqrtf(qs * (1.0f / 256.0f) + RMS_EPS), kr_ = 1.0f / sqrtf(ks * (1.0f / 256.0f) + RMS_EPS);
    const f32x4 qg = *(const f32x4*)(a.in[I0_QN] + 4 * lane), kg = *(const f32x4*)(a.in[I0_KVN] + 4 * lane);
    u32x2 w; w.x = cvtpk(q[0] * qr * qg[0], q[1] * qr * qg[1]); w.y = cvtpk(q[2] * qr * qg[2], q[3] * qr * qg[3]);
    *(u32x2*)((bf16_t*)(ws + WS_CQN) + (size_t)m * 256 + 4 * lane) = w;
    w.x = cvtpk(k[0] * kr_ * kg[0], k[1] * kr_ * kg[1]); w.y = cvtpk(k[2] * kr_ * kg[2], k[3] * kr_ * kg[3]);
    *(u32x2*)((bf16_t*)(ws + WS_CKVN) + (size_t)m * 256 + 4 * lane) = w;
    const int d = lane & 31, t = d >> 3, f = d & 7; const float val = bf2f(U[1024 + d]); const float par = __shfl_xor(val, 8);
    const int j = m % TPB, tt = j - CTX; float outv = val;
    if (tt >= 0) { const int pos = (t < 2) ? (tt >> 6) : (tt & 63); const f32x2 cs = ((const f32x2*)(ws + WS_TAB8))[pos * 8 + f];
        outv = (t & 1) ? (par * cs[1] + val * cs[0]) : (val * cs[0] - par * cs[1]); }
    if (lane < 32) ((bf16_t*)(ws + WS_KR))[(size_t)m * 32 + 16 * (t & 1) + 8 * (t >> 1) + f] = (bf16_t)(cvtpk(outv, 0.f) & 0xffffu);
}
DI void mirror_items(const Args& a, int gw, int NGW, int lane) {
    unsigned char* ws = a.ws; bf16_t* MIX = (bf16_t*)(ws + WS_R3); const bf16_t* At = (const bf16_t*)(ws + WS_R2);
    for (int it = gw; it < NB * 512; it += NGW) { const int b = it >> 9, ch = it & 511; const bf16_t* src = At + (size_t)ch * ROWS + b * TPB + CTX; float s = 0.f;
        for (int i = 0; i < 16; ++i) { const u32x4 w = *(const u32x4*)(src + (i * 64 + lane) * 8);
            s += (bflo(w.x) - bfhi(w.x)) + (bflo(w.y) - bfhi(w.y)) + (bflo(w.z) - bfhi(w.z)) + (bflo(w.w) - bfhi(w.w)); }
        s = wave_sum(s) * 0.011048543456039806f;
        if (lane == 0) MIX[(size_t)(b * TPB + CTX + 4096) * DM + ch] = (bf16_t)(cvtpk(s, 0.f) & 0xffffu); }
    for (int it = gw; it < NB * 4095; it += NGW) { const int b = it / 4095, k = 1 + it % 4095;
        const bf16_t* src = MIX + (size_t)(b * TPB + CTX + k) * DM; bf16_t* dst = MIX + (size_t)(b * TPB + CTX + 8192 - k) * DM;
        const int g = lane >> 4, l0 = 8 * (lane & 15); unsigned short e[8];
#pragma unroll
        for (int i = 0; i < 8; ++i) e[i] = src[g * 128 + ((128 - (l0 + i)) & 127)];
        u32x4 w; w.x = e[0] | ((unsigned)e[1] << 16); w.y = e[2] | ((unsigned)e[3] << 16); w.z = e[4] | ((unsigned)e[5] << 16); w.w = e[6] | ((unsigned)e[7] << 16);
        *(u32x4*)(dst + g * 128 + l0) = w; }
}

DI bool attn_unit_map(int L, int nunits_big, int& bh, int& qb) {
    if (L < nunits_big) { const int i = L >> 8, c = L & 255; bh = 4 * (c & 7) + i; qb = 1 + (c >> 3); return true; }
    bh = L - nunits_big; qb = 0; return bh < 32;
}
DI void attn_mla_unit(const Args& a, LAS unsigned char* lds, int bh, int qb) {
    unsigned char* ws = a.ws; const int tid = otid(), lane = tid & 63, wave = tid >> 6, r = lane & 31, h = lane >> 5;
    const int b = bh >> 3, hd = bh & 7; const int m = b * TPB + qb * 256 + wave * 32 + r;
    const bf16_t* Q = (const bf16_t*)(ws + WS_Q) + (size_t)m * 768;
    const bf16_t* KN = (const bf16_t*)(ws + WS_KN) + (size_t)(b * TPB) * 512 + hd * 64;
    const bf16_t* KR = (const bf16_t*)(ws + WS_KR) + (size_t)(b * TPB) * 32;
    const bf16_t* VT = (const bf16_t*)(ws + WS_VT0) + (size_t)(hd * 64) * ROWS + b * TPB;
    f32x16 o[2]; float l;
    attn_core<64, 32, 64>(o, l, lds, Q + hd * 64, Q + 512 + hd * 32, KN, 512, KR, 32, VT, ROWS, qb == 0 ? CTX / 64 : TPB / 64);
    const float il = 1.0f / l; bf16_t* dst = (bf16_t*)(ws + WS_R3) + (size_t)m * DM + 512 + hd * 64;
#pragma unroll
    for (int blk = 0; blk < 2; ++blk)
#pragma unroll
        for (int g = 0; g < 4; ++g) { u32x2 w; w.x = cvtpk(o[blk][4 * g] * il, o[blk][4 * g + 1] * il); w.y = cvtpk(o[blk][4 * g + 2] * il, o[blk][4 * g + 3] * il);
            *(u32x2*)(dst + 32 * blk + 8 * g + 4 * h) = w; }
}
DI void attn_diff_unit(const Args& a, LAS unsigned char* lds, int bh, int qb, float lam) {
    unsigned char* ws = a.ws; const int tid = otid(), lane = tid & 63, wave = tid >> 6, r = lane & 31, h = lane >> 5;
    const int b = bh >> 3, hd = bh & 7; const int m = b * TPB + qb * 256 + wave * 32 + r;
    const bf16_t* QK = (const bf16_t*)(ws + WS_R3);
    const bf16_t* VT = (const bf16_t*)(ws + WS_VT1) + (size_t)(hd * 128) * ROWS + b * TPB;
    LAS unsigned* stash = (LAS unsigned*)(lds + 55296) + wave * 2048 + lane;
    f32x16 o[4]; float l;
    {
        const bf16_t* q = QK + (size_t)m * 2048 + (hd * 2) * 64; const bf16_t* k = QK + (size_t)(b * TPB) * 2048 + 1024 + (hd * 2) * 64;
        attn_core<64, 0, 128>(o, l, lds, q, q, k, 2048, k, 2048, VT, ROWS, TPB / 64);
        const float il = 1.0f / l;
#pragma unroll
        for (int blk = 0; blk < 4; ++blk)
#pragma unroll
            for (int i = 0; i < 8; ++i) stash[(blk * 8 + i) * 64] = cvtpk(o[blk][2 * i] * il, o[blk][2 * i + 1] * il);
    }
    {
        const bf16_t* q = QK + (size_t)m * 2048 + (hd * 2 + 1) * 64; const bf16_t* k = QK + (size_t)(b * TPB) * 2048 + 1024 + (hd * 2 + 1) * 64;
        attn_core<64, 0, 128>(o, l, lds, q, q, k, 2048, k, 2048, VT, ROWS, TPB / 64);
    }
    const float il = lam / l; float ss = 0.f;
#pragma unroll
    for (int blk = 0; blk < 4; ++blk)
#pragma unroll
        for (int i = 0; i < 8; ++i) { const unsigned aw = stash[(blk * 8 + i) * 64]; const float x0 = bflo(aw) - o[blk][2 * i] * il, x1 = bfhi(aw) - o[blk][2 * i + 1] * il; o[blk][2 * i] = x0; o[blk][2 * i + 1] = x1; ss += x0 * x0 + x1 * x1; }
    ss += __shfl_xor(ss, 32);
    const float rn = (1.0f - LAMBDA_INIT) / sqrtf(ss * (1.0f / 128.0f) + RMS_EPS);
    const float* sub = a.in[I1_SUBLN]; bf16_t* dst = (bf16_t*)(ws + WS_R2) + (size_t)m * DM + hd * 128;
#pragma unroll
    for (int blk = 0; blk < 4; ++blk)
#pragma unroll
        for (int g = 0; g < 4; ++g) { const int d0 = 32 * blk + 8 * g + 4 * h; const f32x4 sg = *(const f32x4*)(sub + d0);
            u32x2 w; w.x = cvtpk(o[blk][4 * g] * rn * sg[0], o[blk][4 * g + 1] * rn * sg[1]); w.y = cvtpk(o[blk][4 * g + 2] * rn * sg[2], o[blk][4 * g + 3] * rn * sg[3]);
            *(u32x2*)(dst + d0) = w; }
}

constexpr int NPHASES = 18;
constexpr int LDS_BYTES = 147456;
struct GOp { int kind; pg8::Gemm g; bf16_t* O; int ldc, o_bs, ai_extra; float scale; int q_tiles, rope_from; };

DI bool get_gemm(int ph, int sub, const Args& a, GOp& op) {
    unsigned char* ws = a.ws;
    bf16_t* R2 = (bf16_t*)(ws + WS_R2); bf16_t* R3 = (bf16_t*)(ws + WS_R3);
    op.kind = 0; op.o_bs = 0; op.ai_extra = 0; op.scale = 1.0f; op.q_tiles = 0; op.rope_from = 0;
    pg8::Gemm& g = op.g; g.nB = 1; g.a_bs = 0; g.b_bs = 0; g.rot = 0; g.a_seg = 0; g.b_seg = 0;
#define SETK(k_) do { g.K = (k_); g.kseg = (k_) / 64; g.a_seg = (k_); g.b_seg = (k_); } while (0)
    switch (ph * 8 + sub) {
    case 2 * 8 + 0:
        g.A = R2; g.a_rs = 1024; g.nM = NRT; g.Bt = (const bf16_t*)(ws + W_IN0); g.b_rs = 1024; g.nN = 5; SETK(1024); op.O = R3; op.ldc = 1280; return true;
    case 3 * 8 + 0:
        g.A = (const bf16_t*)(ws + W_DC); g.a_rs = 128; g.nM = 1; g.Bt = R3; g.b_rs = 1280; g.nN = NRT; g.nB = 4; g.b_bs = 128; SETK(128);
        op.O = R2; op.ldc = ROWS; op.o_bs = 128 * ROWS; op.ai_extra = 384 * ROWS; return true;
    case 4 * 8 + 0:
        op.kind = 1; g.A = (const bf16_t*)(ws + WS_CQN); g.a_rs = 256; g.nM = NRT; g.Bt = (const bf16_t*)(ws + W_UQ); g.b_rs = 256; g.nN = 3; SETK(256);
        op.O = (bf16_t*)(ws + WS_Q); op.ldc = 768; op.scale = MLA_QSCALE; op.q_tiles = 3; op.rope_from = 2; return true;
    case 4 * 8 + 1:
        g.A = (const bf16_t*)(ws + WS_CKVN); g.a_rs = 256; g.nM = NRT; g.Bt = (const bf16_t*)(ws + W_KN); g.b_rs = 256; g.nN = 2; SETK(256); g.rot = 140;
        op.O = (bf16_t*)(ws + WS_KN); op.ldc = 512; return true;
    case 4 * 8 + 2:
        g.A = (const bf16_t*)(ws + W_V0); g.a_rs = 256; g.nM = 2; g.Bt = (const bf16_t*)(ws + WS_CKVN); g.b_rs = 256; g.nN = NRT; SETK(256); g.rot = 148;
        op.O = (bf16_t*)(ws + WS_VT0); op.ldc = ROWS; return true;
    case 4 * 8 + 3:
        g.A = (const bf16_t*)(ws + WS_DN); g.a_rs = 16384; g.nM = 16; g.Bt = R2 + CTX; g.b_rs = ROWS; g.nN = 2; g.nB = 4; g.b_bs = TPB; g.K = 16384; g.kseg = 128; g.a_seg = 8192; g.b_seg = 512 * ROWS; g.rot = 156;
        op.O = R3 + (size_t)CTX * DM; op.ldc = DM; op.o_bs = TPB * DM; return true;
    case 4 * 8 + 4:
        g.A = (const bf16_t*)(ws + W_D256); g.a_rs = 512; g.nM = 1; g.Bt = R2; g.b_rs = ROWS; g.nN = 2; g.nB = 4; g.b_bs = TPB; g.K = 512; g.kseg = 4; g.a_seg = 256; g.b_seg = 512 * ROWS; g.rot = 28;
        op.O = R3; op.ldc = DM; op.o_bs = TPB * DM; return true;
    case 6 * 8 + 0:
        g.A = R3; g.a_rs = 1024; g.nM = NRT; g.Bt = (const bf16_t*)(ws + W_OUT0); g.b_rs = 1024; g.nN = 4; SETK(1024); op.O = (bf16_t*)(ws + WS_Y0); op.ldc = DM; return true;
    case 8 * 8 + 0: case 15 * 8 + 0:
        op.kind = 3; g.A = R2; g.a_rs = 1024; g.nM = NRT; g.Bt = (const bf16_t*)(ws + (ph == 8 ? W_GU0 : W_GU1)); g.b_rs = 1024; g.nN = 22; SETK(1024); op.O = R3; op.ldc = FF; return true;
    case 9 * 8 + 0: case 16 * 8 + 0:
        g.A = R3; g.a_rs = FF; g.nM = NRT; g.Bt = (const bf16_t*)(ws + (ph == 9 ? W_D0 : W_D1)); g.b_rs = FF; g.nN = 4; SETK(FF); op.O = R2; op.ldc = DM; return true;
    case 11 * 8 + 0:
        op.kind = 2; g.A = R2; g.a_rs = 1024; g.nM = NRT; g.Bt = (const bf16_t*)(ws + W_QK1); g.b_rs = 1024; g.nN = 8; SETK(1024);
        op.O = R3; op.ldc = 2048; op.scale = DIFF_QSCALE; op.q_tiles = 4; op.rope_from = 0; return true;
    case 11 * 8 + 1:
        g.A = (const bf16_t*)(ws + W_V1); g.a_rs = 1024; g.nM = 4; g.Bt = R2; g.b_rs = 1024; g.nN = NRT; SETK(1024); g.rot = 32;
        op.O = (bf16_t*)(ws + WS_VT1); op.ldc = ROWS; return true;
    case 13 * 8 + 0:
        g.A = R2; g.a_rs = 1024; g.nM = NRT; g.Bt = (const bf16_t*)(ws + W_OUT1); g.b_rs = 1024; g.nN = 4; SETK(1024); op.O = R3; op.ldc = DM; return true;
    default: return false;
    }
#undef SETK
}

DI bool get_rowpass(int ph, const Args& a, RowPass& P) {
    unsigned char* ws = a.ws; const float* MOD0 = (const float*)(ws + WS_MOD); const float* MOD1 = MOD0 + 5 * 6144;
    float* XC = (float*)(ws + WS_XC); bf16_t* R2 = (bf16_t*)(ws + WS_R2);
    switch (ph) {
    case 1:  P = RowPass{a.in[I_X], a.in[I_CTX], nullptr, nullptr, nullptr, MOD0, 0, nullptr, nullptr, MOD0, 1024, 0, R2}; return true;
    case 7:  P = RowPass{a.in[I_X], a.in[I_CTX], a.out, XC, (const bf16_t*)(ws + WS_Y0), MOD0, 2048, a.in[I0_LN1G], a.in[I0_LN1B], MOD0, 4096, 3072, R2}; return true;
    case 10: P = RowPass{a.out, XC, a.out, XC, R2, MOD0, 5120, a.in[I0_LN2G], a.in[I0_LN2B], MOD1, 1024, 0, R2}; return true;
    case 14: P = RowPass{a.out, XC, a.out, XC, (const bf16_t*)(ws + WS_R3), MOD1, 2048, a.in[I1_LN1G], a.in[I1_LN1B], MOD1, 4096, 3072, R2}; return true;
    case 17: P = RowPass{a.out, XC, a.out, XC, R2, MOD1, 5120, a.in[I1_LN2G], a.in[I1_LN2B], MOD1, 0, 0, nullptr}; return true;
    default: return false;
    }
}

__global__ void __launch_bounds__(512, 2) fwd_kernel(Args a) {
    extern __shared__ __attribute__((aligned(16))) unsigned char lds_raw[];
    LAS unsigned char* lds = (LAS unsigned char*)lds_raw;
    const int G = gridDim.x;
    for (int ph = a.ph_lo; ph < a.ph_hi; ++ph) {
        const int tid = otid(), lane = tid & 63, wave = __builtin_amdgcn_readfirstlane(tid >> 6);
        const int gw = blockIdx.x * 8 + wave, NGW = G * 8;
#ifndef NO_PRO
        if (ph == 0) prologue(a, lds);
#endif
        RowPass P;
        if (get_rowpass(ph, a, P)) { for (int m = gw; m < ROWS; m += NGW) row_pass(P, m, lane); }
        if (ph == 3) { for (int m = gw; m < ROWS; m += NGW) p3_row(a, m, lane); }
#ifndef NO_MLA
        if (ph == 5) {
            mirror_items(a, gw, NGW, lane);
            for (int L = blockIdx.x; ; L += G) { int bh, qb; if (!attn_unit_map(L, 1024, bh, qb)) break; attn_mla_unit(a, lds, bh, qb); }
        }
#endif
#ifndef NO_DIFF
        if (ph == 12) {
            const float p1 = wave_sum(a.in[I1_LQ1][lane] * a.in[I1_LK1][lane]), p2 = wave_sum(a.in[I1_LQ2][lane] * a.in[I1_LK2][lane]);
            const float lam = expf(p1) - expf(p2) + LAMBDA_INIT;
            for (int L = blockIdx.x; L < 1024; L += G) { int bh, qb; attn_unit_map(L, 1024, bh, qb); attn_diff_unit(a, lds, bh, qb, lam); }
        }
#endif
#ifndef NO_GEMM
        for (int sub = 0; sub < 8; ++sub) {
            GOp op; if (!get_gemm(ph, sub, a, op)) break;
            pg8::StaticOrder S; S.init(op.g.nM, op.g.nN, op.g.nB, G, (int)blockIdx.x, op.g.rot);
            if (op.kind == 0) { pg8::EpiStore E{op.O, op.ldc, op.o_bs, op.ai_extra, op.scale}; pg8::gemm_phase(lds, op.g, S, E); }
            else if (op.kind == 1) { pg8::EpiRope<8> E{op.O, op.ldc, op.scale, op.q_tiles, op.rope_from, (const f32x2*)(a.ws + WS_TAB8)}; pg8::gemm_phase(lds, op.g, S, E); }
            else if (op.kind == 2) { pg8::EpiRope<16> E{op.O, op.ldc, op.scale, op.q_tiles, op.rope_from, (const f32x2*)(a.ws + WS_TAB16)}; pg8::gemm_phase(lds, op.g, S, E); }
            else { pg8::EpiSwiglu E{op.O, op.ldc}; pg8::gemm_phase(lds, op.g, S, E); }
        }
#endif
        if (ph + 1 < a.ph_hi) { __threadfence(); cg::this_grid().sync(); }
    }
}

extern "C" void kernel_launch(void* const* d_in, const int* in_sizes, int n_in, void* d_out, int out_size, void* d_ws, size_t ws_size, hipStream_t stream) {
    static int grid = 0;
    if (grid == 0) {
        if (n_in != 35 || ws_size < WS_END) { fprintf(stderr, "kernel_launch: unexpected n_in %d / ws %zu (need %zu)\n", n_in, ws_size, (size_t)WS_END); grid = -1; return; }
        int dev = 0, cus = 0, per_cu = 0;
        hipGetDevice(&dev); hipDeviceGetAttribute(&cus, hipDeviceAttributeMultiprocessorCount, dev);
        hipFuncSetAttribute((const void*)fwd_kernel, hipFuncAttributeMaxDynamicSharedMemorySize, LDS_BYTES);
        hipOccupancyMaxActiveBlocksPerMultiprocessor(&per_cu, (const void*)fwd_kernel, 512, LDS_BYTES);
        if (per_cu < 1) { fprintf(stderr, "kernel_launch: occupancy query says %d blocks/CU\n", per_cu); per_cu = 1; }
        (void)hipGetLastError();
        grid = cus * 1;
    }
    if (grid < 0) return;
    Args a{};
    for (int i = 0; i < 35; ++i) a.in[i] = (const float*)d_in[i];
    a.out = (float*)d_out; a.ws = (unsigned char*)d_ws;
#if MK_MULTI
    for (int ph = 0; ph < NPHASES; ++ph) { a.ph_lo = ph; a.ph_hi = ph + 1; hipLaunchKernelGGL(fwd_kernel, dim3(grid), dim3(512), LDS_BYTES, stream, a); }
#else
    a.ph_lo = 0; a.ph_hi = NPHASES;
    void* args[] = {&a};
    hipError_t e = hipLaunchCooperativeKernel((const void*)fwd_kernel, dim3(grid), dim3(512), args, LDS_BYTES, stream);
    if (e != hipSuccess) fprintf(stderr, "cooperative launch failed: %s (grid %d)\n", hipGetErrorString(e), grid);
#endif
}
```

```cpp
#include <hip/hip_runtime.h>
#include <hip/hip_cooperative_groups.h>
#include <cstdio>
#include <cstdint>
namespace cg = cooperative_groups;

#ifndef MK_MULTI
#define MK_MULTI 0
#endif

#define DI __device__ __forceinline__
#define LAS __attribute__((address_space(3)))
typedef unsigned short bf16_t;
typedef short bf16x8 __attribute__((ext_vector_type(8)));
typedef float f32x4 __attribute__((ext_vector_type(4)));
typedef float f32x2 __attribute__((ext_vector_type(2)));
typedef float f32x16 __attribute__((ext_vector_type(16)));
typedef unsigned u32x4 __attribute__((ext_vector_type(4)));
typedef unsigned u32x2 __attribute__((ext_vector_type(2)));
typedef __bf16 bf16x2_t __attribute__((ext_vector_type(2)));

constexpr int DM = 1024, NB = 4, SEQ = 8192, CTX = 256, TPB = SEQ + CTX  , ROWS = NB * TPB  , FF = 2816;
constexpr int NRT = ROWS / 256;
constexpr float LN_EPS = 1e-6f, RMS_EPS = 1e-6f;
constexpr float DN_ALPHA = 1.41421356237f;
constexpr float LOG2E = 1.4426950408889634f;
constexpr float MLA_QSCALE = 0.10206207261596577f * LOG2E;
constexpr float DIFF_QSCALE = 0.125f * LOG2E;
constexpr float LAMBDA_INIT = 0.35550906f;

constexpr size_t MiB = 1u << 20;
constexpr size_t WS_MOD = 0;
constexpr size_t WS_TAB16 = 256 * 1024;
constexpr size_t WS_TAB8 = WS_TAB16 + 16384;
constexpr size_t WS_BAR = 512 * 1024;
constexpr size_t WS_XC = 1 * MiB;
constexpr size_t WS_W = 5 * MiB;
constexpr size_t W_IN0 = WS_W;
constexpr size_t W_UQ = W_IN0 + 1280 * 1024 * 2;
constexpr size_t W_KN = W_UQ + 768 * 256 * 2;
constexpr size_t W_V0 = W_KN + 512 * 256 * 2;
constexpr size_t W_OUT0 = W_V0 + 512 * 256 * 2;
constexpr size_t W_GU0 = W_OUT0 + 1024 * 1024 * 2;
constexpr size_t W_D0 = W_GU0 + 5632 * 1024 * 2;
constexpr size_t W_QK1 = W_D0 + 1024 * 2816 * 2;
constexpr size_t W_V1 = W_QK1 + 2048 * 1024 * 2;
constexpr size_t W_OUT1 = W_V1 + 1024 * 1024 * 2;
constexpr size_t W_GU1 = W_OUT1 + 1024 * 1024 * 2;
constexpr size_t W_D1 = W_GU1 + 5632 * 1024 * 2;
constexpr size_t W_DC = W_D1 + 1024 * 2816 * 2;
constexpr size_t W_D256 = W_DC + 256 * 128 * 2;
constexpr size_t W_END = W_D256 + 256 * 512 * 2;
static_assert(W_END <= 56 * MiB, "weights region");
constexpr size_t WS_DN = 56 * MiB;
constexpr size_t WS_R2 = 184 * MiB;
constexpr size_t WS_R3 = 250 * MiB;
constexpr size_t WS_R4 = WS_R3 + (size_t)ROWS * 1280 * 2;
constexpr size_t WS_CQN = WS_R4, WS_CKVN = WS_R4 + (size_t)ROWS * 256 * 2;
constexpr size_t WS_R5 = WS_R4 + (size_t)ROWS * 512 * 2;
constexpr size_t WS_Q = WS_R5;
constexpr size_t WS_KN = WS_Q + (size_t)ROWS * 768 * 2;
constexpr size_t WS_KR = WS_KN + (size_t)ROWS * 512 * 2;
constexpr size_t WS_VT0 = WS_KR + (size_t)ROWS * 32 * 2;
constexpr size_t WS_END = WS_VT0 + (size_t)512 * ROWS * 2;
constexpr size_t WS_Y0 = WS_R5;
constexpr size_t WS_VT1 = WS_R3 + (size_t)ROWS * 2048 * 2;
static_assert(WS_END <= 512 * MiB, "workspace");
static_assert(WS_VT1 + (size_t)1024 * ROWS * 2 <= WS_END, "vt1");
static_assert(WS_R3 + (size_t)ROWS * FF * 2 <= WS_END, "hid");

DI int otid() { int t = threadIdx.x; asm volatile("" : "+v"(t)); return t; }
DI float wave_sum(float v) {
#pragma unroll
    for (int o = 1; o < 64; o <<= 1) v += __shfl_xor(v, o);
    return v;
}
DI unsigned cvtpk(float lo, float hi) { f32x2 v = {lo, hi}; bf16x2_t b = __builtin_convertvector(v, bf16x2_t); return __builtin_bit_cast(unsigned, b); }
DI float bf2f(unsigned short b) { return __uint_as_float(((unsigned)b) << 16); }
DI float bflo(unsigned w) { return __uint_as_float(w << 16); }
DI float bfhi(unsigned w) { return __uint_as_float(w & 0xffff0000u); }

namespace pg8 {
constexpr int BM = 256, BK = 64, HALF = 128, HTB = HALF * BK * 2, STAGE_BYTES = 8 * HTB, NXCD = 8, WGM = 8;
__host__ __device__ __forceinline__ int lds_byte(int r, int c) { const int st = (r >> 4) * 2 + (c >> 5), rr = r & 15, cc = c & 31, ob = rr * 64 + cc * 2; return st * 1024 + (ob ^ (((ob >> 9) & 1) << 5)); }
__host__ __device__ __forceinline__ void stage_rc(int b, int& R, int& C) { const int st = b / 1024, sb = b % 1024, swz = sb ^ (((sb >> 9) & 1) << 5); R = (st >> 1) * 16 + swz / 64; C = (st & 1) * 32 + (swz % 64) / 2; }
__host__ __device__ __forceinline__ int perm32(int rho) { const int n = rho >> 4, i = rho & 15; return 8 * (i >> 2) + 4 * n + (i & 3); }

struct Unit { int pm, pn, pb; };
struct Gemm {
    const bf16_t* A; const bf16_t* Bt; int nM, nN, nB, K, kseg;
    int a_rs, b_rs, a_seg, b_seg, a_bs, b_bs;
    int rot;
};
struct StaticOrder {
    int nM, nN, nwg, tot, G, c;
    DI void init(int nM_, int nN_, int nB_, int G_, int c_, int rot) { nM = nM_; nN = nN_; nwg = nM * nN; tot = nwg * nB_; G = G_; c = (c_ + G_ - (rot % G_)) % G_; }
    DI bool next(int i, Unit& u) const {
        const long L = (long)i * G + c; if (L >= tot) return false;
        u.pb = (int)(L / nwg); int wgid = (int)(L % nwg);
        { const int q = nwg / NXCD, r = nwg % NXCD, xcd = wgid % NXCD, off = wgid / NXCD; wgid = (xcd < r ? xcd * (q + 1) : r * (q + 1) + (xcd - r) * q) + off; }
        const int nig = WGM * nN, gid = wgid / nig, fm = gid * WGM, gsz = (nM - fm) < WGM ? (nM - fm) : WGM;
        u.pm = fm + ((wgid % nig) % gsz); u.pn = (wgid % nig) / gsz; return true;
    }
};

struct EpiStore {
    static constexpr bool PERM = true;
    bf16_t* O; int ldc, o_bs, ai_extra; float scale;
    DI void operator()(const f32x4 (&acc)[2][2][4][2], const Unit& u, int wr, int wc, int fr, int fq) const {
        const int row0 = u.pm * BM + wr * 64 + fr, col0 = u.pn * BM + wc * 32 + 8 * fq;
        bf16_t* base = O + (size_t)u.pb * o_bs;
#pragma unroll
        for (int ai = 0; ai < 2; ++ai)
#pragma unroll
            for (int m = 0; m < 4; ++m) { bf16_t* rowp = base + (size_t)(row0 + ai * HALF + m * 16) * ldc + (size_t)ai * ai_extra + col0;
#pragma unroll
                for (int bj = 0; bj < 2; ++bj) { const f32x4 v0 = acc[ai][bj][m][0] * scale, v1 = acc[ai][bj][m][1] * scale;
                    u32x4 w; w.x = cvtpk(v0[0], v0[1]); w.y = cvtpk(v0[2], v0[3]); w.z = cvtpk(v1[0], v1[1]); w.w = cvtpk(v1[2], v1[3]);
                    *(u32x4*)(rowp + bj * HALF) = w; } }
    }
};
struct EpiSwiglu {
    static constexpr bool PERM = true;
    bf16_t* O; int ldc;
    DI void operator()(const f32x4 (&acc)[2][2][4][2], const Unit& u, int wr, int wc, int fr, int fq) const {
        const int row0 = u.pm * BM + wr * 64 + fr, col0 = u.pn * HALF + wc * 32 + 8 * fq;
#pragma unroll
        for (int ai = 0; ai < 2; ++ai)
#pragma unroll
            for (int m = 0; m < 4; ++m) { bf16_t* rowp = O + (size_t)(row0 + ai * HALF + m * 16) * ldc + col0; float h[8];
#pragma unroll
                for (int n = 0; n < 2; ++n)
#pragma unroll
                    for (int i = 0; i < 4; ++i) { const float g = acc[ai][0][m][n][i], up = acc[ai][1][m][n][i];
                        h[n * 4 + i] = g * __builtin_amdgcn_rcpf(1.0f + __builtin_amdgcn_exp2f(-g * LOG2E)) * up; }
                u32x4 w; w.x = cvtpk(h[0], h[1]); w.y = cvtpk(h[2], h[3]); w.z = cvtpk(h[4], h[5]); w.w = cvtpk(h[6], h[7]);
                *(u32x4*)rowp = w; }
    }
};
template <int MODE> struct EpiRope {
    static constexpr bool PERM = false;
    bf16_t* O; int ldc; float qscale; int q_tiles, rope_from; const f32x2* tab;
    DI void operator()(const f32x4 (&acc)[2][2][4][2], const Unit& u, int wr, int wc, int fr, int fq) const {
        const float sc = u.pn < q_tiles ? qscale : 1.0f; const bool rope_tile = u.pn >= rope_from;
        const int col0 = u.pn * BM + wc * 32 + 4 * fq;
#pragma unroll
        for (int ai = 0; ai < 2; ++ai)
#pragma unroll
            for (int m = 0; m < 4; ++m) {
                const int row = u.pm * BM + ai * HALF + wr * 64 + m * 16 + fr; const int j = row % TPB; const int t = j - CTX;
                f32x4 cs0 = {1.f, 0.f, 1.f, 0.f}, cs1 = {1.f, 0.f, 1.f, 0.f};
                if (rope_tile && t >= 0) {
                    int pos, f0;
                    if (MODE == 16) { pos = (wc & 1) ? (t & 63) : (t >> 6); f0 = 4 * fq; } else { pos = (fq >> 1) ? (t & 63) : (t >> 6); f0 = 4 * (fq & 1); }
                    const f32x4* tp = (const f32x4*)(tab + pos * MODE + f0); cs0 = tp[0]; cs1 = tp[1];
                }
                const float c[4] = {cs0[0], cs0[2], cs1[0], cs1[2]}, s[4] = {cs0[1], cs0[3], cs1[1], cs1[3]};
                bf16_t* rowp = O + (size_t)row * ldc + col0;
#pragma unroll
                for (int bj = 0; bj < 2; ++bj) { const f32x4 x1 = acc[ai][bj][m][0] * sc, x2 = acc[ai][bj][m][1] * sc; float o1[4], o2[4];
#pragma unroll
                    for (int i = 0; i < 4; ++i) { o1[i] = x1[i] * c[i] - x2[i] * s[i]; o2[i] = x1[i] * s[i] + x2[i] * c[i]; }
                    u32x2 w1, w2; w1.x = cvtpk(o1[0], o1[1]); w1.y = cvtpk(o1[2], o1[3]); w2.x = cvtpk(o2[0], o2[1]); w2.y = cvtpk(o2[2], o2[3]);
                    *(u32x2*)(rowp + bj * HALF) = w1; *(u32x2*)(rowp + bj * HALF + 16) = w2; }
            }
    }
};

template <class Epi>
DI void gemm_phase(LAS unsigned char* lds, const Gemm g, const StaticOrder& S, const Epi& E) {
    const int tid = otid(), wid = __builtin_amdgcn_readfirstlane(tid >> 6), lane = tid & 63, wr = wid >> 2, wc = wid & 3, fr = lane & 15, fq = lane >> 4;
    const int nt = g.K / BK, kseg = g.kseg;
    unsigned voffA[2], voffB[2];
#pragma unroll
    for (int i = 0; i < 2; ++i) { int R, C; stage_rc(tid * 16 + i * 8192, R, C); const int Rb = Epi::PERM ? ((R & ~31) + perm32(R & 31)) : R;
        voffA[i] = (unsigned)(R * g.a_rs + C) * 2u; voffB[i] = (unsigned)(Rb * g.b_rs + C) * 2u; }
    const int kstep = BK * 2;
    const unsigned hstepA = (unsigned)HALF * g.a_rs * 2, hstepB = (unsigned)HALF * g.b_rs * 2;
    const unsigned tstepA = 2 * hstepA, tstepB = 2 * hstepB;
    const int segA = (g.a_seg - kseg * BK) * 2, segB = (g.b_seg - kseg * BK) * 2;
#define OFFA(t) ((t) * kstep + ((t) >= kseg ? segA : 0))
#define OFFB(t) ((t) * kstep + ((t) >= kseg ? segB : 0))
    const unsigned ldsw = (unsigned)wid * 1024u;
    const int aoff = lds_byte(wr * 64 + fr, fq * 8), boff = lds_byte(wc * 32 + fr, fq * 8);
#define PG8_SA(b, h) (((b) * 2 + (h)) * HTB)
#define PG8_SB(b, h) ((4 + (b) * 2 + (h)) * HTB)
#define PG8_STAGE(bufoff, gbase, voff) do { _Pragma("unroll") for (int _i = 0; _i < 2; ++_i) \
        __builtin_amdgcn_global_load_lds((const unsigned*)((const char*)(gbase) + (voff)[_i]), (LAS unsigned*)(lds + (bufoff) + ldsw + _i * 8192), 16, 0, 0); } while (0)
#define PG8_LDA(dst, b, h) do { _Pragma("unroll") for (int m = 0; m < 4; ++m) _Pragma("unroll") for (int k = 0; k < 2; ++k) dst[m][k] = *(const LAS bf16x8*)(lds + PG8_SA(b, h) + aoff + m * 2048 + k * 1024); } while (0)
#define PG8_LDB(dst, b, h) do { _Pragma("unroll") for (int n = 0; n < 2; ++n) _Pragma("unroll") for (int k = 0; k < 2; ++k) dst[n][k] = *(const LAS bf16x8*)(lds + PG8_SB(b, h) + boff + n * 2048 + k * 1024); } while (0)
#define PG8_MMA(ai, bj, At, Bt) do { __builtin_amdgcn_s_setprio(1); _Pragma("unroll") for (int m = 0; m < 4; ++m) _Pragma("unroll") for (int n = 0; n < 2; ++n) _Pragma("unroll") for (int k = 0; k < 2; ++k) \
        acc[ai][bj][m][n] = __builtin_amdgcn_mfma_f32_16x16x32_bf16(Bt[n][k], At[m][k], acc[ai][bj][m][n], 0, 0, 0); __builtin_amdgcn_s_setprio(0); } while (0)
#define PG8_WAIT_V(n) asm volatile("s_waitcnt vmcnt(" #n ")" ::: "memory")
#define PG8_WAIT_L(n) asm volatile("s_waitcnt lgkmcnt(" #n ")" ::: "memory")
#define PG8_BAR __builtin_amdgcn_s_barrier()
#define PG8_SCHED __builtin_amdgcn_sched_barrier(0)
    Unit cur, nxt; int ui = 0;
    if (!S.next(0, cur)) return;
    f32x4 acc[2][2][4][2];
#pragma unroll
    for (int a = 0; a < 2; ++a)
#pragma unroll
        for (int b = 0; b < 2; ++b)
#pragma unroll
            for (int m = 0; m < 4; ++m)
#pragma unroll
                for (int n = 0; n < 2; ++n) acc[a][b][m][n] = (f32x4){0.f, 0.f, 0.f, 0.f};
    bf16x8 At[4][2], B0[2][2], B1[2][2];
    const char* cA = (const char*)g.A + ((size_t)cur.pb * g.a_bs) * 2 + (size_t)cur.pm * tstepA;
    const char* cB = (const char*)g.Bt + ((size_t)cur.pb * g.b_bs) * 2 + (size_t)cur.pn * tstepB;
    {
        PG8_STAGE(PG8_SB(0, 0), cB, voffB); PG8_STAGE(PG8_SB(0, 1), cB + hstepB, voffB); PG8_STAGE(PG8_SA(0, 0), cA, voffA); PG8_STAGE(PG8_SA(0, 1), cA + hstepA, voffA);
        if (wr == 1) PG8_BAR;
        PG8_WAIT_V(2); PG8_BAR;
        PG8_STAGE(PG8_SB(1, 0), cB + OFFB(1), voffB); PG8_STAGE(PG8_SA(1, 0), cA + OFFA(1), voffA); PG8_STAGE(PG8_SB(1, 1), cB + hstepB + OFFB(1), voffB);
        PG8_WAIT_V(6); PG8_BAR;
    }
    for (;;) {
        const bool has_next = S.next(ui + 1, nxt);
        const char* nA = has_next ? (const char*)g.A + ((size_t)nxt.pb * g.a_bs) * 2 + (size_t)nxt.pm * tstepA : cA;
        const char* nB = has_next ? (const char*)g.Bt + ((size_t)nxt.pb * g.b_bs) * 2 + (size_t)nxt.pn * tstepB : cB;
        for (int t = 0; t < nt; t += 2) {
            const bool last = (t == nt - 2);
            const char* a1 = cA + OFFA(t + 1);
            const char* a2 = last ? nA : cA + OFFA(t + 2); const char* b2 = last ? nB : cB + OFFB(t + 2);
            const char* a3 = last ? nA + OFFA(1) : cA + OFFA(t + 3); const char* b3 = last ? nB + OFFB(1) : cB + OFFB(t + 3);
            PG8_LDB(B0, 0, 0); PG8_LDB(B1, 0, 1); PG8_SCHED; PG8_LDA(At, 0, 0); PG8_STAGE(PG8_SA(1, 1), a1 + hstepA, voffA);
            PG8_WAIT_V(8); PG8_WAIT_L(0); PG8_BAR; PG8_MMA(0, 0, At, B0); PG8_MMA(0, 1, At, B1); PG8_BAR; PG8_SCHED;
            PG8_LDA(At, 0, 1); PG8_STAGE(PG8_SB(0, 0), b2, voffB); PG8_STAGE(PG8_SB(0, 1), b2 + hstepB, voffB); PG8_STAGE(PG8_SA(0, 0), a2, voffA);
            PG8_WAIT_V(8); PG8_WAIT_L(0); PG8_BAR; PG8_MMA(1, 0, At, B0); PG8_MMA(1, 1, At, B1); PG8_BAR; PG8_SCHED;
            PG8_LDB(B0, 1, 0); PG8_LDB(B1, 1, 1); PG8_SCHED; PG8_LDA(At, 1, 0); PG8_STAGE(PG8_SA(0, 1), a2 + hstepA, voffA);
            PG8_WAIT_V(8); PG8_WAIT_L(0); PG8_BAR; PG8_MMA(0, 0, At, B0); PG8_MMA(0, 1, At, B1); PG8_BAR; PG8_SCHED;
            PG8_LDA(At, 1, 1); PG8_STAGE(PG8_SB(1, 0), b3, voffB); PG8_STAGE(PG8_SB(1, 1), b3 + hstepB, voffB); PG8_STAGE(PG8_SA(1, 0), a3, voffA);
            PG8_WAIT_V(8); PG8_WAIT_L(0); PG8_BAR; PG8_MMA(1, 0, At, B0); PG8_MMA(1, 1, At, B1); PG8_BAR; PG8_SCHED;
        }
        if (wr == 0) PG8_BAR;
        E(acc, cur, wr, wc, fr, fq);
        if (!has_next) break;
#pragma unroll
        for (int a = 0; a < 2; ++a)
#pragma unroll
            for (int b = 0; b < 2; ++b)
#pragma unroll
                for (int m = 0; m < 4; ++m)
#pragma unroll
                    for (int n = 0; n < 2; ++n) acc[a][b][m][n] = (f32x4){0.f, 0.f, 0.f, 0.f};
        cur = nxt; cA = nA; cB = nB; ++ui;
        if (wr == 1) PG8_BAR;
    }
    PG8_WAIT_V(0);
    PG8_BAR;
#undef OFFA
#undef OFFB
#undef PG8_SA
#undef PG8_SB
#undef PG8_STAGE
#undef PG8_LDA
#undef PG8_LDB
#undef PG8_MMA
#undef PG8_WAIT_V
#undef PG8_WAIT_L
#undef PG8_BAR
#undef PG8_SCHED
}
}

#define MFMA32(a, b, c) __builtin_amdgcn_mfma_f32_32x32x16_bf16((a), (b), (c), 0, 0, 0)
template <int D1, int D2, int DV>
DI void attn_core(f32x16 (&o)[DV / 32], float& l_out, LAS unsigned char* lds, const bf16_t* q1, const bf16_t* q2,
                  const bf16_t* k1, long ldk1, const bf16_t* k2, long ldk2, const bf16_t* vt, long ldv, int ntiles) {
    constexpr int DQK = D1 + D2, KROW = DQK * 2 + 16, VROW = 144, KT = 64 * KROW, VT = DV * VROW, BUF = KT + VT;
    constexpr int KCH = DQK / 8, NKC = 64 * KCH, NVC = DV * 8, KPT = (NKC + 511) / 512, VPT = NVC / 512;
    const int tid = otid(), lane = tid & 63, r = lane & 31, h = lane >> 5;
    bf16x8 qf[DQK / 16];
#pragma unroll
    for (int d0 = 0; d0 < DQK / 16; ++d0) qf[d0] = (16 * d0 < D1) ? *(const bf16x8*)(q1 + 16 * d0 + 8 * h) : *(const bf16x8*)(q2 + (16 * d0 - D1) + 8 * h);
    u32x4 kreg[KPT], vreg[VPT];
    auto gload = [&](int t) {
#pragma unroll
        for (int i = 0; i < KPT; ++i) { const int c = tid + i * 512; if (c < NKC) { const int row = c / KCH, cc = (c % KCH) * 8;
            kreg[i] = (cc < D1) ? *(const u32x4*)(k1 + (size_t)(t * 64 + row) * ldk1 + cc) : *(const u32x4*)(k2 + (size_t)(t * 64 + row) * ldk2 + (cc - D1)); } }
#pragma unroll
        for (int i = 0; i < VPT; ++i) { const int c = tid + i * 512; const int d = c >> 3, cc = (c & 7) * 8; vreg[i] = *(const u32x4*)(vt + (size_t)d * ldv + t * 64 + cc); }
    };
    auto sstore = [&](int b) {
        LAS unsigned char* kb = lds + b * BUF; LAS unsigned char* vb = kb + KT;
#pragma unroll
        for (int i = 0; i < KPT; ++i) { const int c = tid + i * 512; if (c < NKC) { const int row = c / KCH, cc = (c % KCH) * 8; *(LAS u32x4*)(kb + row * KROW + cc * 2) = kreg[i]; } }
#pragma unroll
        for (int i = 0; i < VPT; ++i) { const int c = tid + i * 512; const int d = c >> 3, cc = (c & 7) * 8; *(LAS u32x4*)(vb + d * VROW + cc * 2) = vreg[i]; }
    };
    const int pr = (r & ~12) | ((r & 4) << 1) | ((r & 8) >> 1);
    float mrun = -1e30f, lrun = 0.f;
#pragma unroll
    for (int b = 0; b < DV / 32; ++b)
#pragma unroll
        for (int i = 0; i < 16; ++i) o[b][i] = 0.f;
    gload(0); sstore(0); __syncthreads();
    for (int t = 0; t < ntiles; ++t) {
        if (t + 1 < ntiles) gload(t + 1);
        const LAS unsigned char* kb = lds + (t & 1) * BUF; const LAS unsigned char* vb = kb + KT;
        f32x16 p[2];
#pragma unroll
        for (int hf = 0; hf < 2; ++hf) {
#pragma unroll
            for (int i = 0; i < 16; ++i) p[hf][i] = 0.f;
#pragma unroll
            for (int d0 = 0; d0 < DQK / 16; ++d0) { const bf16x8 ka = *(const LAS bf16x8*)(kb + (32 * hf + pr) * KROW + (16 * d0 + 8 * h) * 2); p[hf] = MFMA32(ka, qf[d0], p[hf]); }
        }
        float tm = p[0][0];
#pragma unroll
        for (int i = 1; i < 16; ++i) tm = fmaxf(tm, p[0][i]);
#pragma unroll
        for (int i = 0; i < 16; ++i) tm = fmaxf(tm, p[1][i]);
        tm = fmaxf(tm, __shfl_xor(tm, 32));
        const float mnew = fmaxf(mrun, tm), alpha = __builtin_amdgcn_exp2f(mrun - mnew); mrun = mnew;
        float rs = 0.f;
#pragma unroll
        for (int hf = 0; hf < 2; ++hf)
#pragma unroll
            for (int i = 0; i < 16; ++i) { p[hf][i] = __builtin_amdgcn_exp2f(p[hf][i] - mnew); rs += p[hf][i]; }
        lrun = lrun * alpha + rs;
#pragma unroll
        for (int b = 0; b < DV / 32; ++b)
#pragma unroll
            for (int i = 0; i < 16; ++i) o[b][i] *= alpha;
        bf16x8 pf[4];
#pragma unroll
        for (int ks = 0; ks < 4; ++ks) { const int hf = ks >> 1, s8 = (ks & 1) * 8; u32x4 w;
            w.x = cvtpk(p[hf][s8 + 0], p[hf][s8 + 1]); w.y = cvtpk(p[hf][s8 + 2], p[hf][s8 + 3]); w.z = cvtpk(p[hf][s8 + 4], p[hf][s8 + 5]); w.w = cvtpk(p[hf][s8 + 6], p[hf][s8 + 7]);
            pf[ks] = __builtin_bit_cast(bf16x8, w); }
#pragma unroll
        for (int b = 0; b < DV / 32; ++b)
#pragma unroll
            for (int ks = 0; ks < 4; ++ks) { const bf16x8 va = *(const LAS bf16x8*)(vb + (32 * b + r) * VROW + (16 * ks + 8 * h) * 2); o[b] = MFMA32(va, pf[ks], o[b]); }
        if (t + 1 < ntiles) sstore((t + 1) & 1);
        __syncthreads();
    }
    l_out = lrun + __shfl_xor(lrun, 32);
}
constexpr int ATTN_LDS = 2 * (64 * (96 * 2 + 16) + 128 * 144);


#define XB_TMO      128
#define XB_XCNT(j)  (256  + 64 * (j))
#define XB_XSUB(j)  (1280 + 64 * (j))
#define XB_XGEN(j)  (2304 + 64 * (j))
#define XB_TOP      3328
#define XB_TOPGEN   3392
#define XCD_BAR_WORDS 3456
#define XB_SPIN_CAP (1u << 18)
DI unsigned xb_ld(unsigned* p)              { return __hip_atomic_load(p, __ATOMIC_RELAXED, __HIP_MEMORY_SCOPE_AGENT); }
DI unsigned xb_add(unsigned* p, unsigned v) { return __hip_atomic_fetch_add(p, v, __ATOMIC_RELAXED, __HIP_MEMORY_SCOPE_AGENT); }
DI unsigned xb_xcc_id() { return (unsigned)__builtin_amdgcn_s_getreg((3 << 11) | 20) & 0xFu; }
#define XB_SPIN(cond, bar) do { unsigned _sp = 0; while (cond) { __builtin_amdgcn_s_sleep(1); \
    if ((++_sp & 255u) == 0u) { if (xb_ld(&(bar)[XB_TMO])) break; if (_sp > XB_SPIN_CAP) { atomicAdd(&(bar)[XB_TMO], 1u); break; } } } } while (0)
struct XcdBarrier { unsigned* bar; unsigned x; volatile LAS unsigned* st; };
DI XcdBarrier xcd_barrier_post(unsigned* bar, volatile LAS unsigned* st) {
    XcdBarrier b; b.bar = bar; b.x = xb_xcc_id(); b.st = st;
    if (threadIdx.x == 0) (void)xb_add(&bar[XB_XCNT(b.x)], 1u);
    return b;
}
DI void xcd_barrier_complete(unsigned* bar, unsigned x, unsigned& nloc, unsigned& nx) {
    const unsigned G = gridDim.x * gridDim.y * gridDim.z;
    unsigned sum, cnt, mine, sp = 0u;
    for (;;) {
        sum = 0u; cnt = 0u; mine = 0u;
#pragma unroll
        for (unsigned j = 0; j < 16; ++j) { const unsigned c = xb_ld(&bar[XB_XCNT(j)]); sum += c; cnt += (c > 0u) ? 1u : 0u; mine = (j == x) ? c : mine; }
        if (sum == G) break;
        __builtin_amdgcn_s_sleep(1);
        if ((++sp & 255u) == 0u) { if (xb_ld(&bar[XB_TMO])) break; if (sp > XB_SPIN_CAP) { atomicAdd(&bar[XB_TMO], 1u); break; } }
    }
    nloc = mine > 0u ? mine : 1u; nx = cnt > 0u ? cnt : 1u;
}
DI void xcd_barrier(const XcdBarrier& b) {
    asm volatile("s_waitcnt vmcnt(0)" ::: "memory");
    __syncthreads();
    if (threadIdx.x == 0) {
        unsigned* bar = b.bar;
        __builtin_amdgcn_s_waitcnt(0);
        unsigned nloc = b.st[0], nx = b.st[1];
        if (nloc == 0u) { xcd_barrier_complete(bar, b.x, nloc, nx); b.st[0] = nloc; b.st[1] = nx; }
        const unsigned old = xb_add(&bar[XB_XSUB(b.x)], 1u);
        const unsigned gen = old / nloc;
        if (old + 1u == (gen + 1u) * nloc) {
            __builtin_amdgcn_fence(__ATOMIC_RELEASE, "agent");
            asm volatile("s_waitcnt vmcnt(0)" ::: "memory");
            const unsigned og = xb_add(&bar[XB_TOP], 1u);
            const unsigned tg = og / nx;
            if (og + 1u == (tg + 1u) * nx) xb_add(&bar[XB_TOPGEN], 1u);
            else XB_SPIN(xb_ld(&bar[XB_TOPGEN]) == tg, bar);
            __builtin_amdgcn_fence(__ATOMIC_ACQUIRE, "agent");
            xb_add(&bar[XB_XGEN(b.x)], 1u);
            asm volatile("s_waitcnt vmcnt(0)" ::: "memory");
        } else {
            XB_SPIN(xb_ld(&bar[XB_XGEN(b.x)]) == gen, bar);
            __builtin_amdgcn_fence(__ATOMIC_ACQUIRE, "agent");
            asm volatile("s_waitcnt vmcnt(0)" ::: "memory");
        }
    }
    __syncthreads();
}

struct Args {
    const float* in[35]; float* out; unsigned char* ws; int ph_lo, ph_hi;
};
enum { I_X = 0, I_C, I_CTX, I_CCTX,
       I0_WMOD, I0_BMOD, I0_WIN, I0_QN, I0_WUQ, I0_KVN, I0_WUKV, I0_WOUT, I0_LN1G, I0_LN1B, I0_WG, I0_WU, I0_WD, I0_LN2G, I0_LN2B,
       I1_WMOD, I1_BMOD, I1_WIN, I1_LQ1, I1_LK1, I1_LQ2, I1_LK2, I1_SUBLN, I1_WOUT, I1_LN1G, I1_LN1B, I1_WG, I1_WU, I1_WD, I1_LN2G, I1_LN2B };

DI bf16_t* tr_dst(int job, int n, unsigned char* ws) {
    switch (job) {
    case 0: return (bf16_t*)(ws + W_IN0) + (size_t)n * 1024;
    case 1: { const int hd = n / 96, d = n % 96; int row; if (d < 64) row = hd * 64 + d; else { const int e = d - 64, t = e >> 3, f = e & 7; row = 512 + hd * 32 + 16 * (t & 1) + 8 * (t >> 1) + f; }
              return (bf16_t*)(ws + W_UQ) + (size_t)row * 256; }
    case 2: { const int hd = n >> 7, d = n & 127; return d < 64 ? (bf16_t*)(ws + W_KN) + (size_t)(hd * 64 + d) * 256 : (bf16_t*)(ws + W_V0) + (size_t)(hd * 64 + d - 64) * 256; }
    case 3: return (bf16_t*)(ws + W_OUT0) + (size_t)n * 1024;
    case 4: return (bf16_t*)(ws + W_GU0) + (size_t)(256 * (n >> 7) + (n & 127)) * 1024;
    case 5: return (bf16_t*)(ws + W_GU0) + (size_t)(256 * (n >> 7) + 128 + (n & 127)) * 1024;
    case 6: return (bf16_t*)(ws + W_D0) + (size_t)n * 2816;
    case 7: return n < 2048 ? (bf16_t*)(ws + W_QK1) + (size_t)n * 1024 : (bf16_t*)(ws + W_V1) + (size_t)(n - 2048) * 1024;
    case 8: return (bf16_t*)(ws + W_OUT1) + (size_t)n * 1024;
    case 9: return (bf16_t*)(ws + W_GU1) + (size_t)(256 * (n >> 7) + (n & 127)) * 1024;
    case 10: return (bf16_t*)(ws + W_GU1) + (size_t)(256 * (n >> 7) + 128 + (n & 127)) * 1024;
    default: return (bf16_t*)(ws + W_D1) + (size_t)n * 2816;
    }
}
DI void transpose_item(const float* W, int K, int N, int job, unsigned char* ws, LAS float* scr, int item, int lane) {
    const int nblk = N / 32, kb = item / nblk, nb = item % nblk, k0 = 64 * kb, n0 = 32 * nb;
#pragma unroll 8
    for (int i = 0; i < 32; ++i) { const int kk = 2 * i + (lane >> 5); scr[kk * 33 + (lane & 31)] = W[(size_t)(k0 + kk) * N + n0 + (lane & 31)]; }
    asm volatile("s_waitcnt lgkmcnt(0)" ::: "memory");
    const int c = lane & 7;
#pragma unroll
    for (int j = 0; j < 4; ++j) { const int n = (lane >> 3) + 8 * j; const LAS float* s = scr + (8 * c) * 33 + n;
        u32x4 o; o.x = cvtpk(s[0 * 33], s[1 * 33]); o.y = cvtpk(s[2 * 33], s[3 * 33]); o.z = cvtpk(s[4 * 33], s[5 * 33]); o.w = cvtpk(s[6 * 33], s[7 * 33]);
        bf16_t* dst = tr_dst(job, n0 + n, ws); *(u32x4*)(dst + k0 + 8 * c) = o; }
    asm volatile("s_waitcnt lgkmcnt(0)" ::: "memory");
}

DI void prologue(const Args& a, LAS unsigned char* lds) {
    unsigned char* ws = a.ws;
    const int tid = otid(), lane = tid & 63, wave = tid >> 6;
    const int G = gridDim.x, gw = blockIdx.x * 8 + wave, NGW = G * 8;
    const long gt = (long)blockIdx.x * 512 + tid, NGT = (long)G * 512;
    {
        LAS float* scr = (LAS float*)(lds + wave * 16384);
        const int jin[12] = {I0_WIN, I0_WUQ, I0_WUKV, I0_WOUT, I0_WG, I0_WU, I0_WD, I1_WIN, I1_WOUT, I1_WG, I1_WU, I1_WD};
        const int jK[12] = {1024, 256, 256, 1024, 1024, 1024, 2816, 1024, 1024, 1024, 1024, 2816};
        const int jN[12] = {1056, 768, 1024, 1024, 2816, 2816, 1024, 3072, 1024, 2816, 2816, 1024};
        int base = 0;
#pragma unroll
        for (int j = 0; j < 12; ++j) { const int items = (jK[j] / 64) * (jN[j] / 32);
            for (int it = gw; it < items; it += NGW) transpose_item(a.in[jin[j]], jK[j], jN[j], j, ws, scr, it, lane);
            base += items; }
        u32x4 z = {0u, 0u, 0u, 0u};
        for (long i = gt; i < (1280 - 1056) * 1024 / 8; i += NGT) ((u32x4*)((bf16_t*)(ws + W_IN0) + (size_t)1056 * 1024))[i] = z;
    }
    {
        const float sc = 0.011048543456039806f;
        for (long i = gt; i < (long)4096 * 2048; i += NGT) { const int k = (int)(i >> 11), c8 = (int)(i & 2047) * 8; const int part = c8 >> 13, n0 = c8 & 8191; float v[8];
#pragma unroll
            for (int e = 0; e < 8; ++e) { const float ph = (float)((k * (n0 + e)) & 8191) * (1.0f / 8192.0f); v[e] = (part ? __builtin_amdgcn_sinf(ph) : __builtin_amdgcn_cosf(ph)) * sc; }
            u32x4 o; o.x = cvtpk(v[0], v[1]); o.y = cvtpk(v[2], v[3]); o.z = cvtpk(v[4], v[5]); o.w = cvtpk(v[6], v[7]);
            *(u32x4*)((bf16_t*)(ws + WS_DN) + (size_t)k * 16384 + c8) = o; }
        for (long i = gt; i < 256 * 512; i += NGT) { const int k = (int)(i >> 9), c = (int)(i & 511), part = c >> 8, n = c & 255; const float ph = (float)((k * n) & 255) * (1.0f / 256.0f);
            const float v = (part ? __builtin_amdgcn_sinf(ph) : __builtin_amdgcn_cosf(ph)) * 0.0625f; ((bf16_t*)(ws + W_D256))[i] = (bf16_t)(cvtpk(v, 0.f) & 0xffffu); }
        for (long i = gt; i < 256 * 128; i += NGT) { const int rr = (int)(i >> 7), c = (int)(i & 127), part = rr >> 7, l = rr & 127; const float ph = (float)((l * c) & 127) * (1.0f / 128.0f);
            const float v = (part ? -__builtin_amdgcn_sinf(ph) : __builtin_amdgcn_cosf(ph)) * 0.08838834764831845f; ((bf16_t*)(ws + W_DC))[i] = (bf16_t)(cvtpk(v, 0.f) & 0xffffu); }
        for (long i = gt; i < 128 * 16; i += NGT) { const int pos = (int)(i >> 4), f = (int)(i & 15); const float inv = 1.0f / powf(10000.0f, (float)f / 16.0f); const float ang = (float)pos * inv;
            ((f32x2*)(ws + WS_TAB16))[i] = (f32x2){cosf(ang), sinf(ang)}; }
        for (long i = gt; i < 128 * 8; i += NGT) { const int pos = (int)(i >> 3), f = (int)(i & 7); const float inv = 1.0f / powf(10000.0f, (float)f / 8.0f); const float ang = (float)pos * inv;
            ((f32x2*)(ws + WS_TAB8))[i] = (f32x2){cosf(ang), sinf(ang)}; }
    }
    {
        LAS float* red = (LAS float*)lds;
        for (int it = blockIdx.x; it < 2 * 96; it += G) {
            __syncthreads();
            const int layer = it / 96, n = (it % 96) * 64 + lane; const float* w = a.in[layer ? I1_WMOD : I0_WMOD]; const float* bm = a.in[layer ? I1_BMOD : I0_BMOD];
            float acc[5] = {0.f, 0.f, 0.f, 0.f, 0.f};
            for (int kk = 0; kk < 128; ++kk) { const int k = wave * 128 + kk; const float wv = w[(size_t)k * 6144 + n];
#pragma unroll
                for (int cls = 0; cls < 5; ++cls) { const float cv = cls < 4 ? a.in[I_C][cls * 1024 + k] : a.in[I_CCTX][k]; const float sl = cv / (1.0f + __expf(-cv)); acc[cls] += sl * wv; } }
#pragma unroll
            for (int cls = 0; cls < 5; ++cls) red[(wave * 5 + cls) * 64 + lane] = acc[cls];
            __syncthreads();
            if (tid < 320) { const int cls = tid >> 6, l = tid & 63; float s = 0.f;
#pragma unroll
                for (int w8 = 0; w8 < 8; ++w8) s += red[(w8 * 5 + cls) * 64 + l];
                const int nn = (it % 96) * 64 + l; ((float*)(ws + WS_MOD))[(size_t)(layer * 5 + cls) * 6144 + nn] = s + bm[nn]; }
        }
        __syncthreads();
    }
}

struct RowPass {
    const float* xl; const float* xc;
    float* ol; float* oc;
    const bf16_t* Y;
    const float* mod;
    int gate_off; const float* lng; const float* lnb;
    const float* mod2; int sc_off, sh_off;
    bf16_t* H;
};
DI void ln_stats(const f32x4 (&v)[4], float& mean, float& rstd) {
    float s = 0.f;
#pragma unroll
    for (int j = 0; j < 4; ++j) s += (v[j][0] + v[j][1]) + (v[j][2] + v[j][3]);
    mean = wave_sum(s) * (1.0f / DM); float q = 0.f;
#pragma unroll
    for (int j = 0; j < 4; ++j) { const f32x4 d = v[j] - mean; q += (d[0] * d[0] + d[1] * d[1]) + (d[2] * d[2] + d[3] * d[3]); }
    rstd = 1.0f / sqrtf(wave_sum(q) * (1.0f / DM) + LN_EPS);
}
DI void row_pass(const RowPass& P, int m, int lane) {
    const int b = m / TPB, j = m % TPB; const bool isctx = j < CTX; const int cls = isctx ? 4 : b;
    const size_t xoff = isctx ? (size_t)(b * CTX + j) * DM : (size_t)(b * SEQ + j - CTX) * DM;
    const float* xs = (isctx ? P.xc : P.xl) + xoff; float* xd = isctx ? P.oc : P.ol;
    f32x4 v[4];
#pragma unroll
    for (int jj = 0; jj < 4; ++jj) v[jj] = *(const f32x4*)(xs + 4 * lane + 256 * jj);
    if (P.Y) {
        const float* gate = P.mod + (size_t)cls * 6144 + P.gate_off;
#pragma unroll
        for (int jj = 0; jj < 4; ++jj) { const int c0 = 4 * lane + 256 * jj; const u32x2 yw = *(const u32x2*)(P.Y + (size_t)m * DM + c0); const f32x4 g = *(const f32x4*)(gate + c0);
            v[jj][0] = DN_ALPHA * v[jj][0] + g[0] * bflo(yw.x); v[jj][1] = DN_ALPHA * v[jj][1] + g[1] * bfhi(yw.x);
            v[jj][2] = DN_ALPHA * v[jj][2] + g[2] * bflo(yw.y); v[jj][3] = DN_ALPHA * v[jj][3] + g[3] * bfhi(yw.y); }
        float mean, rstd; ln_stats(v, mean, rstd);
#pragma unroll
        for (int jj = 0; jj < 4; ++jj) { const int c0 = 4 * lane + 256 * jj; const f32x4 g = *(const f32x4*)(P.lng + c0), bb = *(const f32x4*)(P.lnb + c0); v[jj] = (v[jj] - mean) * rstd * g + bb; }
        if (xd) {
#pragma unroll
            for (int jj = 0; jj < 4; ++jj) *(f32x4*)(xd + xoff + 4 * lane + 256 * jj) = v[jj];
        }
    }
    if (P.H) {
        float mean, rstd; ln_stats(v, mean, rstd);
        const float* sc = P.mod2 + (size_t)cls * 6144 + P.sc_off; const float* sh = P.mod2 + (size_t)cls * 6144 + P.sh_off;
#pragma unroll
        for (int jj = 0; jj < 4; ++jj) { const int c0 = 4 * lane + 256 * jj; const f32x4 s1 = *(const f32x4*)(sc + c0), s0 = *(const f32x4*)(sh + c0);
            const f32x4 hh = (v[jj] - mean) * rstd * (s1 + 1.0f) + s0; u32x2 w; w.x = cvtpk(hh[0], hh[1]); w.y = cvtpk(hh[2], hh[3]);
            *(u32x2*)(P.H + (size_t)m * DM + c0) = w; }
    }
}
DI void p3_row(const Args& a, int m, int lane) {
    unsigned char* ws = a.ws; const bf16_t* U = (const bf16_t*)(ws + WS_R3) + (size_t)m * 1280;
    const u32x2 qw = *(const u32x2*)(U + 512 + 4 * lane), kw = *(const u32x2*)(U + 768 + 4 * lane);
    float q[4] = {bflo(qw.x), bfhi(qw.x), bflo(qw.y), bfhi(qw.y)}, k[4] = {bflo(kw.x), bfhi(kw.x), bflo(kw.y), bfhi(kw.y)};
    const float qs = wave_sum(q[0] * q[0] + q[1] * q[1] + q[2] * q[2] + q[3] * q[3]), ks = wave_sum(k[0] * k[0] + k[1] * k[1] + k[2] * k[2] + k[3] * k[3]);
    const float qr = 1.0f / sqrtf(qs * (1.0f / 256.0f) + RMS_EPS), kr_ = 1.0f / sqrtf(ks * (1.0f / 256.0f) + RMS_EPS);
    const f32x4 qg = *(const f32x4*)(a.in[I0_QN] + 4 * lane), kg = *(const f32x4*)(a.in[I0_KVN] + 4 * lane);
    u32x2 w; w.x = cvtpk(q[0] * qr * qg[0], q[1] * qr * qg[1]); w.y = cvtpk(q[2] * qr * qg[2], q[3] * qr * qg[3]);
    *(u32x2*)((bf16_t*)(ws + WS_CQN) + (size_t)m * 256 + 4 * lane) = w;
    w.x = cvtpk(k[0] * kr_ * kg[0], k[1] * kr_ * kg[1]); w.y = cvtpk(k[2] * kr_ * kg[2], k[3] * kr_ * kg[3]);
    *(u32x2*)((bf16_t*)(ws + WS_CKVN) + (size_t)m * 256 + 4 * lane) = w;
    const int d = lane & 31, t = d >> 3, f = d & 7; const float val = bf2f(U[1024 + d]); const float par = __shfl_xor(val, 8);
    const int j = m % TPB, tt = j - CTX; float outv = val;
    if (tt >= 0) { const int pos = (t < 2) ? (tt >> 6) : (tt & 63); const f32x2 cs = ((const f32x2*)(ws + WS_TAB8))[pos * 8 + f];
        outv = (t & 1) ? (par * cs[1] + val * cs[0]) : (val * cs[0] - par * cs[1]); }
    if (lane < 32) ((bf16_t*)(ws + WS_KR))[(size_t)m * 32 + 16 * (t & 1) + 8 * (t >> 1) + f] = (bf16_t)(cvtpk(outv, 0.f) & 0xffffu);
}
DI void mirror_items(const Args& a, int gw, int NGW, int lane) {
    unsigned char* ws = a.ws; bf16_t* MIX = (bf16_t*)(ws + WS_R3); const bf16_t* At = (const bf16_t*)(ws + WS_R2);
    for (int it = gw; it < NB * 512; it += NGW) { const int b = it >> 9, ch = it & 511; const bf16_t* src = At + (size_t)ch * ROWS + b * TPB + CTX; float s = 0.f;
        for (int i = 0; i < 16; ++i) { const u32x4 w = *(const u32x4*)(src + (i * 64 + lane) * 8);
            s += (bflo(w.x) - bfhi(w.x)) + (bflo(w.y) - bfhi(w.y)) + (bflo(w.z) - bfhi(w.z)) + (bflo(w.w) - bfhi(w.w)); }
        s = wave_sum(s) * 0.011048543456039806f;
        if (lane == 0) MIX[(size_t)(b * TPB + CTX + 4096) * DM + ch] = (bf16_t)(cvtpk(s, 0.f) & 0xffffu); }
    for (int it = gw; it < NB * 4095; it += NGW) { const int b = it / 4095, k = 1 + it % 4095;
        const bf16_t* src = MIX + (size_t)(b * TPB + CTX + k) * DM; bf16_t* dst = MIX + (size_t)(b * TPB + CTX + 8192 - k) * DM;
        const int g = lane >> 4, l0 = 8 * (lane & 15); unsigned short e[8];
#pragma unroll
        for (int i = 0; i < 8; ++i) e[i] = src[g * 128 + ((128 - (l0 + i)) & 127)];
        u32x4 w; w.x = e[0] | ((unsigned)e[1] << 16); w.y = e[2] | ((unsigned)e[3] << 16); w.z = e[4] | ((unsigned)e[5] << 16); w.w = e[6] | ((unsigned)e[7] << 16);
        *(u32x4*)(dst + g * 128 + l0) = w; }
}

DI bool attn_unit_map(int L, int nunits_big, int& bh, int& qb) {
    if (L < nunits_big) { const int i = L >> 8, c = L & 255; bh = 4 * (c & 7) + i; qb = 1 + (c >> 3); return true; }
    bh = L - nunits_big; qb = 0; return bh < 32;
}
DI void attn_mla_unit(const Args& a, LAS unsigned char* lds, int bh, int qb) {
    unsigned char* ws = a.ws; const int tid = otid(), lane = tid & 63, wave = tid >> 6, r = lane & 31, h = lane >> 5;
    const int b = bh >> 3, hd = bh & 7; const int m = b * TPB + qb * 256 + wave * 32 + r;
    const bf16_t* Q = (const bf16_t*)(ws + WS_Q) + (size_t)m * 768;
    const bf16_t* KN = (const bf16_t*)(ws + WS_KN) + (size_t)(b * TPB) * 512 + hd * 64;
    const bf16_t* KR = (const bf16_t*)(ws + WS_KR) + (size_t)(b * TPB) * 32;
    const bf16_t* VT = (const bf16_t*)(ws + WS_VT0) + (size_t)(hd * 64) * ROWS + b * TPB;
    f32x16 o[2]; float l;
    attn_core<64, 32, 64>(o, l, lds, Q + hd * 64, Q + 512 + hd * 32, KN, 512, KR, 32, VT, ROWS, qb == 0 ? CTX / 64 : TPB / 64);
    const float il = 1.0f / l; bf16_t* dst = (bf16_t*)(ws + WS_R3) + (size_t)m * DM + 512 + hd * 64;
#pragma unroll
    for (int blk = 0; blk < 2; ++blk)
#pragma unroll
        for (int g = 0; g < 4; ++g) { u32x2 w; w.x = cvtpk(o[blk][4 * g] * il, o[blk][4 * g + 1] * il); w.y = cvtpk(o[blk][4 * g + 2] * il, o[blk][4 * g + 3] * il);
            *(u32x2*)(dst + 32 * blk + 8 * g + 4 * h) = w; }
}
DI void attn_diff_unit(const Args& a, LAS unsigned char* lds, int bh, int qb, float lam) {
    unsigned char* ws = a.ws; const int tid = otid(), lane = tid & 63, wave = tid >> 6, r = lane & 31, h = lane >> 5;
    const int b = bh >> 3, hd = bh & 7; const int m = b * TPB + qb * 256 + wave * 32 + r;
    const bf16_t* QK = (const bf16_t*)(ws + WS_R3);
    const bf16_t* VT = (const bf16_t*)(ws + WS_VT1) + (size_t)(hd * 128) * ROWS + b * TPB;
    LAS unsigned* stash = (LAS unsigned*)(lds + 55296) + wave * 2048 + lane;
    f32x16 o[4]; float l;
    {
        const bf16_t* q = QK + (size_t)m * 2048 + (hd * 2) * 64; const bf16_t* k = QK + (size_t)(b * TPB) * 2048 + 1024 + (hd * 2) * 64;
        attn_core<64, 0, 128>(o, l, lds, q, q, k, 2048, k, 2048, VT, ROWS, TPB / 64);
        const float il = 1.0f / l;
#pragma unroll
        for (int blk = 0; blk < 4; ++blk)
#pragma unroll
            for (int i = 0; i < 8; ++i) stash[(blk * 8 + i) * 64] = cvtpk(o[blk][2 * i] * il, o[blk][2 * i + 1] * il);
    }
    {
        const bf16_t* q = QK + (size_t)m * 2048 + (hd * 2 + 1) * 64; const bf16_t* k = QK + (size_t)(b * TPB) * 2048 + 1024 + (hd * 2 + 1) * 64;
        attn_core<64, 0, 128>(o, l, lds, q, q, k, 2048, k, 2048, VT, ROWS, TPB / 64);
    }
    const float il = lam / l; float ss = 0.f;
#pragma unroll
    for (int blk = 0; blk < 4; ++blk)
#pragma unroll
        for (int i = 0; i < 8; ++i) { const unsigned aw = stash[(blk * 8 + i) * 64]; const float x0 = bflo(aw) - o[blk][2 * i] * il, x1 = bfhi(aw) - o[blk][2 * i + 1] * il; o[blk][2 * i] = x0; o[blk][2 * i + 1] = x1; ss += x0 * x0 + x1 * x1; }
    ss += __shfl_xor(ss, 32);
    const float rn = (1.0f - LAMBDA_INIT) / sqrtf(ss * (1.0f / 128.0f) + RMS_EPS);
    const float* sub = a.in[I1_SUBLN]; bf16_t* dst = (bf16_t*)(ws + WS_R2) + (size_t)m * DM + hd * 128;
#pragma unroll
    for (int blk = 0; blk < 4; ++blk)
#pragma unroll
        for (int g = 0; g < 4; ++g) { const int d0 = 32 * blk + 8 * g + 4 * h; const f32x4 sg = *(const f32x4*)(sub + d0);
            u32x2 w; w.x = cvtpk(o[blk][4 * g] * rn * sg[0], o[blk][4 * g + 1] * rn * sg[1]); w.y = cvtpk(o[blk][4 * g + 2] * rn * sg[2], o[blk][4 * g + 3] * rn * sg[3]);
            *(u32x2*)(dst + d0) = w; }
}

constexpr int NPHASES = 18;
constexpr int LDS_BYTES = 147456;
struct GOp { int kind; pg8::Gemm g; bf16_t* O; int ldc, o_bs, ai_extra; float scale; int q_tiles, rope_from; };

DI bool get_gemm(int ph, int sub, const Args& a, GOp& op) {
    unsigned char* ws = a.ws;
    bf16_t* R2 = (bf16_t*)(ws + WS_R2); bf16_t* R3 = (bf16_t*)(ws + WS_R3);
    op.kind = 0; op.o_bs = 0; op.ai_extra = 0; op.scale = 1.0f; op.q_tiles = 0; op.rope_from = 0;
    pg8::Gemm& g = op.g; g.nB = 1; g.a_bs = 0; g.b_bs = 0; g.rot = 0; g.a_seg = 0; g.b_seg = 0;
#define SETK(k_) do { g.K = (k_); g.kseg = (k_) / 64; g.a_seg = (k_); g.b_seg = (k_); } while (0)
    switch (ph * 8 + sub) {
    case 2 * 8 + 0:
        g.A = R2; g.a_rs = 1024; g.nM = NRT; g.Bt = (const bf16_t*)(ws + W_IN0); g.b_rs = 1024; g.nN = 5; SETK(1024); op.O = R3; op.ldc = 1280; return true;
    case 3 * 8 + 0:
        g.A = (const bf16_t*)(ws + W_DC); g.a_rs = 128; g.nM = 1; g.Bt = R3; g.b_rs = 1280; g.nN = NRT; g.nB = 4; g.b_bs = 128; SETK(128);
        op.O = R2; op.ldc = ROWS; op.o_bs = 128 * ROWS; op.ai_extra = 384 * ROWS; return true;
    case 4 * 8 + 0:
        op.kind = 1; g.A = (const bf16_t*)(ws + WS_CQN); g.a_rs = 256; g.nM = NRT; g.Bt = (const bf16_t*)(ws + W_UQ); g.b_rs = 256; g.nN = 3; SETK(256);
        op.O = (bf16_t*)(ws + WS_Q); op.ldc = 768; op.scale = MLA_QSCALE; op.q_tiles = 3; op.rope_from = 2; return true;
    case 4 * 8 + 1:
        g.A = (const bf16_t*)(ws + WS_CKVN); g.a_rs = 256; g.nM = NRT; g.Bt = (const bf16_t*)(ws + W_KN); g.b_rs = 256; g.nN = 2; SETK(256); g.rot = 140;
        op.O = (bf16_t*)(ws + WS_KN); op.ldc = 512; return true;
    case 4 * 8 + 2:
        g.A = (const bf16_t*)(ws + W_V0); g.a_rs = 256; g.nM = 2; g.Bt = (const bf16_t*)(ws + WS_CKVN); g.b_rs = 256; g.nN = NRT; SETK(256); g.rot = 148;
        op.O = (bf16_t*)(ws + WS_VT0); op.ldc = ROWS; return true;
    case 4 * 8 + 3:
        g.A = (const bf16_t*)(ws + WS_DN); g.a_rs = 16384; g.nM = 16; g.Bt = R2 + CTX; g.b_rs = ROWS; g.nN = 2; g.nB = 4; g.b_bs = TPB; g.K = 16384; g.kseg = 128; g.a_seg = 8192; g.b_seg = 512 * ROWS; g.rot = 156;
        op.O = R3 + (size_t)CTX * DM; op.ldc = DM; op.o_bs = TPB * DM; return true;
    case 4 * 8 + 4:
        g.A = (const bf16_t*)(ws + W_D256); g.a_rs = 512; g.nM = 1; g.Bt = R2; g.b_rs = ROWS; g.nN = 2; g.nB = 4; g.b_bs = TPB; g.K = 512; g.kseg = 4; g.a_seg = 256; g.b_seg = 512 * ROWS; g.rot = 28;
        op.O = R3; op.ldc = DM; op.o_bs = TPB * DM; return true;
    case 6 * 8 + 0:
        g.A = R3; g.a_rs = 1024; g.nM = NRT; g.Bt = (const bf16_t*)(ws + W_OUT0); g.b_rs = 1024; g.nN = 4; SETK(1024); op.O = (bf16_t*)(ws + WS_Y0); op.ldc = DM; return true;
    case 8 * 8 + 0: case 15 * 8 + 0:
        op.kind = 3; g.A = R2; g.a_rs = 1024; g.nM = NRT; g.Bt = (const bf16_t*)(ws + (ph == 8 ? W_GU0 : W_GU1)); g.b_rs = 1024; g.nN = 22; SETK(1024); op.O = R3; op.ldc = FF; return true;
    case 9 * 8 + 0: case 16 * 8 + 0:
        g.A = R3; g.a_rs = FF; g.nM = NRT; g.Bt = (const bf16_t*)(ws + (ph == 9 ? W_D0 : W_D1)); g.b_rs = FF; g.nN = 4; SETK(FF); op.O = R2; op.ldc = DM; return true;
    case 11 * 8 + 0:
        op.kind = 2; g.A = R2; g.a_rs = 1024; g.nM = NRT; g.Bt = (const bf16_t*)(ws + W_QK1); g.b_rs = 1024; g.nN = 8; SETK(1024);
        op.O = R3; op.ldc = 2048; op.scale = DIFF_QSCALE; op.q_tiles = 4; op.rope_from = 0; return true;
    case 11 * 8 + 1:
        g.A = (const bf16_t*)(ws + W_V1); g.a_rs = 1024; g.nM = 4; g.Bt = R2; g.b_rs = 1024; g.nN = NRT; SETK(1024); g.rot = 32;
        op.O = (bf16_t*)(ws + WS_VT1); op.ldc = ROWS; return true;
    case 13 * 8 + 0:
        g.A = R2; g.a_rs = 1024; g.nM = NRT; g.Bt = (const bf16_t*)(ws + W_OUT1); g.b_rs = 1024; g.nN = 4; SETK(1024); op.O = R3; op.ldc = DM; return true;
    default: return false;
    }
#undef SETK
}

DI bool get_rowpass(int ph, const Args& a, RowPass& P) {
    unsigned char* ws = a.ws; const float* MOD0 = (const float*)(ws + WS_MOD); const float* MOD1 = MOD0 + 5 * 6144;
    float* XC = (float*)(ws + WS_XC); bf16_t* R2 = (bf16_t*)(ws + WS_R2);
    switch (ph) {
    case 1:  P = RowPass{a.in[I_X], a.in[I_CTX], nullptr, nullptr, nullptr, MOD0, 0, nullptr, nullptr, MOD0, 1024, 0, R2}; return true;
    case 7:  P = RowPass{a.in[I_X], a.in[I_CTX], a.out, XC, (const bf16_t*)(ws + WS_Y0), MOD0, 2048, a.in[I0_LN1G], a.in[I0_LN1B], MOD0, 4096, 3072, R2}; return true;
    case 10: P = RowPass{a.out, XC, a.out, XC, R2, MOD0, 5120, a.in[I0_LN2G], a.in[I0_LN2B], MOD1, 1024, 0, R2}; return true;
    case 14: P = RowPass{a.out, XC, a.out, XC, (const bf16_t*)(ws + WS_R3), MOD1, 2048, a.in[I1_LN1G], a.in[I1_LN1B], MOD1, 4096, 3072, R2}; return true;
    case 17: P = RowPass{a.out, XC, a.out, XC, R2, MOD1, 5120, a.in[I1_LN2G], a.in[I1_LN2B], MOD1, 0, 0, nullptr}; return true;
    default: return false;
    }
}

__global__ void __launch_bounds__(512, 2) fwd_kernel(Args a) {
    extern __shared__ __attribute__((aligned(16))) unsigned char lds_raw[];
    LAS unsigned char* lds = (LAS unsigned char*)lds_raw;
    const int G = gridDim.x;
    volatile LAS unsigned* bst = (volatile LAS unsigned*)(lds + LDS_BYTES - 64);
    if (threadIdx.x < 2) bst[threadIdx.x] = 0u;
    __syncthreads();
    XcdBarrier xbar = xcd_barrier_post((unsigned*)(a.ws + WS_BAR), bst);
    for (int ph = a.ph_lo; ph < a.ph_hi; ++ph) {
        const int tid = otid(), lane = tid & 63, wave = __builtin_amdgcn_readfirstlane(tid >> 6);
        const int gw = blockIdx.x * 8 + wave, NGW = G * 8;
#ifndef NO_PRO
        if (ph == 0) prologue(a, lds);
#endif
        RowPass P;
        if (get_rowpass(ph, a, P)) { for (int m = gw; m < ROWS; m += NGW) row_pass(P, m, lane); }
        if (ph == 3) { for (int m = gw; m < ROWS; m += NGW) p3_row(a, m, lane); }
#ifndef NO_MLA
        if (ph == 5) {
            mirror_items(a, gw, NGW, lane);
            for (int L = blockIdx.x; ; L += G) { int bh, qb; if (!attn_unit_map(L, 1024, bh, qb)) break; attn_mla_unit(a, lds, bh, qb); }
        }
#endif
#ifndef NO_DIFF
        if (ph == 12) {
            const float p1 = wave_sum(a.in[I1_LQ1][lane] * a.in[I1_LK1][lane]), p2 = wave_sum(a.in[I1_LQ2][lane] * a.in[I1_LK2][lane]);
            const float lam = expf(p1) - expf(p2) + LAMBDA_INIT;
            for (int L = blockIdx.x; L < 1024; L += G) { int bh, qb; attn_unit_map(L, 1024, bh, qb); attn_diff_unit(a, lds, bh, qb, lam); }
        }
#endif
#ifndef NO_GEMM
        for (int sub = 0; sub < 8; ++sub) {
            GOp op; if (!get_gemm(ph, sub, a, op)) break;
            pg8::StaticOrder S; S.init(op.g.nM, op.g.nN, op.g.nB, G, (int)blockIdx.x, op.g.rot);
            if (op.kind == 0) { pg8::EpiStore E{op.O, op.ldc, op.o_bs, op.ai_extra, op.scale}; pg8::gemm_phase(lds, op.g, S, E); }
            else if (op.kind == 1) { pg8::EpiRope<8> E{op.O, op.ldc, op.scale, op.q_tiles, op.rope_from, (const f32x2*)(a.ws + WS_TAB8)}; pg8::gemm_phase(lds, op.g, S, E); }
            else if (op.kind == 2) { pg8::EpiRope<16> E{op.O, op.ldc, op.scale, op.q_tiles, op.rope_from, (const f32x2*)(a.ws + WS_TAB16)}; pg8::gemm_phase(lds, op.g, S, E); }
            else { pg8::EpiSwiglu E{op.O, op.ldc}; pg8::gemm_phase(lds, op.g, S, E); }
        }
#endif
        if (ph + 1 < a.ph_hi) { if (ph == a.ph_lo) { __threadfence(); cg::this_grid().sync(); } else xcd_barrier(xbar); }
    }
}

extern "C" void kernel_launch(void* const* d_in, const int* in_sizes, int n_in, void* d_out, int out_size, void* d_ws, size_t ws_size, hipStream_t stream) {
    static int grid = 0;
    if (grid == 0) {
        if (n_in != 35 || ws_size < WS_END) { fprintf(stderr, "kernel_launch: unexpected n_in %d / ws %zu (need %zu)\n", n_in, ws_size, (size_t)WS_END); grid = -1; return; }
        int dev = 0, cus = 0, per_cu = 0;
        hipGetDevice(&dev); hipDeviceGetAttribute(&cus, hipDeviceAttributeMultiprocessorCount, dev);
        hipFuncSetAttribute((const void*)fwd_kernel, hipFuncAttributeMaxDynamicSharedMemorySize, LDS_BYTES);
        hipOccupancyMaxActiveBlocksPerMultiprocessor(&per_cu, (const void*)fwd_kernel, 512, LDS_BYTES);
        if (per_cu < 1) { fprintf(stderr, "kernel_launch: occupancy query says %d blocks/CU\n", per_cu); per_cu = 1; }
        (void)hipGetLastError();
        grid = cus * 1;
    }
    if (grid < 0) return;
    Args a{};
    for (int i = 0; i < 35; ++i) a.in[i] = (const float*)d_in[i];
    a.out = (float*)d_out; a.ws = (unsigned char*)d_ws;
#if MK_MULTI
    for (int ph = 0; ph < NPHASES; ++ph) { a.ph_lo = ph; a.ph_hi = ph + 1; hipLaunchKernelGGL(fwd_kernel, dim3(grid), dim3(512), LDS_BYTES, stream, a); }
#else
    a.ph_lo = 0; a.ph_hi = NPHASES;
    hipMemsetAsync((char*)d_ws + WS_BAR, 0, 16384, stream);
    void* args[] = {&a};
    hipError_t e = hipLaunchCooperativeKernel((const void*)fwd_kernel, dim3(grid), dim3(512), args, LDS_BYTES, stream);
    if (e != hipSuccess) fprintf(stderr, "cooperative launch failed: %s (grid %d)\n", hipGetErrorString(e), grid);
#endif
}
```

```cpp
#include <hip/hip_runtime.h>
#include <hip/hip_cooperative_groups.h>
#include <cstdio>
#include <cstdint>
namespace cg = cooperative_groups;

#ifndef MK_MULTI
#define MK_MULTI 0
#endif

#define DI __device__ __forceinline__
#define LAS __attribute__((address_space(3)))
typedef unsigned short bf16_t;
typedef short bf16x8 __attribute__((ext_vector_type(8)));
typedef float f32x4 __attribute__((ext_vector_type(4)));
typedef float f32x2 __attribute__((ext_vector_type(2)));
typedef float f32x16 __attribute__((ext_vector_type(16)));
typedef unsigned u32x4 __attribute__((ext_vector_type(4)));
typedef unsigned u32x2 __attribute__((ext_vector_type(2)));
typedef __bf16 bf16x2_t __attribute__((ext_vector_type(2)));

constexpr int DM = 1024, NB = 4, SEQ = 8192, CTX = 256, TPB = SEQ + CTX  , ROWS = NB * TPB  , FF = 2816;
constexpr int NRT = ROWS / 256;
constexpr float LN_EPS = 1e-6f, RMS_EPS = 1e-6f;
constexpr float DN_ALPHA = 1.41421356237f;
constexpr float LOG2E = 1.4426950408889634f;
constexpr float MLA_QSCALE = 0.10206207261596577f * LOG2E;
constexpr float DIFF_QSCALE = 0.125f * LOG2E;
constexpr float LAMBDA_INIT = 0.35550906f;

constexpr size_t MiB = 1u << 20;
constexpr size_t WS_MOD = 0;
constexpr size_t WS_TAB16 = 256 * 1024;
constexpr size_t WS_TAB8 = WS_TAB16 + 16384;
constexpr size_t WS_BAR = 512 * 1024;
constexpr size_t WS_XC = 1 * MiB;
constexpr size_t WS_W = 5 * MiB;
constexpr size_t W_IN0 = WS_W;
constexpr size_t W_UQ = W_IN0 + 1280 * 1024 * 2;
constexpr size_t W_KN = W_UQ + 768 * 256 * 2;
constexpr size_t W_V0 = W_KN + 512 * 256 * 2;
constexpr size_t W_OUT0 = W_V0 + 512 * 256 * 2;
constexpr size_t W_GU0 = W_OUT0 + 1024 * 1024 * 2;
constexpr size_t W_D0 = W_GU0 + 5632 * 1024 * 2;
constexpr size_t W_QK1 = W_D0 + 1024 * 2816 * 2;
constexpr size_t W_V1 = W_QK1 + 2048 * 1024 * 2;
constexpr size_t W_OUT1 = W_V1 + 1024 * 1024 * 2;
constexpr size_t W_GU1 = W_OUT1 + 1024 * 1024 * 2;
constexpr size_t W_D1 = W_GU1 + 5632 * 1024 * 2;
constexpr size_t W_DC = W_D1 + 1024 * 2816 * 2;
constexpr size_t W_D256 = W_DC + 256 * 128 * 2;
constexpr size_t W_END = W_D256 + 256 * 512 * 2;
static_assert(W_END <= 56 * MiB, "weights region");
constexpr size_t WS_DN = 56 * MiB;
constexpr size_t WS_R2 = 184 * MiB;
constexpr size_t WS_R3 = 250 * MiB;
constexpr size_t WS_R4 = WS_R3 + (size_t)ROWS * 1280 * 2;
constexpr size_t WS_CQN = WS_R4, WS_CKVN = WS_R4 + (size_t)ROWS * 256 * 2;
constexpr size_t WS_R5 = WS_R4 + (size_t)ROWS * 512 * 2;
constexpr size_t WS_Q = WS_R5;
constexpr size_t WS_KN = WS_Q + (size_t)ROWS * 768 * 2;
constexpr size_t WS_KR = WS_KN + (size_t)ROWS * 512 * 2;
constexpr size_t WS_VT0 = WS_KR + (size_t)ROWS * 32 * 2;
constexpr size_t WS_END = WS_VT0 + (size_t)512 * ROWS * 2;
constexpr size_t WS_Y0 = WS_R5;
constexpr size_t WS_VT1 = WS_R3 + (size_t)ROWS * 2048 * 2;
static_assert(WS_END <= 512 * MiB, "workspace");
static_assert(WS_VT1 + (size_t)1024 * ROWS * 2 <= WS_END, "vt1");
static_assert(WS_R3 + (size_t)ROWS * FF * 2 <= WS_END, "hid");

DI int otid() { int t = threadIdx.x; asm volatile("" : "+v"(t)); return t; }
DI float wave_sum(float v) {
#pragma unroll
    for (int o = 1; o < 64; o <<= 1) v += __shfl_xor(v, o);
    return v;
}
DI unsigned cvtpk(float lo, float hi) { f32x2 v = {lo, hi}; bf16x2_t b = __builtin_convertvector(v, bf16x2_t); return __builtin_bit_cast(unsigned, b); }
DI float bf2f(unsigned short b) { return __uint_as_float(((unsigned)b) << 16); }
DI float bflo(unsigned w) { return __uint_as_float(w << 16); }
DI float bfhi(unsigned w) { return __uint_as_float(w & 0xffff0000u); }

namespace pg8 {
constexpr int BM = 256, BK = 64, HALF = 128, HTB = HALF * BK * 2, STAGE_BYTES = 8 * HTB, NXCD = 8, WGM = 8;
__host__ __device__ __forceinline__ int lds_byte(int r, int c) { const int st = (r >> 4) * 2 + (c >> 5), rr = r & 15, cc = c & 31, ob = rr * 64 + cc * 2; return st * 1024 + (ob ^ (((ob >> 9) & 1) << 5)); }
__host__ __device__ __forceinline__ void stage_rc(int b, int& R, int& C) { const int st = b / 1024, sb = b % 1024, swz = sb ^ (((sb >> 9) & 1) << 5); R = (st >> 1) * 16 + swz / 64; C = (st & 1) * 32 + (swz % 64) / 2; }
__host__ __device__ __forceinline__ int perm32(int rho) { const int n = rho >> 4, i = rho & 15; return 8 * (i >> 2) + 4 * n + (i & 3); }

struct Unit { int pm, pn, pb; };
struct Gemm {
    const bf16_t* A; const bf16_t* Bt; int nM, nN, nB, K, kseg;
    int a_rs, b_rs, a_seg, b_seg, a_bs, b_bs;
    int rot;
};
struct StaticOrder {
    int nM, nN, nwg, tot, G, c;
    DI void init(int nM_, int nN_, int nB_, int G_, int c_, int rot) { nM = nM_; nN = nN_; nwg = nM * nN; tot = nwg * nB_; G = G_; c = (c_ + G_ - (rot % G_)) % G_; }
    DI bool next(int i, Unit& u) const {
        const long L = (long)i * G + c; if (L >= tot) return false;
        u.pb = (int)(L / nwg); int wgid = (int)(L % nwg);
        { const int q = nwg / NXCD, r = nwg % NXCD, xcd = wgid % NXCD, off = wgid / NXCD; wgid = (xcd < r ? xcd * (q + 1) : r * (q + 1) + (xcd - r) * q) + off; }
        const int nig = WGM * nN, gid = wgid / nig, fm = gid * WGM, gsz = (nM - fm) < WGM ? (nM - fm) : WGM;
        u.pm = fm + ((wgid % nig) % gsz); u.pn = (wgid % nig) / gsz; return true;
    }
};

struct EpiStore {
    static constexpr bool PERM = true;
    bf16_t* O; int ldc, o_bs, ai_extra; float scale;
    DI void operator()(const f32x4 (&acc)[2][2][4][2], const Unit& u, int wr, int wc, int fr, int fq) const {
        const int row0 = u.pm * BM + wr * 64 + fr, col0 = u.pn * BM + wc * 32 + 8 * fq;
        bf16_t* base = O + (size_t)u.pb * o_bs;
#pragma unroll
        for (int ai = 0; ai < 2; ++ai)
#pragma unroll
            for (int m = 0; m < 4; ++m) { bf16_t* rowp = base + (size_t)(row0 + ai * HALF + m * 16) * ldc + (size_t)ai * ai_extra + col0;
#pragma unroll
                for (int bj = 0; bj < 2; ++bj) { const f32x4 v0 = acc[ai][bj][m][0] * scale, v1 = acc[ai][bj][m][1] * scale;
                    u32x4 w; w.x = cvtpk(v0[0], v0[1]); w.y = cvtpk(v0[2], v0[3]); w.z = cvtpk(v1[0], v1[1]); w.w = cvtpk(v1[2], v1[3]);
                    *(u32x4*)(rowp + bj * HALF) = w; } }
    }
};
struct EpiSwiglu {
    static constexpr bool PERM = true;
    bf16_t* O; int ldc;
    DI void operator()(const f32x4 (&acc)[2][2][4][2], const Unit& u, int wr, int wc, int fr, int fq) const {
        const int row0 = u.pm * BM + wr * 64 + fr, col0 = u.pn * HALF + wc * 32 + 8 * fq;
#pragma unroll
        for (int ai = 0; ai < 2; ++ai)
#pragma unroll
            for (int m = 0; m < 4; ++m) { bf16_t* rowp = O + (size_t)(row0 + ai * HALF + m * 16) * ldc + col0; float h[8];
#pragma unroll
                for (int n = 0; n < 2; ++n)
#pragma unroll
                    for (int i = 0; i < 4; ++i) { const float g = acc[ai][0][m][n][i], up = acc[ai][1][m][n][i];
                        h[n * 4 + i] = g * __builtin_amdgcn_rcpf(1.0f + __builtin_amdgcn_exp2f(-g * LOG2E)) * up; }
                u32x4 w; w.x = cvtpk(h[0], h[1]); w.y = cvtpk(h[2], h[3]); w.z = cvtpk(h[4], h[5]); w.w = cvtpk(h[6], h[7]);
                *(u32x4*)rowp = w; }
    }
};
template <int MODE> struct EpiRope {
    static constexpr bool PERM = false;
    bf16_t* O; int ldc; float qscale; int q_tiles, rope_from; const f32x2* tab;
    DI void operator()(const f32x4 (&acc)[2][2][4][2], const Unit& u, int wr, int wc, int fr, int fq) const {
        const float sc = u.pn < q_tiles ? qscale : 1.0f; const bool rope_tile = u.pn >= rope_from;
        const int col0 = u.pn * BM + wc * 32 + 4 * fq;
#pragma unroll
        for (int ai = 0; ai < 2; ++ai)
#pragma unroll
            for (int m = 0; m < 4; ++m) {
                const int row = u.pm * BM + ai * HALF + wr * 64 + m * 16 + fr; const int j = row % TPB; const int t = j - CTX;
                f32x4 cs0 = {1.f, 0.f, 1.f, 0.f}, cs1 = {1.f, 0.f, 1.f, 0.f};
                if (rope_tile && t >= 0) {
                    int pos, f0;
                    if (MODE == 16) { pos = (wc & 1) ? (t & 63) : (t >> 6); f0 = 4 * fq; } else { pos = (fq >> 1) ? (t & 63) : (t >> 6); f0 = 4 * (fq & 1); }
                    const f32x4* tp = (const f32x4*)(tab + pos * MODE + f0); cs0 = tp[0]; cs1 = tp[1];
                }
                const float c[4] = {cs0[0], cs0[2], cs1[0], cs1[2]}, s[4] = {cs0[1], cs0[3], cs1[1], cs1[3]};
                bf16_t* rowp = O + (size_t)row * ldc + col0;
#pragma unroll
                for (int bj = 0; bj < 2; ++bj) { const f32x4 x1 = acc[ai][bj][m][0] * sc, x2 = acc[ai][bj][m][1] * sc; float o1[4], o2[4];
#pragma unroll
                    for (int i = 0; i < 4; ++i) { o1[i] = x1[i] * c[i] - x2[i] * s[i]; o2[i] = x1[i] * s[i] + x2[i] * c[i]; }
                    u32x2 w1, w2; w1.x = cvtpk(o1[0], o1[1]); w1.y = cvtpk(o1[2], o1[3]); w2.x = cvtpk(o2[0], o2[1]); w2.y = cvtpk(o2[2], o2[3]);
                    *(u32x2*)(rowp + bj * HALF) = w1; *(u32x2*)(rowp + bj * HALF + 16) = w2; }
            }
    }
};

template <class Epi>
DI void gemm_phase(LAS unsigned char* lds, const Gemm g, const StaticOrder& S, const Epi& E) {
    const int tid = otid(), wid = __builtin_amdgcn_readfirstlane(tid >> 6), lane = tid & 63, wr = wid >> 2, wc = wid & 3, fr = lane & 15, fq = lane >> 4;
    const int nt = g.K / BK, kseg = g.kseg;
    unsigned voffA[2], voffB[2];
#pragma unroll
    for (int i = 0; i < 2; ++i) { int R, C; stage_rc(tid * 16 + i * 8192, R, C); const int Rb = Epi::PERM ? ((R & ~31) + perm32(R & 31)) : R;
        voffA[i] = (unsigned)(R * g.a_rs + C) * 2u; voffB[i] = (unsigned)(Rb * g.b_rs + C) * 2u; }
    const int kstep = BK * 2;
    const unsigned hstepA = (unsigned)HALF * g.a_rs * 2, hstepB = (unsigned)HALF * g.b_rs * 2;
    const unsigned tstepA = 2 * hstepA, tstepB = 2 * hstepB;
    const int segA = (g.a_seg - kseg * BK) * 2, segB = (g.b_seg - kseg * BK) * 2;
#define OFFA(t) ((t) * kstep + ((t) >= kseg ? segA : 0))
#define OFFB(t) ((t) * kstep + ((t) >= kseg ? segB : 0))
    const unsigned ldsw = (unsigned)wid * 1024u;
    const int aoff = lds_byte(wr * 64 + fr, fq * 8), boff = lds_byte(wc * 32 + fr, fq * 8);
#define PG8_SA(b, h) (((b) * 2 + (h)) * HTB)
#define PG8_SB(b, h) ((4 + (b) * 2 + (h)) * HTB)
#define PG8_STAGE(bufoff, gbase, voff) do { _Pragma("unroll") for (int _i = 0; _i < 2; ++_i) \
        __builtin_amdgcn_global_load_lds((const unsigned*)((const char*)(gbase) + (voff)[_i]), (LAS unsigned*)(lds + (bufoff) + ldsw + _i * 8192), 16, 0, 0); } while (0)
#define PG8_LDA(dst, b, h) do { _Pragma("unroll") for (int m = 0; m < 4; ++m) _Pragma("unroll") for (int k = 0; k < 2; ++k) dst[m][k] = *(const LAS bf16x8*)(lds + PG8_SA(b, h) + aoff + m * 2048 + k * 1024); } while (0)
#define PG8_LDB(dst, b, h) do { _Pragma("unroll") for (int n = 0; n < 2; ++n) _Pragma("unroll") for (int k = 0; k < 2; ++k) dst[n][k] = *(const LAS bf16x8*)(lds + PG8_SB(b, h) + boff + n * 2048 + k * 1024); } while (0)
#define PG8_MMA(ai, bj, At, Bt) do { __builtin_amdgcn_s_setprio(1); _Pragma("unroll") for (int m = 0; m < 4; ++m) _Pragma("unroll") for (int n = 0; n < 2; ++n) _Pragma("unroll") for (int k = 0; k < 2; ++k) \
        acc[ai][bj][m][n] = __builtin_amdgcn_mfma_f32_16x16x32_bf16(Bt[n][k], At[m][k], acc[ai][bj][m][n], 0, 0, 0); __builtin_amdgcn_s_setprio(0); } while (0)
#define PG8_WAIT_V(n) asm volatile("s_waitcnt vmcnt(" #n ")" ::: "memory")
#define PG8_WAIT_L(n) asm volatile("s_waitcnt lgkmcnt(" #n ")" ::: "memory")
#define PG8_BAR __builtin_amdgcn_s_barrier()
#define PG8_SCHED __builtin_amdgcn_sched_barrier(0)
    Unit cur, nxt; int ui = 0;
    if (!S.next(0, cur)) return;
    f32x4 acc[2][2][4][2];
#pragma unroll
    for (int a = 0; a < 2; ++a)
#pragma unroll
        for (int b = 0; b < 2; ++b)
#pragma unroll
            for (int m = 0; m < 4; ++m)
#pragma unroll
                for (int n = 0; n < 2; ++n) acc[a][b][m][n] = (f32x4){0.f, 0.f, 0.f, 0.f};
    bf16x8 At[4][2], B0[2][2], B1[2][2];
    const char* cA = (const char*)g.A + ((size_t)cur.pb * g.a_bs) * 2 + (size_t)cur.pm * tstepA;
    const char* cB = (const char*)g.Bt + ((size_t)cur.pb * g.b_bs) * 2 + (size_t)cur.pn * tstepB;
    {
        PG8_STAGE(PG8_SB(0, 0), cB, voffB); PG8_STAGE(PG8_SB(0, 1), cB + hstepB, voffB); PG8_STAGE(PG8_SA(0, 0), cA, voffA); PG8_STAGE(PG8_SA(0, 1), cA + hstepA, voffA);
        if (wr == 1) PG8_BAR;
        PG8_WAIT_V(2); PG8_BAR;
        PG8_STAGE(PG8_SB(1, 0), cB + OFFB(1), voffB); PG8_STAGE(PG8_SA(1, 0), cA + OFFA(1), voffA); PG8_STAGE(PG8_SB(1, 1), cB + hstepB + OFFB(1), voffB);
        PG8_WAIT_V(6); PG8_BAR;
    }
    for (;;) {
        const bool has_next = S.next(ui + 1, nxt);
        const char* nA = has_next ? (const char*)g.A + ((size_t)nxt.pb * g.a_bs) * 2 + (size_t)nxt.pm * tstepA : cA;
        const char* nB = has_next ? (const char*)g.Bt + ((size_t)nxt.pb * g.b_bs) * 2 + (size_t)nxt.pn * tstepB : cB;
        for (int t = 0; t < nt; t += 2) {
            const bool last = (t == nt - 2);
            const char* a1 = cA + OFFA(t + 1);
            const char* a2 = last ? nA : cA + OFFA(t + 2); const char* b2 = last ? nB : cB + OFFB(t + 2);
            const char* a3 = last ? nA + OFFA(1) : cA + OFFA(t + 3); const char* b3 = last ? nB + OFFB(1) : cB + OFFB(t + 3);
            PG8_LDB(B0, 0, 0); PG8_LDB(B1, 0, 1); PG8_SCHED; PG8_LDA(At, 0, 0); PG8_STAGE(PG8_SA(1, 1), a1 + hstepA, voffA);
            PG8_WAIT_V(8); PG8_WAIT_L(0); PG8_BAR; PG8_MMA(0, 0, At, B0); PG8_MMA(0, 1, At, B1); PG8_BAR; PG8_SCHED;
            PG8_LDA(At, 0, 1); PG8_STAGE(PG8_SB(0, 0), b2, voffB); PG8_STAGE(PG8_SB(0, 1), b2 + hstepB, voffB); PG8_STAGE(PG8_SA(0, 0), a2, voffA);
            PG8_WAIT_V(8); PG8_WAIT_L(0); PG8_BAR; PG8_MMA(1, 0, At, B0); PG8_MMA(1, 1, At, B1); PG8_BAR; PG8_SCHED;
            PG8_LDB(B0, 1, 0); PG8_LDB(B1, 1, 1); PG8_SCHED; PG8_LDA(At, 1, 0); PG8_STAGE(PG8_SA(0, 1), a2 + hstepA, voffA);
            PG8_WAIT_V(8); PG8_WAIT_L(0); PG8_BAR; PG8_MMA(0, 0, At, B0); PG8_MMA(0, 1, At, B1); PG8_BAR; PG8_SCHED;
            PG8_LDA(At, 1, 1); PG8_STAGE(PG8_SB(1, 0), b3, voffB); PG8_STAGE(PG8_SB(1, 1), b3 + hstepB, voffB); PG8_STAGE(PG8_SA(1, 0), a3, voffA);
            PG8_WAIT_V(8); PG8_WAIT_L(0); PG8_BAR; PG8_MMA(1, 0, At, B0); PG8_MMA(1, 1, At, B1); PG8_BAR; PG8_SCHED;
        }
        if (wr == 0) PG8_BAR;
        E(acc, cur, wr, wc, fr, fq);
        if (!has_next) break;
#pragma unroll
        for (int a = 0; a < 2; ++a)
#pragma unroll
            for (int b = 0; b < 2; ++b)
#pragma unroll
                for (int m = 0; m < 4; ++m)
#pragma unroll
                    for (int n = 0; n < 2; ++n) acc[a][b][m][n] = (f32x4){0.f, 0.f, 0.f, 0.f};
        cur = nxt; cA = nA; cB = nB; ++ui;
        if (wr == 1) PG8_BAR;
    }
    PG8_WAIT_V(0);
    PG8_BAR;
#undef OFFA
#undef OFFB
#undef PG8_SA
#undef PG8_SB
#undef PG8_STAGE
#undef PG8_LDA
#undef PG8_LDB
#undef PG8_MMA
#undef PG8_WAIT_V
#undef PG8_WAIT_L
#undef PG8_BAR
#undef PG8_SCHED
}
}

#define MFMA32(a, b, c) __builtin_amdgcn_mfma_f32_32x32x16_bf16((a), (b), (c), 0, 0, 0)
template <int D1, int D2, int DV>
DI void attn_core(f32x16 (&o)[DV / 32], float& l_out, LAS unsigned char* lds, const bf16_t* q1, const bf16_t* q2,
                  const bf16_t* k1, long ldk1, const bf16_t* k2, long ldk2, const bf16_t* vt, long ldv, int ntiles) {
    constexpr int DQK = D1 + D2, KROW = DQK * 2 + 16, VROW = 144, KT = 64 * KROW, VT = DV * VROW, BUF = KT + VT;
    constexpr int KCH = DQK / 8, NKC = 64 * KCH, NVC = DV * 8, KPT = (NKC + 511) / 512, VPT = NVC / 512;
    const int tid = otid(), lane = tid & 63, r = lane & 31, h = lane >> 5;
    bf16x8 qf[DQK / 16];
#pragma unroll
    for (int d0 = 0; d0 < DQK / 16; ++d0) qf[d0] = (16 * d0 < D1) ? *(const bf16x8*)(q1 + 16 * d0 + 8 * h) : *(const bf16x8*)(q2 + (16 * d0 - D1) + 8 * h);
    u32x4 kreg[KPT], vreg[VPT];
    auto gload = [&](int t) {
#pragma unroll
        for (int i = 0; i < KPT; ++i) { const int c = tid + i * 512; if (c < NKC) { const int row = c / KCH, cc = (c % KCH) * 8;
            kreg[i] = (cc < D1) ? *(const u32x4*)(k1 + (size_t)(t * 64 + row) * ldk1 + cc) : *(const u32x4*)(k2 + (size_t)(t * 64 + row) * ldk2 + (cc - D1)); } }
#pragma unroll
        for (int i = 0; i < VPT; ++i) { const int c = tid + i * 512; const int d = c >> 3, cc = (c & 7) * 8; vreg[i] = *(const u32x4*)(vt + (size_t)d * ldv + t * 64 + cc); }
    };
    auto sstore = [&](int b) {
        LAS unsigned char* kb = lds + b * BUF; LAS unsigned char* vb = kb + KT;
#pragma unroll
        for (int i = 0; i < KPT; ++i) { const int c = tid + i * 512; if (c < NKC) { const int row = c / KCH, cc = (c % KCH) * 8; *(LAS u32x4*)(kb + row * KROW + cc * 2) = kreg[i]; } }
#pragma unroll
        for (int i = 0; i < VPT; ++i) { const int c = tid + i * 512; const int d = c >> 3, cc = (c & 7) * 8; *(LAS u32x4*)(vb + d * VROW + cc * 2) = vreg[i]; }
    };
    const int pr = (r & ~12) | ((r & 4) << 1) | ((r & 8) >> 1);
    float mrun = 0.f, lrun = 0.f;
    f32x16 negm;
#pragma unroll
    for (int i = 0; i < 16; ++i) negm[i] = 0.f;
#pragma unroll
    for (int b = 0; b < DV / 32; ++b)
#pragma unroll
        for (int i = 0; i < 16; ++i) o[b][i] = 0.f;
    gload(0); sstore(0); __syncthreads();
    for (int t = 0; t < ntiles; ++t) {
        if (t + 1 < ntiles) gload(t + 1);
        const LAS unsigned char* kb = lds + (t & 1) * BUF; const LAS unsigned char* vb = kb + KT;
        f32x16 p[2];
#pragma unroll
        for (int hf = 0; hf < 2; ++hf) {
#pragma unroll
            for (int d0 = 0; d0 < DQK / 16; ++d0) { const bf16x8 ka = *(const LAS bf16x8*)(kb + (32 * hf + pr) * KROW + (16 * d0 + 8 * h) * 2);
                if (d0 == 0) p[hf] = MFMA32(ka, qf[0], negm); else p[hf] = MFMA32(ka, qf[d0], p[hf]); }
        }
        float ta = fmaxf(fmaxf(p[0][0], p[0][1]), p[1][0]), tb = fmaxf(fmaxf(p[0][2], p[0][3]), p[1][1]);
        ta = fmaxf(fmaxf(ta, p[1][2]), p[1][3]);
#pragma unroll
        for (int i = 4; i < 16; i += 4) { ta = fmaxf(fmaxf(ta, p[0][i]), p[0][i + 1]); tb = fmaxf(fmaxf(tb, p[0][i + 2]), p[0][i + 3]); ta = fmaxf(fmaxf(ta, p[1][i]), p[1][i + 1]); tb = fmaxf(fmaxf(tb, p[1][i + 2]), p[1][i + 3]); }
        float tm = fmaxf(ta, tb); tm = fmaxf(tm, __shfl_xor(tm, 32));
        if (__any(t == 0 || tm > 8.0f)) {
            const float dl = (t == 0 || tm > 0.f) ? tm : 0.f; mrun += dl;
            const float alpha = __builtin_amdgcn_exp2f(-dl); lrun *= alpha;
#pragma unroll
            for (int i = 0; i < 16; ++i) { p[0][i] -= dl; p[1][i] -= dl; negm[i] = -mrun; }
#pragma unroll
            for (int b = 0; b < DV / 32; ++b)
#pragma unroll
                for (int i = 0; i < 16; ++i) o[b][i] *= alpha;
        }
        float rs0 = 0.f, rs1 = 0.f;
#pragma unroll
        for (int i = 0; i < 16; ++i) { p[0][i] = __builtin_amdgcn_exp2f(p[0][i]); rs0 += p[0][i]; p[1][i] = __builtin_amdgcn_exp2f(p[1][i]); rs1 += p[1][i]; }
        lrun += rs0 + rs1;
        bf16x8 pf[4];
#pragma unroll
        for (int ks = 0; ks < 4; ++ks) { const int hf = ks >> 1, s8 = (ks & 1) * 8; u32x4 w;
            w.x = cvtpk(p[hf][s8 + 0], p[hf][s8 + 1]); w.y = cvtpk(p[hf][s8 + 2], p[hf][s8 + 3]); w.z = cvtpk(p[hf][s8 + 4], p[hf][s8 + 5]); w.w = cvtpk(p[hf][s8 + 6], p[hf][s8 + 7]);
            pf[ks] = __builtin_bit_cast(bf16x8, w); }
#pragma unroll
        for (int b = 0; b < DV / 32; ++b)
#pragma unroll
            for (int ks = 0; ks < 4; ++ks) { const bf16x8 va = *(const LAS bf16x8*)(vb + (32 * b + r) * VROW + (16 * ks + 8 * h) * 2); o[b] = MFMA32(va, pf[ks], o[b]); }
        if (t + 1 < ntiles) sstore((t + 1) & 1);
        __syncthreads();
    }
    l_out = lrun + __shfl_xor(lrun, 32);
}
constexpr int ATTN_LDS = 2 * (64 * (96 * 2 + 16) + 128 * 144);


#define XB_TMO      128
#define XB_XCNT(j)  (256  + 64 * (j))
#define XB_XSUB(j)  (1280 + 64 * (j))
#define XB_XGEN(j)  (2304 + 64 * (j))
#define XB_TOP      3328
#define XB_TOPGEN   3392
#define XCD_BAR_WORDS 3456
#define XB_SPIN_CAP (1u << 18)
DI unsigned xb_ld(unsigned* p)              { return __hip_atomic_load(p, __ATOMIC_RELAXED, __HIP_MEMORY_SCOPE_AGENT); }
DI unsigned xb_add(unsigned* p, unsigned v) { return __hip_atomic_fetch_add(p, v, __ATOMIC_RELAXED, __HIP_MEMORY_SCOPE_AGENT); }
DI unsigned xb_xcc_id() { return (unsigned)__builtin_amdgcn_s_getreg((3 << 11) | 20) & 0xFu; }
#define XB_SPIN(cond, bar) do { unsigned _sp = 0; while (cond) { __builtin_amdgcn_s_sleep(1); \
    if ((++_sp & 255u) == 0u) { if (xb_ld(&(bar)[XB_TMO])) break; if (_sp > XB_SPIN_CAP) { atomicAdd(&(bar)[XB_TMO], 1u); break; } } } } while (0)
struct XcdBarrier { unsigned* bar; unsigned x; volatile LAS unsigned* st; };
DI XcdBarrier xcd_barrier_post(unsigned* bar, volatile LAS unsigned* st) {
    XcdBarrier b; b.bar = bar; b.x = xb_xcc_id(); b.st = st;
    if (threadIdx.x == 0) (void)xb_add(&bar[XB_XCNT(b.x)], 1u);
    return b;
}
DI void xcd_barrier_complete(unsigned* bar, unsigned x, unsigned& nloc, unsigned& nx) {
    const unsigned G = gridDim.x * gridDim.y * gridDim.z;
    unsigned sum, cnt, mine, sp = 0u;
    for (;;) {
        sum = 0u; cnt = 0u; mine = 0u;
#pragma unroll
        for (unsigned j = 0; j < 16; ++j) { const unsigned c = xb_ld(&bar[XB_XCNT(j)]); sum += c; cnt += (c > 0u) ? 1u : 0u; mine = (j == x) ? c : mine; }
        if (sum == G) break;
        __builtin_amdgcn_s_sleep(1);
        if ((++sp & 255u) == 0u) { if (xb_ld(&bar[XB_TMO])) break; if (sp > XB_SPIN_CAP) { atomicAdd(&bar[XB_TMO], 1u); break; } }
    }
    nloc = mine > 0u ? mine : 1u; nx = cnt > 0u ? cnt : 1u;
}
DI void xcd_barrier(const XcdBarrier& b) {
    asm volatile("s_waitcnt vmcnt(0)" ::: "memory");
    __syncthreads();
    if (threadIdx.x == 0) {
        unsigned* bar = b.bar;
        __builtin_amdgcn_s_waitcnt(0);
        unsigned nloc = b.st[0], nx = b.st[1];
        if (nloc == 0u) { xcd_barrier_complete(bar, b.x, nloc, nx); b.st[0] = nloc; b.st[1] = nx; }
        const unsigned old = xb_add(&bar[XB_XSUB(b.x)], 1u);
        const unsigned gen = old / nloc;
        if (old + 1u == (gen + 1u) * nloc) {
            __builtin_amdgcn_fence(__ATOMIC_RELEASE, "agent");
            asm volatile("s_waitcnt vmcnt(0)" ::: "memory");
            const unsigned og = xb_add(&bar[XB_TOP], 1u);
            const unsigned tg = og / nx;
            if (og + 1u == (tg + 1u) * nx) xb_add(&bar[XB_TOPGEN], 1u);
            else XB_SPIN(xb_ld(&bar[XB_TOPGEN]) == tg, bar);
            __builtin_amdgcn_fence(__ATOMIC_ACQUIRE, "agent");
            xb_add(&bar[XB_XGEN(b.x)], 1u);
            asm volatile("s_waitcnt vmcnt(0)" ::: "memory");
        } else {
            XB_SPIN(xb_ld(&bar[XB_XGEN(b.x)]) == gen, bar);
            __builtin_amdgcn_fence(__ATOMIC_ACQUIRE, "agent");
            asm volatile("s_waitcnt vmcnt(0)" ::: "memory");
        }
    }
    __syncthreads();
}

struct Args {
    const float* in[35]; float* out; unsigned char* ws; int ph_lo, ph_hi;
};
enum { I_X = 0, I_C, I_CTX, I_CCTX,
       I0_WMOD, I0_BMOD, I0_WIN, I0_QN, I0_WUQ, I0_KVN, I0_WUKV, I0_WOUT, I0_LN1G, I0_LN1B, I0_WG, I0_WU, I0_WD, I0_LN2G, I0_LN2B,
       I1_WMOD, I1_BMOD, I1_WIN, I1_LQ1, I1_LK1, I1_LQ2, I1_LK2, I1_SUBLN, I1_WOUT, I1_LN1G, I1_LN1B, I1_WG, I1_WU, I1_WD, I1_LN2G, I1_LN2B };

DI bf16_t* tr_dst(int job, int n, unsigned char* ws) {
    switch (job) {
    case 0: return (bf16_t*)(ws + W_IN0) + (size_t)n * 1024;
    case 1: { const int hd = n / 96, d = n % 96; int row; if (d < 64) row = hd * 64 + d; else { const int e = d - 64, t = e >> 3, f = e & 7; row = 512 + hd * 32 + 16 * (t & 1) + 8 * (t >> 1) + f; }
              return (bf16_t*)(ws + W_UQ) + (size_t)row * 256; }
    case 2: { const int hd = n >> 7, d = n & 127; return d < 64 ? (bf16_t*)(ws + W_KN) + (size_t)(hd * 64 + d) * 256 : (bf16_t*)(ws + W_V0) + (size_t)(hd * 64 + d - 64) * 256; }
    case 3: return (bf16_t*)(ws + W_OUT0) + (size_t)n * 1024;
    case 4: return (bf16_t*)(ws + W_GU0) + (size_t)(256 * (n >> 7) + (n & 127)) * 1024;
    case 5: return (bf16_t*)(ws + W_GU0) + (size_t)(256 * (n >> 7) + 128 + (n & 127)) * 1024;
    case 6: return (bf16_t*)(ws + W_D0) + (size_t)n * 2816;
    case 7: return n < 2048 ? (bf16_t*)(ws + W_QK1) + (size_t)n * 1024 : (bf16_t*)(ws + W_V1) + (size_t)(n - 2048) * 1024;
    case 8: return (bf16_t*)(ws + W_OUT1) + (size_t)n * 1024;
    case 9: return (bf16_t*)(ws + W_GU1) + (size_t)(256 * (n >> 7) + (n & 127)) * 1024;
    case 10: return (bf16_t*)(ws + W_GU1) + (size_t)(256 * (n >> 7) + 128 + (n & 127)) * 1024;
    default: return (bf16_t*)(ws + W_D1) + (size_t)n * 2816;
    }
}
DI void transpose_item(const float* W, int K, int N, int job, unsigned char* ws, LAS float* scr, int item, int lane) {
    const int nblk = N / 32, kb = item / nblk, nb = item % nblk, k0 = 64 * kb, n0 = 32 * nb;
#pragma unroll 8
    for (int i = 0; i < 32; ++i) { const int kk = 2 * i + (lane >> 5); scr[kk * 33 + (lane & 31)] = W[(size_t)(k0 + kk) * N + n0 + (lane & 31)]; }
    asm volatile("s_waitcnt lgkmcnt(0)" ::: "memory");
    const int c = lane & 7;
#pragma unroll
    for (int j = 0; j < 4; ++j) { const int n = (lane >> 3) + 8 * j; const LAS float* s = scr + (8 * c) * 33 + n;
        u32x4 o; o.x = cvtpk(s[0 * 33], s[1 * 33]); o.y = cvtpk(s[2 * 33], s[3 * 33]); o.z = cvtpk(s[4 * 33], s[5 * 33]); o.w = cvtpk(s[6 * 33], s[7 * 33]);
        bf16_t* dst = tr_dst(job, n0 + n, ws); *(u32x4*)(dst + k0 + 8 * c) = o; }
    asm volatile("s_waitcnt lgkmcnt(0)" ::: "memory");
}

DI void prologue(const Args& a, LAS unsigned char* lds) {
    unsigned char* ws = a.ws;
    const int tid = otid(), lane = tid & 63, wave = tid >> 6;
    const int G = gridDim.x, gw = blockIdx.x * 8 + wave, NGW = G * 8;
    const long gt = (long)blockIdx.x * 512 + tid, NGT = (long)G * 512;
    {
        LAS float* scr = (LAS float*)(lds + wave * 16384);
        const int jin[12] = {I0_WIN, I0_WUQ, I0_WUKV, I0_WOUT, I0_WG, I0_WU, I0_WD, I1_WIN, I1_WOUT, I1_WG, I1_WU, I1_WD};
        const int jK[12] = {1024, 256, 256, 1024, 1024, 1024, 2816, 1024, 1024, 1024, 1024, 2816};
        const int jN[12] = {1056, 768, 1024, 1024, 2816, 2816, 1024, 3072, 1024, 2816, 2816, 1024};
        int base = 0;
#pragma unroll
        for (int j = 0; j < 12; ++j) { const int items = (jK[j] / 64) * (jN[j] / 32);
            for (int it = gw; it < items; it += NGW) transpose_item(a.in[jin[j]], jK[j], jN[j], j, ws, scr, it, lane);
            base += items; }
        u32x4 z = {0u, 0u, 0u, 0u};
        for (long i = gt; i < (1280 - 1056) * 1024 / 8; i += NGT) ((u32x4*)((bf16_t*)(ws + W_IN0) + (size_t)1056 * 1024))[i] = z;
    }
    {
        const float sc = 0.011048543456039806f;
        for (long i = gt; i < (long)4096 * 2048; i += NGT) { const int k = (int)(i >> 11), c8 = (int)(i & 2047) * 8; const int part = c8 >> 13, n0 = c8 & 8191; float v[8];
#pragma unroll
            for (int e = 0; e < 8; ++e) { const float ph = (float)((k * (n0 + e)) & 8191) * (1.0f / 8192.0f); v[e] = (part ? __builtin_amdgcn_sinf(ph) : __builtin_amdgcn_cosf(ph)) * sc; }
            u32x4 o; o.x = cvtpk(v[0], v[1]); o.y = cvtpk(v[2], v[3]); o.z = cvtpk(v[4], v[5]); o.w = cvtpk(v[6], v[7]);
            *(u32x4*)((bf16_t*)(ws + WS_DN) + (size_t)k * 16384 + c8) = o; }
        for (long i = gt; i < 256 * 512; i += NGT) { const int k = (int)(i >> 9), c = (int)(i & 511), part = c >> 8, n = c & 255; const float ph = (float)((k * n) & 255) * (1.0f / 256.0f);
            const float v = (part ? __builtin_amdgcn_sinf(ph) : __builtin_amdgcn_cosf(ph)) * 0.0625f; ((bf16_t*)(ws + W_D256))[i] = (bf16_t)(cvtpk(v, 0.f) & 0xffffu); }
        for (long i = gt; i < 256 * 128; i += NGT) { const int rr = (int)(i >> 7), c = (int)(i & 127), part = rr >> 7, l = rr & 127; const float ph = (float)((l * c) & 127) * (1.0f / 128.0f);
            const float v = (part ? -__builtin_amdgcn_sinf(ph) : __builtin_amdgcn_cosf(ph)) * 0.08838834764831845f; ((bf16_t*)(ws + W_DC))[i] = (bf16_t)(cvtpk(v, 0.f) & 0xffffu); }
        for (long i = gt; i < 128 * 16; i += NGT) { const int pos = (int)(i >> 4), f = (int)(i & 15); const float inv = 1.0f / powf(10000.0f, (float)f / 16.0f); const float ang = (float)pos * inv;
            ((f32x2*)(ws + WS_TAB16))[i] = (f32x2){cosf(ang), sinf(ang)}; }
        for (long i = gt; i < 128 * 8; i += NGT) { const int pos = (int)(i >> 3), f = (int)(i & 7); const float inv = 1.0f / powf(10000.0f, (float)f / 8.0f); const float ang = (float)pos * inv;
            ((f32x2*)(ws + WS_TAB8))[i] = (f32x2){cosf(ang), sinf(ang)}; }
    }
    {
        LAS float* red = (LAS float*)lds;
        for (int it = blockIdx.x; it < 2 * 96; it += G) {
            __syncthreads();
            const int layer = it / 96, n = (it % 96) * 64 + lane; const float* w = a.in[layer ? I1_WMOD : I0_WMOD]; const float* bm = a.in[layer ? I1_BMOD : I0_BMOD];
            float acc[5] = {0.f, 0.f, 0.f, 0.f, 0.f};
            for (int kk = 0; kk < 128; ++kk) { const int k = wave * 128 + kk; const float wv = w[(size_t)k * 6144 + n];
#pragma unroll
                for (int cls = 0; cls < 5; ++cls) { const float cv = cls < 4 ? a.in[I_C][cls * 1024 + k] : a.in[I_CCTX][k]; const float sl = cv / (1.0f + __expf(-cv)); acc[cls] += sl * wv; } }
#pragma unroll
            for (int cls = 0; cls < 5; ++cls) red[(wave * 5 + cls) * 64 + lane] = acc[cls];
            __syncthreads();
            if (tid < 320) { const int cls = tid >> 6, l = tid & 63; float s = 0.f;
#pragma unroll
                for (int w8 = 0; w8 < 8; ++w8) s += red[(w8 * 5 + cls) * 64 + l];
                const int nn = (it % 96) * 64 + l; ((float*)(ws + WS_MOD))[(size_t)(layer * 5 + cls) * 6144 + nn] = s + bm[nn]; }
        }
        __syncthreads();
    }
}

struct RowPass {
    const float* xl; const float* xc;
    float* ol; float* oc;
    const bf16_t* Y;
    const float* mod;
    int gate_off; const float* lng; const float* lnb;
    const float* mod2; int sc_off, sh_off;
    bf16_t* H;
};
DI void ln_stats(const f32x4 (&v)[4], float& mean, float& rstd) {
    float s = 0.f;
#pragma unroll
    for (int j = 0; j < 4; ++j) s += (v[j][0] + v[j][1]) + (v[j][2] + v[j][3]);
    mean = wave_sum(s) * (1.0f / DM); float q = 0.f;
#pragma unroll
    for (int j = 0; j < 4; ++j) { const f32x4 d = v[j] - mean; q += (d[0] * d[0] + d[1] * d[1]) + (d[2] * d[2] + d[3] * d[3]); }
    rstd = 1.0f / sqrtf(wave_sum(q) * (1.0f / DM) + LN_EPS);
}
DI void row_pass(const RowPass& P, int m, int lane) {
    const int b = m / TPB, j = m % TPB; const bool isctx = j < CTX; const int cls = isctx ? 4 : b;
    const size_t xoff = isctx ? (size_t)(b * CTX + j) * DM : (size_t)(b * SEQ + j - CTX) * DM;
    const float* xs = (isctx ? P.xc : P.xl) + xoff; float* xd = isctx ? P.oc : P.ol;
    f32x4 v[4];
#pragma unroll
    for (int jj = 0; jj < 4; ++jj) v[jj] = *(const f32x4*)(xs + 4 * lane + 256 * jj);
    if (P.Y) {
        const float* gate = P.mod + (size_t)cls * 6144 + P.gate_off;
#pragma unroll
        for (int jj = 0; jj < 4; ++jj) { const int c0 = 4 * lane + 256 * jj; const u32x2 yw = *(const u32x2*)(P.Y + (size_t)m * DM + c0); const f32x4 g = *(const f32x4*)(gate + c0);
            v[jj][0] = DN_ALPHA * v[jj][0] + g[0] * bflo(yw.x); v[jj][1] = DN_ALPHA * v[jj][1] + g[1] * bfhi(yw.x);
            v[jj][2] = DN_ALPHA * v[jj][2] + g[2] * bflo(yw.y); v[jj][3] = DN_ALPHA * v[jj][3] + g[3] * bfhi(yw.y); }
        float mean, rstd; ln_stats(v, mean, rstd);
#pragma unroll
        for (int jj = 0; jj < 4; ++jj) { const int c0 = 4 * lane + 256 * jj; const f32x4 g = *(const f32x4*)(P.lng + c0), bb = *(const f32x4*)(P.lnb + c0); v[jj] = (v[jj] - mean) * rstd * g + bb; }
        if (xd) {
#pragma unroll
            for (int jj = 0; jj < 4; ++jj) *(f32x4*)(xd + xoff + 4 * lane + 256 * jj) = v[jj];
        }
    }
    if (P.H) {
        float mean, rstd; ln_stats(v, mean, rstd);
        const float* sc = P.mod2 + (size_t)cls * 6144 + P.sc_off; const float* sh = P.mod2 + (size_t)cls * 6144 + P.sh_off;
#pragma unroll
        for (int jj = 0; jj < 4; ++jj) { const int c0 = 4 * lane + 256 * jj; const f32x4 s1 = *(const f32x4*)(sc + c0), s0 = *(const f32x4*)(sh + c0);
            const f32x4 hh = (v[jj] - mean) * rstd * (s1 + 1.0f) + s0; u32x2 w; w.x = cvtpk(hh[0], hh[1]); w.y = cvtpk(hh[2], hh[3]);
            *(u32x2*)(P.H + (size_t)m * DM + c0) = w; }
    }
}
DI void p3_row(const Args& a, int m, int lane) {
    unsigned char* ws = a.ws; const bf16_t* U = (const bf16_t*)(ws + WS_R3) + (size_t)m * 1280;
    const u32x2 qw = *(const u32x2*)(U + 512 + 4 * lane), kw = *(const u32x2*)(U + 768 + 4 * lane);
    float q[4] = {bflo(qw.x), bfhi(qw.x), bflo(qw.y), bfhi(qw.y)}, k[4] = {bflo(kw.x), bfhi(kw.x), bflo(kw.y), bfhi(kw.y)};
    const float qs = wave_sum(q[0] * q[0] + q[1] * q[1] + q[2] * q[2] + q[3] * q[3]), ks = wave_sum(k[0] * k[0] + k[1] * k[1] + k[2] * k[2] + k[3] * k[3]);
    const float qr = 1.0f / sqrtf(qs * (1.0f / 256.0f) + RMS_EPS), kr_ = 1.0f / sqrtf(ks * (1.0f / 256.0f) + RMS_EPS);
    const f32x4 qg = *(const f32x4*)(a.in[I0_QN] + 4 * lane), kg = *(const f32x4*)(a.in[I0_KVN] + 4 * lane);
    u32x2 w; w.x = cvtpk(q[0] * qr * qg[0], q[1] * qr * qg[1]); w.y = cvtpk(q[2] * qr * qg[2], q[3] * qr * qg[3]);
    *(u32x2*)((bf16_t*)(ws + WS_CQN) + (size_t)m * 256 + 4 * lane) = w;
    w.x = cvtpk(k[0] * kr_ * kg[0], k[1] * kr_ * kg[1]); w.y = cvtpk(k[2] * kr_ * kg[2], k[3] * kr_ * kg[3]);
    *(u32x2*)((bf16_t*)(ws + WS_CKVN) + (size_t)m * 256 + 4 * lane) = w;
    const int d = lane & 31, t = d >> 3, f = d & 7; const float val = bf2f(U[1024 + d]); const float par = __shfl_xor(val, 8);
    const int j = m % TPB, tt = j - CTX; float outv = val;
    if (tt >= 0) { const int pos = (t < 2) ? (tt >> 6) : (tt & 63); const f32x2 cs = ((const f32x2*)(ws + WS_TAB8))[pos * 8 + f];
        outv = (t & 1) ? (par * cs[1] + val * cs[0]) : (val * cs[0] - par * cs[1]); }
    if (lane < 32) ((bf16_t*)(ws + WS_KR))[(size_t)m * 32 + 16 * (t & 1) + 8 * (t >> 1) + f] = (bf16_t)(cvtpk(outv, 0.f) & 0xffffu);
}
DI void mirror_items(const Args& a, int gw, int NGW, int lane) {
    unsigned char* ws = a.ws; bf16_t* MIX = (bf16_t*)(ws + WS_R3); const bf16_t* At = (const bf16_t*)(ws + WS_R2);
    for (int it = gw; it < NB * 512; it += NGW) { const int b = it >> 9, ch = it & 511; const bf16_t* src = At + (size_t)ch * ROWS + b * TPB + CTX; float s = 0.f;
        for (int i = 0; i < 16; ++i) { const u32x4 w = *(const u32x4*)(src + (i * 64 + lane) * 8);
            s += (bflo(w.x) - bfhi(w.x)) + (bflo(w.y) - bfhi(w.y)) + (bflo(w.z) - bfhi(w.z)) + (bflo(w.w) - bfhi(w.w)); }
        s = wave_sum(s) * 0.011048543456039806f;
        if (lane == 0) MIX[(size_t)(b * TPB + CTX + 4096) * DM + ch] = (bf16_t)(cvtpk(s, 0.f) & 0xffffu); }
    for (int it = gw; it < NB * 4095; it += NGW) { const int b = it / 4095, k = 1 + it % 4095;
        const bf16_t* src = MIX + (size_t)(b * TPB + CTX + k) * DM; bf16_t* dst = MIX + (size_t)(b * TPB + CTX + 8192 - k) * DM;
        const int g = lane >> 4, l0 = 8 * (lane & 15); unsigned short e[8];
#pragma unroll
        for (int i = 0; i < 8; ++i) e[i] = src[g * 128 + ((128 - (l0 + i)) & 127)];
        u32x4 w; w.x = e[0] | ((unsigned)e[1] << 16); w.y = e[2] | ((unsigned)e[3] << 16); w.z = e[4] | ((unsigned)e[5] << 16); w.w = e[6] | ((unsigned)e[7] << 16);
        *(u32x4*)(dst + g * 128 + l0) = w; }
}

DI bool attn_unit_map(int L, int nunits_big, int& bh, int& qb) {
    if (L < nunits_big) { const int i = L >> 8, c = L & 255; bh = 4 * (c & 7) + i; qb = 1 + (c >> 3); return true; }
    bh = L - nunits_big; qb = 0; return bh < 32;
}
DI void attn_mla_unit(const Args& a, LAS unsigned char* lds, int bh, int qb) {
    unsigned char* ws = a.ws; const int tid = otid(), lane = tid & 63, wave = tid >> 6, r = lane & 31, h = lane >> 5;
    const int b = bh >> 3, hd = bh & 7; const int m = b * TPB + qb * 256 + wave * 32 + r;
    const bf16_t* Q = (const bf16_t*)(ws + WS_Q) + (size_t)m * 768;
    const bf16_t* KN = (const bf16_t*)(ws + WS_KN) + (size_t)(b * TPB) * 512 + hd * 64;
    const bf16_t* KR = (const bf16_t*)(ws + WS_KR) + (size_t)(b * TPB) * 32;
    const bf16_t* VT = (const bf16_t*)(ws + WS_VT0) + (size_t)(hd * 64) * ROWS + b * TPB;
    f32x16 o[2]; float l;
    attn_core<64, 32, 64>(o, l, lds, Q + hd * 64, Q + 512 + hd * 32, KN, 512, KR, 32, VT, ROWS, qb == 0 ? CTX / 64 : TPB / 64);
    const float il = 1.0f / l; bf16_t* dst = (bf16_t*)(ws + WS_R3) + (size_t)m * DM + 512 + hd * 64;
#pragma unroll
    for (int blk = 0; blk < 2; ++blk)
#pragma unroll
        for (int g = 0; g < 4; ++g) { u32x2 w; w.x = cvtpk(o[blk][4 * g] * il, o[blk][4 * g + 1] * il); w.y = cvtpk(o[blk][4 * g + 2] * il, o[blk][4 * g + 3] * il);
            *(u32x2*)(dst + 32 * blk + 8 * g + 4 * h) = w; }
}
DI void attn_diff_unit(const Args& a, LAS unsigned char* lds, int bh, int qb, float lam) {
    unsigned char* ws = a.ws; const int tid = otid(), lane = tid & 63, wave = tid >> 6, r = lane & 31, h = lane >> 5;
    const int b = bh >> 3, hd = bh & 7; const int m = b * TPB + qb * 256 + wave * 32 + r;
    const bf16_t* QK = (const bf16_t*)(ws + WS_R3);
    const bf16_t* VT = (const bf16_t*)(ws + WS_VT1) + (size_t)(hd * 128) * ROWS + b * TPB;
    LAS unsigned* stash = (LAS unsigned*)(lds + 55296) + wave * 2048 + lane;
    f32x16 o[4]; float l;
    {
        const bf16_t* q = QK + (size_t)m * 2048 + (hd * 2) * 64; const bf16_t* k = QK + (size_t)(b * TPB) * 2048 + 1024 + (hd * 2) * 64;
        attn_core<64, 0, 128>(o, l, lds, q, q, k, 2048, k, 2048, VT, ROWS, TPB / 64);
        const float il = 1.0f / l;
#pragma unroll
        for (int blk = 0; blk < 4; ++blk)
#pragma unroll
            for (int i = 0; i < 8; ++i) stash[(blk * 8 + i) * 64] = cvtpk(o[blk][2 * i] * il, o[blk][2 * i + 1] * il);
    }
    {
        const bf16_t* q = QK + (size_t)m * 2048 + (hd * 2 + 1) * 64; const bf16_t* k = QK + (size_t)(b * TPB) * 2048 + 1024 + (hd * 2 + 1) * 64;
        attn_core<64, 0, 128>(o, l, lds, q, q, k, 2048, k, 2048, VT, ROWS, TPB / 64);
    }
    const float il = lam / l; float ss = 0.f;
#pragma unroll
    for (int blk = 0; blk < 4; ++blk)
#pragma unroll
        for (int i = 0; i < 8; ++i) { const unsigned aw = stash[(blk * 8 + i) * 64]; const float x0 = bflo(aw) - o[blk][2 * i] * il, x1 = bfhi(aw) - o[blk][2 * i + 1] * il; o[blk][2 * i] = x0; o[blk][2 * i + 1] = x1; ss += x0 * x0 + x1 * x1; }
    ss += __shfl_xor(ss, 32);
    const float rn = (1.0f - LAMBDA_INIT) / sqrtf(ss * (1.0f / 128.0f) + RMS_EPS);
    const float* sub = a.in[I1_SUBLN]; bf16_t* dst = (bf16_t*)(ws + WS_R2) + (size_t)m * DM + hd * 128;
#pragma unroll
    for (int blk = 0; blk < 4; ++blk)
#pragma unroll
        for (int g = 0; g < 4; ++g) { const int d0 = 32 * blk + 8 * g + 4 * h; const f32x4 sg = *(const f32x4*)(sub + d0);
            u32x2 w; w.x = cvtpk(o[blk][4 * g] * rn * sg[0], o[blk][4 * g + 1] * rn * sg[1]); w.y = cvtpk(o[blk][4 * g + 2] * rn * sg[2], o[blk][4 * g + 3] * rn * sg[3]);
            *(u32x2*)(dst + d0) = w; }
}

constexpr int NPHASES = 18;
constexpr int LDS_BYTES = 147456;
struct GOp { int kind; pg8::Gemm g; bf16_t* O; int ldc, o_bs, ai_extra; float scale; int q_tiles, rope_from; };

DI bool get_gemm(int ph, int sub, const Args& a, GOp& op) {
    unsigned char* ws = a.ws;
    bf16_t* R2 = (bf16_t*)(ws + WS_R2); bf16_t* R3 = (bf16_t*)(ws + WS_R3);
    op.kind = 0; op.o_bs = 0; op.ai_extra = 0; op.scale = 1.0f; op.q_tiles = 0; op.rope_from = 0;
    pg8::Gemm& g = op.g; g.nB = 1; g.a_bs = 0; g.b_bs = 0; g.rot = 0; g.a_seg = 0; g.b_seg = 0;
#define SETK(k_) do { g.K = (k_); g.kseg = (k_) / 64; g.a_seg = (k_); g.b_seg = (k_); } while (0)
    switch (ph * 8 + sub) {
    case 2 * 8 + 0:
        g.A = R2; g.a_rs = 1024; g.nM = NRT; g.Bt = (const bf16_t*)(ws + W_IN0); g.b_rs = 1024; g.nN = 5; SETK(1024); op.O = R3; op.ldc = 1280; return true;
    case 3 * 8 + 0:
        g.A = (const bf16_t*)(ws + W_DC); g.a_rs = 128; g.nM = 1; g.Bt = R3; g.b_rs = 1280; g.nN = NRT; g.nB = 4; g.b_bs = 128; SETK(128);
        op.O = R2; op.ldc = ROWS; op.o_bs = 128 * ROWS; op.ai_extra = 384 * ROWS; return true;
    case 4 * 8 + 0:
        op.kind = 1; g.A = (const bf16_t*)(ws + WS_CQN); g.a_rs = 256; g.nM = NRT; g.Bt = (const bf16_t*)(ws + W_UQ); g.b_rs = 256; g.nN = 3; SETK(256);
        op.O = (bf16_t*)(ws + WS_Q); op.ldc = 768; op.scale = MLA_QSCALE; op.q_tiles = 3; op.rope_from = 2; return true;
    case 4 * 8 + 1:
        g.A = (const bf16_t*)(ws + WS_CKVN); g.a_rs = 256; g.nM = NRT; g.Bt = (const bf16_t*)(ws + W_KN); g.b_rs = 256; g.nN = 2; SETK(256); g.rot = 140;
        op.O = (bf16_t*)(ws + WS_KN); op.ldc = 512; return true;
    case 4 * 8 + 2:
        g.A = (const bf16_t*)(ws + W_V0); g.a_rs = 256; g.nM = 2; g.Bt = (const bf16_t*)(ws + WS_CKVN); g.b_rs = 256; g.nN = NRT; SETK(256); g.rot = 148;
        op.O = (bf16_t*)(ws + WS_VT0); op.ldc = ROWS; return true;
    case 4 * 8 + 3:
        g.A = (const bf16_t*)(ws + WS_DN); g.a_rs = 16384; g.nM = 16; g.Bt = R2 + CTX; g.b_rs = ROWS; g.nN = 2; g.nB = 4; g.b_bs = TPB; g.K = 16384; g.kseg = 128; g.a_seg = 8192; g.b_seg = 512 * ROWS; g.rot = 156;
        op.O = R3 + (size_t)CTX * DM; op.ldc = DM; op.o_bs = TPB * DM; return true;
    case 4 * 8 + 4:
        g.A = (const bf16_t*)(ws + W_D256); g.a_rs = 512; g.nM = 1; g.Bt = R2; g.b_rs = ROWS; g.nN = 2; g.nB = 4; g.b_bs = TPB; g.K = 512; g.kseg = 4; g.a_seg = 256; g.b_seg = 512 * ROWS; g.rot = 28;
        op.O = R3; op.ldc = DM; op.o_bs = TPB * DM; return true;
    case 6 * 8 + 0:
        g.A = R3; g.a_rs = 1024; g.nM = NRT; g.Bt = (const bf16_t*)(ws + W_OUT0); g.b_rs = 1024; g.nN = 4; SETK(1024); op.O = (bf16_t*)(ws + WS_Y0); op.ldc = DM; return true;
    case 8 * 8 + 0: case 15 * 8 + 0:
        op.kind = 3; g.A = R2; g.a_rs = 1024; g.nM = NRT; g.Bt = (const bf16_t*)(ws + (ph == 8 ? W_GU0 : W_GU1)); g.b_rs = 1024; g.nN = 22; SETK(1024); op.O = R3; op.ldc = FF; return true;
    case 9 * 8 + 0: case 16 * 8 + 0:
        g.A = R3; g.a_rs = FF; g.nM = NRT; g.Bt = (const bf16_t*)(ws + (ph == 9 ? W_D0 : W_D1)); g.b_rs = FF; g.nN = 4; SETK(FF); op.O = R2; op.ldc = DM; return true;
    case 11 * 8 + 0:
        op.kind = 2; g.A = R2; g.a_rs = 1024; g.nM = NRT; g.Bt = (const bf16_t*)(ws + W_QK1); g.b_rs = 1024; g.nN = 8; SETK(1024);
        op.O = R3; op.ldc = 2048; op.scale = DIFF_QSCALE; op.q_tiles = 4; op.rope_from = 0; return true;
    case 11 * 8 + 1:
        g.A = (const bf16_t*)(ws + W_V1); g.a_rs = 1024; g.nM = 4; g.Bt = R2; g.b_rs = 1024; g.nN = NRT; SETK(1024); g.rot = 32;
        op.O = (bf16_t*)(ws + WS_VT1); op.ldc = ROWS; return true;
    case 13 * 8 + 0:
        g.A = R2; g.a_rs = 1024; g.nM = NRT; g.Bt = (const bf16_t*)(ws + W_OUT1); g.b_rs = 1024; g.nN = 4; SETK(1024); op.O = R3; op.ldc = DM; return true;
    default: return false;
    }
#undef SETK
}

DI bool get_rowpass(int ph, const Args& a, RowPass& P) {
    unsigned char* ws = a.ws; const float* MOD0 = (const float*)(ws + WS_MOD); const float* MOD1 = MOD0 + 5 * 6144;
    float* XC = (float*)(ws + WS_XC); bf16_t* R2 = (bf16_t*)(ws + WS_R2);
    switch (ph) {
    case 1:  P = RowPass{a.in[I_X], a.in[I_CTX], nullptr, nullptr, nullptr, MOD0, 0, nullptr, nullptr, MOD0, 1024, 0, R2}; return true;
    case 7:  P = RowPass{a.in[I_X], a.in[I_CTX], a.out, XC, (const bf16_t*)(ws + WS_Y0), MOD0, 2048, a.in[I0_LN1G], a.in[I0_LN1B], MOD0, 4096, 3072, R2}; return true;
    case 10: P = RowPass{a.out, XC, a.out, XC, R2, MOD0, 5120, a.in[I0_LN2G], a.in[I0_LN2B], MOD1, 1024, 0, R2}; return true;
    case 14: P = RowPass{a.out, XC, a.out, XC, (const bf16_t*)(ws + WS_R3), MOD1, 2048, a.in[I1_LN1G], a.in[I1_LN1B], MOD1, 4096, 3072, R2}; return true;
    case 17: P = RowPass{a.out, XC, a.out, XC, R2, MOD1, 5120, a.in[I1_LN2G], a.in[I1_LN2B], MOD1, 0, 0, nullptr}; return true;
    default: return false;
    }
}

__global__ void __launch_bounds__(512, 2) fwd_kernel(Args a) {
    extern __shared__ __attribute__((aligned(16))) unsigned char lds_raw[];
    LAS unsigned char* lds = (LAS unsigned char*)lds_raw;
    const int G = gridDim.x;
    volatile LAS unsigned* bst = (volatile LAS unsigned*)(lds + LDS_BYTES - 64);
    if (threadIdx.x < 2) bst[threadIdx.x] = 0u;
    __syncthreads();
    XcdBarrier xbar = xcd_barrier_post((unsigned*)(a.ws + WS_BAR), bst);
    for (int ph = a.ph_lo; ph < a.ph_hi; ++ph) {
        const int tid = otid(), lane = tid & 63, wave = __builtin_amdgcn_readfirstlane(tid >> 6);
        const int gw = blockIdx.x * 8 + wave, NGW = G * 8;
#ifndef NO_PRO
        if (ph == 0) prologue(a, lds);
#endif
        RowPass P;
        if (get_rowpass(ph, a, P)) { for (int m = gw; m < ROWS; m += NGW) row_pass(P, m, lane); }
        if (ph == 3) { for (int m = gw; m < ROWS; m += NGW) p3_row(a, m, lane); }
#ifndef NO_MLA
        if (ph == 5) {
            mirror_items(a, gw, NGW, lane);
            for (int L = blockIdx.x; ; L += G) { int bh, qb; if (!attn_unit_map(L, 1024, bh, qb)) break; attn_mla_unit(a, lds, bh, qb); }
        }
#endif
#ifndef NO_DIFF
        if (ph == 12) {
            const float p1 = wave_sum(a.in[I1_LQ1][lane] * a.in[I1_LK1][lane]), p2 = wave_sum(a.in[I1_LQ2][lane] * a.in[I1_LK2][lane]);
            const float lam = expf(p1) - expf(p2) + LAMBDA_INIT;
            for (int L = blockIdx.x; L < 1024; L += G) { int bh, qb; attn_unit_map(L, 1024, bh, qb); attn_diff_unit(a, lds, bh, qb, lam); }
        }
#endif
#ifndef NO_GEMM
        for (int sub = 0; sub < 8; ++sub) {
            GOp op; if (!get_gemm(ph, sub, a, op)) break;
            pg8::StaticOrder S; S.init(op.g.nM, op.g.nN, op.g.nB, G, (int)blockIdx.x, op.g.rot);
            if (op.kind == 0) { pg8::EpiStore E{op.O, op.ldc, op.o_bs, op.ai_extra, op.scale}; pg8::gemm_phase(lds, op.g, S, E); }
            else if (op.kind == 1) { pg8::EpiRope<8> E{op.O, op.ldc, op.scale, op.q_tiles, op.rope_from, (const f32x2*)(a.ws + WS_TAB8)}; pg8::gemm_phase(lds, op.g, S, E); }
            else if (op.kind == 2) { pg8::EpiRope<16> E{op.O, op.ldc, op.scale, op.q_tiles, op.rope_from, (const f32x2*)(a.ws + WS_TAB16)}; pg8::gemm_phase(lds, op.g, S, E); }
            else { pg8::EpiSwiglu E{op.O, op.ldc}; pg8::gemm_phase(lds, op.g, S, E); }
        }
#endif
        if (ph + 1 < a.ph_hi) { if (ph == a.ph_lo) { __threadfence(); cg::this_grid().sync(); } else xcd_barrier(xbar); }
    }
}

extern "C" void kernel_launch(void* const* d_in, const int* in_sizes, int n_in, void* d_out, int out_size, void* d_ws, size_t ws_size, hipStream_t stream) {
    static int grid = 0;
    if (grid == 0) {
        if (n_in != 35 || ws_size < WS_END) { fprintf(stderr, "kernel_launch: unexpected n_in %d / ws %zu (need %zu)\n", n_in, ws_size, (size_t)WS_END); grid = -1; return; }
        int dev = 0, cus = 0, per_cu = 0;
        hipGetDevice(&dev); hipDeviceGetAttribute(&cus, hipDeviceAttributeMultiprocessorCount, dev);
        hipFuncSetAttribute((const void*)fwd_kernel, hipFuncAttributeMaxDynamicSharedMemorySize, LDS_BYTES);
        hipOccupancyMaxActiveBlocksPerMultiprocessor(&per_cu, (const void*)fwd_kernel, 512, LDS_BYTES);
        if (per_cu < 1) { fprintf(stderr, "kernel_launch: occupancy query says %d blocks/CU\n", per_cu); per_cu = 1; }
        (void)hipGetLastError();
        grid = cus * 1;
    }
    if (grid < 0) return;
    Args a{};
    for (int i = 0; i < 35; ++i) a.in[i] = (const float*)d_in[i];
    a.out = (float*)d_out; a.ws = (unsigned char*)d_ws;
#if MK_MULTI
    for (int ph = 0; ph < NPHASES; ++ph) { a.ph_lo = ph; a.ph_hi = ph + 1; hipLaunchKernelGGL(fwd_kernel, dim3(grid), dim3(512), LDS_BYTES, stream, a); }
#else
    a.ph_lo = 0; a.ph_hi = NPHASES;
    hipMemsetAsync((char*)d_ws + WS_BAR, 0, 16384, stream);
    void* args[] = {&a};
    hipError_t e = hipLaunchCooperativeKernel((const void*)fwd_kernel, dim3(grid), dim3(512), args, LDS_BYTES, stream);
    if (e != hipSuccess) fprintf(stderr, "cooperative launch failed: %s (grid %d)\n", hipGetErrorString(e), grid);
#endif
}
```

```cpp
#include <hip/hip_runtime.h>
#include <hip/hip_cooperative_groups.h>
#include <cstdio>
#include <cstdint>
namespace cg = cooperative_groups;

#ifndef MK_MULTI
#define MK_MULTI 0
#endif

#define DI __device__ __forceinline__
#define LAS __attribute__((address_space(3)))
typedef unsigned short bf16_t;
typedef short bf16x8 __attribute__((ext_vector_type(8)));
typedef float f32x4 __attribute__((ext_vector_type(4)));
typedef float f32x2 __attribute__((ext_vector_type(2)));
typedef float f32x16 __attribute__((ext_vector_type(16)));
typedef unsigned u32x4 __attribute__((ext_vector_type(4)));
typedef unsigned u32x2 __attribute__((ext_vector_type(2)));
typedef __bf16 bf16x2_t __attribute__((ext_vector_type(2)));

constexpr int DM = 1024, NB = 4, SEQ = 8192, CTX = 256, TPB = SEQ + CTX  , ROWS = NB * TPB  , FF = 2816;
constexpr int NRT = ROWS / 256;
constexpr float LN_EPS = 1e-6f, RMS_EPS = 1e-6f;
constexpr float DN_ALPHA = 1.41421356237f;
constexpr float LOG2E = 1.4426950408889634f;
constexpr float MLA_QSCALE = 0.10206207261596577f * LOG2E;
constexpr float DIFF_QSCALE = 0.125f * LOG2E;
constexpr float LAMBDA_INIT = 0.35550906f;

constexpr size_t MiB = 1u << 20;
constexpr size_t WS_MOD = 0;
constexpr size_t WS_TAB16 = 256 * 1024;
constexpr size_t WS_TAB8 = WS_TAB16 + 16384;
constexpr size_t WS_BAR = 512 * 1024;
constexpr size_t WS_XC = 1 * MiB;
constexpr size_t WS_W = 5 * MiB;
constexpr size_t W_IN0 = WS_W;
constexpr size_t W_UQ = W_IN0 + 1280 * 1024 * 2;
constexpr size_t W_KN = W_UQ + 768 * 256 * 2;
constexpr size_t W_V0 = W_KN + 512 * 256 * 2;
constexpr size_t W_OUT0 = W_V0 + 512 * 256 * 2;
constexpr size_t W_GU0 = W_OUT0 + 1024 * 1024 * 2;
constexpr size_t W_D0 = W_GU0 + 5632 * 1024 * 2;
constexpr size_t W_QK1 = W_D0 + 1024 * 2816 * 2;
constexpr size_t W_V1 = W_QK1 + 2048 * 1024 * 2;
constexpr size_t W_OUT1 = W_V1 + 1024 * 1024 * 2;
constexpr size_t W_GU1 = W_OUT1 + 1024 * 1024 * 2;
constexpr size_t W_D1 = W_GU1 + 5632 * 1024 * 2;
constexpr size_t W_DC = W_D1 + 1024 * 2816 * 2;
constexpr size_t W_D256 = W_DC + 256 * 128 * 2;
constexpr size_t W_END = W_D256 + 256 * 512 * 2;
static_assert(W_END <= 56 * MiB, "weights region");
constexpr size_t WS_DN = 56 * MiB;
constexpr size_t WS_R2 = 184 * MiB;
constexpr size_t WS_R3 = 250 * MiB;
constexpr size_t WS_R4 = WS_R3 + (size_t)ROWS * 1280 * 2;
constexpr size_t WS_CQN = WS_R4, WS_CKVN = WS_R4 + (size_t)ROWS * 256 * 2;
constexpr size_t WS_R5 = WS_R4 + (size_t)ROWS * 512 * 2;
constexpr size_t WS_Q = WS_R5;
constexpr size_t WS_KN = WS_Q + (size_t)ROWS * 768 * 2;
constexpr size_t WS_KR = WS_KN + (size_t)ROWS * 512 * 2;
constexpr size_t WS_VT0 = WS_KR + (size_t)ROWS * 32 * 2;
constexpr size_t WS_END = WS_VT0 + (size_t)512 * ROWS * 2;
constexpr size_t WS_Y0 = WS_R5;
constexpr size_t WS_PS = WS_R3 + (size_t)ROWS * DM * 2;
static_assert(WS_PS + (size_t)4 * 4096 * 512 * 2 <= WS_R4, "ps");
constexpr size_t WS_VT1 = WS_R3 + (size_t)ROWS * 2048 * 2;
static_assert(WS_END <= 512 * MiB, "workspace");
static_assert(WS_VT1 + (size_t)1024 * ROWS * 2 <= WS_END, "vt1");
static_assert(WS_R3 + (size_t)ROWS * FF * 2 <= WS_END, "hid");

DI int otid() { int t = threadIdx.x; asm volatile("" : "+v"(t)); return t; }
DI float wave_sum(float v) {
#pragma unroll
    for (int o = 1; o < 64; o <<= 1) v += __shfl_xor(v, o);
    return v;
}
DI unsigned cvtpk(float lo, float hi) { f32x2 v = {lo, hi}; bf16x2_t b = __builtin_convertvector(v, bf16x2_t); return __builtin_bit_cast(unsigned, b); }
DI float bf2f(unsigned short b) { return __uint_as_float(((unsigned)b) << 16); }
DI float bflo(unsigned w) { return __uint_as_float(w << 16); }
DI float bfhi(unsigned w) { return __uint_as_float(w & 0xffff0000u); }

namespace pg8 {
constexpr int BM = 256, BK = 64, HALF = 128, HTB = HALF * BK * 2, STAGE_BYTES = 8 * HTB, NXCD = 8, WGM = 8;
__host__ __device__ __forceinline__ int lds_byte(int r, int c) { const int st = (r >> 4) * 2 + (c >> 5), rr = r & 15, cc = c & 31, ob = rr * 64 + cc * 2; return st * 1024 + (ob ^ (((ob >> 9) & 1) << 5)); }
__host__ __device__ __forceinline__ void stage_rc(int b, int& R, int& C) { const int st = b / 1024, sb = b % 1024, swz = sb ^ (((sb >> 9) & 1) << 5); R = (st >> 1) * 16 + swz / 64; C = (st & 1) * 32 + (swz % 64) / 2; }
__host__ __device__ __forceinline__ int perm32(int rho) { const int n = rho >> 4, i = rho & 15; return 8 * (i >> 2) + 4 * n + (i & 3); }

struct Unit { int pm, pn, pb; };
struct Gemm {
    const bf16_t* A; const bf16_t* Bt; int nM, nN, nB, K, kseg;
    int a_rs, b_rs, a_seg, b_seg, a_bs, b_bs;
    int rot, skipctx;
};
struct StaticOrder {
    int nM, nN, nwg, tot, G, c, skipctx;
    DI void init(int nM_, int nN_, int nB_, int G_, int c_, int rot, int skip) { skipctx = skip; nM = nM_; nN = nN_; nwg = nM * nN; tot = nwg * nB_; G = G_; c = (c_ + G_ - (rot % G_)) % G_; }
    DI bool next(int i, Unit& u) const {
        const long L = (long)i * G + c; if (L >= tot) return false;
        u.pb = (int)(L / nwg); int wgid = (int)(L % nwg);
        { const int q = nwg / NXCD, r = nwg % NXCD, xcd = wgid % NXCD, off = wgid / NXCD; wgid = (xcd < r ? xcd * (q + 1) : r * (q + 1) + (xcd - r) * q) + off; }
        const int nig = WGM * nN, gid = wgid / nig, fm = gid * WGM, gsz = (nM - fm) < WGM ? (nM - fm) : WGM;
        u.pm = fm + ((wgid % nig) % gsz); u.pn = (wgid % nig) / gsz; if (skipctx) u.pm += (u.pm >> 5) + 1; return true;
    }
};

struct EpiStore {
    static constexpr bool PERM = true;
    bf16_t* O; int ldc, o_bs, ai_extra; float scale;
    DI void operator()(const f32x4 (&acc)[2][2][4][2], const Unit& u, int wr, int wc, int fr, int fq) const {
        const int row0 = u.pm * BM + wr * 64 + fr, col0 = u.pn * BM + wc * 32 + 8 * fq;
        bf16_t* base = O + (size_t)u.pb * o_bs;
#pragma unroll
        for (int ai = 0; ai < 2; ++ai)
#pragma unroll
            for (int m = 0; m < 4; ++m) { bf16_t* rowp = base + (size_t)(row0 + ai * HALF + m * 16) * ldc + (size_t)ai * ai_extra + col0;
#pragma unroll
                for (int bj = 0; bj < 2; ++bj) { const f32x4 v0 = acc[ai][bj][m][0] * scale, v1 = acc[ai][bj][m][1] * scale;
                    u32x4 w; w.x = cvtpk(v0[0], v0[1]); w.y = cvtpk(v0[2], v0[3]); w.z = cvtpk(v1[0], v1[1]); w.w = cvtpk(v1[2], v1[3]);
                    *(u32x4*)(rowp + bj * HALF) = w; } }
    }
};
struct EpiSwiglu {
    static constexpr bool PERM = true;
    bf16_t* O; int ldc;
    DI void operator()(const f32x4 (&acc)[2][2][4][2], const Unit& u, int wr, int wc, int fr, int fq) const {
        const int row0 = u.pm * BM + wr * 64 + fr, col0 = u.pn * HALF + wc * 32 + 8 * fq;
#pragma unroll
        for (int ai = 0; ai < 2; ++ai)
#pragma unroll
            for (int m = 0; m < 4; ++m) { bf16_t* rowp = O + (size_t)(row0 + ai * HALF + m * 16) * ldc + col0; float h[8];
#pragma unroll
                for (int n = 0; n < 2; ++n)
#pragma unroll
                    for (int i = 0; i < 4; ++i) { const float g = acc[ai][0][m][n][i], up = acc[ai][1][m][n][i];
                        h[n * 4 + i] = g * __builtin_amdgcn_rcpf(1.0f + __builtin_amdgcn_exp2f(-g * LOG2E)) * up; }
                u32x4 w; w.x = cvtpk(h[0], h[1]); w.y = cvtpk(h[2], h[3]); w.z = cvtpk(h[4], h[5]); w.w = cvtpk(h[6], h[7]);
                *(u32x4*)rowp = w; }
    }
};
template <int MODE> struct EpiRope {
    static constexpr bool PERM = false;
    bf16_t* O; int ldc; float qscale; int q_tiles, rope_from; const f32x2* tab;
    DI void operator()(const f32x4 (&acc)[2][2][4][2], const Unit& u, int wr, int wc, int fr, int fq) const {
        const float sc = u.pn < q_tiles ? qscale : 1.0f; const bool rope_tile = u.pn >= rope_from;
        const int col0 = u.pn * BM + wc * 32 + 4 * fq;
#pragma unroll
        for (int ai = 0; ai < 2; ++ai)
#pragma unroll
            for (int m = 0; m < 4; ++m) {
                const int row = u.pm * BM + ai * HALF + wr * 64 + m * 16 + fr; const int j = row % TPB; const int t = j - CTX;
                f32x4 cs0 = {1.f, 0.f, 1.f, 0.f}, cs1 = {1.f, 0.f, 1.f, 0.f};
                if (rope_tile && t >= 0) {
                    int pos, f0;
                    if (MODE == 16) { pos = (wc & 1) ? (t & 63) : (t >> 6); f0 = 4 * fq; } else { pos = (fq >> 1) ? (t & 63) : (t >> 6); f0 = 4 * (fq & 1); }
                    const f32x4* tp = (const f32x4*)(tab + pos * MODE + f0); cs0 = tp[0]; cs1 = tp[1];
                }
                const float c[4] = {cs0[0], cs0[2], cs1[0], cs1[2]}, s[4] = {cs0[1], cs0[3], cs1[1], cs1[3]};
                bf16_t* rowp = O + (size_t)row * ldc + col0;
#pragma unroll
                for (int bj = 0; bj < 2; ++bj) { const f32x4 x1 = acc[ai][bj][m][0] * sc, x2 = acc[ai][bj][m][1] * sc; float o1[4], o2[4];
#pragma unroll
                    for (int i = 0; i < 4; ++i) { o1[i] = x1[i] * c[i] - x2[i] * s[i]; o2[i] = x1[i] * s[i] + x2[i] * c[i]; }
                    u32x2 w1, w2; w1.x = cvtpk(o1[0], o1[1]); w1.y = cvtpk(o1[2], o1[3]); w2.x = cvtpk(o2[0], o2[1]); w2.y = cvtpk(o2[2], o2[3]);
                    *(u32x2*)(rowp + bj * HALF) = w1; *(u32x2*)(rowp + bj * HALF + 16) = w2; }
            }
    }
};

template <class Epi>
DI void gemm_phase(LAS unsigned char* lds, const Gemm g, const StaticOrder& S, const Epi& E) {
    const int tid = otid(), wid = __builtin_amdgcn_readfirstlane(tid >> 6), lane = tid & 63, wr = wid >> 2, wc = wid & 3, fr = lane & 15, fq = lane >> 4;
    const int nt = g.K / BK, kseg = g.kseg;
    unsigned voffA[2], voffB[2];
#pragma unroll
    for (int i = 0; i < 2; ++i) { int R, C; stage_rc(tid * 16 + i * 8192, R, C); const int Rb = Epi::PERM ? ((R & ~31) + perm32(R & 31)) : R;
        voffA[i] = (unsigned)(R * g.a_rs + C) * 2u; voffB[i] = (unsigned)(Rb * g.b_rs + C) * 2u; }
    const int kstep = BK * 2;
    const unsigned hstepA = (unsigned)HALF * g.a_rs * 2, hstepB = (unsigned)HALF * g.b_rs * 2;
    const unsigned tstepA = 2 * hstepA, tstepB = 2 * hstepB;
    const int segA = (g.a_seg - kseg * BK) * 2, segB = (g.b_seg - kseg * BK) * 2;
#define OFFA(t) ((t) * kstep + ((t) >= kseg ? segA : 0))
#define OFFB(t) ((t) * kstep + ((t) >= kseg ? segB : 0))
    const unsigned ldsw = (unsigned)wid * 1024u;
    const int aoff = lds_byte(wr * 64 + fr, fq * 8), boff = lds_byte(wc * 32 + fr, fq * 8);
#define PG8_SA(b, h) (((b) * 2 + (h)) * HTB)
#define PG8_SB(b, h) ((4 + (b) * 2 + (h)) * HTB)
#define PG8_STAGE(bufoff, gbase, voff) do { _Pragma("unroll") for (int _i = 0; _i < 2; ++_i) \
        __builtin_amdgcn_global_load_lds((const unsigned*)((const char*)(gbase) + (voff)[_i]), (LAS unsigned*)(lds + (bufoff) + ldsw + _i * 8192), 16, 0, 0); } while (0)
#define PG8_LDA(dst, b, h) do { _Pragma("unroll") for (int m = 0; m < 4; ++m) _Pragma("unroll") for (int k = 0; k < 2; ++k) dst[m][k] = *(const LAS bf16x8*)(lds + PG8_SA(b, h) + aoff + m * 2048 + k * 1024); } while (0)
#define PG8_LDB(dst, b, h) do { _Pragma("unroll") for (int n = 0; n < 2; ++n) _Pragma("unroll") for (int k = 0; k < 2; ++k) dst[n][k] = *(const LAS bf16x8*)(lds + PG8_SB(b, h) + boff + n * 2048 + k * 1024); } while (0)
#define PG8_MMA(ai, bj, At, Bt) do { __builtin_amdgcn_s_setprio(1); _Pragma("unroll") for (int m = 0; m < 4; ++m) _Pragma("unroll") for (int n = 0; n < 2; ++n) _Pragma("unroll") for (int k = 0; k < 2; ++k) \
        acc[ai][bj][m][n] = __builtin_amdgcn_mfma_f32_16x16x32_bf16(Bt[n][k], At[m][k], acc[ai][bj][m][n], 0, 0, 0); __builtin_amdgcn_s_setprio(0); } while (0)
#define PG8_WAIT_V(n) asm volatile("s_waitcnt vmcnt(" #n ")" ::: "memory")
#define PG8_WAIT_L(n) asm volatile("s_waitcnt lgkmcnt(" #n ")" ::: "memory")
#define PG8_BAR __builtin_amdgcn_s_barrier()
#define PG8_SCHED __builtin_amdgcn_sched_barrier(0)
    Unit cur, nxt; int ui = 0;
    if (!S.next(0, cur)) return;
    f32x4 acc[2][2][4][2];
#pragma unroll
    for (int a = 0; a < 2; ++a)
#pragma unroll
        for (int b = 0; b < 2; ++b)
#pragma unroll
            for (int m = 0; m < 4; ++m)
#pragma unroll
                for (int n = 0; n < 2; ++n) acc[a][b][m][n] = (f32x4){0.f, 0.f, 0.f, 0.f};
    bf16x8 At[4][2], B0[2][2], B1[2][2];
    const char* cA = (const char*)g.A + ((size_t)cur.pb * g.a_bs) * 2 + (size_t)cur.pm * tstepA;
    const char* cB = (const char*)g.Bt + ((size_t)cur.pb * g.b_bs) * 2 + (size_t)cur.pn * tstepB;
    {
        PG8_STAGE(PG8_SB(0, 0), cB, voffB); PG8_STAGE(PG8_SB(0, 1), cB + hstepB, voffB); PG8_STAGE(PG8_SA(0, 0), cA, voffA); PG8_STAGE(PG8_SA(0, 1), cA + hstepA, voffA);
        if (wr == 1) PG8_BAR;
        PG8_WAIT_V(2); PG8_BAR;
        PG8_STAGE(PG8_SB(1, 0), cB + OFFB(1), voffB); PG8_STAGE(PG8_SA(1, 0), cA + OFFA(1), voffA); PG8_STAGE(PG8_SB(1, 1), cB + hstepB + OFFB(1), voffB);
        PG8_WAIT_V(6); PG8_BAR;
    }
    for (;;) {
        const bool has_next = S.next(ui + 1, nxt);
        const char* nA = has_next ? (const char*)g.A + ((size_t)nxt.pb * g.a_bs) * 2 + (size_t)nxt.pm * tstepA : cA;
        const char* nB = has_next ? (const char*)g.Bt + ((size_t)nxt.pb * g.b_bs) * 2 + (size_t)nxt.pn * tstepB : cB;
        for (int t = 0; t < nt; t += 2) {
            const bool last = (t == nt - 2);
            const char* a1 = cA + OFFA(t + 1);
            const char* a2 = last ? nA : cA + OFFA(t + 2); const char* b2 = last ? nB : cB + OFFB(t + 2);
            const char* a3 = last ? nA + OFFA(1) : cA + OFFA(t + 3); const char* b3 = last ? nB + OFFB(1) : cB + OFFB(t + 3);
            PG8_LDB(B0, 0, 0); PG8_LDB(B1, 0, 1); PG8_SCHED; PG8_LDA(At, 0, 0); PG8_STAGE(PG8_SA(1, 1), a1 + hstepA, voffA);
            PG8_WAIT_V(8); PG8_WAIT_L(0); PG8_BAR; PG8_MMA(0, 0, At, B0); PG8_MMA(0, 1, At, B1); PG8_BAR; PG8_SCHED;
            PG8_LDA(At, 0, 1); PG8_STAGE(PG8_SB(0, 0), b2, voffB); PG8_STAGE(PG8_SB(0, 1), b2 + hstepB, voffB); PG8_STAGE(PG8_SA(0, 0), a2, voffA);
            PG8_WAIT_V(8); PG8_WAIT_L(0); PG8_BAR; PG8_MMA(1, 0, At, B0); PG8_MMA(1, 1, At, B1); PG8_BAR; PG8_SCHED;
            PG8_LDB(B0, 1, 0); PG8_LDB(B1, 1, 1); PG8_SCHED; PG8_LDA(At, 1, 0); PG8_STAGE(PG8_SA(0, 1), a2 + hstepA, voffA);
            PG8_WAIT_V(8); PG8_WAIT_L(0); PG8_BAR; PG8_MMA(0, 0, At, B0); PG8_MMA(0, 1, At, B1); PG8_BAR; PG8_SCHED;
            PG8_LDA(At, 1, 1); PG8_STAGE(PG8_SB(1, 0), b3, voffB); PG8_STAGE(PG8_SB(1, 1), b3 + hstepB, voffB); PG8_STAGE(PG8_SA(1, 0), a3, voffA);
            PG8_WAIT_V(8); PG8_WAIT_L(0); PG8_BAR; PG8_MMA(1, 0, At, B0); PG8_MMA(1, 1, At, B1); PG8_BAR; PG8_SCHED;
        }
        if (wr == 0) PG8_BAR;
        E(acc, cur, wr, wc, fr, fq);
        if (!has_next) break;
#pragma unroll
        for (int a = 0; a < 2; ++a)
#pragma unroll
            for (int b = 0; b < 2; ++b)
#pragma unroll
                for (int m = 0; m < 4; ++m)
#pragma unroll
                    for (int n = 0; n < 2; ++n) acc[a][b][m][n] = (f32x4){0.f, 0.f, 0.f, 0.f};
        cur = nxt; cA = nA; cB = nB; ++ui;
        if (wr == 1) PG8_BAR;
    }
    PG8_WAIT_V(0);
    PG8_BAR;
#undef OFFA
#undef OFFB
#undef PG8_SA
#undef PG8_SB
#undef PG8_STAGE
#undef PG8_LDA
#undef PG8_LDB
#undef PG8_MMA
#undef PG8_WAIT_V
#undef PG8_WAIT_L
#undef PG8_BAR
#undef PG8_SCHED
}
}

#define MFMA32(a, b, c) __builtin_amdgcn_mfma_f32_32x32x16_bf16((a), (b), (c), 0, 0, 0)
template <int D1, int D2, int DV>
DI void attn_core(f32x16 (&o)[DV / 32], float& l_out, LAS unsigned char* lds, const bf16_t* q1, const bf16_t* q2,
                  const bf16_t* k1, long ldk1, const bf16_t* k2, long ldk2, const bf16_t* vt, long ldv, int ntiles) {
    constexpr int DQK = D1 + D2, KROW = DQK * 2 + 16, VROW = 144, KT = 64 * KROW, VT = DV * VROW, BUF = KT + VT;
    constexpr int KCH = DQK / 8, NKC = 64 * KCH, NVC = DV * 8, KPT = (NKC + 511) / 512, VPT = NVC / 512;
    const int tid = otid(), lane = tid & 63, r = lane & 31, h = lane >> 5;
    bf16x8 qf[DQK / 16];
#pragma unroll
    for (int d0 = 0; d0 < DQK / 16; ++d0) qf[d0] = (16 * d0 < D1) ? *(const bf16x8*)(q1 + 16 * d0 + 8 * h) : *(const bf16x8*)(q2 + (16 * d0 - D1) + 8 * h);
    u32x4 kreg[KPT], vreg[VPT];
    auto gload = [&](int t) {
#pragma unroll
        for (int i = 0; i < KPT; ++i) { const int c = tid + i * 512; if (c < NKC) { const int row = c / KCH, cc = (c % KCH) * 8;
            kreg[i] = (cc < D1) ? *(const u32x4*)(k1 + (size_t)(t * 64 + row) * ldk1 + cc) : *(const u32x4*)(k2 + (size_t)(t * 64 + row) * ldk2 + (cc - D1)); } }
#pragma unroll
        for (int i = 0; i < VPT; ++i) { const int c = tid + i * 512; const int d = c >> 3, cc = (c & 7) * 8; vreg[i] = *(const u32x4*)(vt + (size_t)d * ldv + t * 64 + cc); }
    };
    auto sstore = [&](int b) {
        LAS unsigned char* kb = lds + b * BUF; LAS unsigned char* vb = kb + KT;
#pragma unroll
        for (int i = 0; i < KPT; ++i) { const int c = tid + i * 512; if (c < NKC) { const int row = c / KCH, cc = (c % KCH) * 8; *(LAS u32x4*)(kb + row * KROW + cc * 2) = kreg[i]; } }
#pragma unroll
        for (int i = 0; i < VPT; ++i) { const int c = tid + i * 512; const int d = c >> 3, cc = (c & 7) * 8; *(LAS u32x4*)(vb + d * VROW + cc * 2) = vreg[i]; }
    };
    const int pr = (r & ~12) | ((r & 4) << 1) | ((r & 8) >> 1);
    float mrun = 0.f, lrun = 0.f;
    f32x16 negm;
#pragma unroll
    for (int i = 0; i < 16; ++i) negm[i] = 0.f;
#pragma unroll
    for (int b = 0; b < DV / 32; ++b)
#pragma unroll
        for (int i = 0; i < 16; ++i) o[b][i] = 0.f;
    gload(0); sstore(0); __syncthreads();
    for (int t = 0; t < ntiles; ++t) {
        if (t + 1 < ntiles) gload(t + 1);
        const LAS unsigned char* kb = lds + (t & 1) * BUF; const LAS unsigned char* vb = kb + KT;
        f32x16 p[2];
#pragma unroll
        for (int hf = 0; hf < 2; ++hf) {
#pragma unroll
            for (int d0 = 0; d0 < DQK / 16; ++d0) { const bf16x8 ka = *(const LAS bf16x8*)(kb + (32 * hf + pr) * KROW + (16 * d0 + 8 * h) * 2);
                if (d0 == 0) p[hf] = MFMA32(ka, qf[0], negm); else p[hf] = MFMA32(ka, qf[d0], p[hf]); }
        }
        float ta = fmaxf(fmaxf(p[0][0], p[0][1]), p[1][0]), tb = fmaxf(fmaxf(p[0][2], p[0][3]), p[1][1]);
        ta = fmaxf(fmaxf(ta, p[1][2]), p[1][3]);
#pragma unroll
        for (int i = 4; i < 16; i += 4) { ta = fmaxf(fmaxf(ta, p[0][i]), p[0][i + 1]); tb = fmaxf(fmaxf(tb, p[0][i + 2]), p[0][i + 3]); ta = fmaxf(fmaxf(ta, p[1][i]), p[1][i + 1]); tb = fmaxf(fmaxf(tb, p[1][i + 2]), p[1][i + 3]); }
        float tm = fmaxf(ta, tb); tm = fmaxf(tm, __shfl_xor(tm, 32));
        if (__any(t == 0 || tm > 8.0f)) {
            const float dl = (t == 0 || tm > 0.f) ? tm : 0.f; mrun += dl;
            const float alpha = __builtin_amdgcn_exp2f(-dl); lrun *= alpha;
#pragma unroll
            for (int i = 0; i < 16; ++i) { p[0][i] -= dl; p[1][i] -= dl; negm[i] = -mrun; }
#pragma unroll
            for (int b = 0; b < DV / 32; ++b)
#pragma unroll
                for (int i = 0; i < 16; ++i) o[b][i] *= alpha;
        }
        float rs0 = 0.f, rs1 = 0.f;
#pragma unroll
        for (int i = 0; i < 16; ++i) { p[0][i] = __builtin_amdgcn_exp2f(p[0][i]); rs0 += p[0][i]; p[1][i] = __builtin_amdgcn_exp2f(p[1][i]); rs1 += p[1][i]; }
        lrun += rs0 + rs1;
        bf16x8 pf[4];
#pragma unroll
        for (int ks = 0; ks < 4; ++ks) { const int hf = ks >> 1, s8 = (ks & 1) * 8; u32x4 w;
            w.x = cvtpk(p[hf][s8 + 0], p[hf][s8 + 1]); w.y = cvtpk(p[hf][s8 + 2], p[hf][s8 + 3]); w.z = cvtpk(p[hf][s8 + 4], p[hf][s8 + 5]); w.w = cvtpk(p[hf][s8 + 6], p[hf][s8 + 7]);
            pf[ks] = __builtin_bit_cast(bf16x8, w); }
#pragma unroll
        for (int b = 0; b < DV / 32; ++b)
#pragma unroll
            for (int ks = 0; ks < 4; ++ks) { const bf16x8 va = *(const LAS bf16x8*)(vb + (32 * b + r) * VROW + (16 * ks + 8 * h) * 2); o[b] = MFMA32(va, pf[ks], o[b]); }
        if (t + 1 < ntiles) sstore((t + 1) & 1);
        __syncthreads();
    }
    l_out = lrun + __shfl_xor(lrun, 32);
}
constexpr int ATTN_LDS = 2 * (64 * (96 * 2 + 16) + 128 * 144);


#define XB_TMO      128
#define XB_XCNT(j)  (256  + 64 * (j))
#define XB_XSUB(j)  (1280 + 64 * (j))
#define XB_XGEN(j)  (2304 + 64 * (j))
#define XB_TOP      3328
#define XB_TOPGEN   3392
#define XCD_BAR_WORDS 3456
#define XB_SPIN_CAP (1u << 18)
DI unsigned xb_ld(unsigned* p)              { return __hip_atomic_load(p, __ATOMIC_RELAXED, __HIP_MEMORY_SCOPE_AGENT); }
DI unsigned xb_add(unsigned* p, unsigned v) { return __hip_atomic_fetch_add(p, v, __ATOMIC_RELAXED, __HIP_MEMORY_SCOPE_AGENT); }
DI unsigned xb_xcc_id() { return (unsigned)__builtin_amdgcn_s_getreg((3 << 11) | 20) & 0xFu; }
#define XB_SPIN(cond, bar) do { unsigned _sp = 0; while (cond) { __builtin_amdgcn_s_sleep(1); \
    if ((++_sp & 255u) == 0u) { if (xb_ld(&(bar)[XB_TMO])) break; if (_sp > XB_SPIN_CAP) { atomicAdd(&(bar)[XB_TMO], 1u); break; } } } } while (0)
struct XcdBarrier { unsigned* bar; unsigned x; volatile LAS unsigned* st; };
DI XcdBarrier xcd_barrier_post(unsigned* bar, volatile LAS unsigned* st) {
    XcdBarrier b; b.bar = bar; b.x = xb_xcc_id(); b.st = st;
    if (threadIdx.x == 0) (void)xb_add(&bar[XB_XCNT(b.x)], 1u);
    return b;
}
DI void xcd_barrier_complete(unsigned* bar, unsigned x, unsigned& nloc, unsigned& nx) {
    const unsigned G = gridDim.x * gridDim.y * gridDim.z;
    unsigned sum, cnt, mine, sp = 0u;
    for (;;) {
        sum = 0u; cnt = 0u; mine = 0u;
#pragma unroll
        for (unsigned j = 0; j < 16; ++j) { const unsigned c = xb_ld(&bar[XB_XCNT(j)]); sum += c; cnt += (c > 0u) ? 1u : 0u; mine = (j == x) ? c : mine; }
        if (sum == G) break;
        __builtin_amdgcn_s_sleep(1);
        if ((++sp & 255u) == 0u) { if (xb_ld(&bar[XB_TMO])) break; if (sp > XB_SPIN_CAP) { atomicAdd(&bar[XB_TMO], 1u); break; } }
    }
    nloc = mine > 0u ? mine : 1u; nx = cnt > 0u ? cnt : 1u;
}
DI void xcd_barrier(const XcdBarrier& b) {
    asm volatile("s_waitcnt vmcnt(0)" ::: "memory");
    __syncthreads();
    if (threadIdx.x == 0) {
        unsigned* bar = b.bar;
        __builtin_amdgcn_s_waitcnt(0);
        unsigned nloc = b.st[0], nx = b.st[1];
        if (nloc == 0u) { xcd_barrier_complete(bar, b.x, nloc, nx); b.st[0] = nloc; b.st[1] = nx; }
        const unsigned old = xb_add(&bar[XB_XSUB(b.x)], 1u);
        const unsigned gen = old / nloc;
        if (old + 1u == (gen + 1u) * nloc) {
            __builtin_amdgcn_fence(__ATOMIC_RELEASE, "agent");
            asm volatile("s_waitcnt vmcnt(0)" ::: "memory");
            const unsigned og = xb_add(&bar[XB_TOP], 1u);
            const unsigned tg = og / nx;
            if (og + 1u == (tg + 1u) * nx) xb_add(&bar[XB_TOPGEN], 1u);
            else XB_SPIN(xb_ld(&bar[XB_TOPGEN]) == tg, bar);
            __builtin_amdgcn_fence(__ATOMIC_ACQUIRE, "agent");
            xb_add(&bar[XB_XGEN(b.x)], 1u);
            asm volatile("s_waitcnt vmcnt(0)" ::: "memory");
        } else {
            XB_SPIN(xb_ld(&bar[XB_XGEN(b.x)]) == gen, bar);
            __builtin_amdgcn_fence(__ATOMIC_ACQUIRE, "agent");
            asm volatile("s_waitcnt vmcnt(0)" ::: "memory");
        }
    }
    __syncthreads();
}

struct Args {
    const float* in[35]; float* out; unsigned char* ws; int ph_lo, ph_hi;
};
enum { I_X = 0, I_C, I_CTX, I_CCTX,
       I0_WMOD, I0_BMOD, I0_WIN, I0_QN, I0_WUQ, I0_KVN, I0_WUKV, I0_WOUT, I0_LN1G, I0_LN1B, I0_WG, I0_WU, I0_WD, I0_LN2G, I0_LN2B,
       I1_WMOD, I1_BMOD, I1_WIN, I1_LQ1, I1_LK1, I1_LQ2, I1_LK2, I1_SUBLN, I1_WOUT, I1_LN1G, I1_LN1B, I1_WG, I1_WU, I1_WD, I1_LN2G, I1_LN2B };

DI bf16_t* tr_dst(int job, int n, unsigned char* ws) {
    switch (job) {
    case 0: return (bf16_t*)(ws + W_IN0) + (size_t)n * 1024;
    case 1: { const int hd = n / 96, d = n % 96; int row; if (d < 64) row = hd * 64 + d; else { const int e = d - 64, t = e >> 3, f = e & 7; row = 512 + hd * 32 + 16 * (t & 1) + 8 * (t >> 1) + f; }
              return (bf16_t*)(ws + W_UQ) + (size_t)row * 256; }
    case 2: { const int hd = n >> 7, d = n & 127; return d < 64 ? (bf16_t*)(ws + W_KN) + (size_t)(hd * 64 + d) * 256 : (bf16_t*)(ws + W_V0) + (size_t)(hd * 64 + d - 64) * 256; }
    case 3: return (bf16_t*)(ws + W_OUT0) + (size_t)n * 1024;
    case 4: return (bf16_t*)(ws + W_GU0) + (size_t)(256 * (n >> 7) + (n & 127)) * 1024;
    case 5: return (bf16_t*)(ws + W_GU0) + (size_t)(256 * (n >> 7) + 128 + (n & 127)) * 1024;
    case 6: return (bf16_t*)(ws + W_D0) + (size_t)n * 2816;
    case 7: return n < 2048 ? (bf16_t*)(ws + W_QK1) + (size_t)n * 1024 : (bf16_t*)(ws + W_V1) + (size_t)(n - 2048) * 1024;
    case 8: return (bf16_t*)(ws + W_OUT1) + (size_t)n * 1024;
    case 9: return (bf16_t*)(ws + W_GU1) + (size_t)(256 * (n >> 7) + (n & 127)) * 1024;
    case 10: return (bf16_t*)(ws + W_GU1) + (size_t)(256 * (n >> 7) + 128 + (n & 127)) * 1024;
    default: return (bf16_t*)(ws + W_D1) + (size_t)n * 2816;
    }
}
DI void transpose_item(const float* W, int K, int N, int job, unsigned char* ws, LAS float* scr, int item, int lane) {
    const int nblk = N / 32, kb = item / nblk, nb = item % nblk, k0 = 64 * kb, n0 = 32 * nb;
#pragma unroll 8
    for (int i = 0; i < 32; ++i) { const int kk = 2 * i + (lane >> 5); scr[kk * 33 + (lane & 31)] = W[(size_t)(k0 + kk) * N + n0 + (lane & 31)]; }
    asm volatile("s_waitcnt lgkmcnt(0)" ::: "memory");
    const int c = lane & 7;
#pragma unroll
    for (int j = 0; j < 4; ++j) { const int n = (lane >> 3) + 8 * j; const LAS float* s = scr + (8 * c) * 33 + n;
        u32x4 o; o.x = cvtpk(s[0 * 33], s[1 * 33]); o.y = cvtpk(s[2 * 33], s[3 * 33]); o.z = cvtpk(s[4 * 33], s[5 * 33]); o.w = cvtpk(s[6 * 33], s[7 * 33]);
        bf16_t* dst = tr_dst(job, n0 + n, ws); *(u32x4*)(dst + k0 + 8 * c) = o; }
    asm volatile("s_waitcnt lgkmcnt(0)" ::: "memory");
}

DI void prologue(const Args& a, LAS unsigned char* lds) {
    unsigned char* ws = a.ws;
    const int tid = otid(), lane = tid & 63, wave = tid >> 6;
    const int G = gridDim.x, gw = blockIdx.x * 8 + wave, NGW = G * 8;
    const long gt = (long)blockIdx.x * 512 + tid, NGT = (long)G * 512;
    {
        LAS float* scr = (LAS float*)(lds + wave * 16384);
        const int jin[12] = {I0_WIN, I0_WUQ, I0_WUKV, I0_WOUT, I0_WG, I0_WU, I0_WD, I1_WIN, I1_WOUT, I1_WG, I1_WU, I1_WD};
        const int jK[12] = {1024, 256, 256, 1024, 1024, 1024, 2816, 1024, 1024, 1024, 1024, 2816};
        const int jN[12] = {1056, 768, 1024, 1024, 2816, 2816, 1024, 3072, 1024, 2816, 2816, 1024};
        int base = 0;
#pragma unroll
        for (int j = 0; j < 12; ++j) { const int items = (jK[j] / 64) * (jN[j] / 32);
            for (int it = gw; it < items; it += NGW) transpose_item(a.in[jin[j]], jK[j], jN[j], j, ws, scr, it, lane);
            base += items; }
        u32x4 z = {0u, 0u, 0u, 0u};
        for (long i = gt; i < (1280 - 1056) * 1024 / 8; i += NGT) ((u32x4*)((bf16_t*)(ws + W_IN0) + (size_t)1056 * 1024))[i] = z;
    }
    {
        const float sc = 0.011048543456039806f;
        for (long i = gt; i < (long)4096 * 2048; i += NGT) { const int k = (int)(i >> 11), c8 = (int)(i & 2047) * 8; const int part = c8 >> 13, n0 = c8 & 8191; float v[8];
#pragma unroll
            for (int e = 0; e < 8; ++e) { const float ph = (float)((k * (n0 + e)) & 8191) * (1.0f / 8192.0f); v[e] = (part ? __builtin_amdgcn_sinf(ph) : __builtin_amdgcn_cosf(ph)) * sc; }
            u32x4 o; o.x = cvtpk(v[0], v[1]); o.y = cvtpk(v[2], v[3]); o.z = cvtpk(v[4], v[5]); o.w = cvtpk(v[6], v[7]);
            *(u32x4*)((bf16_t*)(ws + WS_DN) + (size_t)k * 16384 + c8) = o; }
        for (long i = gt; i < 256 * 512; i += NGT) { const int k = (int)(i >> 9), c = (int)(i & 511), part = c >> 8, n = c & 255; const float ph = (float)((k * n) & 255) * (1.0f / 256.0f);
            const float v = (part ? __builtin_amdgcn_sinf(ph) : __builtin_amdgcn_cosf(ph)) * 0.0625f; ((bf16_t*)(ws + W_D256))[i] = (bf16_t)(cvtpk(v, 0.f) & 0xffffu); }
        for (long i = gt; i < 256 * 128; i += NGT) { const int rr = (int)(i >> 7), c = (int)(i & 127), part = rr >> 7, l = rr & 127; const float ph = (float)((l * c) & 127) * (1.0f / 128.0f);
            const float v = (part ? -__builtin_amdgcn_sinf(ph) : __builtin_amdgcn_cosf(ph)) * 0.08838834764831845f; ((bf16_t*)(ws + W_DC))[i] = (bf16_t)(cvtpk(v, 0.f) & 0xffffu); }
        for (long i = gt; i < 128 * 16; i += NGT) { const int pos = (int)(i >> 4), f = (int)(i & 15); const float inv = 1.0f / powf(10000.0f, (float)f / 16.0f); const float ang = (float)pos * inv;
            ((f32x2*)(ws + WS_TAB16))[i] = (f32x2){cosf(ang), sinf(ang)}; }
        for (long i = gt; i < 128 * 8; i += NGT) { const int pos = (int)(i >> 3), f = (int)(i & 7); const float inv = 1.0f / powf(10000.0f, (float)f / 8.0f); const float ang = (float)pos * inv;
            ((f32x2*)(ws + WS_TAB8))[i] = (f32x2){cosf(ang), sinf(ang)}; }
    }
    {
        LAS float* red = (LAS float*)lds;
        for (int it = blockIdx.x; it < 2 * 96; it += G) {
            __syncthreads();
            const int layer = it / 96, n = (it % 96) * 64 + lane; const float* w = a.in[layer ? I1_WMOD : I0_WMOD]; const float* bm = a.in[layer ? I1_BMOD : I0_BMOD];
            float acc[5] = {0.f, 0.f, 0.f, 0.f, 0.f};
            for (int kk = 0; kk < 128; ++kk) { const int k = wave * 128 + kk; const float wv = w[(size_t)k * 6144 + n];
#pragma unroll
                for (int cls = 0; cls < 5; ++cls) { const float cv = cls < 4 ? a.in[I_C][cls * 1024 + k] : a.in[I_CCTX][k]; const float sl = cv / (1.0f + __expf(-cv)); acc[cls] += sl * wv; } }
#pragma unroll
            for (int cls = 0; cls < 5; ++cls) red[(wave * 5 + cls) * 64 + lane] = acc[cls];
            __syncthreads();
            if (tid < 320) { const int cls = tid >> 6, l = tid & 63; float s = 0.f;
#pragma unroll
                for (int w8 = 0; w8 < 8; ++w8) s += red[(w8 * 5 + cls) * 64 + l];
                const int nn = (it % 96) * 64 + l; ((float*)(ws + WS_MOD))[(size_t)(layer * 5 + cls) * 6144 + nn] = s + bm[nn]; }
        }
        __syncthreads();
    }
}

struct RowPass {
    const float* xl; const float* xc;
    float* ol; float* oc;
    const bf16_t* Y;
    const float* mod;
    int gate_off; const float* lng; const float* lnb;
    const float* mod2; int sc_off, sh_off;
    bf16_t* H;
    int skipctx;
};
DI void ln_stats(const f32x4 (&v)[4], float& mean, float& rstd) {
    float s = 0.f;
#pragma unroll
    for (int j = 0; j < 4; ++j) s += (v[j][0] + v[j][1]) + (v[j][2] + v[j][3]);
    mean = wave_sum(s) * (1.0f / DM); float q = 0.f;
#pragma unroll
    for (int j = 0; j < 4; ++j) { const f32x4 d = v[j] - mean; q += (d[0] * d[0] + d[1] * d[1]) + (d[2] * d[2] + d[3] * d[3]); }
    rstd = 1.0f / sqrtf(wave_sum(q) * (1.0f / DM) + LN_EPS);
}
DI void row_pass(const RowPass& P, int m, int lane) {
    const int b = m / TPB, j = m % TPB; const bool isctx = j < CTX; const int cls = isctx ? 4 : b;
    if (P.skipctx && isctx) return;
    const size_t xoff = isctx ? (size_t)(b * CTX + j) * DM : (size_t)(b * SEQ + j - CTX) * DM;
    const float* xs = (isctx ? P.xc : P.xl) + xoff; float* xd = isctx ? P.oc : P.ol;
    f32x4 v[4];
#pragma unroll
    for (int jj = 0; jj < 4; ++jj) v[jj] = *(const f32x4*)(xs + 4 * lane + 256 * jj);
    if (P.Y) {
        const float* gate = P.mod + (size_t)cls * 6144 + P.gate_off;
#pragma unroll
        for (int jj = 0; jj < 4; ++jj) { const int c0 = 4 * lane + 256 * jj; const u32x2 yw = *(const u32x2*)(P.Y + (size_t)m * DM + c0); const f32x4 g = *(const f32x4*)(gate + c0);
            v[jj][0] = DN_ALPHA * v[jj][0] + g[0] * bflo(yw.x); v[jj][1] = DN_ALPHA * v[jj][1] + g[1] * bfhi(yw.x);
            v[jj][2] = DN_ALPHA * v[jj][2] + g[2] * bflo(yw.y); v[jj][3] = DN_ALPHA * v[jj][3] + g[3] * bfhi(yw.y); }
        float mean, rstd; ln_stats(v, mean, rstd);
#pragma unroll
        for (int jj = 0; jj < 4; ++jj) { const int c0 = 4 * lane + 256 * jj; const f32x4 g = *(const f32x4*)(P.lng + c0), bb = *(const f32x4*)(P.lnb + c0); v[jj] = (v[jj] - mean) * rstd * g + bb; }
        if (xd) {
#pragma unroll
            for (int jj = 0; jj < 4; ++jj) *(f32x4*)(xd + xoff + 4 * lane + 256 * jj) = v[jj];
        }
    }
    if (P.H) {
        float mean, rstd; ln_stats(v, mean, rstd);
        const float* sc = P.mod2 + (size_t)cls * 6144 + P.sc_off; const float* sh = P.mod2 + (size_t)cls * 6144 + P.sh_off;
#pragma unroll
        for (int jj = 0; jj < 4; ++jj) { const int c0 = 4 * lane + 256 * jj; const f32x4 s1 = *(const f32x4*)(sc + c0), s0 = *(const f32x4*)(sh + c0);
            const f32x4 hh = (v[jj] - mean) * rstd * (s1 + 1.0f) + s0; u32x2 w; w.x = cvtpk(hh[0], hh[1]); w.y = cvtpk(hh[2], hh[3]);
            *(u32x2*)(P.H + (size_t)m * DM + c0) = w; }
    }
}
DI void p3_row(const Args& a, int m, int lane) {
    unsigned char* ws = a.ws; const bf16_t* U = (const bf16_t*)(ws + WS_R3) + (size_t)m * 1280;
    const u32x2 qw = *(const u32x2*)(U + 512 + 4 * lane), kw = *(const u32x2*)(U + 768 + 4 * lane);
    float q[4] = {bflo(qw.x), bfhi(qw.x), bflo(qw.y), bfhi(qw.y)}, k[4] = {bflo(kw.x), bfhi(kw.x), bflo(kw.y), bfhi(kw.y)};
    const float qs = wave_sum(q[0] * q[0] + q[1] * q[1] + q[2] * q[2] + q[3] * q[3]), ks = wave_sum(k[0] * k[0] + k[1] * k[1] + k[2] * k[2] + k[3] * k[3]);
    const float qr = 1.0f / sqrtf(qs * (1.0f / 256.0f) + RMS_EPS), kr_ = 1.0f / sqrtf(ks * (1.0f / 256.0f) + RMS_EPS);
    const f32x4 qg = *(const f32x4*)(a.in[I0_QN] + 4 * lane), kg = *(const f32x4*)(a.in[I0_KVN] + 4 * lane);
    u32x2 w; w.x = cvtpk(q[0] * qr * qg[0], q[1] * qr * qg[1]); w.y = cvtpk(q[2] * qr * qg[2], q[3] * qr * qg[3]);
    *(u32x2*)((bf16_t*)(ws + WS_CQN) + (size_t)m * 256 + 4 * lane) = w;
    w.x = cvtpk(k[0] * kr_ * kg[0], k[1] * kr_ * kg[1]); w.y = cvtpk(k[2] * kr_ * kg[2], k[3] * kr_ * kg[3]);
    *(u32x2*)((bf16_t*)(ws + WS_CKVN) + (size_t)m * 256 + 4 * lane) = w;
    const int d = lane & 31, t = d >> 3, f = d & 7; const float val = bf2f(U[1024 + d]); const float par = __shfl_xor(val, 8);
    const int j = m % TPB, tt = j - CTX; float outv = val;
    if (tt >= 0) { const int pos = (t < 2) ? (tt >> 6) : (tt & 63); const f32x2 cs = ((const f32x2*)(ws + WS_TAB8))[pos * 8 + f];
        outv = (t & 1) ? (par * cs[1] + val * cs[0]) : (val * cs[0] - par * cs[1]); }
    if (lane < 32) ((bf16_t*)(ws + WS_KR))[(size_t)m * 32 + 16 * (t & 1) + 8 * (t >> 1) + f] = (bf16_t)(cvtpk(outv, 0.f) & 0xffffu);
}
DI void mirror_items(const Args& a, int gw, int NGW, int lane) {
    unsigned char* ws = a.ws; bf16_t* MIX = (bf16_t*)(ws + WS_R3); const bf16_t* At = (const bf16_t*)(ws + WS_R2);
    for (int it = gw; it < NB * 512; it += NGW) { const int b = it >> 9, ch = it & 511; const bf16_t* src = At + (size_t)ch * ROWS + b * TPB + CTX; float s = 0.f;
        for (int i = 0; i < 16; ++i) { const u32x4 w = *(const u32x4*)(src + (i * 64 + lane) * 8);
            s += (bflo(w.x) - bfhi(w.x)) + (bflo(w.y) - bfhi(w.y)) + (bflo(w.z) - bfhi(w.z)) + (bflo(w.w) - bfhi(w.w)); }
        s = wave_sum(s) * 0.011048543456039806f;
        if (lane == 0) MIX[(size_t)(b * TPB + CTX + 4096) * DM + ch] = (bf16_t)(cvtpk(s, 0.f) & 0xffffu); }
    const bf16_t* PS = (const bf16_t*)(ws + WS_PS);
    for (int it = gw; it < NB * 4096; it += NGW) { const int b = it >> 12, k = it & 4095;
        bf16_t* src = MIX + (size_t)(b * TPB + CTX + k) * DM + 8 * lane; const u32x4 pc = *(const u32x4*)src; const u32x4 ps = *(const u32x4*)(PS + ((size_t)(b * 4096 + k)) * 512 + 8 * lane);
        u32x4 sm, df;
        sm.x = cvtpk(bflo(pc.x) + bflo(ps.x), bfhi(pc.x) + bfhi(ps.x)); df.x = cvtpk(bflo(pc.x) - bflo(ps.x), bfhi(pc.x) - bfhi(ps.x));
        sm.y = cvtpk(bflo(pc.y) + bflo(ps.y), bfhi(pc.y) + bfhi(ps.y)); df.y = cvtpk(bflo(pc.y) - bflo(ps.y), bfhi(pc.y) - bfhi(ps.y));
        sm.z = cvtpk(bflo(pc.z) + bflo(ps.z), bfhi(pc.z) + bfhi(ps.z)); df.z = cvtpk(bflo(pc.z) - bflo(ps.z), bfhi(pc.z) - bfhi(ps.z));
        sm.w = cvtpk(bflo(pc.w) + bflo(ps.w), bfhi(pc.w) + bfhi(ps.w)); df.w = cvtpk(bflo(pc.w) - bflo(ps.w), bfhi(pc.w) - bfhi(ps.w));
        *(u32x4*)src = sm;
        if (k >= 1) *(u32x4*)(MIX + (size_t)(b * TPB + CTX + 8192 - k) * DM + 8 * lane) = df; }
}

DI bool attn_unit_map(int L, int nunits_big, int& bh, int& qb) {
    if (L < nunits_big) { const int i = L >> 8, c = L & 255; bh = 4 * (c & 7) + i; qb = 1 + (c >> 3); return true; }
    bh = L - nunits_big; qb = 0; return bh < 32;
}
DI void attn_mla_unit(const Args& a, LAS unsigned char* lds, int bh, int qb) {
    unsigned char* ws = a.ws; const int tid = otid(), lane = tid & 63, wave = tid >> 6, r = lane & 31, h = lane >> 5;
    const int b = bh >> 3, hd = bh & 7; const int m = b * TPB + qb * 256 + wave * 32 + r;
    const bf16_t* Q = (const bf16_t*)(ws + WS_Q) + (size_t)m * 768;
    const bf16_t* KN = (const bf16_t*)(ws + WS_KN) + (size_t)(b * TPB) * 512 + hd * 64;
    const bf16_t* KR = (const bf16_t*)(ws + WS_KR) + (size_t)(b * TPB) * 32;
    const bf16_t* VT = (const bf16_t*)(ws + WS_VT0) + (size_t)(hd * 64) * ROWS + b * TPB;
    f32x16 o[2]; float l;
    attn_core<64, 32, 64>(o, l, lds, Q + hd * 64, Q + 512 + hd * 32, KN, 512, KR, 32, VT, ROWS, qb == 0 ? CTX / 64 : TPB / 64);
    const float il = 1.0f / l; bf16_t* dst = (bf16_t*)(ws + WS_R3) + (size_t)m * DM + 512 + hd * 64;
#pragma unroll
    for (int blk = 0; blk < 2; ++blk)
#pragma unroll
        for (int g = 0; g < 4; ++g) { u32x2 w; w.x = cvtpk(o[blk][4 * g] * il, o[blk][4 * g + 1] * il); w.y = cvtpk(o[blk][4 * g + 2] * il, o[blk][4 * g + 3] * il);
            *(u32x2*)(dst + 32 * blk + 8 * g + 4 * h) = w; }
}
DI void attn_diff_unit(const Args& a, LAS unsigned char* lds, int bh, int qb, float lam) {
    unsigned char* ws = a.ws; const int tid = otid(), lane = tid & 63, wave = tid >> 6, r = lane & 31, h = lane >> 5;
    const int b = bh >> 3, hd = bh & 7; const int m = b * TPB + qb * 256 + wave * 32 + r;
    const bf16_t* QK = (const bf16_t*)(ws + WS_R3);
    const bf16_t* VT = (const bf16_t*)(ws + WS_VT1) + (size_t)(hd * 128) * ROWS + b * TPB;
    LAS unsigned* stash = (LAS unsigned*)(lds + 55296) + wave * 2048 + lane;
    f32x16 o[4]; float l;
    {
        const bf16_t* q = QK + (size_t)m * 2048 + (hd * 2) * 64; const bf16_t* k = QK + (size_t)(b * TPB) * 2048 + 1024 + (hd * 2) * 64;
        attn_core<64, 0, 128>(o, l, lds, q, q, k, 2048, k, 2048, VT, ROWS, TPB / 64);
        const float il = 1.0f / l;
#pragma unroll
        for (int blk = 0; blk < 4; ++blk)
#pragma unroll
            for (int i = 0; i < 8; ++i) stash[(blk * 8 + i) * 64] = cvtpk(o[blk][2 * i] * il, o[blk][2 * i + 1] * il);
    }
    {
        const bf16_t* q = QK + (size_t)m * 2048 + (hd * 2 + 1) * 64; const bf16_t* k = QK + (size_t)(b * TPB) * 2048 + 1024 + (hd * 2 + 1) * 64;
        attn_core<64, 0, 128>(o, l, lds, q, q, k, 2048, k, 2048, VT, ROWS, TPB / 64);
    }
    const float il = lam / l; float ss = 0.f;
#pragma unroll
    for (int blk = 0; blk < 4; ++blk)
#pragma unroll
        for (int i = 0; i < 8; ++i) { const unsigned aw = stash[(blk * 8 + i) * 64]; const float x0 = bflo(aw) - o[blk][2 * i] * il, x1 = bfhi(aw) - o[blk][2 * i + 1] * il; o[blk][2 * i] = x0; o[blk][2 * i + 1] = x1; ss += x0 * x0 + x1 * x1; }
    ss += __shfl_xor(ss, 32);
    const float rn = (1.0f - LAMBDA_INIT) / sqrtf(ss * (1.0f / 128.0f) + RMS_EPS);
    const float* sub = a.in[I1_SUBLN]; bf16_t* dst = (bf16_t*)(ws + WS_R2) + (size_t)m * DM + hd * 128;
#pragma unroll
    for (int blk = 0; blk < 4; ++blk)
#pragma unroll
        for (int g = 0; g < 4; ++g) { const int d0 = 32 * blk + 8 * g + 4 * h; const f32x4 sg = *(const f32x4*)(sub + d0);
            u32x2 w; w.x = cvtpk(o[blk][4 * g] * rn * sg[0], o[blk][4 * g + 1] * rn * sg[1]); w.y = cvtpk(o[blk][4 * g + 2] * rn * sg[2], o[blk][4 * g + 3] * rn * sg[3]);
            *(u32x2*)(dst + d0) = w; }
}

constexpr int NPHASES = 18;
constexpr int LDS_BYTES = 147456;
struct GOp { int kind; pg8::Gemm g; bf16_t* O; int ldc, o_bs, ai_extra; float scale; int q_tiles, rope_from; };

DI bool get_gemm(int ph, int sub, const Args& a, GOp& op) {
    unsigned char* ws = a.ws;
    bf16_t* R2 = (bf16_t*)(ws + WS_R2); bf16_t* R3 = (bf16_t*)(ws + WS_R3);
    op.kind = 0; op.o_bs = 0; op.ai_extra = 0; op.scale = 1.0f; op.q_tiles = 0; op.rope_from = 0;
    pg8::Gemm& g = op.g; g.nB = 1; g.a_bs = 0; g.b_bs = 0; g.rot = 0; g.a_seg = 0; g.b_seg = 0; g.skipctx = 0;
#define SETK(k_) do { g.K = (k_); g.kseg = (k_) / 64; g.a_seg = (k_); g.b_seg = (k_); } while (0)
    switch (ph * 8 + sub) {
    case 2 * 8 + 0:
        g.A = R2; g.a_rs = 1024; g.nM = NRT; g.Bt = (const bf16_t*)(ws + W_IN0); g.b_rs = 1024; g.nN = 5; SETK(1024); op.O = R3; op.ldc = 1280; return true;
    case 3 * 8 + 0:
        g.A = (const bf16_t*)(ws + W_DC); g.a_rs = 128; g.nM = 1; g.Bt = R3; g.b_rs = 1280; g.nN = NRT; g.nB = 4; g.b_bs = 128; SETK(128);
        op.O = R2; op.ldc = ROWS; op.o_bs = 128 * ROWS; op.ai_extra = 384 * ROWS; return true;
    case 4 * 8 + 0:
        op.kind = 1; g.A = (const bf16_t*)(ws + WS_CQN); g.a_rs = 256; g.nM = NRT; g.Bt = (const bf16_t*)(ws + W_UQ); g.b_rs = 256; g.nN = 3; SETK(256);
        op.O = (bf16_t*)(ws + WS_Q); op.ldc = 768; op.scale = MLA_QSCALE; op.q_tiles = 3; op.rope_from = 2; return true;
    case 4 * 8 + 1:
        g.A = (const bf16_t*)(ws + WS_CKVN); g.a_rs = 256; g.nM = NRT; g.Bt = (const bf16_t*)(ws + W_KN); g.b_rs = 256; g.nN = 2; SETK(256); g.rot = 140;
        op.O = (bf16_t*)(ws + WS_KN); op.ldc = 512; return true;
    case 4 * 8 + 2:
        g.A = (const bf16_t*)(ws + W_V0); g.a_rs = 256; g.nM = 2; g.Bt = (const bf16_t*)(ws + WS_CKVN); g.b_rs = 256; g.nN = NRT; SETK(256); g.rot = 148;
        op.O = (bf16_t*)(ws + WS_VT0); op.ldc = ROWS; return true;
    case 4 * 8 + 3:
        g.A = (const bf16_t*)(ws + WS_DN); g.a_rs = 16384; g.nM = 16; g.Bt = R2 + CTX; g.b_rs = ROWS; g.nN = 2; g.nB = 4; g.b_bs = TPB; SETK(8192); g.rot = 152;
        op.O = R3 + (size_t)CTX * DM; op.ldc = DM; op.o_bs = TPB * DM; return true;
    case 4 * 8 + 4:
        g.A = (const bf16_t*)(ws + WS_DN) + 8192; g.a_rs = 16384; g.nM = 16; g.Bt = R2 + CTX + (size_t)512 * ROWS; g.b_rs = ROWS; g.nN = 2; g.nB = 4; g.b_bs = TPB; SETK(8192); g.rot = 24;
        op.O = (bf16_t*)(ws + WS_PS); op.ldc = 512; op.o_bs = 4096 * 512; return true;
    case 4 * 8 + 5:
        g.A = (const bf16_t*)(ws + W_D256); g.a_rs = 512; g.nM = 1; g.Bt = R2; g.b_rs = ROWS; g.nN = 2; g.nB = 4; g.b_bs = TPB; g.K = 512; g.kseg = 4; g.a_seg = 256; g.b_seg = 512 * ROWS; g.rot = 0;
        op.O = R3; op.ldc = DM; op.o_bs = TPB * DM; return true;
    case 6 * 8 + 0:
        g.A = R3; g.a_rs = 1024; g.nM = NRT; g.Bt = (const bf16_t*)(ws + W_OUT0); g.b_rs = 1024; g.nN = 4; SETK(1024); op.O = (bf16_t*)(ws + WS_Y0); op.ldc = DM; return true;
    case 8 * 8 + 0: case 15 * 8 + 0:
        op.kind = 3; g.A = R2; g.a_rs = 1024; g.nM = (ph == 8 ? NRT : 128); g.skipctx = (ph != 8); g.Bt = (const bf16_t*)(ws + (ph == 8 ? W_GU0 : W_GU1)); g.b_rs = 1024; g.nN = 22; SETK(1024); op.O = R3; op.ldc = FF; return true;
    case 9 * 8 + 0: case 16 * 8 + 0:
        g.A = R3; g.a_rs = FF; g.nM = (ph == 9 ? NRT : 128); g.skipctx = (ph != 9); g.Bt = (const bf16_t*)(ws + (ph == 9 ? W_D0 : W_D1)); g.b_rs = FF; g.nN = 4; SETK(FF); op.O = R2; op.ldc = DM; return true;
    case 11 * 8 + 0:
        op.kind = 2; g.A = R2; g.a_rs = 1024; g.nM = NRT; g.Bt = (const bf16_t*)(ws + W_QK1); g.b_rs = 1024; g.nN = 8; SETK(1024);
        op.O = R3; op.ldc = 2048; op.scale = DIFF_QSCALE; op.q_tiles = 4; op.rope_from = 0; return true;
    case 11 * 8 + 1:
        g.A = (const bf16_t*)(ws + W_V1); g.a_rs = 1024; g.nM = 4; g.Bt = R2; g.b_rs = 1024; g.nN = NRT; SETK(1024); g.rot = 32;
        op.O = (bf16_t*)(ws + WS_VT1); op.ldc = ROWS; return true;
    case 13 * 8 + 0:
        g.A = R2; g.a_rs = 1024; g.nM = 128; g.skipctx = 1; g.Bt = (const bf16_t*)(ws + W_OUT1); g.b_rs = 1024; g.nN = 4; SETK(1024); op.O = R3; op.ldc = DM; return true;
    default: return false;
    }
#undef SETK
}

DI bool get_rowpass(int ph, const Args& a, RowPass& P) {
    unsigned char* ws = a.ws; const float* MOD0 = (const float*)(ws + WS_MOD); const float* MOD1 = MOD0 + 5 * 6144;
    float* XC = (float*)(ws + WS_XC); bf16_t* R2 = (bf16_t*)(ws + WS_R2);
    switch (ph) {
    case 1:  P = RowPass{a.in[I_X], a.in[I_CTX], nullptr, nullptr, nullptr, MOD0, 0, nullptr, nullptr, MOD0, 1024, 0, R2, 0}; return true;
    case 7:  P = RowPass{a.in[I_X], a.in[I_CTX], a.out, XC, (const bf16_t*)(ws + WS_Y0), MOD0, 2048, a.in[I0_LN1G], a.in[I0_LN1B], MOD0, 4096, 3072, R2, 0}; return true;
    case 10: P = RowPass{a.out, XC, a.out, XC, R2, MOD0, 5120, a.in[I0_LN2G], a.in[I0_LN2B], MOD1, 1024, 0, R2, 0}; return true;
    case 14: P = RowPass{a.out, XC, a.out, XC, (const bf16_t*)(ws + WS_R3), MOD1, 2048, a.in[I1_LN1G], a.in[I1_LN1B], MOD1, 4096, 3072, R2, 1}; return true;
    case 17: P = RowPass{a.out, XC, a.out, XC, R2, MOD1, 5120, a.in[I1_LN2G], a.in[I1_LN2B], MOD1, 0, 0, nullptr, 1}; return true;
    default: return false;
    }
}

__global__ void __launch_bounds__(512, 2) fwd_kernel(Args a) {
    extern __shared__ __attribute__((aligned(16))) unsigned char lds_raw[];
    LAS unsigned char* lds = (LAS unsigned char*)lds_raw;
    const int G = gridDim.x;
    volatile LAS unsigned* bst = (volatile LAS unsigned*)(lds + LDS_BYTES - 64);
    if (threadIdx.x < 2) bst[threadIdx.x] = 0u;
    __syncthreads();
    XcdBarrier xbar = xcd_barrier_post((unsigned*)(a.ws + WS_BAR), bst);
    for (int ph = a.ph_lo; ph < a.ph_hi; ++ph) {
        const int tid = otid(), lane = tid & 63, wave = __builtin_amdgcn_readfirstlane(tid >> 6);
        const int gw = blockIdx.x * 8 + wave, NGW = G * 8;
#ifndef NO_PRO
        if (ph == 0) prologue(a, lds);
#endif
        RowPass P;
        if (get_rowpass(ph, a, P)) { for (int m = gw; m < ROWS; m += NGW) row_pass(P, m, lane); }
        if (ph == 3) { for (int m = gw; m < ROWS; m += NGW) p3_row(a, m, lane); }
#ifndef NO_MLA
        if (ph == 5) {
            mirror_items(a, gw, NGW, lane);
            for (int L = blockIdx.x; ; L += G) { int bh, qb; if (!attn_unit_map(L, 1024, bh, qb)) break; attn_mla_unit(a, lds, bh, qb); }
        }
#endif
#ifndef NO_DIFF
        if (ph == 12) {
            const float p1 = wave_sum(a.in[I1_LQ1][lane] * a.in[I1_LK1][lane]), p2 = wave_sum(a.in[I1_LQ2][lane] * a.in[I1_LK2][lane]);
            const float lam = expf(p1) - expf(p2) + LAMBDA_INIT;
            for (int L = blockIdx.x; L < 1024; L += G) { int bh, qb; attn_unit_map(L, 1024, bh, qb); attn_diff_unit(a, lds, bh, qb, lam); }
        }
#endif
#ifndef NO_GEMM
        for (int sub = 0; sub < 8; ++sub) {
            GOp op; if (!get_gemm(ph, sub, a, op)) break;
            pg8::StaticOrder S; S.init(op.g.nM, op.g.nN, op.g.nB, G, (int)blockIdx.x, op.g.rot, op.g.skipctx);
            if (op.kind == 0) { pg8::EpiStore E{op.O, op.ldc, op.o_bs, op.ai_extra, op.scale}; pg8::gemm_phase(lds, op.g, S, E); }
            else if (op.kind == 1) { pg8::EpiRope<8> E{op.O, op.ldc, op.scale, op.q_tiles, op.rope_from, (const f32x2*)(a.ws + WS_TAB8)}; pg8::gemm_phase(lds, op.g, S, E); }
            else if (op.kind == 2) { pg8::EpiRope<16> E{op.O, op.ldc, op.scale, op.q_tiles, op.rope_from, (const f32x2*)(a.ws + WS_TAB16)}; pg8::gemm_phase(lds, op.g, S, E); }
            else { pg8::EpiSwiglu E{op.O, op.ldc}; pg8::gemm_phase(lds, op.g, S, E); }
        }
#endif
        if (ph + 1 < a.ph_hi) { if (ph == a.ph_lo) { __threadfence(); cg::this_grid().sync(); } else xcd_barrier(xbar); }
    }
}

extern "C" void kernel_launch(void* const* d_in, const int* in_sizes, int n_in, void* d_out, int out_size, void* d_ws, size_t ws_size, hipStream_t stream) {
    static int grid = 0;
    if (grid == 0) {
        if (n_in != 35 || ws_size < WS_END) { fprintf(stderr, "kernel_launch: unexpected n_in %d / ws %zu (need %zu)\n", n_in, ws_size, (size_t)WS_END); grid = -1; return; }
        int dev = 0, cus = 0, per_cu = 0;
        hipGetDevice(&dev); hipDeviceGetAttribute(&cus, hipDeviceAttributeMultiprocessorCount, dev);
        hipFuncSetAttribute((const void*)fwd_kernel, hipFuncAttributeMaxDynamicSharedMemorySize, LDS_BYTES);
        hipOccupancyMaxActiveBlocksPerMultiprocessor(&per_cu, (const void*)fwd_kernel, 512, LDS_BYTES);
        if (per_cu < 1) { fprintf(stderr, "kernel_launch: occupancy query says %d blocks/CU\n", per_cu); per_cu = 1; }
        (void)hipGetLastError();
        grid = cus * 1;
    }
    if (grid < 0) return;
    Args a{};
    for (int i = 0; i < 35; ++i) a.in[i] = (const float*)d_in[i];
    a.out = (float*)d_out; a.ws = (unsigned char*)d_ws;
#if MK_MULTI
    for (int ph = 0; ph < NPHASES; ++ph) { a.ph_lo = ph; a.ph_hi = ph + 1; hipLaunchKernelGGL(fwd_kernel, dim3(grid), dim3(512), LDS_BYTES, stream, a); }
#else
    a.ph_lo = 0; a.ph_hi = NPHASES;
    hipMemsetAsync((char*)d_ws + WS_BAR, 0, 16384, stream);
    void* args[] = {&a};
    hipError_t e = hipLaunchCooperativeKernel((const void*)fwd_kernel, dim3(grid), dim3(512), args, LDS_BYTES, stream);
    if (e != hipSuccess) fprintf(stderr, "cooperative launch failed: %s (grid %d)\n", hipGetErrorString(e), grid);
#endif
}
```

```cpp
#include <hip/hip_runtime.h>
#include <hip/hip_cooperative_groups.h>
#include <cstdio>
#include <cstdint>
namespace cg = cooperative_groups;

#ifndef MK_MULTI
#define MK_MULTI 0
#endif

#define DI __device__ __forceinline__
#define LAS __attribute__((address_space(3)))
typedef unsigned short bf16_t;
typedef short bf16x8 __attribute__((ext_vector_type(8)));
typedef float f32x4 __attribute__((ext_vector_type(4)));
typedef float f32x2 __attribute__((ext_vector_type(2)));
typedef float f32x16 __attribute__((ext_vector_type(16)));
typedef unsigned u32x4 __attribute__((ext_vector_type(4)));
typedef unsigned u32x2 __attribute__((ext_vector_type(2)));
typedef __bf16 bf16x2_t __attribute__((ext_vector_type(2)));

constexpr int DM = 1024, NB = 4, SEQ = 8192, CTX = 256, TPB = SEQ + CTX  , ROWS = NB * TPB  , FF = 2816;
constexpr int NRT = ROWS / 256;
constexpr float LN_EPS = 1e-6f, RMS_EPS = 1e-6f;
constexpr float DN_ALPHA = 1.41421356237f;
constexpr float LOG2E = 1.4426950408889634f;
constexpr float MLA_QSCALE = 0.10206207261596577f * LOG2E;
constexpr float DIFF_QSCALE = 0.125f * LOG2E;
constexpr float LAMBDA_INIT = 0.35550906f;

constexpr size_t MiB = 1u << 20;
constexpr size_t WS_MOD = 0;
constexpr size_t WS_TAB16 = 256 * 1024;
constexpr size_t WS_TAB8 = WS_TAB16 + 16384;
constexpr size_t WS_BAR = 512 * 1024;
constexpr size_t WS_XC = 1 * MiB;
constexpr size_t WS_W = 5 * MiB;
constexpr size_t W_IN0 = WS_W;
constexpr size_t W_UQ = W_IN0 + 1280 * 1024 * 2;
constexpr size_t W_KN = W_UQ + 768 * 256 * 2;
constexpr size_t W_V0 = W_KN + 512 * 256 * 2;
constexpr size_t W_OUT0 = W_V0 + 512 * 256 * 2;
constexpr size_t W_GU0 = W_OUT0 + 1024 * 1024 * 2;
constexpr size_t W_D0 = W_GU0 + 5632 * 1024 * 2;
constexpr size_t W_QK1 = W_D0 + 1024 * 2816 * 2;
constexpr size_t W_V1 = W_QK1 + 2048 * 1024 * 2;
constexpr size_t W_OUT1 = W_V1 + 1024 * 1024 * 2;
constexpr size_t W_GU1 = W_OUT1 + 1024 * 1024 * 2;
constexpr size_t W_D1 = W_GU1 + 5632 * 1024 * 2;
constexpr size_t W_DC = W_D1 + 1024 * 2816 * 2;
constexpr size_t W_D256 = W_DC + 256 * 128 * 2;
constexpr size_t W_END = W_D256 + 256 * 512 * 2;
static_assert(W_END <= 56 * MiB, "weights region");
constexpr size_t WS_DN = 56 * MiB;
constexpr size_t WS_R2 = 184 * MiB;
constexpr size_t WS_R3 = 250 * MiB;
constexpr size_t WS_R4 = WS_R3 + (size_t)ROWS * 1280 * 2;
constexpr size_t WS_CQN = WS_R4, WS_CKVN = WS_R4 + (size_t)ROWS * 256 * 2;
constexpr size_t WS_R5 = WS_R4 + (size_t)ROWS * 512 * 2;
constexpr size_t WS_Q = WS_R5;
constexpr size_t WS_KN = WS_Q + (size_t)ROWS * 768 * 2;
constexpr size_t WS_KR = WS_KN + (size_t)ROWS * 512 * 2;
constexpr size_t WS_VT0 = WS_KR + (size_t)ROWS * 32 * 2;
constexpr size_t WS_END = WS_VT0 + (size_t)512 * ROWS * 2;
constexpr size_t WS_Y0 = WS_R5;
constexpr size_t WS_PS = WS_R3 + (size_t)ROWS * DM * 2;
static_assert(WS_PS + (size_t)4 * 4096 * 512 * 2 <= WS_R4, "ps");
constexpr size_t WS_VT1 = WS_R3 + (size_t)ROWS * 2048 * 2;
static_assert(WS_END <= 512 * MiB, "workspace");
static_assert(WS_VT1 + (size_t)1024 * ROWS * 2 <= WS_END, "vt1");
static_assert(WS_R3 + (size_t)ROWS * FF * 2 <= WS_END, "hid");

DI int otid() { int t = threadIdx.x; asm volatile("" : "+v"(t)); return t; }
DI float wave_sum(float v) {
#pragma unroll
    for (int o = 1; o < 64; o <<= 1) v += __shfl_xor(v, o);
    return v;
}
DI unsigned cvtpk(float lo, float hi) { f32x2 v = {lo, hi}; bf16x2_t b = __builtin_convertvector(v, bf16x2_t); return __builtin_bit_cast(unsigned, b); }
DI float bf2f(unsigned short b) { return __uint_as_float(((unsigned)b) << 16); }
DI float bflo(unsigned w) { return __uint_as_float(w << 16); }
DI float bfhi(unsigned w) { return __uint_as_float(w & 0xffff0000u); }

namespace pg8 {
constexpr int BM = 256, BK = 64, HALF = 128, HTB = HALF * BK * 2, STAGE_BYTES = 8 * HTB, NXCD = 8, WGM = 8;
__host__ __device__ __forceinline__ int lds_byte(int r, int c) { const int st = (r >> 4) * 2 + (c >> 5), rr = r & 15, cc = c & 31, ob = rr * 64 + cc * 2; return st * 1024 + (ob ^ (((ob >> 9) & 1) << 5)); }
__host__ __device__ __forceinline__ void stage_rc(int b, int& R, int& C) { const int st = b / 1024, sb = b % 1024, swz = sb ^ (((sb >> 9) & 1) << 5); R = (st >> 1) * 16 + swz / 64; C = (st & 1) * 32 + (swz % 64) / 2; }
__host__ __device__ __forceinline__ int perm32(int rho) { const int n = rho >> 4, i = rho & 15; return 8 * (i >> 2) + 4 * n + (i & 3); }

struct Unit { int pm, pn, pb; };
struct Gemm {
    const bf16_t* A; const bf16_t* Bt; int nM, nN, nB, K, kseg;
    int a_rs, b_rs, a_seg, b_seg, a_bs, b_bs;
    int rot, skipctx;
};
struct StaticOrder {
    int nM, nN, nwg, tot, G, c, skipctx;
    DI void init(int nM_, int nN_, int nB_, int G_, int c_, int rot, int skip) { skipctx = skip; nM = nM_; nN = nN_; nwg = nM * nN; tot = nwg * nB_; G = G_; c = (c_ + G_ - (rot % G_)) % G_; }
    DI bool next(int i, Unit& u) const {
        const long L = (long)i * G + c; if (L >= tot) return false;
        u.pb = (int)(L / nwg); int wgid = (int)(L % nwg);
        { const int q = nwg / NXCD, r = nwg % NXCD, xcd = wgid % NXCD, off = wgid / NXCD; wgid = (xcd < r ? xcd * (q + 1) : r * (q + 1) + (xcd - r) * q) + off; }
        const int nig = WGM * nN, gid = wgid / nig, fm = gid * WGM, gsz = (nM - fm) < WGM ? (nM - fm) : WGM;
        u.pm = fm + ((wgid % nig) % gsz); u.pn = (wgid % nig) / gsz; if (skipctx) u.pm += (u.pm >> 5) + 1; return true;
    }
};

struct EpiStore {
    static constexpr bool PERM = true;
    bf16_t* O; int ldc, o_bs, ai_extra; float scale;
    DI void operator()(const f32x4 (&acc)[2][2][4][2], const Unit& u, int wr, int wc, int fr, int fq) const {
        const int row0 = u.pm * BM + wr * 64 + fr, col0 = u.pn * BM + wc * 32 + 8 * fq;
        bf16_t* base = O + (size_t)u.pb * o_bs;
#pragma unroll
        for (int ai = 0; ai < 2; ++ai)
#pragma unroll
            for (int m = 0; m < 4; ++m) { bf16_t* rowp = base + (size_t)(row0 + ai * HALF + m * 16) * ldc + (size_t)ai * ai_extra + col0;
#pragma unroll
                for (int bj = 0; bj < 2; ++bj) { const f32x4 v0 = acc[ai][bj][m][0] * scale, v1 = acc[ai][bj][m][1] * scale;
                    u32x4 w; w.x = cvtpk(v0[0], v0[1]); w.y = cvtpk(v0[2], v0[3]); w.z = cvtpk(v1[0], v1[1]); w.w = cvtpk(v1[2], v1[3]);
                    *(u32x4*)(rowp + bj * HALF) = w; } }
    }
};
struct EpiSwiglu {
    static constexpr bool PERM = true;
    bf16_t* O; int ldc;
    DI void operator()(const f32x4 (&acc)[2][2][4][2], const Unit& u, int wr, int wc, int fr, int fq) const {
        const int row0 = u.pm * BM + wr * 64 + fr, col0 = u.pn * HALF + wc * 32 + 8 * fq;
#pragma unroll
        for (int ai = 0; ai < 2; ++ai)
#pragma unroll
            for (int m = 0; m < 4; ++m) { bf16_t* rowp = O + (size_t)(row0 + ai * HALF + m * 16) * ldc + col0; float h[8];
#pragma unroll
                for (int n = 0; n < 2; ++n)
#pragma unroll
                    for (int i = 0; i < 4; ++i) { const float g = acc[ai][0][m][n][i], up = acc[ai][1][m][n][i];
                        h[n * 4 + i] = g * __builtin_amdgcn_rcpf(1.0f + __builtin_amdgcn_exp2f(-g * LOG2E)) * up; }
                u32x4 w; w.x = cvtpk(h[0], h[1]); w.y = cvtpk(h[2], h[3]); w.z = cvtpk(h[4], h[5]); w.w = cvtpk(h[6], h[7]);
                *(u32x4*)rowp = w; }
    }
};
template <int MODE> struct EpiRope {
    static constexpr bool PERM = false;
    bf16_t* O; int ldc; float qscale; int q_tiles, rope_from; const f32x2* tab;
    DI void operator()(const f32x4 (&acc)[2][2][4][2], const Unit& u, int wr, int wc, int fr, int fq) const {
        const float sc = u.pn < q_tiles ? qscale : 1.0f; const bool rope_tile = u.pn >= rope_from;
        const int col0 = u.pn * BM + wc * 32 + 4 * fq;
#pragma unroll
        for (int ai = 0; ai < 2; ++ai)
#pragma unroll
            for (int m = 0; m < 4; ++m) {
                const int row = u.pm * BM + ai * HALF + wr * 64 + m * 16 + fr; const int j = row % TPB; const int t = j - CTX;
                f32x4 cs0 = {1.f, 0.f, 1.f, 0.f}, cs1 = {1.f, 0.f, 1.f, 0.f};
                if (rope_tile && t >= 0) {
                    int pos, f0;
                    if (MODE == 16) { pos = (wc & 1) ? (t & 63) : (t >> 6); f0 = 4 * fq; } else { pos = (fq >> 1) ? (t & 63) : (t >> 6); f0 = 4 * (fq & 1); }
                    const f32x4* tp = (const f32x4*)(tab + pos * MODE + f0); cs0 = tp[0]; cs1 = tp[1];
                }
                const float c[4] = {cs0[0], cs0[2], cs1[0], cs1[2]}, s[4] = {cs0[1], cs0[3], cs1[1], cs1[3]};
                bf16_t* rowp = O + (size_t)row * ldc + col0;
#pragma unroll
                for (int bj = 0; bj < 2; ++bj) { const f32x4 x1 = acc[ai][bj][m][0] * sc, x2 = acc[ai][bj][m][1] * sc; float o1[4], o2[4];
#pragma unroll
                    for (int i = 0; i < 4; ++i) { o1[i] = x1[i] * c[i] - x2[i] * s[i]; o2[i] = x1[i] * s[i] + x2[i] * c[i]; }
                    u32x2 w1, w2; w1.x = cvtpk(o1[0], o1[1]); w1.y = cvtpk(o1[2], o1[3]); w2.x = cvtpk(o2[0], o2[1]); w2.y = cvtpk(o2[2], o2[3]);
                    *(u32x2*)(rowp + bj * HALF) = w1; *(u32x2*)(rowp + bj * HALF + 16) = w2; }
            }
    }
};

template <class Epi>
DI void gemm_phase(LAS unsigned char* lds, const Gemm g, const StaticOrder& S, const Epi& E) {
    const int tid = otid(), wid = __builtin_amdgcn_readfirstlane(tid >> 6), lane = tid & 63, wr = wid >> 2, wc = wid & 3, fr = lane & 15, fq = lane >> 4;
    const int nt = g.K / BK, kseg = g.kseg;
    unsigned voffA[2], voffB[2];
#pragma unroll
    for (int i = 0; i < 2; ++i) { int R, C; stage_rc(tid * 16 + i * 8192, R, C); const int Rb = Epi::PERM ? ((R & ~31) + perm32(R & 31)) : R;
        voffA[i] = (unsigned)(R * g.a_rs + C) * 2u; voffB[i] = (unsigned)(Rb * g.b_rs + C) * 2u; }
    const int kstep = BK * 2;
    const unsigned hstepA = (unsigned)HALF * g.a_rs * 2, hstepB = (unsigned)HALF * g.b_rs * 2;
    const unsigned tstepA = 2 * hstepA, tstepB = 2 * hstepB;
    const int segA = (g.a_seg - kseg * BK) * 2, segB = (g.b_seg - kseg * BK) * 2;
#define OFFA(t) ((t) * kstep + ((t) >= kseg ? segA : 0))
#define OFFB(t) ((t) * kstep + ((t) >= kseg ? segB : 0))
    const unsigned ldsw = (unsigned)wid * 1024u;
    const int aoff = lds_byte(wr * 64 + fr, fq * 8), boff = lds_byte(wc * 32 + fr, fq * 8);
#define PG8_SA(b, h) (((b) * 2 + (h)) * HTB)
#define PG8_SB(b, h) ((4 + (b) * 2 + (h)) * HTB)
#define PG8_STAGE(bufoff, gbase, voff) do { _Pragma("unroll") for (int _i = 0; _i < 2; ++_i) \
        __builtin_amdgcn_global_load_lds((const unsigned*)((const char*)(gbase) + (voff)[_i]), (LAS unsigned*)(lds + (bufoff) + ldsw + _i * 8192), 16, 0, 0); } while (0)
#define PG8_LDA(dst, b, h) do { _Pragma("unroll") for (int m = 0; m < 4; ++m) _Pragma("unroll") for (int k = 0; k < 2; ++k) dst[m][k] = *(const LAS bf16x8*)(lds + PG8_SA(b, h) + aoff + m * 2048 + k * 1024); } while (0)
#define PG8_LDB(dst, b, h) do { _Pragma("unroll") for (int n = 0; n < 2; ++n) _Pragma("unroll") for (int k = 0; k < 2; ++k) dst[n][k] = *(const LAS bf16x8*)(lds + PG8_SB(b, h) + boff + n * 2048 + k * 1024); } while (0)
#define PG8_MMA(ai, bj, At, Bt) do { __builtin_amdgcn_s_setprio(1); _Pragma("unroll") for (int m = 0; m < 4; ++m) _Pragma("unroll") for (int n = 0; n < 2; ++n) _Pragma("unroll") for (int k = 0; k < 2; ++k) \
        acc[ai][bj][m][n] = __builtin_amdgcn_mfma_f32_16x16x32_bf16(Bt[n][k], At[m][k], acc[ai][bj][m][n], 0, 0, 0); __builtin_amdgcn_s_setprio(0); } while (0)
#define PG8_WAIT_V(n) asm volatile("s_waitcnt vmcnt(" #n ")" ::: "memory")
#define PG8_WAIT_L(n) asm volatile("s_waitcnt lgkmcnt(" #n ")" ::: "memory")
#define PG8_BAR __builtin_amdgcn_s_barrier()
#define PG8_SCHED __builtin_amdgcn_sched_barrier(0)
    Unit cur, nxt; int ui = 0;
    if (!S.next(0, cur)) return;
    f32x4 acc[2][2][4][2];
#pragma unroll
    for (int a = 0; a < 2; ++a)
#pragma unroll
        for (int b = 0; b < 2; ++b)
#pragma unroll
            for (int m = 0; m < 4; ++m)
#pragma unroll
                for (int n = 0; n < 2; ++n) acc[a][b][m][n] = (f32x4){0.f, 0.f, 0.f, 0.f};
    bf16x8 At[4][2], B0[2][2], B1[2][2];
    const char* cA = (const char*)g.A + ((size_t)cur.pb * g.a_bs) * 2 + (size_t)cur.pm * tstepA;
    const char* cB = (const char*)g.Bt + ((size_t)cur.pb * g.b_bs) * 2 + (size_t)cur.pn * tstepB;
    {
        PG8_STAGE(PG8_SB(0, 0), cB, voffB); PG8_STAGE(PG8_SB(0, 1), cB + hstepB, voffB); PG8_STAGE(PG8_SA(0, 0), cA, voffA); PG8_STAGE(PG8_SA(0, 1), cA + hstepA, voffA);
        if (wr == 1) PG8_BAR;
        PG8_WAIT_V(2); PG8_BAR;
        PG8_STAGE(PG8_SB(1, 0), cB + OFFB(1), voffB); PG8_STAGE(PG8_SA(1, 0), cA + OFFA(1), voffA); PG8_STAGE(PG8_SB(1, 1), cB + hstepB + OFFB(1), voffB);
        PG8_WAIT_V(6); PG8_BAR;
    }
    for (;;) {
        const bool has_next = S.next(ui + 1, nxt);
        const char* nA = has_next ? (const char*)g.A + ((size_t)nxt.pb * g.a_bs) * 2 + (size_t)nxt.pm * tstepA : cA;
        const char* nB = has_next ? (const char*)g.Bt + ((size_t)nxt.pb * g.b_bs) * 2 + (size_t)nxt.pn * tstepB : cB;
        for (int t = 0; t < nt; t += 2) {
            const bool last = (t == nt - 2);
            const char* a1 = cA + OFFA(t + 1);
            const char* a2 = last ? nA : cA + OFFA(t + 2); const char* b2 = last ? nB : cB + OFFB(t + 2);
            const char* a3 = last ? nA + OFFA(1) : cA + OFFA(t + 3); const char* b3 = last ? nB + OFFB(1) : cB + OFFB(t + 3);
            PG8_LDB(B0, 0, 0); PG8_LDB(B1, 0, 1); PG8_SCHED; PG8_LDA(At, 0, 0); PG8_STAGE(PG8_SA(1, 1), a1 + hstepA, voffA);
            PG8_WAIT_V(8); PG8_WAIT_L(0); PG8_BAR; PG8_MMA(0, 0, At, B0); PG8_MMA(0, 1, At, B1); PG8_BAR; PG8_SCHED;
            PG8_LDA(At, 0, 1); PG8_STAGE(PG8_SB(0, 0), b2, voffB); PG8_STAGE(PG8_SB(0, 1), b2 + hstepB, voffB); PG8_STAGE(PG8_SA(0, 0), a2, voffA);
            PG8_WAIT_V(8); PG8_WAIT_L(0); PG8_BAR; PG8_MMA(1, 0, At, B0); PG8_MMA(1, 1, At, B1); PG8_BAR; PG8_SCHED;
            PG8_LDB(B0, 1, 0); PG8_LDB(B1, 1, 1); PG8_SCHED; PG8_LDA(At, 1, 0); PG8_STAGE(PG8_SA(0, 1), a2 + hstepA, voffA);
            PG8_WAIT_V(8); PG8_WAIT_L(0); PG8_BAR; PG8_MMA(0, 0, At, B0); PG8_MMA(0, 1, At, B1); PG8_BAR; PG8_SCHED;
            PG8_LDA(At, 1, 1); PG8_STAGE(PG8_SB(1, 0), b3, voffB); PG8_STAGE(PG8_SB(1, 1), b3 + hstepB, voffB); PG8_STAGE(PG8_SA(1, 0), a3, voffA);
            PG8_WAIT_V(8); PG8_WAIT_L(0); PG8_BAR; PG8_MMA(1, 0, At, B0); PG8_MMA(1, 1, At, B1); PG8_BAR; PG8_SCHED;
        }
        if (wr == 0) PG8_BAR;
        E(acc, cur, wr, wc, fr, fq);
        if (!has_next) break;
#pragma unroll
        for (int a = 0; a < 2; ++a)
#pragma unroll
            for (int b = 0; b < 2; ++b)
#pragma unroll
                for (int m = 0; m < 4; ++m)
#pragma unroll
                    for (int n = 0; n < 2; ++n) acc[a][b][m][n] = (f32x4){0.f, 0.f, 0.f, 0.f};
        cur = nxt; cA = nA; cB = nB; ++ui;
        if (wr == 1) PG8_BAR;
    }
    PG8_WAIT_V(0);
    PG8_BAR;
#undef OFFA
#undef OFFB
#undef PG8_SA
#undef PG8_SB
#undef PG8_STAGE
#undef PG8_LDA
#undef PG8_LDB
#undef PG8_MMA
#undef PG8_WAIT_V
#undef PG8_WAIT_L
#undef PG8_BAR
#undef PG8_SCHED
}
}

#define MFMA32(a, b, c) __builtin_amdgcn_mfma_f32_32x32x16_bf16((a), (b), (c), 0, 0, 0)
template <int D1, int D2, int DV>
DI void attn_core(f32x16 (&o)[DV / 32], float& l_out, LAS unsigned char* lds, const bf16_t* q1, const bf16_t* q2,
                  const bf16_t* k1, long ldk1, const bf16_t* k2, long ldk2, const bf16_t* vt, long ldv, int ntiles) {
    constexpr int DQK = D1 + D2, KROW = DQK * 2 + 16, VROW = 144, KT = 64 * KROW, VT = DV * VROW, BUF = KT + VT;
    constexpr int KCH = DQK / 8, NKC = 64 * KCH, NVC = DV * 8, KPT = (NKC + 511) / 512, VPT = NVC / 512;
    const int tid = otid(), lane = tid & 63, r = lane & 31, h = lane >> 5;
    bf16x8 qf[DQK / 16];
#pragma unroll
    for (int d0 = 0; d0 < DQK / 16; ++d0) qf[d0] = (16 * d0 < D1) ? *(const bf16x8*)(q1 + 16 * d0 + 8 * h) : *(const bf16x8*)(q2 + (16 * d0 - D1) + 8 * h);
    u32x4 kreg[KPT], vreg[VPT];
    auto gload = [&](int t) {
#pragma unroll
        for (int i = 0; i < KPT; ++i) { const int c = tid + i * 512; if (c < NKC) { const int row = c / KCH, cc = (c % KCH) * 8;
            kreg[i] = (cc < D1) ? *(const u32x4*)(k1 + (size_t)(t * 64 + row) * ldk1 + cc) : *(const u32x4*)(k2 + (size_t)(t * 64 + row) * ldk2 + (cc - D1)); } }
#pragma unroll
        for (int i = 0; i < VPT; ++i) { const int c = tid + i * 512; const int d = c >> 3, cc = (c & 7) * 8; vreg[i] = *(const u32x4*)(vt + (size_t)d * ldv + t * 64 + cc); }
    };
    auto sstore = [&](int b) {
        LAS unsigned char* kb = lds + b * BUF; LAS unsigned char* vb = kb + KT;
#pragma unroll
        for (int i = 0; i < KPT; ++i) { const int c = tid + i * 512; if (c < NKC) { const int row = c / KCH, cc = (c % KCH) * 8; *(LAS u32x4*)(kb + row * KROW + cc * 2) = kreg[i]; } }
#pragma unroll
        for (int i = 0; i < VPT; ++i) { const int c = tid + i * 512; const int d = c >> 3, cc = (c & 7) * 8; *(LAS u32x4*)(vb + d * VROW + cc * 2) = vreg[i]; }
    };
    const int pr = (r & ~12) | ((r & 4) << 1) | ((r & 8) >> 1);
    float mrun = 0.f, lrun = 0.f;
    f32x16 negm;
#pragma unroll
    for (int i = 0; i < 16; ++i) negm[i] = 0.f;
#pragma unroll
    for (int b = 0; b < DV / 32; ++b)
#pragma unroll
        for (int i = 0; i < 16; ++i) o[b][i] = 0.f;
    gload(0); sstore(0); __syncthreads();
    for (int t = 0; t < ntiles; ++t) {
        if (t + 1 < ntiles) gload(t + 1);
        const LAS unsigned char* kb = lds + (t & 1) * BUF; const LAS unsigned char* vb = kb + KT;
        f32x16 p[2];
        {
            bf16x8 kf[2][DQK / 16];
#pragma unroll
            for (int hf = 0; hf < 2; ++hf)
#pragma unroll
                for (int d0 = 0; d0 < DQK / 16; ++d0) kf[hf][d0] = *(const LAS bf16x8*)(kb + (32 * hf + pr) * KROW + (16 * d0 + 8 * h) * 2);
            __builtin_amdgcn_sched_barrier(0);
#pragma unroll
            for (int d0 = 0; d0 < DQK / 16; ++d0)
#pragma unroll
                for (int hf = 0; hf < 2; ++hf) p[hf] = MFMA32(kf[hf][d0], qf[d0], d0 == 0 ? negm : p[hf]);
            __builtin_amdgcn_sched_barrier(0);
        }
        bf16x8 vf[DV / 32][4];
#define LDV(b) do { _Pragma("unroll") for (int i = 0; i < 4; ++i) vf[b][i] = *(const LAS bf16x8*)(vb + (32 * (b) + r) * VROW + (16 * i + 8 * h) * 2); } while (0)
        LDV(0);
        __builtin_amdgcn_sched_barrier(0);
        float ta = fmaxf(fmaxf(p[0][0], p[0][1]), p[1][0]), tb = fmaxf(fmaxf(p[0][2], p[0][3]), p[1][1]);
        ta = fmaxf(fmaxf(ta, p[1][2]), p[1][3]);
#pragma unroll
        for (int i = 4; i < 16; i += 4) { ta = fmaxf(fmaxf(ta, p[0][i]), p[0][i + 1]); tb = fmaxf(fmaxf(tb, p[0][i + 2]), p[0][i + 3]); ta = fmaxf(fmaxf(ta, p[1][i]), p[1][i + 1]); tb = fmaxf(fmaxf(tb, p[1][i + 2]), p[1][i + 3]); }
        float tm = fmaxf(ta, tb); tm = fmaxf(tm, __shfl_xor(tm, 32));
        if (__any(t == 0 || tm > 8.0f)) {
            const float dl = (t == 0 || tm > 0.f) ? tm : 0.f; mrun += dl;
            const float alpha = __builtin_amdgcn_exp2f(-dl); lrun *= alpha;
#pragma unroll
            for (int i = 0; i < 16; ++i) { p[0][i] -= dl; p[1][i] -= dl; negm[i] = -mrun; }
#pragma unroll
            for (int b = 0; b < DV / 32; ++b)
#pragma unroll
                for (int i = 0; i < 16; ++i) o[b][i] *= alpha;
        }
        float rs0 = 0.f, rs1 = 0.f;
#pragma unroll
        for (int i = 0; i < 16; ++i) { p[0][i] = __builtin_amdgcn_exp2f(p[0][i]); rs0 += p[0][i]; p[1][i] = __builtin_amdgcn_exp2f(p[1][i]); rs1 += p[1][i]; }
        lrun += rs0 + rs1;
        bf16x8 pf[4];
#pragma unroll
        for (int ks = 0; ks < 4; ++ks) { const int hf = ks >> 1, s8 = (ks & 1) * 8; u32x4 w;
            w.x = cvtpk(p[hf][s8 + 0], p[hf][s8 + 1]); w.y = cvtpk(p[hf][s8 + 2], p[hf][s8 + 3]); w.z = cvtpk(p[hf][s8 + 4], p[hf][s8 + 5]); w.w = cvtpk(p[hf][s8 + 6], p[hf][s8 + 7]);
            pf[ks] = __builtin_bit_cast(bf16x8, w); }
        __builtin_amdgcn_sched_barrier(0);
#pragma unroll
        for (int b = 0; b < DV / 32; ++b) {
            if (b + 1 < DV / 32) LDV(b + 1);
            __builtin_amdgcn_sched_barrier(0);
#pragma unroll
            for (int i = 0; i < 4; ++i) o[b] = MFMA32(vf[b][i], pf[i], o[b]);
            __builtin_amdgcn_sched_barrier(0);
        }
#undef LDV
        if (t + 1 < ntiles) sstore((t + 1) & 1);
        __syncthreads();
    }
    l_out = lrun + __shfl_xor(lrun, 32);
}
constexpr int ATTN_LDS = 2 * (64 * (96 * 2 + 16) + 128 * 144);


#define XB_TMO      128
#define XB_XCNT(j)  (256  + 64 * (j))
#define XB_XSUB(j)  (1280 + 64 * (j))
#define XB_XGEN(j)  (2304 + 64 * (j))
#define XB_TOP      3328
#define XB_TOPGEN   3392
#define XCD_BAR_WORDS 3456
#define XB_SPIN_CAP (1u << 18)
DI unsigned xb_ld(unsigned* p)              { return __hip_atomic_load(p, __ATOMIC_RELAXED, __HIP_MEMORY_SCOPE_AGENT); }
DI unsigned xb_add(unsigned* p, unsigned v) { return __hip_atomic_fetch_add(p, v, __ATOMIC_RELAXED, __HIP_MEMORY_SCOPE_AGENT); }
DI unsigned xb_xcc_id() { return (unsigned)__builtin_amdgcn_s_getreg((3 << 11) | 20) & 0xFu; }
#define XB_SPIN(cond, bar) do { unsigned _sp = 0; while (cond) { __builtin_amdgcn_s_sleep(1); \
    if ((++_sp & 255u) == 0u) { if (xb_ld(&(bar)[XB_TMO])) break; if (_sp > XB_SPIN_CAP) { atomicAdd(&(bar)[XB_TMO], 1u); break; } } } } while (0)
struct XcdBarrier { unsigned* bar; unsigned x; volatile LAS unsigned* st; };
DI XcdBarrier xcd_barrier_post(unsigned* bar, volatile LAS unsigned* st) {
    XcdBarrier b; b.bar = bar; b.x = xb_xcc_id(); b.st = st;
    if (threadIdx.x == 0) (void)xb_add(&bar[XB_XCNT(b.x)], 1u);
    return b;
}
DI void xcd_barrier_complete(unsigned* bar, unsigned x, unsigned& nloc, unsigned& nx) {
    const unsigned G = gridDim.x * gridDim.y * gridDim.z;
    unsigned sum, cnt, mine, sp = 0u;
    for (;;) {
        sum = 0u; cnt = 0u; mine = 0u;
#pragma unroll
        for (unsigned j = 0; j < 16; ++j) { const unsigned c = xb_ld(&bar[XB_XCNT(j)]); sum += c; cnt += (c > 0u) ? 1u : 0u; mine = (j == x) ? c : mine; }
        if (sum == G) break;
        __builtin_amdgcn_s_sleep(1);
        if ((++sp & 255u) == 0u) { if (xb_ld(&bar[XB_TMO])) break; if (sp > XB_SPIN_CAP) { atomicAdd(&bar[XB_TMO], 1u); break; } }
    }
    nloc = mine > 0u ? mine : 1u; nx = cnt > 0u ? cnt : 1u;
}
DI void xcd_barrier(const XcdBarrier& b) {
    asm volatile("s_waitcnt vmcnt(0)" ::: "memory");
    __syncthreads();
    if (threadIdx.x == 0) {
        unsigned* bar = b.bar;
        __builtin_amdgcn_s_waitcnt(0);
        unsigned nloc = b.st[0], nx = b.st[1];
        if (nloc == 0u) { xcd_barrier_complete(bar, b.x, nloc, nx); b.st[0] = nloc; b.st[1] = nx; }
        const unsigned old = xb_add(&bar[XB_XSUB(b.x)], 1u);
        const unsigned gen = old / nloc;
        if (old + 1u == (gen + 1u) * nloc) {
            __builtin_amdgcn_fence(__ATOMIC_RELEASE, "agent");
            asm volatile("s_waitcnt vmcnt(0)" ::: "memory");
            const unsigned og = xb_add(&bar[XB_TOP], 1u);
            const unsigned tg = og / nx;
            if (og + 1u == (tg + 1u) * nx) xb_add(&bar[XB_TOPGEN], 1u);
            else XB_SPIN(xb_ld(&bar[XB_TOPGEN]) == tg, bar);
            __builtin_amdgcn_fence(__ATOMIC_ACQUIRE, "agent");
            xb_add(&bar[XB_XGEN(b.x)], 1u);
            asm volatile("s_waitcnt vmcnt(0)" ::: "memory");
        } else {
            XB_SPIN(xb_ld(&bar[XB_XGEN(b.x)]) == gen, bar);
            __builtin_amdgcn_fence(__ATOMIC_ACQUIRE, "agent");
            asm volatile("s_waitcnt vmcnt(0)" ::: "memory");
        }
    }
    __syncthreads();
}

struct Args {
    const float* in[35]; float* out; unsigned char* ws; int ph_lo, ph_hi;
};
enum { I_X = 0, I_C, I_CTX, I_CCTX,
       I0_WMOD, I0_BMOD, I0_WIN, I0_QN, I0_WUQ, I0_KVN, I0_WUKV, I0_WOUT, I0_LN1G, I0_LN1B, I0_WG, I0_WU, I0_WD, I0_LN2G, I0_LN2B,
       I1_WMOD, I1_BMOD, I1_WIN, I1_LQ1, I1_LK1, I1_LQ2, I1_LK2, I1_SUBLN, I1_WOUT, I1_LN1G, I1_LN1B, I1_WG, I1_WU, I1_WD, I1_LN2G, I1_LN2B };

DI bf16_t* tr_dst(int job, int n, unsigned char* ws) {
    switch (job) {
    case 0: return (bf16_t*)(ws + W_IN0) + (size_t)n * 1024;
    case 1: { const int hd = n / 96, d = n % 96; int row; if (d < 64) row = hd * 64 + d; else { const int e = d - 64, t = e >> 3, f = e & 7; row = 512 + hd * 32 + 16 * (t & 1) + 8 * (t >> 1) + f; }
              return (bf16_t*)(ws + W_UQ) + (size_t)row * 256; }
    case 2: { const int hd = n >> 7, d = n & 127; return d < 64 ? (bf16_t*)(ws + W_KN) + (size_t)(hd * 64 + d) * 256 : (bf16_t*)(ws + W_V0) + (size_t)(hd * 64 + d - 64) * 256; }
    case 3: return (bf16_t*)(ws + W_OUT0) + (size_t)n * 1024;
    case 4: return (bf16_t*)(ws + W_GU0) + (size_t)(256 * (n >> 7) + (n & 127)) * 1024;
    case 5: return (bf16_t*)(ws + W_GU0) + (size_t)(256 * (n >> 7) + 128 + (n & 127)) * 1024;
    case 6: return (bf16_t*)(ws + W_D0) + (size_t)n * 2816;
    case 7: return n < 2048 ? (bf16_t*)(ws + W_QK1) + (size_t)n * 1024 : (bf16_t*)(ws + W_V1) + (size_t)(n - 2048) * 1024;
    case 8: return (bf16_t*)(ws + W_OUT1) + (size_t)n * 1024;
    case 9: return (bf16_t*)(ws + W_GU1) + (size_t)(256 * (n >> 7) + (n & 127)) * 1024;
    case 10: return (bf16_t*)(ws + W_GU1) + (size_t)(256 * (n >> 7) + 128 + (n & 127)) * 1024;
    default: return (bf16_t*)(ws + W_D1) + (size_t)n * 2816;
    }
}
DI void transpose_item(const float* W, int K, int N, int job, unsigned char* ws, LAS float* scr, int item, int lane) {
    const int nblk = N / 32, kb = item / nblk, nb = item % nblk, k0 = 64 * kb, n0 = 32 * nb;
#pragma unroll 8
    for (int i = 0; i < 32; ++i) { const int kk = 2 * i + (lane >> 5); scr[kk * 33 + (lane & 31)] = W[(size_t)(k0 + kk) * N + n0 + (lane & 31)]; }
    asm volatile("s_waitcnt lgkmcnt(0)" ::: "memory");
    const int c = lane & 7;
#pragma unroll
    for (int j = 0; j < 4; ++j) { const int n = (lane >> 3) + 8 * j; const LAS float* s = scr + (8 * c) * 33 + n;
        u32x4 o; o.x = cvtpk(s[0 * 33], s[1 * 33]); o.y = cvtpk(s[2 * 33], s[3 * 33]); o.z = cvtpk(s[4 * 33], s[5 * 33]); o.w = cvtpk(s[6 * 33], s[7 * 33]);
        bf16_t* dst = tr_dst(job, n0 + n, ws); *(u32x4*)(dst + k0 + 8 * c) = o; }
    asm volatile("s_waitcnt lgkmcnt(0)" ::: "memory");
}

DI void prologue(const Args& a, LAS unsigned char* lds) {
    unsigned char* ws = a.ws;
    const int tid = otid(), lane = tid & 63, wave = tid >> 6;
    const int G = gridDim.x, gw = blockIdx.x * 8 + wave, NGW = G * 8;
    const long gt = (long)blockIdx.x * 512 + tid, NGT = (long)G * 512;
    {
        LAS float* scr = (LAS float*)(lds + wave * 16384);
        const int jin[12] = {I0_WIN, I0_WUQ, I0_WUKV, I0_WOUT, I0_WG, I0_WU, I0_WD, I1_WIN, I1_WOUT, I1_WG, I1_WU, I1_WD};
        const int jK[12] = {1024, 256, 256, 1024, 1024, 1024, 2816, 1024, 1024, 1024, 1024, 2816};
        const int jN[12] = {1056, 768, 1024, 1024, 2816, 2816, 1024, 3072, 1024, 2816, 2816, 1024};
        int base = 0;
#pragma unroll
        for (int j = 0; j < 12; ++j) { const int items = (jK[j] / 64) * (jN[j] / 32);
            for (int it = gw; it < items; it += NGW) transpose_item(a.in[jin[j]], jK[j], jN[j], j, ws, scr, it, lane);
            base += items; }
        u32x4 z = {0u, 0u, 0u, 0u};
        for (long i = gt; i < (1280 - 1056) * 1024 / 8; i += NGT) ((u32x4*)((bf16_t*)(ws + W_IN0) + (size_t)1056 * 1024))[i] = z;
    }
    {
        const float sc = 0.011048543456039806f;
        for (long i = gt; i < (long)4096 * 2048; i += NGT) { const int k = (int)(i >> 11), c8 = (int)(i & 2047) * 8; const int part = c8 >> 13, n0 = c8 & 8191; float v[8];
#pragma unroll
            for (int e = 0; e < 8; ++e) { const float ph = (float)((k * (n0 + e)) & 8191) * (1.0f / 8192.0f); v[e] = (part ? __builtin_amdgcn_sinf(ph) : __builtin_amdgcn_cosf(ph)) * sc; }
            u32x4 o; o.x = cvtpk(v[0], v[1]); o.y = cvtpk(v[2], v[3]); o.z = cvtpk(v[4], v[5]); o.w = cvtpk(v[6], v[7]);
            *(u32x4*)((bf16_t*)(ws + WS_DN) + (size_t)k * 16384 + c8) = o; }
        for (long i = gt; i < 256 * 512; i += NGT) { const int k = (int)(i >> 9), c = (int)(i & 511), part = c >> 8, n = c & 255; const float ph = (float)((k * n) & 255) * (1.0f / 256.0f);
            const float v = (part ? __builtin_amdgcn_sinf(ph) : __builtin_amdgcn_cosf(ph)) * 0.0625f; ((bf16_t*)(ws + W_D256))[i] = (bf16_t)(cvtpk(v, 0.f) & 0xffffu); }
        for (long i = gt; i < 256 * 128; i += NGT) { const int rr = (int)(i >> 7), c = (int)(i & 127), part = rr >> 7, l = rr & 127; const float ph = (float)((l * c) & 127) * (1.0f / 128.0f);
            const float v = (part ? -__builtin_amdgcn_sinf(ph) : __builtin_amdgcn_cosf(ph)) * 0.08838834764831845f; ((bf16_t*)(ws + W_DC))[i] = (bf16_t)(cvtpk(v, 0.f) & 0xffffu); }
        for (long i = gt; i < 128 * 16; i += NGT) { const int pos = (int)(i >> 4), f = (int)(i & 15); const float inv = 1.0f / powf(10000.0f, (float)f / 16.0f); const float ang = (float)pos * inv;
            ((f32x2*)(ws + WS_TAB16))[i] = (f32x2){cosf(ang), sinf(ang)}; }
        for (long i = gt; i < 128 * 8; i += NGT) { const int pos = (int)(i >> 3), f = (int)(i & 7); const float inv = 1.0f / powf(10000.0f, (float)f / 8.0f); const float ang = (float)pos * inv;
            ((f32x2*)(ws + WS_TAB8))[i] = (f32x2){cosf(ang), sinf(ang)}; }
    }
    {
        LAS float* red = (LAS float*)lds;
        for (int it = blockIdx.x; it < 2 * 96; it += G) {
            __syncthreads();
            const int layer = it / 96, n = (it % 96) * 64 + lane; const float* w = a.in[layer ? I1_WMOD : I0_WMOD]; const float* bm = a.in[layer ? I1_BMOD : I0_BMOD];
            float acc[5] = {0.f, 0.f, 0.f, 0.f, 0.f};
            for (int kk = 0; kk < 128; ++kk) { const int k = wave * 128 + kk; const float wv = w[(size_t)k * 6144 + n];
#pragma unroll
                for (int cls = 0; cls < 5; ++cls) { const float cv = cls < 4 ? a.in[I_C][cls * 1024 + k] : a.in[I_CCTX][k]; const float sl = cv / (1.0f + __expf(-cv)); acc[cls] += sl * wv; } }
#pragma unroll
            for (int cls = 0; cls < 5; ++cls) red[(wave * 5 + cls) * 64 + lane] = acc[cls];
            __syncthreads();
            if (tid < 320) { const int cls = tid >> 6, l = tid & 63; float s = 0.f;
#pragma unroll
                for (int w8 = 0; w8 < 8; ++w8) s += red[(w8 * 5 + cls) * 64 + l];
                const int nn = (it % 96) * 64 + l; ((float*)(ws + WS_MOD))[(size_t)(layer * 5 + cls) * 6144 + nn] = s + bm[nn]; }
        }
        __syncthreads();
    }
}

struct RowPass {
    const float* xl; const float* xc;
    float* ol; float* oc;
    const bf16_t* Y;
    const float* mod;
    int gate_off; const float* lng; const float* lnb;
    const float* mod2; int sc_off, sh_off;
    bf16_t* H;
    int skipctx;
};
DI void ln_stats(const f32x4 (&v)[4], float& mean, float& rstd) {
    float s = 0.f;
#pragma unroll
    for (int j = 0; j < 4; ++j) s += (v[j][0] + v[j][1]) + (v[j][2] + v[j][3]);
    mean = wave_sum(s) * (1.0f / DM); float q = 0.f;
#pragma unroll
    for (int j = 0; j < 4; ++j) { const f32x4 d = v[j] - mean; q += (d[0] * d[0] + d[1] * d[1]) + (d[2] * d[2] + d[3] * d[3]); }
    rstd = 1.0f / sqrtf(wave_sum(q) * (1.0f / DM) + LN_EPS);
}
DI void row_pass(const RowPass& P, int m, int lane) {
    const int b = m / TPB, j = m % TPB; const bool isctx = j < CTX; const int cls = isctx ? 4 : b;
    if (P.skipctx && isctx) return;
    const size_t xoff = isctx ? (size_t)(b * CTX + j) * DM : (size_t)(b * SEQ + j - CTX) * DM;
    const float* xs = (isctx ? P.xc : P.xl) + xoff; float* xd = isctx ? P.oc : P.ol;
    f32x4 v[4];
#pragma unroll
    for (int jj = 0; jj < 4; ++jj) v[jj] = *(const f32x4*)(xs + 4 * lane + 256 * jj);
    if (P.Y) {
        const float* gate = P.mod + (size_t)cls * 6144 + P.gate_off;
#pragma unroll
        for (int jj = 0; jj < 4; ++jj) { const int c0 = 4 * lane + 256 * jj; const u32x2 yw = *(const u32x2*)(P.Y + (size_t)m * DM + c0); const f32x4 g = *(const f32x4*)(gate + c0);
            v[jj][0] = DN_ALPHA * v[jj][0] + g[0] * bflo(yw.x); v[jj][1] = DN_ALPHA * v[jj][1] + g[1] * bfhi(yw.x);
            v[jj][2] = DN_ALPHA * v[jj][2] + g[2] * bflo(yw.y); v[jj][3] = DN_ALPHA * v[jj][3] + g[3] * bfhi(yw.y); }
        float mean, rstd; ln_stats(v, mean, rstd);
#pragma unroll
        for (int jj = 0; jj < 4; ++jj) { const int c0 = 4 * lane + 256 * jj; const f32x4 g = *(const f32x4*)(P.lng + c0), bb = *(const f32x4*)(P.lnb + c0); v[jj] = (v[jj] - mean) * rstd * g + bb; }
        if (xd) {
#pragma unroll
            for (int jj = 0; jj < 4; ++jj) *(f32x4*)(xd + xoff + 4 * lane + 256 * jj) = v[jj];
        }
    }
    if (P.H) {
        float mean, rstd; ln_stats(v, mean, rstd);
        const float* sc = P.mod2 + (size_t)cls * 6144 + P.sc_off; const float* sh = P.mod2 + (size_t)cls * 6144 + P.sh_off;
#pragma unroll
        for (int jj = 0; jj < 4; ++jj) { const int c0 = 4 * lane + 256 * jj; const f32x4 s1 = *(const f32x4*)(sc + c0), s0 = *(const f32x4*)(sh + c0);
            const f32x4 hh = (v[jj] - mean) * rstd * (s1 + 1.0f) + s0; u32x2 w; w.x = cvtpk(hh[0], hh[1]); w.y = cvtpk(hh[2], hh[3]);
            *(u32x2*)(P.H + (size_t)m * DM + c0) = w; }
    }
}
DI void p3_row(const Args& a, int m, int lane) {
    unsigned char* ws = a.ws; const bf16_t* U = (const bf16_t*)(ws + WS_R3) + (size_t)m * 1280;
    const u32x2 qw = *(const u32x2*)(U + 512 + 4 * lane), kw = *(const u32x2*)(U + 768 + 4 * lane);
    float q[4] = {bflo(qw.x), bfhi(qw.x), bflo(qw.y), bfhi(qw.y)}, k[4] = {bflo(kw.x), bfhi(kw.x), bflo(kw.y), bfhi(kw.y)};
    const float qs = wave_sum(q[0] * q[0] + q[1] * q[1] + q[2] * q[2] + q[3] * q[3]), ks = wave_sum(k[0] * k[0] + k[1] * k[1] + k[2] * k[2] + k[3] * k[3]);
    const float qr = 1.0f / sqrtf(qs * (1.0f / 256.0f) + RMS_EPS), kr_ = 1.0f / sqrtf(ks * (1.0f / 256.0f) + RMS_EPS);
    const f32x4 qg = *(const f32x4*)(a.in[I0_QN] + 4 * lane), kg = *(const f32x4*)(a.in[I0_KVN] + 4 * lane);
    u32x2 w; w.x = cvtpk(q[0] * qr * qg[0], q[1] * qr * qg[1]); w.y = cvtpk(q[2] * qr * qg[2], q[3] * qr * qg[3]);
    *(u32x2*)((bf16_t*)(ws + WS_CQN) + (size_t)m * 256 + 4 * lane) = w;
    w.x = cvtpk(k[0] * kr_ * kg[0], k[1] * kr_ * kg[1]); w.y = cvtpk(k[2] * kr_ * kg[2], k[3] * kr_ * kg[3]);
    *(u32x2*)((bf16_t*)(ws + WS_CKVN) + (size_t)m * 256 + 4 * lane) = w;
    const int d = lane & 31, t = d >> 3, f = d & 7; const float val = bf2f(U[1024 + d]); const float par = __shfl_xor(val, 8);
    const int j = m % TPB, tt = j - CTX; float outv = val;
    if (tt >= 0) { const int pos = (t < 2) ? (tt >> 6) : (tt & 63); const f32x2 cs = ((const f32x2*)(ws + WS_TAB8))[pos * 8 + f];
        outv = (t & 1) ? (par * cs[1] + val * cs[0]) : (val * cs[0] - par * cs[1]); }
    if (lane < 32) ((bf16_t*)(ws + WS_KR))[(size_t)m * 32 + 16 * (t & 1) + 8 * (t >> 1) + f] = (bf16_t)(cvtpk(outv, 0.f) & 0xffffu);
}
DI void mirror_items(const Args& a, int gw, int NGW, int lane) {
    unsigned char* ws = a.ws; bf16_t* MIX = (bf16_t*)(ws + WS_R3); const bf16_t* At = (const bf16_t*)(ws + WS_R2);
    for (int it = gw; it < NB * 512; it += NGW) { const int b = it >> 9, ch = it & 511; const bf16_t* src = At + (size_t)ch * ROWS + b * TPB + CTX; float s = 0.f;
        for (int i = 0; i < 16; ++i) { const u32x4 w = *(const u32x4*)(src + (i * 64 + lane) * 8);
            s += (bflo(w.x) - bfhi(w.x)) + (bflo(w.y) - bfhi(w.y)) + (bflo(w.z) - bfhi(w.z)) + (bflo(w.w) - bfhi(w.w)); }
        s = wave_sum(s) * 0.011048543456039806f;
        if (lane == 0) MIX[(size_t)(b * TPB + CTX + 4096) * DM + ch] = (bf16_t)(cvtpk(s, 0.f) & 0xffffu); }
    const bf16_t* PS = (const bf16_t*)(ws + WS_PS);
    for (int it = gw; it < NB * 4096; it += NGW) { const int b = it >> 12, k = it & 4095;
        bf16_t* src = MIX + (size_t)(b * TPB + CTX + k) * DM + 8 * lane; const u32x4 pc = *(const u32x4*)src; const u32x4 ps = *(const u32x4*)(PS + ((size_t)(b * 4096 + k)) * 512 + 8 * lane);
        u32x4 sm, df;
        sm.x = cvtpk(bflo(pc.x) + bflo(ps.x), bfhi(pc.x) + bfhi(ps.x)); df.x = cvtpk(bflo(pc.x) - bflo(ps.x), bfhi(pc.x) - bfhi(ps.x));
        sm.y = cvtpk(bflo(pc.y) + bflo(ps.y), bfhi(pc.y) + bfhi(ps.y)); df.y = cvtpk(bflo(pc.y) - bflo(ps.y), bfhi(pc.y) - bfhi(ps.y));
        sm.z = cvtpk(bflo(pc.z) + bflo(ps.z), bfhi(pc.z) + bfhi(ps.z)); df.z = cvtpk(bflo(pc.z) - bflo(ps.z), bfhi(pc.z) - bfhi(ps.z));
        sm.w = cvtpk(bflo(pc.w) + bflo(ps.w), bfhi(pc.w) + bfhi(ps.w)); df.w = cvtpk(bflo(pc.w) - bflo(ps.w), bfhi(pc.w) - bfhi(ps.w));
        *(u32x4*)src = sm;
        if (k >= 1) *(u32x4*)(MIX + (size_t)(b * TPB + CTX + 8192 - k) * DM + 8 * lane) = df; }
}

DI bool attn_unit_map(int L, int nunits_big, int& bh, int& qb) {
    if (L < nunits_big) { const int i = L >> 8, c = L & 255; bh = 4 * (c & 7) + i; qb = 1 + (c >> 3); return true; }
    bh = L - nunits_big; qb = 0; return bh < 32;
}
DI void attn_mla_unit(const Args& a, LAS unsigned char* lds, int bh, int qb) {
    unsigned char* ws = a.ws; const int tid = otid(), lane = tid & 63, wave = tid >> 6, r = lane & 31, h = lane >> 5;
    const int b = bh >> 3, hd = bh & 7; const int m = b * TPB + qb * 256 + wave * 32 + r;
    const bf16_t* Q = (const bf16_t*)(ws + WS_Q) + (size_t)m * 768;
    const bf16_t* KN = (const bf16_t*)(ws + WS_KN) + (size_t)(b * TPB) * 512 + hd * 64;
    const bf16_t* KR = (const bf16_t*)(ws + WS_KR) + (size_t)(b * TPB) * 32;
    const bf16_t* VT = (const bf16_t*)(ws + WS_VT0) + (size_t)(hd * 64) * ROWS + b * TPB;
    f32x16 o[2]; float l;
    attn_core<64, 32, 64>(o, l, lds, Q + hd * 64, Q + 512 + hd * 32, KN, 512, KR, 32, VT, ROWS, qb == 0 ? CTX / 64 : TPB / 64);
    const float il = 1.0f / l; bf16_t* dst = (bf16_t*)(ws + WS_R3) + (size_t)m * DM + 512 + hd * 64;
#pragma unroll
    for (int blk = 0; blk < 2; ++blk)
#pragma unroll
        for (int g = 0; g < 4; ++g) { u32x2 w; w.x = cvtpk(o[blk][4 * g] * il, o[blk][4 * g + 1] * il); w.y = cvtpk(o[blk][4 * g + 2] * il, o[blk][4 * g + 3] * il);
            *(u32x2*)(dst + 32 * blk + 8 * g + 4 * h) = w; }
}
DI void attn_diff_unit(const Args& a, LAS unsigned char* lds, int bh, int qb, float lam) {
    unsigned char* ws = a.ws; const int tid = otid(), lane = tid & 63, wave = tid >> 6, r = lane & 31, h = lane >> 5;
    const int b = bh >> 3, hd = bh & 7; const int m = b * TPB + qb * 256 + wave * 32 + r;
    const bf16_t* QK = (const bf16_t*)(ws + WS_R3);
    const bf16_t* VT = (const bf16_t*)(ws + WS_VT1) + (size_t)(hd * 128) * ROWS + b * TPB;
    LAS unsigned* stash = (LAS unsigned*)(lds + 55296) + wave * 2048 + lane;
    f32x16 o[4]; float l;
    {
        const bf16_t* q = QK + (size_t)m * 2048 + (hd * 2) * 64; const bf16_t* k = QK + (size_t)(b * TPB) * 2048 + 1024 + (hd * 2) * 64;
        attn_core<64, 0, 128>(o, l, lds, q, q, k, 2048, k, 2048, VT, ROWS, TPB / 64);
        const float il = 1.0f / l;
#pragma unroll
        for (int blk = 0; blk < 4; ++blk)
#pragma unroll
            for (int i = 0; i < 8; ++i) stash[(blk * 8 + i) * 64] = cvtpk(o[blk][2 * i] * il, o[blk][2 * i + 1] * il);
    }
    {
        const bf16_t* q = QK + (size_t)m * 2048 + (hd * 2 + 1) * 64; const bf16_t* k = QK + (size_t)(b * TPB) * 2048 + 1024 + (hd * 2 + 1) * 64;
        attn_core<64, 0, 128>(o, l, lds, q, q, k, 2048, k, 2048, VT, ROWS, TPB / 64);
    }
    const float il = lam / l; float ss = 0.f;
#pragma unroll
    for (int blk = 0; blk < 4; ++blk)
#pragma unroll
        for (int i = 0; i < 8; ++i) { const unsigned aw = stash[(blk * 8 + i) * 64]; const float x0 = bflo(aw) - o[blk][2 * i] * il, x1 = bfhi(aw) - o[blk][2 * i + 1] * il; o[blk][2 * i] = x0; o[blk][2 * i + 1] = x1; ss += x0 * x0 + x1 * x1; }
    ss += __shfl_xor(ss, 32);
    const float rn = (1.0f - LAMBDA_INIT) / sqrtf(ss * (1.0f / 128.0f) + RMS_EPS);
    const float* sub = a.in[I1_SUBLN]; bf16_t* dst = (bf16_t*)(ws + WS_R2) + (size_t)m * DM + hd * 128;
#pragma unroll
    for (int blk = 0; blk < 4; ++blk)
#pragma unroll
        for (int g = 0; g < 4; ++g) { const int d0 = 32 * blk + 8 * g + 4 * h; const f32x4 sg = *(const f32x4*)(sub + d0);
            u32x2 w; w.x = cvtpk(o[blk][4 * g] * rn * sg[0], o[blk][4 * g + 1] * rn * sg[1]); w.y = cvtpk(o[blk][4 * g + 2] * rn * sg[2], o[blk][4 * g + 3] * rn * sg[3]);
            *(u32x2*)(dst + d0) = w; }
}

constexpr int NPHASES = 18;
constexpr int LDS_BYTES = 147456;
struct GOp { int kind; pg8::Gemm g; bf16_t* O; int ldc, o_bs, ai_extra; float scale; int q_tiles, rope_from; };

DI bool get_gemm(int ph, int sub, const Args& a, GOp& op) {
    unsigned char* ws = a.ws;
    bf16_t* R2 = (bf16_t*)(ws + WS_R2); bf16_t* R3 = (bf16_t*)(ws + WS_R3);
    op.kind = 0; op.o_bs = 0; op.ai_extra = 0; op.scale = 1.0f; op.q_tiles = 0; op.rope_from = 0;
    pg8::Gemm& g = op.g; g.nB = 1; g.a_bs = 0; g.b_bs = 0; g.rot = 0; g.a_seg = 0; g.b_seg = 0; g.skipctx = 0;
#define SETK(k_) do { g.K = (k_); g.kseg = (k_) / 64; g.a_seg = (k_); g.b_seg = (k_); } while (0)
    switch (ph * 8 + sub) {
    case 2 * 8 + 0:
        g.A = R2; g.a_rs = 1024; g.nM = NRT; g.Bt = (const bf16_t*)(ws + W_IN0); g.b_rs = 1024; g.nN = 5; SETK(1024); op.O = R3; op.ldc = 1280; return true;
    case 3 * 8 + 0:
        g.A = (const bf16_t*)(ws + W_DC); g.a_rs = 128; g.nM = 1; g.Bt = R3; g.b_rs = 1280; g.nN = NRT; g.nB = 4; g.b_bs = 128; SETK(128);
        op.O = R2; op.ldc = ROWS; op.o_bs = 128 * ROWS; op.ai_extra = 384 * ROWS; return true;
    case 4 * 8 + 0:
        op.kind = 1; g.A = (const bf16_t*)(ws + WS_CQN); g.a_rs = 256; g.nM = NRT; g.Bt = (const bf16_t*)(ws + W_UQ); g.b_rs = 256; g.nN = 3; SETK(256);
        op.O = (bf16_t*)(ws + WS_Q); op.ldc = 768; op.scale = MLA_QSCALE; op.q_tiles = 3; op.rope_from = 2; return true;
    case 4 * 8 + 1:
        g.A = (const bf16_t*)(ws + WS_CKVN); g.a_rs = 256; g.nM = NRT; g.Bt = (const bf16_t*)(ws + W_KN); g.b_rs = 256; g.nN = 2; SETK(256); g.rot = 140;
        op.O = (bf16_t*)(ws + WS_KN); op.ldc = 512; return true;
    case 4 * 8 + 2:
        g.A = (const bf16_t*)(ws + W_V0); g.a_rs = 256; g.nM = 2; g.Bt = (const bf16_t*)(ws + WS_CKVN); g.b_rs = 256; g.nN = NRT; SETK(256); g.rot = 148;
        op.O = (bf16_t*)(ws + WS_VT0); op.ldc = ROWS; return true;
    case 4 * 8 + 3:
        g.A = (const bf16_t*)(ws + WS_DN); g.a_rs = 16384; g.nM = 16; g.Bt = R2 + CTX; g.b_rs = ROWS; g.nN = 2; g.nB = 4; g.b_bs = TPB; SETK(8192); g.rot = 152;
        op.O = R3 + (size_t)CTX * DM; op.ldc = DM; op.o_bs = TPB * DM; return true;
    case 4 * 8 + 4:
        g.A = (const bf16_t*)(ws + WS_DN) + 8192; g.a_rs = 16384; g.nM = 16; g.Bt = R2 + CTX + (size_t)512 * ROWS; g.b_rs = ROWS; g.nN = 2; g.nB = 4; g.b_bs = TPB; SETK(8192); g.rot = 24;
        op.O = (bf16_t*)(ws + WS_PS); op.ldc = 512; op.o_bs = 4096 * 512; return true;
    case 4 * 8 + 5:
        g.A = (const bf16_t*)(ws + W_D256); g.a_rs = 512; g.nM = 1; g.Bt = R2; g.b_rs = ROWS; g.nN = 2; g.nB = 4; g.b_bs = TPB; g.K = 512; g.kseg = 4; g.a_seg = 256; g.b_seg = 512 * ROWS; g.rot = 0;
        op.O = R3; op.ldc = DM; op.o_bs = TPB * DM; return true;
    case 6 * 8 + 0:
        g.A = R3; g.a_rs = 1024; g.nM = NRT; g.Bt = (const bf16_t*)(ws + W_OUT0); g.b_rs = 1024; g.nN = 4; SETK(1024); op.O = (bf16_t*)(ws + WS_Y0); op.ldc = DM; return true;
    case 8 * 8 + 0: case 15 * 8 + 0:
        op.kind = 3; g.A = R2; g.a_rs = 1024; g.nM = (ph == 8 ? NRT : 128); g.skipctx = (ph != 8); g.Bt = (const bf16_t*)(ws + (ph == 8 ? W_GU0 : W_GU1)); g.b_rs = 1024; g.nN = 22; SETK(1024); op.O = R3; op.ldc = FF; return true;
    case 9 * 8 + 0: case 16 * 8 + 0:
        g.A = R3; g.a_rs = FF; g.nM = (ph == 9 ? NRT : 128); g.skipctx = (ph != 9); g.Bt = (const bf16_t*)(ws + (ph == 9 ? W_D0 : W_D1)); g.b_rs = FF; g.nN = 4; SETK(FF); op.O = R2; op.ldc = DM; return true;
    case 11 * 8 + 0:
        op.kind = 2; g.A = R2; g.a_rs = 1024; g.nM = NRT; g.Bt = (const bf16_t*)(ws + W_QK1); g.b_rs = 1024; g.nN = 8; SETK(1024);
        op.O = R3; op.ldc = 2048; op.scale = DIFF_QSCALE; op.q_tiles = 4; op.rope_from = 0; return true;
    case 11 * 8 + 1:
        g.A = (const bf16_t*)(ws + W_V1); g.a_rs = 1024; g.nM = 4; g.Bt = R2; g.b_rs = 1024; g.nN = NRT; SETK(1024); g.rot = 32;
        op.O = (bf16_t*)(ws + WS_VT1); op.ldc = ROWS; return true;
    case 13 * 8 + 0:
        g.A = R2; g.a_rs = 1024; g.nM = 128; g.skipctx = 1; g.Bt = (const bf16_t*)(ws + W_OUT1); g.b_rs = 1024; g.nN = 4; SETK(1024); op.O = R3; op.ldc = DM; return true;
    default: return false;
    }
#undef SETK
}

DI bool get_rowpass(int ph, const Args& a, RowPass& P) {
    unsigned char* ws = a.ws; const float* MOD0 = (const float*)(ws + WS_MOD); const float* MOD1 = MOD0 + 5 * 6144;
    float* XC = (float*)(ws + WS_XC); bf16_t* R2 = (bf16_t*)(ws + WS_R2);
    switch (ph) {
    case 1:  P = RowPass{a.in[I_X], a.in[I_CTX], nullptr, nullptr, nullptr, MOD0, 0, nullptr, nullptr, MOD0, 1024, 0, R2, 0}; return true;
    case 7:  P = RowPass{a.in[I_X], a.in[I_CTX], a.out, XC, (const bf16_t*)(ws + WS_Y0), MOD0, 2048, a.in[I0_LN1G], a.in[I0_LN1B], MOD0, 4096, 3072, R2, 0}; return true;
    case 10: P = RowPass{a.out, XC, a.out, XC, R2, MOD0, 5120, a.in[I0_LN2G], a.in[I0_LN2B], MOD1, 1024, 0, R2, 0}; return true;
    case 14: P = RowPass{a.out, XC, a.out, XC, (const bf16_t*)(ws + WS_R3), MOD1, 2048, a.in[I1_LN1G], a.in[I1_LN1B], MOD1, 4096, 3072, R2, 1}; return true;
    case 17: P = RowPass{a.out, XC, a.out, XC, R2, MOD1, 5120, a.in[I1_LN2G], a.in[I1_LN2B], MOD1, 0, 0, nullptr, 1}; return true;
    default: return false;
    }
}

__global__ void __launch_bounds__(512, 2) fwd_kernel(Args a) {
    extern __shared__ __attribute__((aligned(16))) unsigned char lds_raw[];
    LAS unsigned char* lds = (LAS unsigned char*)lds_raw;
    const int G = gridDim.x;
    volatile LAS unsigned* bst = (volatile LAS unsigned*)(lds + LDS_BYTES - 64);
    if (threadIdx.x < 2) bst[threadIdx.x] = 0u;
    __syncthreads();
    XcdBarrier xbar = xcd_barrier_post((unsigned*)(a.ws + WS_BAR), bst);
    for (int ph = a.ph_lo; ph < a.ph_hi; ++ph) {
        const int tid = otid(), lane = tid & 63, wave = __builtin_amdgcn_readfirstlane(tid >> 6);
        const int gw = blockIdx.x * 8 + wave, NGW = G * 8;
#ifndef NO_PRO
        if (ph == 0) prologue(a, lds);
#endif
        RowPass P;
        if (get_rowpass(ph, a, P)) { for (int m = gw; m < ROWS; m += NGW) row_pass(P, m, lane); }
        if (ph == 3) { for (int m = gw; m < ROWS; m += NGW) p3_row(a, m, lane); }
#ifndef NO_MLA
        if (ph == 5) {
            mirror_items(a, gw, NGW, lane);
            for (int L = blockIdx.x; ; L += G) { int bh, qb; if (!attn_unit_map(L, 1024, bh, qb)) break; attn_mla_unit(a, lds, bh, qb); }
        }
#endif
#ifndef NO_DIFF
        if (ph == 12) {
            const float p1 = wave_sum(a.in[I1_LQ1][lane] * a.in[I1_LK1][lane]), p2 = wave_sum(a.in[I1_LQ2][lane] * a.in[I1_LK2][lane]);
            const float lam = expf(p1) - expf(p2) + LAMBDA_INIT;
            for (int L = blockIdx.x; L < 1024; L += G) { int bh, qb; attn_unit_map(L, 1024, bh, qb); attn_diff_unit(a, lds, bh, qb, lam); }
        }
#endif
#ifndef NO_GEMM
        for (int sub = 0; sub < 8; ++sub) {
            GOp op; if (!get_gemm(ph, sub, a, op)) break;
            pg8::StaticOrder S; S.init(op.g.nM, op.g.nN, op.g.nB, G, (int)blockIdx.x, op.g.rot, op.g.skipctx);
            if (op.kind == 0) { pg8::EpiStore E{op.O, op.ldc, op.o_bs, op.ai_extra, op.scale}; pg8::gemm_phase(lds, op.g, S, E); }
            else if (op.kind == 1) { pg8::EpiRope<8> E{op.O, op.ldc, op.scale, op.q_tiles, op.rope_from, (const f32x2*)(a.ws + WS_TAB8)}; pg8::gemm_phase(lds, op.g, S, E); }
            else if (op.kind == 2) { pg8::EpiRope<16> E{op.O, op.ldc, op.scale, op.q_tiles, op.rope_from, (const f32x2*)(a.ws + WS_TAB16)}; pg8::gemm_phase(lds, op.g, S, E); }
            else { pg8::EpiSwiglu E{op.O, op.ldc}; pg8::gemm_phase(lds, op.g, S, E); }
        }
#endif
        if (ph + 1 < a.ph_hi) { if (ph == a.ph_lo) { __threadfence(); cg::this_grid().sync(); } else xcd_barrier(xbar); }
    }
}

extern "C" void kernel_launch(void* const* d_in, const int* in_sizes, int n_in, void* d_out, int out_size, void* d_ws, size_t ws_size, hipStream_t stream) {
    static int grid = 0;
    if (grid == 0) {
        if (n_in != 35 || ws_size < WS_END) { fprintf(stderr, "kernel_launch: unexpected n_in %d / ws %zu (need %zu)\n", n_in, ws_size, (size_t)WS_END); grid = -1; return; }
        int dev = 0, cus = 0, per_cu = 0;
        hipGetDevice(&dev); hipDeviceGetAttribute(&cus, hipDeviceAttributeMultiprocessorCount, dev);
        hipFuncSetAttribute((const void*)fwd_kernel, hipFuncAttributeMaxDynamicSharedMemorySize, LDS_BYTES);
        hipOccupancyMaxActiveBlocksPerMultiprocessor(&per_cu, (const void*)fwd_kernel, 512, LDS_BYTES);
        if (per_cu < 1) { fprintf(stderr, "kernel_launch: occupancy query says %d blocks/CU\n", per_cu); per_cu = 1; }
        (void)hipGetLastError();
        grid = cus * 1;
    }
    if (grid < 0) return;
    Args a{};
    for (int i = 0; i < 35; ++i) a.in[i] = (const float*)d_in[i];
    a.out = (float*)d_out; a.ws = (unsigned char*)d_ws;
#if MK_MULTI
    for (int ph = 0; ph < NPHASES; ++ph) { a.ph_lo = ph; a.ph_hi = ph + 1; hipLaunchKernelGGL(fwd_kernel, dim3(grid), dim3(512), LDS_BYTES, stream, a); }
#else
    a.ph_lo = 0; a.ph_hi = NPHASES;
    hipMemsetAsync((char*)d_ws + WS_BAR, 0, 16384, stream);
    void* args[] = {&a};
    hipError_t e = hipLaunchCooperativeKernel((const void*)fwd_kernel, dim3(grid), dim3(512), args, LDS_BYTES, stream);
    if (e != hipSuccess) fprintf(stderr, "cooperative launch failed: %s (grid %d)\n", hipGetErrorString(e), grid);
#endif
}
```

```cpp
#include <hip/hip_runtime.h>
#include <hip/hip_cooperative_groups.h>
#include <cstdio>
#include <cstdint>
namespace cg = cooperative_groups;

#ifndef MK_MULTI
#define MK_MULTI 0
#endif

#define DI __device__ __forceinline__
#define LAS __attribute__((address_space(3)))
typedef unsigned short bf16_t;
typedef short bf16x8 __attribute__((ext_vector_type(8)));
typedef float f32x4 __attribute__((ext_vector_type(4)));
typedef float f32x2 __attribute__((ext_vector_type(2)));
typedef float f32x16 __attribute__((ext_vector_type(16)));
typedef unsigned u32x4 __attribute__((ext_vector_type(4)));
typedef unsigned u32x2 __attribute__((ext_vector_type(2)));
typedef __bf16 bf16x2_t __attribute__((ext_vector_type(2)));

constexpr int DM = 1024, NB = 4, SEQ = 8192, CTX = 256, TPB = SEQ + CTX  , ROWS = NB * TPB  , FF = 2816;
constexpr int NRT = ROWS / 256;
constexpr float LN_EPS = 1e-6f, RMS_EPS = 1e-6f;
constexpr float DN_ALPHA = 1.41421356237f;
constexpr float LOG2E = 1.4426950408889634f;
constexpr float MLA_QSCALE = 0.10206207261596577f * LOG2E;
constexpr float DIFF_QSCALE = 0.125f * LOG2E;
constexpr float LAMBDA_INIT = 0.35550906f;

constexpr size_t MiB = 1u << 20;
constexpr size_t WS_MOD = 0;
constexpr size_t WS_TAB16 = 256 * 1024;
constexpr size_t WS_TAB8 = WS_TAB16 + 16384;
constexpr size_t WS_BAR = 512 * 1024;
constexpr size_t WS_XC = 1 * MiB;
constexpr size_t WS_W = 5 * MiB;
constexpr size_t W_IN0 = WS_W;
constexpr size_t W_UQ = W_IN0 + 1280 * 1024 * 2;
constexpr size_t W_KN = W_UQ + 768 * 256 * 2;
constexpr size_t W_V0 = W_KN + 512 * 256 * 2;
constexpr size_t W_OUT0 = W_V0 + 512 * 256 * 2;
constexpr size_t W_GU0 = W_OUT0 + 1024 * 1024 * 2;
constexpr size_t W_D0 = W_GU0 + 5632 * 1024 * 2;
constexpr size_t W_QK1 = W_D0 + 1024 * 2816 * 2;
constexpr size_t W_V1 = W_QK1 + 2048 * 1024 * 2;
constexpr size_t W_OUT1 = W_V1 + 1024 * 1024 * 2;
constexpr size_t W_GU1 = W_OUT1 + 1024 * 1024 * 2;
constexpr size_t W_D1 = W_GU1 + 5632 * 1024 * 2;
constexpr size_t W_DC = W_D1 + 1024 * 2816 * 2;
constexpr size_t W_D256 = W_DC + 256 * 128 * 2;
constexpr size_t W_END = W_D256 + 256 * 512 * 2;
static_assert(W_END <= 56 * MiB, "weights region");
constexpr size_t WS_DN = 56 * MiB;
constexpr size_t WS_R2 = 184 * MiB;
constexpr size_t WS_R3 = 250 * MiB;
constexpr size_t WS_R4 = WS_R3 + (size_t)ROWS * 1280 * 2;
constexpr size_t WS_CQN = WS_R4, WS_CKVN = WS_R4 + (size_t)ROWS * 256 * 2;
constexpr size_t WS_R5 = WS_R4 + (size_t)ROWS * 512 * 2;
constexpr size_t WS_Q = WS_R5;
constexpr size_t WS_KN = WS_Q + (size_t)ROWS * 768 * 2;
constexpr size_t WS_KR = WS_KN + (size_t)ROWS * 512 * 2;
constexpr size_t WS_VT0 = WS_KR + (size_t)ROWS * 32 * 2;
constexpr size_t WS_END = WS_VT0 + (size_t)512 * ROWS * 2;
constexpr size_t WS_Y0 = WS_R5;
constexpr size_t WS_PS = WS_R3 + (size_t)ROWS * DM * 2;
static_assert(WS_PS + (size_t)4 * 4096 * 512 * 2 <= WS_R4, "ps");
constexpr size_t WS_VT1 = WS_R3 + (size_t)ROWS * 2048 * 2;
static_assert(WS_END <= 512 * MiB, "workspace");
static_assert(WS_VT1 + (size_t)1024 * ROWS * 2 <= WS_END, "vt1");
static_assert(WS_R3 + (size_t)ROWS * FF * 2 <= WS_END, "hid");

DI int otid() { int t = threadIdx.x; asm volatile("" : "+v"(t)); return t; }
DI float wave_sum(float v) {
#pragma unroll
    for (int o = 1; o < 64; o <<= 1) v += __shfl_xor(v, o);
    return v;
}
DI unsigned cvtpk(float lo, float hi) { f32x2 v = {lo, hi}; bf16x2_t b = __builtin_convertvector(v, bf16x2_t); return __builtin_bit_cast(unsigned, b); }
DI float bf2f(unsigned short b) { return __uint_as_float(((unsigned)b) << 16); }
DI float bflo(unsigned w) { return __uint_as_float(w << 16); }
DI float bfhi(unsigned w) { return __uint_as_float(w & 0xffff0000u); }

namespace pg8 {
constexpr int BM = 256, BK = 64, HALF = 128, HTB = HALF * BK * 2, STAGE_BYTES = 8 * HTB, NXCD = 8, WGM = 8;
__host__ __device__ __forceinline__ int lds_byte(int r, int c) { const int st = (r >> 4) * 2 + (c >> 5), rr = r & 15, cc = c & 31, ob = rr * 64 + cc * 2; return st * 1024 + (ob ^ (((ob >> 9) & 1) << 5)); }
__host__ __device__ __forceinline__ void stage_rc(int b, int& R, int& C) { const int st = b / 1024, sb = b % 1024, swz = sb ^ (((sb >> 9) & 1) << 5); R = (st >> 1) * 16 + swz / 64; C = (st & 1) * 32 + (swz % 64) / 2; }
__host__ __device__ __forceinline__ int perm32(int rho) { const int n = rho >> 4, i = rho & 15; return 8 * (i >> 2) + 4 * n + (i & 3); }

struct Unit { int pm, pn, pb; };
struct Gemm {
    const bf16_t* A; const bf16_t* Bt; int nM, nN, nB, K, kseg;
    int a_rs, b_rs, a_seg, b_seg, a_bs, b_bs;
    int rot, skipctx;
};
struct StaticOrder {
    int nM, nN, nwg, tot, G, c, skipctx;
    DI void init(int nM_, int nN_, int nB_, int G_, int c_, int rot, int skip) { skipctx = skip; nM = nM_; nN = nN_; nwg = nM * nN; tot = nwg * nB_; G = G_; c = (c_ + G_ - (rot % G_)) % G_; }
    DI bool next(int i, Unit& u) const {
        const long L = (long)i * G + c; if (L >= tot) return false;
        u.pb = (int)(L / nwg); int wgid = (int)(L % nwg);
        { const int q = nwg / NXCD, r = nwg % NXCD, xcd = wgid % NXCD, off = wgid / NXCD; wgid = (xcd < r ? xcd * (q + 1) : r * (q + 1) + (xcd - r) * q) + off; }
        const int nig = WGM * nN, gid = wgid / nig, fm = gid * WGM, gsz = (nM - fm) < WGM ? (nM - fm) : WGM;
        u.pm = fm + ((wgid % nig) % gsz); u.pn = (wgid % nig) / gsz; if (skipctx) u.pm += (u.pm >> 5) + 1; return true;
    }
};

struct EpiStore {
    static constexpr bool PERM = true;
    bf16_t* O; int ldc, o_bs, ai_extra; float scale;
    DI void operator()(const f32x4 (&acc)[2][2][4][2], const Unit& u, int wr, int wc, int fr, int fq) const {
        const int row0 = u.pm * BM + wr * 64 + fr, col0 = u.pn * BM + wc * 32 + 8 * fq;
        bf16_t* base = O + (size_t)u.pb * o_bs;
#pragma unroll
        for (int ai = 0; ai < 2; ++ai)
#pragma unroll
            for (int m = 0; m < 4; ++m) { bf16_t* rowp = base + (size_t)(row0 + ai * HALF + m * 16) * ldc + (size_t)ai * ai_extra + col0;
#pragma unroll
                for (int bj = 0; bj < 2; ++bj) { const f32x4 v0 = acc[ai][bj][m][0] * scale, v1 = acc[ai][bj][m][1] * scale;
                    u32x4 w; w.x = cvtpk(v0[0], v0[1]); w.y = cvtpk(v0[2], v0[3]); w.z = cvtpk(v1[0], v1[1]); w.w = cvtpk(v1[2], v1[3]);
                    *(u32x4*)(rowp + bj * HALF) = w; } }
    }
};
struct EpiSwiglu {
    static constexpr bool PERM = true;
    bf16_t* O; int ldc;
    DI void operator()(const f32x4 (&acc)[2][2][4][2], const Unit& u, int wr, int wc, int fr, int fq) const {
        const int row0 = u.pm * BM + wr * 64 + fr, col0 = u.pn * HALF + wc * 32 + 8 * fq;
#pragma unroll
        for (int ai = 0; ai < 2; ++ai)
#pragma unroll
            for (int m = 0; m < 4; ++m) { bf16_t* rowp = O + (size_t)(row0 + ai * HALF + m * 16) * ldc + col0; float h[8];
#pragma unroll
                for (int n = 0; n < 2; ++n)
#pragma unroll
                    for (int i = 0; i < 4; ++i) { const float g = acc[ai][0][m][n][i], up = acc[ai][1][m][n][i];
                        h[n * 4 + i] = g * __builtin_amdgcn_rcpf(1.0f + __builtin_amdgcn_exp2f(-g * LOG2E)) * up; }
                u32x4 w; w.x = cvtpk(h[0], h[1]); w.y = cvtpk(h[2], h[3]); w.z = cvtpk(h[4], h[5]); w.w = cvtpk(h[6], h[7]);
                *(u32x4*)rowp = w; }
    }
};
template <int MODE> struct EpiRope {
    static constexpr bool PERM = false;
    bf16_t* O; int ldc; float qscale; int q_tiles, rope_from; const f32x2* tab;
    DI void operator()(const f32x4 (&acc)[2][2][4][2], const Unit& u, int wr, int wc, int fr, int fq) const {
        const float sc = u.pn < q_tiles ? qscale : 1.0f; const bool rope_tile = u.pn >= rope_from;
        const int col0 = u.pn * BM + wc * 32 + 4 * fq;
#pragma unroll
        for (int ai = 0; ai < 2; ++ai)
#pragma unroll
            for (int m = 0; m < 4; ++m) {
                const int row = u.pm * BM + ai * HALF + wr * 64 + m * 16 + fr; const int j = row % TPB; const int t = j - CTX;
                f32x4 cs0 = {1.f, 0.f, 1.f, 0.f}, cs1 = {1.f, 0.f, 1.f, 0.f};
                if (rope_tile && t >= 0) {
                    int pos, f0;
                    if (MODE == 16) { pos = (wc & 1) ? (t & 63) : (t >> 6); f0 = 4 * fq; } else { pos = (fq >> 1) ? (t & 63) : (t >> 6); f0 = 4 * (fq & 1); }
                    const f32x4* tp = (const f32x4*)(tab + pos * MODE + f0); cs0 = tp[0]; cs1 = tp[1];
                }
                const float c[4] = {cs0[0], cs0[2], cs1[0], cs1[2]}, s[4] = {cs0[1], cs0[3], cs1[1], cs1[3]};
                bf16_t* rowp = O + (size_t)row * ldc + col0;
#pragma unroll
                for (int bj = 0; bj < 2; ++bj) { const f32x4 x1 = acc[ai][bj][m][0] * sc, x2 = acc[ai][bj][m][1] * sc; float o1[4], o2[4];
#pragma unroll
                    for (int i = 0; i < 4; ++i) { o1[i] = x1[i] * c[i] - x2[i] * s[i]; o2[i] = x1[i] * s[i] + x2[i] * c[i]; }
                    u32x2 w1, w2; w1.x = cvtpk(o1[0], o1[1]); w1.y = cvtpk(o1[2], o1[3]); w2.x = cvtpk(o2[0], o2[1]); w2.y = cvtpk(o2[2], o2[3]);
                    *(u32x2*)(rowp + bj * HALF) = w1; *(u32x2*)(rowp + bj * HALF + 16) = w2; }
            }
    }
};

template <class Epi>
DI void gemm_phase(LAS unsigned char* lds, const Gemm g, const StaticOrder& S, const Epi& E) {
    const int tid = otid(), wid = __builtin_amdgcn_readfirstlane(tid >> 6), lane = tid & 63, wr = wid >> 2, wc = wid & 3, fr = lane & 15, fq = lane >> 4;
    const int nt = g.K / BK, kseg = g.kseg;
    unsigned voffA[2], voffB[2];
#pragma unroll
    for (int i = 0; i < 2; ++i) { int R, C; stage_rc(tid * 16 + i * 8192, R, C); const int Rb = Epi::PERM ? ((R & ~31) + perm32(R & 31)) : R;
        voffA[i] = (unsigned)(R * g.a_rs + C) * 2u; voffB[i] = (unsigned)(Rb * g.b_rs + C) * 2u; }
    const int kstep = BK * 2;
    const unsigned hstepA = (unsigned)HALF * g.a_rs * 2, hstepB = (unsigned)HALF * g.b_rs * 2;
    const unsigned tstepA = 2 * hstepA, tstepB = 2 * hstepB;
    const int segA = (g.a_seg - kseg * BK) * 2, segB = (g.b_seg - kseg * BK) * 2;
#define OFFA(t) ((t) * kstep + ((t) >= kseg ? segA : 0))
#define OFFB(t) ((t) * kstep + ((t) >= kseg ? segB : 0))
    const unsigned ldsw = (unsigned)wid * 1024u;
    const int aoff = lds_byte(wr * 64 + fr, fq * 8), boff = lds_byte(wc * 32 + fr, fq * 8);
#define PG8_SA(b, h) (((b) * 2 + (h)) * HTB)
#define PG8_SB(b, h) ((4 + (b) * 2 + (h)) * HTB)
#define PG8_STAGE(bufoff, gbase, voff) do { _Pragma("unroll") for (int _i = 0; _i < 2; ++_i) \
        __builtin_amdgcn_global_load_lds((const unsigned*)((const char*)(gbase) + (voff)[_i]), (LAS unsigned*)(lds + (bufoff) + ldsw + _i * 8192), 16, 0, 0); } while (0)
#define PG8_LDA(dst, b, h) do { _Pragma("unroll") for (int m = 0; m < 4; ++m) _Pragma("unroll") for (int k = 0; k < 2; ++k) dst[m][k] = *(const LAS bf16x8*)(lds + PG8_SA(b, h) + aoff + m * 2048 + k * 1024); } while (0)
#define PG8_LDB(dst, b, h) do { _Pragma("unroll") for (int n = 0; n < 2; ++n) _Pragma("unroll") for (int k = 0; k < 2; ++k) dst[n][k] = *(const LAS bf16x8*)(lds + PG8_SB(b, h) + boff + n * 2048 + k * 1024); } while (0)
#define PG8_MMA(ai, bj, At, Bt) do { __builtin_amdgcn_s_setprio(1); _Pragma("unroll") for (int m = 0; m < 4; ++m) _Pragma("unroll") for (int n = 0; n < 2; ++n) _Pragma("unroll") for (int k = 0; k < 2; ++k) \
        acc[ai][bj][m][n] = __builtin_amdgcn_mfma_f32_16x16x32_bf16(Bt[n][k], At[m][k], acc[ai][bj][m][n], 0, 0, 0); __builtin_amdgcn_s_setprio(0); } while (0)
#define PG8_WAIT_V(n) asm volatile("s_waitcnt vmcnt(" #n ")" ::: "memory")
#define PG8_WAIT_L(n) asm volatile("s_waitcnt lgkmcnt(" #n ")" ::: "memory")
#define PG8_BAR __builtin_amdgcn_s_barrier()
#define PG8_SCHED __builtin_amdgcn_sched_barrier(0)
    Unit cur, nxt; int ui = 0;
    if (!S.next(0, cur)) return;
    f32x4 acc[2][2][4][2];
#pragma unroll
    for (int a = 0; a < 2; ++a)
#pragma unroll
        for (int b = 0; b < 2; ++b)
#pragma unroll
            for (int m = 0; m < 4; ++m)
#pragma unroll
                for (int n = 0; n < 2; ++n) acc[a][b][m][n] = (f32x4){0.f, 0.f, 0.f, 0.f};
    bf16x8 At[4][2], B0[2][2], B1[2][2];
    const char* cA = (const char*)g.A + ((size_t)cur.pb * g.a_bs) * 2 + (size_t)cur.pm * tstepA;
    const char* cB = (const char*)g.Bt + ((size_t)cur.pb * g.b_bs) * 2 + (size_t)cur.pn * tstepB;
    {
        PG8_STAGE(PG8_SB(0, 0), cB, voffB); PG8_STAGE(PG8_SB(0, 1), cB + hstepB, voffB); PG8_STAGE(PG8_SA(0, 0), cA, voffA); PG8_STAGE(PG8_SA(0, 1), cA + hstepA, voffA);
        if (wr == 1) PG8_BAR;
        PG8_WAIT_V(2); PG8_BAR;
        PG8_STAGE(PG8_SB(1, 0), cB + OFFB(1), voffB); PG8_STAGE(PG8_SA(1, 0), cA + OFFA(1), voffA); PG8_STAGE(PG8_SB(1, 1), cB + hstepB + OFFB(1), voffB);
        PG8_WAIT_V(6); PG8_BAR;
    }
    for (;;) {
        const bool has_next = S.next(ui + 1, nxt);
        const char* nA = has_next ? (const char*)g.A + ((size_t)nxt.pb * g.a_bs) * 2 + (size_t)nxt.pm * tstepA : cA;
        const char* nB = has_next ? (const char*)g.Bt + ((size_t)nxt.pb * g.b_bs) * 2 + (size_t)nxt.pn * tstepB : cB;
        for (int t = 0; t < nt; t += 2) {
            const bool last = (t == nt - 2);
            const char* a1 = cA + OFFA(t + 1);
            const char* a2 = last ? nA : cA + OFFA(t + 2); const char* b2 = last ? nB : cB + OFFB(t + 2);
            const char* a3 = last ? nA + OFFA(1) : cA + OFFA(t + 3); const char* b3 = last ? nB + OFFB(1) : cB + OFFB(t + 3);
            PG8_LDB(B0, 0, 0); PG8_LDB(B1, 0, 1); PG8_SCHED; PG8_LDA(At, 0, 0); PG8_STAGE(PG8_SA(1, 1), a1 + hstepA, voffA);
            PG8_WAIT_V(8); PG8_WAIT_L(0); PG8_BAR; PG8_MMA(0, 0, At, B0); PG8_MMA(0, 1, At, B1); PG8_BAR; PG8_SCHED;
            PG8_LDA(At, 0, 1); PG8_STAGE(PG8_SB(0, 0), b2, voffB); PG8_STAGE(PG8_SB(0, 1), b2 + hstepB, voffB); PG8_STAGE(PG8_SA(0, 0), a2, voffA);
            PG8_WAIT_V(8); PG8_WAIT_L(0); PG8_BAR; PG8_MMA(1, 0, At, B0); PG8_MMA(1, 1, At, B1); PG8_BAR; PG8_SCHED;
            PG8_LDB(B0, 1, 0); PG8_LDB(B1, 1, 1); PG8_SCHED; PG8_LDA(At, 1, 0); PG8_STAGE(PG8_SA(0, 1), a2 + hstepA, voffA);
            PG8_WAIT_V(8); PG8_WAIT_L(0); PG8_BAR; PG8_MMA(0, 0, At, B0); PG8_MMA(0, 1, At, B1); PG8_BAR; PG8_SCHED;
            PG8_LDA(At, 1, 1); PG8_STAGE(PG8_SB(1, 0), b3, voffB); PG8_STAGE(PG8_SB(1, 1), b3 + hstepB, voffB); PG8_STAGE(PG8_SA(1, 0), a3, voffA);
            PG8_WAIT_V(8); PG8_WAIT_L(0); PG8_BAR; PG8_MMA(1, 0, At, B0); PG8_MMA(1, 1, At, B1); PG8_BAR; PG8_SCHED;
        }
        if (wr == 0) PG8_BAR;
        E(acc, cur, wr, wc, fr, fq);
        if (!has_next) break;
#pragma unroll
        for (int a = 0; a < 2; ++a)
#pragma unroll
            for (int b = 0; b < 2; ++b)
#pragma unroll
                for (int m = 0; m < 4; ++m)
#pragma unroll
                    for (int n = 0; n < 2; ++n) acc[a][b][m][n] = (f32x4){0.f, 0.f, 0.f, 0.f};
        cur = nxt; cA = nA; cB = nB; ++ui;
        if (wr == 1) PG8_BAR;
    }
    PG8_WAIT_V(0);
    PG8_BAR;
#undef OFFA
#undef OFFB
#undef PG8_SA
#undef PG8_SB
#undef PG8_STAGE
#undef PG8_LDA
#undef PG8_LDB
#undef PG8_MMA
#undef PG8_WAIT_V
#undef PG8_WAIT_L
#undef PG8_BAR
#undef PG8_SCHED
}
}

#define MFMA32(a, b, c) __builtin_amdgcn_mfma_f32_32x32x16_bf16((a), (b), (c), 0, 0, 0)
template <int D1, int D2, int DV>
DI void attn_core(f32x16 (&o)[DV / 32], float& l_out, LAS unsigned char* lds, const bf16_t* q1, const bf16_t* q2,
                  const bf16_t* k1, long ldk1, const bf16_t* k2, long ldk2, const bf16_t* vt, long ldv, int ntiles) {
    constexpr int DQK = D1 + D2, KROW = DQK * 2 + 16, VROW = 144, KT = 64 * KROW, VT = DV * VROW, BUF = KT + VT;
    constexpr int KCH = DQK / 8, NKC = 64 * KCH, NVC = DV * 8, KPT = (NKC + 511) / 512, VPT = NVC / 512;
    const int tid = otid(), lane = tid & 63, r = lane & 31, h = lane >> 5;
    bf16x8 qf[DQK / 16];
#pragma unroll
    for (int d0 = 0; d0 < DQK / 16; ++d0) qf[d0] = (16 * d0 < D1) ? *(const bf16x8*)(q1 + 16 * d0 + 8 * h) : *(const bf16x8*)(q2 + (16 * d0 - D1) + 8 * h);
    u32x4 kreg[KPT], vreg[VPT];
    auto gload = [&](int t) {
#pragma unroll
        for (int i = 0; i < KPT; ++i) { const int c = tid + i * 512; if (c < NKC) { const int row = c / KCH, cc = (c % KCH) * 8;
            kreg[i] = (cc < D1) ? *(const u32x4*)(k1 + (size_t)(t * 64 + row) * ldk1 + cc) : *(const u32x4*)(k2 + (size_t)(t * 64 + row) * ldk2 + (cc - D1)); } }
#pragma unroll
        for (int i = 0; i < VPT; ++i) { const int c = tid + i * 512; const int d = c >> 3, cc = (c & 7) * 8; vreg[i] = *(const u32x4*)(vt + (size_t)d * ldv + t * 64 + cc); }
    };
    auto sstore = [&](int b) {
        LAS unsigned char* kb = lds + b * BUF; LAS unsigned char* vb = kb + KT;
#pragma unroll
        for (int i = 0; i < KPT; ++i) { const int c = tid + i * 512; if (c < NKC) { const int row = c / KCH, cc = (c % KCH) * 8; *(LAS u32x4*)(kb + row * KROW + cc * 2) = kreg[i]; } }
#pragma unroll
        for (int i = 0; i < VPT; ++i) { const int c = tid + i * 512; const int d = c >> 3, cc = (c & 7) * 8; *(LAS u32x4*)(vb + d * VROW + cc * 2) = vreg[i]; }
    };
    const int pr = (r & ~12) | ((r & 4) << 1) | ((r & 8) >> 1);
    float mrun = 0.f, lrun = 0.f;
    f32x16 negm;
#pragma unroll
    for (int i = 0; i < 16; ++i) negm[i] = 0.f;
#pragma unroll
    for (int b = 0; b < DV / 32; ++b)
#pragma unroll
        for (int i = 0; i < 16; ++i) o[b][i] = 0.f;
    gload(0); sstore(0); if (ntiles > 1) { gload(1); sstore(1); } __syncthreads();
    for (int t = 0; t < ntiles; ++t) {
        if (t + 2 < ntiles) gload(t + 2);
        const LAS unsigned char* kb = lds + (t & 3) * BUF; const LAS unsigned char* vb = kb + KT;
        f32x16 p[2];
        {
            bf16x8 kf[2][DQK / 16];
#pragma unroll
            for (int hf = 0; hf < 2; ++hf)
#pragma unroll
                for (int d0 = 0; d0 < DQK / 16; ++d0) kf[hf][d0] = *(const LAS bf16x8*)(kb + (32 * hf + pr) * KROW + (16 * d0 + 8 * h) * 2);
            __builtin_amdgcn_sched_barrier(0);
#pragma unroll
            for (int d0 = 0; d0 < DQK / 16; ++d0)
#pragma unroll
                for (int hf = 0; hf < 2; ++hf) p[hf] = MFMA32(kf[hf][d0], qf[d0], d0 == 0 ? negm : p[hf]);
            __builtin_amdgcn_sched_barrier(0);
        }
        constexpr int NBLK = DV / 32;
        bf16x8 vk[2][NBLK];
#define LDVK(buf, ks) do { _Pragma("unroll") for (int b_ = 0; b_ < NBLK; ++b_) vk[buf][b_] = *(const LAS bf16x8*)(vb + (32 * b_ + r) * VROW + (16 * (ks) + 8 * h) * 2); } while (0)
        LDVK(0, 0);
        __builtin_amdgcn_sched_barrier(0);
        float ta = fmaxf(fmaxf(p[0][0], p[0][1]), p[1][0]), tb = fmaxf(fmaxf(p[0][2], p[0][3]), p[1][1]);
        ta = fmaxf(fmaxf(ta, p[1][2]), p[1][3]);
#pragma unroll
        for (int i = 4; i < 16; i += 4) { ta = fmaxf(fmaxf(ta, p[0][i]), p[0][i + 1]); tb = fmaxf(fmaxf(tb, p[0][i + 2]), p[0][i + 3]); ta = fmaxf(fmaxf(ta, p[1][i]), p[1][i + 1]); tb = fmaxf(fmaxf(tb, p[1][i + 2]), p[1][i + 3]); }
        float tm = fmaxf(ta, tb); tm = fmaxf(tm, __shfl_xor(tm, 32));
        if (__any(t == 0 || tm > 8.0f)) {
            const float dl = (t == 0 || tm > 0.f) ? tm : 0.f; mrun += dl;
            const float alpha = __builtin_amdgcn_exp2f(-dl); lrun *= alpha;
#pragma unroll
            for (int i = 0; i < 16; ++i) { p[0][i] -= dl; p[1][i] -= dl; negm[i] = -mrun; }
#pragma unroll
            for (int b = 0; b < DV / 32; ++b)
#pragma unroll
                for (int i = 0; i < 16; ++i) o[b][i] *= alpha;
        }
        bf16x8 pf[4]; float rs = 0.f; u32x4 wq;
#define EXPPART(ks, j) do { const int hf_ = (ks) >> 1, s8_ = ((ks) & 1) * 8; const float e0_ = __builtin_amdgcn_exp2f(p[hf_][s8_ + 2 * (j)]), e1_ = __builtin_amdgcn_exp2f(p[hf_][s8_ + 2 * (j) + 1]); \
        rs += e0_; rs += e1_; wq[j] = cvtpk(e0_, e1_); } while (0)
        EXPPART(0, 0); EXPPART(0, 1); EXPPART(0, 2); EXPPART(0, 3); pf[0] = __builtin_bit_cast(bf16x8, wq);
        __builtin_amdgcn_sched_barrier(0);
#pragma unroll
        for (int ks = 0; ks < 4; ++ks) {
            if (ks < 3) LDVK((ks + 1) & 1, ks + 1);
            __builtin_amdgcn_sched_barrier(0);
#pragma unroll
            for (int b = 0; b < NBLK; ++b) {
                o[b] = MFMA32(vk[ks & 1][b], pf[ks], o[b]);
                if (ks < 3) {
#pragma unroll
                    for (int j = b * (4 / NBLK); j < (b + 1) * (4 / NBLK); ++j) {
                        if (ks == 0) EXPPART(1, j); else if (ks == 1) EXPPART(2, j); else EXPPART(3, j);
                    }
                }
                __builtin_amdgcn_sched_barrier(0);
            }
            if (ks < 3) pf[ks + 1] = __builtin_bit_cast(bf16x8, wq);
        }
        lrun += rs;
#undef LDVK
#undef EXPPART
        if (t + 2 < ntiles) sstore((t + 2) & 3);
        if (t & 1) __syncthreads();
    }
    l_out = lrun + __shfl_xor(lrun, 32);
}
constexpr int ATTN_LDS = 2 * (64 * (96 * 2 + 16) + 128 * 144);


#define XB_TMO      128
#define XB_XCNT(j)  (256  + 64 * (j))
#define XB_XSUB(j)  (1280 + 64 * (j))
#define XB_XGEN(j)  (2304 + 64 * (j))
#define XB_TOP      3328
#define XB_TOPGEN   3392
#define XCD_BAR_WORDS 3456
#define XB_SPIN_CAP (1u << 18)
DI unsigned xb_ld(unsigned* p)              { return __hip_atomic_load(p, __ATOMIC_RELAXED, __HIP_MEMORY_SCOPE_AGENT); }
DI unsigned xb_add(unsigned* p, unsigned v) { return __hip_atomic_fetch_add(p, v, __ATOMIC_RELAXED, __HIP_MEMORY_SCOPE_AGENT); }
DI unsigned xb_xcc_id() { return (unsigned)__builtin_amdgcn_s_getreg((3 << 11) | 20) & 0xFu; }
#define XB_SPIN(cond, bar) do { unsigned _sp = 0; while (cond) { __builtin_amdgcn_s_sleep(1); \
    if ((++_sp & 255u) == 0u) { if (xb_ld(&(bar)[XB_TMO])) break; if (_sp > XB_SPIN_CAP) { atomicAdd(&(bar)[XB_TMO], 1u); break; } } } } while (0)
struct XcdBarrier { unsigned* bar; unsigned x; volatile LAS unsigned* st; };
DI XcdBarrier xcd_barrier_post(unsigned* bar, volatile LAS unsigned* st) {
    XcdBarrier b; b.bar = bar; b.x = xb_xcc_id(); b.st = st;
    if (threadIdx.x == 0) (void)xb_add(&bar[XB_XCNT(b.x)], 1u);
    return b;
}
DI void xcd_barrier_complete(unsigned* bar, unsigned x, unsigned& nloc, unsigned& nx) {
    const unsigned G = gridDim.x * gridDim.y * gridDim.z;
    unsigned sum, cnt, mine, sp = 0u;
    for (;;) {
        sum = 0u; cnt = 0u; mine = 0u;
#pragma unroll
        for (unsigned j = 0; j < 16; ++j) { const unsigned c = xb_ld(&bar[XB_XCNT(j)]); sum += c; cnt += (c > 0u) ? 1u : 0u; mine = (j == x) ? c : mine; }
        if (sum == G) break;
        __builtin_amdgcn_s_sleep(1);
        if ((++sp & 255u) == 0u) { if (xb_ld(&bar[XB_TMO])) break; if (sp > XB_SPIN_CAP) { atomicAdd(&bar[XB_TMO], 1u); break; } }
    }
    nloc = mine > 0u ? mine : 1u; nx = cnt > 0u ? cnt : 1u;
}
DI void xcd_barrier(const XcdBarrier& b) {
    asm volatile("s_waitcnt vmcnt(0)" ::: "memory");
    __syncthreads();
    if (threadIdx.x == 0) {
        unsigned* bar = b.bar;
        __builtin_amdgcn_s_waitcnt(0);
        unsigned nloc = b.st[0], nx = b.st[1];
        if (nloc == 0u) { xcd_barrier_complete(bar, b.x, nloc, nx); b.st[0] = nloc; b.st[1] = nx; }
        const unsigned old = xb_add(&bar[XB_XSUB(b.x)], 1u);
        const unsigned gen = old / nloc;
        if (old + 1u == (gen + 1u) * nloc) {
            __builtin_amdgcn_fence(__ATOMIC_RELEASE, "agent");
            asm volatile("s_waitcnt vmcnt(0)" ::: "memory");
            const unsigned og = xb_add(&bar[XB_TOP], 1u);
            const unsigned tg = og / nx;
            if (og + 1u == (tg + 1u) * nx) xb_add(&bar[XB_TOPGEN], 1u);
            else XB_SPIN(xb_ld(&bar[XB_TOPGEN]) == tg, bar);
            __builtin_amdgcn_fence(__ATOMIC_ACQUIRE, "agent");
            xb_add(&bar[XB_XGEN(b.x)], 1u);
            asm volatile("s_waitcnt vmcnt(0)" ::: "memory");
        } else {
            XB_SPIN(xb_ld(&bar[XB_XGEN(b.x)]) == gen, bar);
            __builtin_amdgcn_fence(__ATOMIC_ACQUIRE, "agent");
            asm volatile("s_waitcnt vmcnt(0)" ::: "memory");
        }
    }
    __syncthreads();
}

struct Args {
    const float* in[35]; float* out; unsigned char* ws; int ph_lo, ph_hi;
};
enum { I_X = 0, I_C, I_CTX, I_CCTX,
       I0_WMOD, I0_BMOD, I0_WIN, I0_QN, I0_WUQ, I0_KVN, I0_WUKV, I0_WOUT, I0_LN1G, I0_LN1B, I0_WG, I0_WU, I0_WD, I0_LN2G, I0_LN2B,
       I1_WMOD, I1_BMOD, I1_WIN, I1_LQ1, I1_LK1, I1_LQ2, I1_LK2, I1_SUBLN, I1_WOUT, I1_LN1G, I1_LN1B, I1_WG, I1_WU, I1_WD, I1_LN2G, I1_LN2B };

DI bf16_t* tr_dst(int job, int n, unsigned char* ws) {
    switch (job) {
    case 0: return (bf16_t*)(ws + W_IN0) + (size_t)n * 1024;
    case 1: { const int hd = n / 96, d = n % 96; int row; if (d < 64) row = hd * 64 + d; else { const int e = d - 64, t = e >> 3, f = e & 7; row = 512 + hd * 32 + 16 * (t & 1) + 8 * (t >> 1) + f; }
              return (bf16_t*)(ws + W_UQ) + (size_t)row * 256; }
    case 2: { const int hd = n >> 7, d = n & 127; return d < 64 ? (bf16_t*)(ws + W_KN) + (size_t)(hd * 64 + d) * 256 : (bf16_t*)(ws + W_V0) + (size_t)(hd * 64 + d - 64) * 256; }
    case 3: return (bf16_t*)(ws + W_OUT0) + (size_t)n * 1024;
    case 4: return (bf16_t*)(ws + W_GU0) + (size_t)(256 * (n >> 7) + (n & 127)) * 1024;
    case 5: return (bf16_t*)(ws + W_GU0) + (size_t)(256 * (n >> 7) + 128 + (n & 127)) * 1024;
    case 6: return (bf16_t*)(ws + W_D0) + (size_t)n * 2816;
    case 7: return n < 2048 ? (bf16_t*)(ws + W_QK1) + (size_t)n * 1024 : (bf16_t*)(ws + W_V1) + (size_t)(n - 2048) * 1024;
    case 8: return (bf16_t*)(ws + W_OUT1) + (size_t)n * 1024;
    case 9: return (bf16_t*)(ws + W_GU1) + (size_t)(256 * (n >> 7) + (n & 127)) * 1024;
    case 10: return (bf16_t*)(ws + W_GU1) + (size_t)(256 * (n >> 7) + 128 + (n & 127)) * 1024;
    default: return (bf16_t*)(ws + W_D1) + (size_t)n * 2816;
    }
}
DI void transpose_item(const float* W, int K, int N, int job, unsigned char* ws, LAS float* scr, int item, int lane) {
    const int nblk = N / 32, kb = item / nblk, nb = item % nblk, k0 = 64 * kb, n0 = 32 * nb;
#pragma unroll 8
    for (int i = 0; i < 32; ++i) { const int kk = 2 * i + (lane >> 5); scr[kk * 33 + (lane & 31)] = W[(size_t)(k0 + kk) * N + n0 + (lane & 31)]; }
    asm volatile("s_waitcnt lgkmcnt(0)" ::: "memory");
    const int c = lane & 7;
#pragma unroll
    for (int j = 0; j < 4; ++j) { const int n = (lane >> 3) + 8 * j; const LAS float* s = scr + (8 * c) * 33 + n;
        u32x4 o; o.x = cvtpk(s[0 * 33], s[1 * 33]); o.y = cvtpk(s[2 * 33], s[3 * 33]); o.z = cvtpk(s[4 * 33], s[5 * 33]); o.w = cvtpk(s[6 * 33], s[7 * 33]);
        bf16_t* dst = tr_dst(job, n0 + n, ws); *(u32x4*)(dst + k0 + 8 * c) = o; }
    asm volatile("s_waitcnt lgkmcnt(0)" ::: "memory");
}

DI void prologue(const Args& a, LAS unsigned char* lds) {
    unsigned char* ws = a.ws;
    const int tid = otid(), lane = tid & 63, wave = tid >> 6;
    const int G = gridDim.x, gw = blockIdx.x * 8 + wave, NGW = G * 8;
    const long gt = (long)blockIdx.x * 512 + tid, NGT = (long)G * 512;
    {
        LAS float* scr = (LAS float*)(lds + wave * 16384);
        const int jin[12] = {I0_WIN, I0_WUQ, I0_WUKV, I0_WOUT, I0_WG, I0_WU, I0_WD, I1_WIN, I1_WOUT, I1_WG, I1_WU, I1_WD};
        const int jK[12] = {1024, 256, 256, 1024, 1024, 1024, 2816, 1024, 1024, 1024, 1024, 2816};
        const int jN[12] = {1056, 768, 1024, 1024, 2816, 2816, 1024, 3072, 1024, 2816, 2816, 1024};
        int base = 0;
#pragma unroll
        for (int j = 0; j < 12; ++j) { const int items = (jK[j] / 64) * (jN[j] / 32);
            for (int it = gw; it < items; it += NGW) transpose_item(a.in[jin[j]], jK[j], jN[j], j, ws, scr, it, lane);
            base += items; }
        u32x4 z = {0u, 0u, 0u, 0u};
        for (long i = gt; i < (1280 - 1056) * 1024 / 8; i += NGT) ((u32x4*)((bf16_t*)(ws + W_IN0) + (size_t)1056 * 1024))[i] = z;
    }
    {
        const float sc = 0.011048543456039806f;
        for (long i = gt; i < (long)4096 * 2048; i += NGT) { const int k = (int)(i >> 11), c8 = (int)(i & 2047) * 8; const int part = c8 >> 13, n0 = c8 & 8191; float v[8];
#pragma unroll
            for (int e = 0; e < 8; ++e) { const float ph = (float)((k * (n0 + e)) & 8191) * (1.0f / 8192.0f); v[e] = (part ? __builtin_amdgcn_sinf(ph) : __builtin_amdgcn_cosf(ph)) * sc; }
            u32x4 o; o.x = cvtpk(v[0], v[1]); o.y = cvtpk(v[2], v[3]); o.z = cvtpk(v[4], v[5]); o.w = cvtpk(v[6], v[7]);
            *(u32x4*)((bf16_t*)(ws + WS_DN) + (size_t)k * 16384 + c8) = o; }
        for (long i = gt; i < 256 * 512; i += NGT) { const int k = (int)(i >> 9), c = (int)(i & 511), part = c >> 8, n = c & 255; const float ph = (float)((k * n) & 255) * (1.0f / 256.0f);
            const float v = (part ? __builtin_amdgcn_sinf(ph) : __builtin_amdgcn_cosf(ph)) * 0.0625f; ((bf16_t*)(ws + W_D256))[i] = (bf16_t)(cvtpk(v, 0.f) & 0xffffu); }
        for (long i = gt; i < 256 * 128; i += NGT) { const int rr = (int)(i >> 7), c = (int)(i & 127), part = rr >> 7, l = rr & 127; const float ph = (float)((l * c) & 127) * (1.0f / 128.0f);
            const float v = (part ? -__builtin_amdgcn_sinf(ph) : __builtin_amdgcn_cosf(ph)) * 0.08838834764831845f; ((bf16_t*)(ws + W_DC))[i] = (bf16_t)(cvtpk(v, 0.f) & 0xffffu); }
        for (long i = gt; i < 128 * 16; i += NGT) { const int pos = (int)(i >> 4), f = (int)(i & 15); const float inv = 1.0f / powf(10000.0f, (float)f / 16.0f); const float ang = (float)pos * inv;
            ((f32x2*)(ws + WS_TAB16))[i] = (f32x2){cosf(ang), sinf(ang)}; }
        for (long i = gt; i < 128 * 8; i += NGT) { const int pos = (int)(i >> 3), f = (int)(i & 7); const float inv = 1.0f / powf(10000.0f, (float)f / 8.0f); const float ang = (float)pos * inv;
            ((f32x2*)(ws + WS_TAB8))[i] = (f32x2){cosf(ang), sinf(ang)}; }
    }
    {
        LAS float* red = (LAS float*)lds;
        for (int it = blockIdx.x; it < 2 * 96; it += G) {
            __syncthreads();
            const int layer = it / 96, n = (it % 96) * 64 + lane; const float* w = a.in[layer ? I1_WMOD : I0_WMOD]; const float* bm = a.in[layer ? I1_BMOD : I0_BMOD];
            float acc[5] = {0.f, 0.f, 0.f, 0.f, 0.f};
            for (int kk = 0; kk < 128; ++kk) { const int k = wave * 128 + kk; const float wv = w[(size_t)k * 6144 + n];
#pragma unroll
                for (int cls = 0; cls < 5; ++cls) { const float cv = cls < 4 ? a.in[I_C][cls * 1024 + k] : a.in[I_CCTX][k]; const float sl = cv / (1.0f + __expf(-cv)); acc[cls] += sl * wv; } }
#pragma unroll
            for (int cls = 0; cls < 5; ++cls) red[(wave * 5 + cls) * 64 + lane] = acc[cls];
            __syncthreads();
            if (tid < 320) { const int cls = tid >> 6, l = tid & 63; float s = 0.f;
#pragma unroll
                for (int w8 = 0; w8 < 8; ++w8) s += red[(w8 * 5 + cls) * 64 + l];
                const int nn = (it % 96) * 64 + l; ((float*)(ws + WS_MOD))[(size_t)(layer * 5 + cls) * 6144 + nn] = s + bm[nn]; }
        }
        __syncthreads();
    }
}

struct RowPass {
    const float* xl; const float* xc;
    float* ol; float* oc;
    const bf16_t* Y;
    const float* mod;
    int gate_off; const float* lng; const float* lnb;
    const float* mod2; int sc_off, sh_off;
    bf16_t* H;
    int skipctx;
};
DI void ln_stats(const f32x4 (&v)[4], float& mean, float& rstd) {
    float s = 0.f;
#pragma unroll
    for (int j = 0; j < 4; ++j) s += (v[j][0] + v[j][1]) + (v[j][2] + v[j][3]);
    mean = wave_sum(s) * (1.0f / DM); float q = 0.f;
#pragma unroll
    for (int j = 0; j < 4; ++j) { const f32x4 d = v[j] - mean; q += (d[0] * d[0] + d[1] * d[1]) + (d[2] * d[2] + d[3] * d[3]); }
    rstd = 1.0f / sqrtf(wave_sum(q) * (1.0f / DM) + LN_EPS);
}
DI void row_pass(const RowPass& P, int m, int lane) {
    const int b = m / TPB, j = m % TPB; const bool isctx = j < CTX; const int cls = isctx ? 4 : b;
    if (P.skipctx && isctx) return;
    const size_t xoff = isctx ? (size_t)(b * CTX + j) * DM : (size_t)(b * SEQ + j - CTX) * DM;
    const float* xs = (isctx ? P.xc : P.xl) + xoff; float* xd = isctx ? P.oc : P.ol;
    f32x4 v[4];
#pragma unroll
    for (int jj = 0; jj < 4; ++jj) v[jj] = *(const f32x4*)(xs + 4 * lane + 256 * jj);
    if (P.Y) {
        const float* gate = P.mod + (size_t)cls * 6144 + P.gate_off;
#pragma unroll
        for (int jj = 0; jj < 4; ++jj) { const int c0 = 4 * lane + 256 * jj; const u32x2 yw = *(const u32x2*)(P.Y + (size_t)m * DM + c0); const f32x4 g = *(const f32x4*)(gate + c0);
            v[jj][0] = DN_ALPHA * v[jj][0] + g[0] * bflo(yw.x); v[jj][1] = DN_ALPHA * v[jj][1] + g[1] * bfhi(yw.x);
            v[jj][2] = DN_ALPHA * v[jj][2] + g[2] * bflo(yw.y); v[jj][3] = DN_ALPHA * v[jj][3] + g[3] * bfhi(yw.y); }
        float mean, rstd; ln_stats(v, mean, rstd);
#pragma unroll
        for (int jj = 0; jj < 4; ++jj) { const int c0 = 4 * lane + 256 * jj; const f32x4 g = *(const f32x4*)(P.lng + c0), bb = *(const f32x4*)(P.lnb + c0); v[jj] = (v[jj] - mean) * rstd * g + bb; }
        if (xd) {
#pragma unroll
            for (int jj = 0; jj < 4; ++jj) *(f32x4*)(xd + xoff + 4 * lane + 256 * jj) = v[jj];
        }
    }
    if (P.H) {
        float mean, rstd; ln_stats(v, mean, rstd);
        const float* sc = P.mod2 + (size_t)cls * 6144 + P.sc_off; const float* sh = P.mod2 + (size_t)cls * 6144 + P.sh_off;
#pragma unroll
        for (int jj = 0; jj < 4; ++jj) { const int c0 = 4 * lane + 256 * jj; const f32x4 s1 = *(const f32x4*)(sc + c0), s0 = *(const f32x4*)(sh + c0);
            const f32x4 hh = (v[jj] - mean) * rstd * (s1 + 1.0f) + s0; u32x2 w; w.x = cvtpk(hh[0], hh[1]); w.y = cvtpk(hh[2], hh[3]);
            *(u32x2*)(P.H + (size_t)m * DM + c0) = w; }
    }
}
DI void p3_row(const Args& a, int m, int lane) {
    unsigned char* ws = a.ws; const bf16_t* U = (const bf16_t*)(ws + WS_R3) + (size_t)m * 1280;
    const u32x2 qw = *(const u32x2*)(U + 512 + 4 * lane), kw = *(const u32x2*)(U + 768 + 4 * lane);
    float q[4] = {bflo(qw.x), bfhi(qw.x), bflo(qw.y), bfhi(qw.y)}, k[4] = {bflo(kw.x), bfhi(kw.x), bflo(kw.y), bfhi(kw.y)};
    const float qs = wave_sum(q[0] * q[0] + q[1] * q[1] + q[2] * q[2] + q[3] * q[3]), ks = wave_sum(k[0] * k[0] + k[1] * k[1] + k[2] * k[2] + k[3] * k[3]);
    const float qr = 1.0f / sqrtf(qs * (1.0f / 256.0f) + RMS_EPS), kr_ = 1.0f / sqrtf(ks * (1.0f / 256.0f) + RMS_EPS);
    const f32x4 qg = *(const f32x4*)(a.in[I0_QN] + 4 * lane), kg = *(const f32x4*)(a.in[I0_KVN] + 4 * lane);
    u32x2 w; w.x = cvtpk(q[0] * qr * qg[0], q[1] * qr * qg[1]); w.y = cvtpk(q[2] * qr * qg[2], q[3] * qr * qg[3]);
    *(u32x2*)((bf16_t*)(ws + WS_CQN) + (size_t)m * 256 + 4 * lane) = w;
    w.x = cvtpk(k[0] * kr_ * kg[0], k[1] * kr_ * kg[1]); w.y = cvtpk(k[2] * kr_ * kg[2], k[3] * kr_ * kg[3]);
    *(u32x2*)((bf16_t*)(ws + WS_CKVN) + (size_t)m * 256 + 4 * lane) = w;
    const int d = lane & 31, t = d >> 3, f = d & 7; const float val = bf2f(U[1024 + d]); const float par = __shfl_xor(val, 8);
    const int j = m % TPB, tt = j - CTX; float outv = val;
    if (tt >= 0) { const int pos = (t < 2) ? (tt >> 6) : (tt & 63); const f32x2 cs = ((const f32x2*)(ws + WS_TAB8))[pos * 8 + f];
        outv = (t & 1) ? (par * cs[1] + val * cs[0]) : (val * cs[0] - par * cs[1]); }
    if (lane < 32) ((bf16_t*)(ws + WS_KR))[(size_t)m * 32 + 16 * (t & 1) + 8 * (t >> 1) + f] = (bf16_t)(cvtpk(outv, 0.f) & 0xffffu);
}
DI void mirror_items(const Args& a, int gw, int NGW, int lane) {
    unsigned char* ws = a.ws; bf16_t* MIX = (bf16_t*)(ws + WS_R3); const bf16_t* At = (const bf16_t*)(ws + WS_R2);
    for (int it = gw; it < NB * 512; it += NGW) { const int b = it >> 9, ch = it & 511; const bf16_t* src = At + (size_t)ch * ROWS + b * TPB + CTX; float s = 0.f;
        for (int i = 0; i < 16; ++i) { const u32x4 w = *(const u32x4*)(src + (i * 64 + lane) * 8);
            s += (bflo(w.x) - bfhi(w.x)) + (bflo(w.y) - bfhi(w.y)) + (bflo(w.z) - bfhi(w.z)) + (bflo(w.w) - bfhi(w.w)); }
        s = wave_sum(s) * 0.011048543456039806f;
        if (lane == 0) MIX[(size_t)(b * TPB + CTX + 4096) * DM + ch] = (bf16_t)(cvtpk(s, 0.f) & 0xffffu); }
    const bf16_t* PS = (const bf16_t*)(ws + WS_PS);
    for (int it = gw; it < NB * 4096; it += NGW) { const int b = it >> 12, k = it & 4095;
        bf16_t* src = MIX + (size_t)(b * TPB + CTX + k) * DM + 8 * lane; const u32x4 pc = *(const u32x4*)src; const u32x4 ps = *(const u32x4*)(PS + ((size_t)(b * 4096 + k)) * 512 + 8 * lane);
        u32x4 sm, df;
        sm.x = cvtpk(bflo(pc.x) + bflo(ps.x), bfhi(pc.x) + bfhi(ps.x)); df.x = cvtpk(bflo(pc.x) - bflo(ps.x), bfhi(pc.x) - bfhi(ps.x));
        sm.y = cvtpk(bflo(pc.y) + bflo(ps.y), bfhi(pc.y) + bfhi(ps.y)); df.y = cvtpk(bflo(pc.y) - bflo(ps.y), bfhi(pc.y) - bfhi(ps.y));
        sm.z = cvtpk(bflo(pc.z) + bflo(ps.z), bfhi(pc.z) + bfhi(ps.z)); df.z = cvtpk(bflo(pc.z) - bflo(ps.z), bfhi(pc.z) - bfhi(ps.z));
        sm.w = cvtpk(bflo(pc.w) + bflo(ps.w), bfhi(pc.w) + bfhi(ps.w)); df.w = cvtpk(bflo(pc.w) - bflo(ps.w), bfhi(pc.w) - bfhi(ps.w));
        *(u32x4*)src = sm;
        if (k >= 1) *(u32x4*)(MIX + (size_t)(b * TPB + CTX + 8192 - k) * DM + 8 * lane) = df; }
}

DI bool attn_unit_map(int L, int nunits_big, int& bh, int& qb) {
    if (L < nunits_big) { const int i = L >> 8, c = L & 255; bh = 4 * (c & 7) + i; qb = 1 + (c >> 3); return true; }
    bh = L - nunits_big; qb = 0; return bh < 32;
}
DI void attn_mla_unit(const Args& a, LAS unsigned char* lds, int bh, int qb) {
    unsigned char* ws = a.ws; const int tid = otid(), lane = tid & 63, wave = tid >> 6, r = lane & 31, h = lane >> 5;
    const int b = bh >> 3, hd = bh & 7; const int m = b * TPB + qb * 256 + wave * 32 + r;
    const bf16_t* Q = (const bf16_t*)(ws + WS_Q) + (size_t)m * 768;
    const bf16_t* KN = (const bf16_t*)(ws + WS_KN) + (size_t)(b * TPB) * 512 + hd * 64;
    const bf16_t* KR = (const bf16_t*)(ws + WS_KR) + (size_t)(b * TPB) * 32;
    const bf16_t* VT = (const bf16_t*)(ws + WS_VT0) + (size_t)(hd * 64) * ROWS + b * TPB;
    f32x16 o[2]; float l;
    attn_core<64, 32, 64>(o, l, lds, Q + hd * 64, Q + 512 + hd * 32, KN, 512, KR, 32, VT, ROWS, qb == 0 ? CTX / 64 : TPB / 64);
    const float il = 1.0f / l; bf16_t* dst = (bf16_t*)(ws + WS_R3) + (size_t)m * DM + 512 + hd * 64;
#pragma unroll
    for (int blk = 0; blk < 2; ++blk)
#pragma unroll
        for (int g = 0; g < 4; ++g) { u32x2 w; w.x = cvtpk(o[blk][4 * g] * il, o[blk][4 * g + 1] * il); w.y = cvtpk(o[blk][4 * g + 2] * il, o[blk][4 * g + 3] * il);
            *(u32x2*)(dst + 32 * blk + 8 * g + 4 * h) = w; }
}
DI void attn_diff_unit(const Args& a, LAS unsigned char* lds, int bh, int qb, float lam) {
    unsigned char* ws = a.ws; const int tid = otid(), lane = tid & 63, wave = tid >> 6, r = lane & 31, h = lane >> 5;
    const int b = bh >> 3, hd = bh & 7; const int m = b * TPB + qb * 256 + wave * 32 + r;
    const bf16_t* QK = (const bf16_t*)(ws + WS_R3);
    const bf16_t* VT = (const bf16_t*)(ws + WS_VT1) + (size_t)(hd * 128) * ROWS + b * TPB;
    bf16_t* dst = (bf16_t*)(ws + WS_R2) + (size_t)m * DM + hd * 128;
    f32x16 o[4]; float l;
    {
        const bf16_t* q = QK + (size_t)m * 2048 + (hd * 2) * 64; const bf16_t* k = QK + (size_t)(b * TPB) * 2048 + 1024 + (hd * 2) * 64;
        attn_core<64, 0, 128>(o, l, lds, q, q, k, 2048, k, 2048, VT, ROWS, TPB / 64);
        const float il = 1.0f / l;
#pragma unroll
        for (int blk = 0; blk < 4; ++blk)
#pragma unroll
            for (int g = 0; g < 4; ++g) { u32x2 w; w.x = cvtpk(o[blk][4 * g] * il, o[blk][4 * g + 1] * il); w.y = cvtpk(o[blk][4 * g + 2] * il, o[blk][4 * g + 3] * il); *(u32x2*)(dst + 32 * blk + 8 * g + 4 * h) = w; }
    }
    {
        const bf16_t* q = QK + (size_t)m * 2048 + (hd * 2 + 1) * 64; const bf16_t* k = QK + (size_t)(b * TPB) * 2048 + 1024 + (hd * 2 + 1) * 64;
        attn_core<64, 0, 128>(o, l, lds, q, q, k, 2048, k, 2048, VT, ROWS, TPB / 64);
    }
    const float il = lam / l; float ss = 0.f;
#pragma unroll
    for (int blk = 0; blk < 4; ++blk)
#pragma unroll
        for (int g = 0; g < 4; ++g) { const u32x2 aw = *(const u32x2*)(dst + 32 * blk + 8 * g + 4 * h);
            const float x0 = bflo(aw.x) - o[blk][4 * g] * il, x1 = bfhi(aw.x) - o[blk][4 * g + 1] * il, x2 = bflo(aw.y) - o[blk][4 * g + 2] * il, x3 = bfhi(aw.y) - o[blk][4 * g + 3] * il;
            o[blk][4 * g] = x0; o[blk][4 * g + 1] = x1; o[blk][4 * g + 2] = x2; o[blk][4 * g + 3] = x3; ss += (x0 * x0 + x1 * x1) + (x2 * x2 + x3 * x3); }
    ss += __shfl_xor(ss, 32);
    const float rn = (1.0f - LAMBDA_INIT) / sqrtf(ss * (1.0f / 128.0f) + RMS_EPS);
    const float* sub = a.in[I1_SUBLN];
#pragma unroll
    for (int blk = 0; blk < 4; ++blk)
#pragma unroll
        for (int g = 0; g < 4; ++g) { const int d0 = 32 * blk + 8 * g + 4 * h; const f32x4 sg = *(const f32x4*)(sub + d0);
            u32x2 w; w.x = cvtpk(o[blk][4 * g] * rn * sg[0], o[blk][4 * g + 1] * rn * sg[1]); w.y = cvtpk(o[blk][4 * g + 2] * rn * sg[2], o[blk][4 * g + 3] * rn * sg[3]);
            *(u32x2*)(dst + d0) = w; }
}

constexpr int NPHASES = 18;
constexpr int LDS_BYTES = 147456;
struct GOp { int kind; pg8::Gemm g; bf16_t* O; int ldc, o_bs, ai_extra; float scale; int q_tiles, rope_from; };

DI bool get_gemm(int ph, int sub, const Args& a, GOp& op) {
    unsigned char* ws = a.ws;
    bf16_t* R2 = (bf16_t*)(ws + WS_R2); bf16_t* R3 = (bf16_t*)(ws + WS_R3);
    op.kind = 0; op.o_bs = 0; op.ai_extra = 0; op.scale = 1.0f; op.q_tiles = 0; op.rope_from = 0;
    pg8::Gemm& g = op.g; g.nB = 1; g.a_bs = 0; g.b_bs = 0; g.rot = 0; g.a_seg = 0; g.b_seg = 0; g.skipctx = 0;
#define SETK(k_) do { g.K = (k_); g.kseg = (k_) / 64; g.a_seg = (k_); g.b_seg = (k_); } while (0)
    switch (ph * 8 + sub) {
    case 2 * 8 + 0:
        g.A = R2; g.a_rs = 1024; g.nM = NRT; g.Bt = (const bf16_t*)(ws + W_IN0); g.b_rs = 1024; g.nN = 5; SETK(1024); op.O = R3; op.ldc = 1280; return true;
    case 3 * 8 + 0:
        g.A = (const bf16_t*)(ws + W_DC); g.a_rs = 128; g.nM = 1; g.Bt = R3; g.b_rs = 1280; g.nN = NRT; g.nB = 4; g.b_bs = 128; SETK(128);
        op.O = R2; op.ldc = ROWS; op.o_bs = 128 * ROWS; op.ai_extra = 384 * ROWS; return true;
    case 4 * 8 + 0:
        op.kind = 1; g.A = (const bf16_t*)(ws + WS_CQN); g.a_rs = 256; g.nM = NRT; g.Bt = (const bf16_t*)(ws + W_UQ); g.b_rs = 256; g.nN = 3; SETK(256);
        op.O = (bf16_t*)(ws + WS_Q); op.ldc = 768; op.scale = MLA_QSCALE; op.q_tiles = 3; op.rope_from = 2; return true;
    case 4 * 8 + 1:
        g.A = (const bf16_t*)(ws + WS_CKVN); g.a_rs = 256; g.nM = NRT; g.Bt = (const bf16_t*)(ws + W_KN); g.b_rs = 256; g.nN = 2; SETK(256); g.rot = 140;
        op.O = (bf16_t*)(ws + WS_KN); op.ldc = 512; return true;
    case 4 * 8 + 2:
        g.A = (const bf16_t*)(ws + W_V0); g.a_rs = 256; g.nM = 2; g.Bt = (const bf16_t*)(ws + WS_CKVN); g.b_rs = 256; g.nN = NRT; SETK(256); g.rot = 148;
        op.O = (bf16_t*)(ws + WS_VT0); op.ldc = ROWS; return true;
    case 4 * 8 + 3:
        g.A = (const bf16_t*)(ws + WS_DN); g.a_rs = 16384; g.nM = 16; g.Bt = R2 + CTX; g.b_rs = ROWS; g.nN = 2; g.nB = 4; g.b_bs = TPB; SETK(8192); g.rot = 152;
        op.O = R3 + (size_t)CTX * DM; op.ldc = DM; op.o_bs = TPB * DM; return true;
    case 4 * 8 + 4:
        g.A = (const bf16_t*)(ws + WS_DN) + 8192; g.a_rs = 16384; g.nM = 16; g.Bt = R2 + CTX + (size_t)512 * ROWS; g.b_rs = ROWS; g.nN = 2; g.nB = 4; g.b_bs = TPB; SETK(8192); g.rot = 24;
        op.O = (bf16_t*)(ws + WS_PS); op.ldc = 512; op.o_bs = 4096 * 512; return true;
    case 4 * 8 + 5:
        g.A = (const bf16_t*)(ws + W_D256); g.a_rs = 512; g.nM = 1; g.Bt = R2; g.b_rs = ROWS; g.nN = 2; g.nB = 4; g.b_bs = TPB; g.K = 512; g.kseg = 4; g.a_seg = 256; g.b_seg = 512 * ROWS; g.rot = 0;
        op.O = R3; op.ldc = DM; op.o_bs = TPB * DM; return true;
    case 6 * 8 + 0:
        g.A = R3; g.a_rs = 1024; g.nM = NRT; g.Bt = (const bf16_t*)(ws + W_OUT0); g.b_rs = 1024; g.nN = 4; SETK(1024); op.O = (bf16_t*)(ws + WS_Y0); op.ldc = DM; return true;
    case 8 * 8 + 0: case 15 * 8 + 0:
        op.kind = 3; g.A = R2; g.a_rs = 1024; g.nM = (ph == 8 ? NRT : 128); g.skipctx = (ph != 8); g.Bt = (const bf16_t*)(ws + (ph == 8 ? W_GU0 : W_GU1)); g.b_rs = 1024; g.nN = 22; SETK(1024); op.O = R3; op.ldc = FF; return true;
    case 9 * 8 + 0: case 16 * 8 + 0:
        g.A = R3; g.a_rs = FF; g.nM = (ph == 9 ? NRT : 128); g.skipctx = (ph != 9); g.Bt = (const bf16_t*)(ws + (ph == 9 ? W_D0 : W_D1)); g.b_rs = FF; g.nN = 4; SETK(FF); op.O = R2; op.ldc = DM; return true;
    case 11 * 8 + 0:
        op.kind = 2; g.A = R2; g.a_rs = 1024; g.nM = NRT; g.Bt = (const bf16_t*)(ws + W_QK1); g.b_rs = 1024; g.nN = 8; SETK(1024);
        op.O = R3; op.ldc = 2048; op.scale = DIFF_QSCALE; op.q_tiles = 4; op.rope_from = 0; return true;
    case 11 * 8 + 1:
        g.A = (const bf16_t*)(ws + W_V1); g.a_rs = 1024; g.nM = 4; g.Bt = R2; g.b_rs = 1024; g.nN = NRT; SETK(1024); g.rot = 32;
        op.O = (bf16_t*)(ws + WS_VT1); op.ldc = ROWS; return true;
    case 13 * 8 + 0:
        g.A = R2; g.a_rs = 1024; g.nM = 128; g.skipctx = 1; g.Bt = (const bf16_t*)(ws + W_OUT1); g.b_rs = 1024; g.nN = 4; SETK(1024); op.O = R3; op.ldc = DM; return true;
    default: return false;
    }
#undef SETK
}

DI bool get_rowpass(int ph, const Args& a, RowPass& P) {
    unsigned char* ws = a.ws; const float* MOD0 = (const float*)(ws + WS_MOD); const float* MOD1 = MOD0 + 5 * 6144;
    float* XC = (float*)(ws + WS_XC); bf16_t* R2 = (bf16_t*)(ws + WS_R2);
    switch (ph) {
    case 1:  P = RowPass{a.in[I_X], a.in[I_CTX], nullptr, nullptr, nullptr, MOD0, 0, nullptr, nullptr, MOD0, 1024, 0, R2, 0}; return true;
    case 7:  P = RowPass{a.in[I_X], a.in[I_CTX], a.out, XC, (const bf16_t*)(ws + WS_Y0), MOD0, 2048, a.in[I0_LN1G], a.in[I0_LN1B], MOD0, 4096, 3072, R2, 0}; return true;
    case 10: P = RowPass{a.out, XC, a.out, XC, R2, MOD0, 5120, a.in[I0_LN2G], a.in[I0_LN2B], MOD1, 1024, 0, R2, 0}; return true;
    case 14: P = RowPass{a.out, XC, a.out, XC, (const bf16_t*)(ws + WS_R3), MOD1, 2048, a.in[I1_LN1G], a.in[I1_LN1B], MOD1, 4096, 3072, R2, 1}; return true;
    case 17: P = RowPass{a.out, XC, a.out, XC, R2, MOD1, 5120, a.in[I1_LN2G], a.in[I1_LN2B], MOD1, 0, 0, nullptr, 1}; return true;
    default: return false;
    }
}

__global__ void __launch_bounds__(512, 2) fwd_kernel(Args a) {
    extern __shared__ __attribute__((aligned(16))) unsigned char lds_raw[];
    LAS unsigned char* lds = (LAS unsigned char*)lds_raw;
    const int G = gridDim.x;
    volatile LAS unsigned* bst = (volatile LAS unsigned*)(lds + LDS_BYTES - 64);
    if (threadIdx.x < 2) bst[threadIdx.x] = 0u;
    __syncthreads();
    XcdBarrier xbar = xcd_barrier_post((unsigned*)(a.ws + WS_BAR), bst);
    for (int ph = a.ph_lo; ph < a.ph_hi; ++ph) {
        const int tid = otid(), lane = tid & 63, wave = __builtin_amdgcn_readfirstlane(tid >> 6);
        const int gw = blockIdx.x * 8 + wave, NGW = G * 8;
#ifndef NO_PRO
        if (ph == 0) prologue(a, lds);
#endif
        RowPass P;
        if (get_rowpass(ph, a, P)) { for (int m = gw; m < ROWS; m += NGW) row_pass(P, m, lane); }
        if (ph == 3) { for (int m = gw; m < ROWS; m += NGW) p3_row(a, m, lane); }
#ifndef NO_MLA
        if (ph == 5) {
            mirror_items(a, gw, NGW, lane);
            for (int L = blockIdx.x; ; L += G) { int bh, qb; if (!attn_unit_map(L, 1024, bh, qb)) break; attn_mla_unit(a, lds, bh, qb); }
        }
#endif
#ifndef NO_DIFF
        if (ph == 12) {
            const float p1 = wave_sum(a.in[I1_LQ1][lane] * a.in[I1_LK1][lane]), p2 = wave_sum(a.in[I1_LQ2][lane] * a.in[I1_LK2][lane]);
            const float lam = expf(p1) - expf(p2) + LAMBDA_INIT;
            for (int L = blockIdx.x; L < 1024; L += G) { int bh, qb; attn_unit_map(L, 1024, bh, qb); attn_diff_unit(a, lds, bh, qb, lam); }
        }
#endif
#ifndef NO_GEMM
        for (int sub = 0; sub < 8; ++sub) {
            GOp op; if (!get_gemm(ph, sub, a, op)) break;
            pg8::StaticOrder S; S.init(op.g.nM, op.g.nN, op.g.nB, G, (int)blockIdx.x, op.g.rot, op.g.skipctx);
            if (op.kind == 0) { pg8::EpiStore E{op.O, op.ldc, op.o_bs, op.ai_extra, op.scale}; pg8::gemm_phase(lds, op.g, S, E); }
            else if (op.kind == 1) { pg8::EpiRope<8> E{op.O, op.ldc, op.scale, op.q_tiles, op.rope_from, (const f32x2*)(a.ws + WS_TAB8)}; pg8::gemm_phase(lds, op.g, S, E); }
            else if (op.kind == 2) { pg8::EpiRope<16> E{op.O, op.ldc, op.scale, op.q_tiles, op.rope_from, (const f32x2*)(a.ws + WS_TAB16)}; pg8::gemm_phase(lds, op.g, S, E); }
            else { pg8::EpiSwiglu E{op.O, op.ldc}; pg8::gemm_phase(lds, op.g, S, E); }
        }
#endif
        if (ph + 1 < a.ph_hi) { if (ph == a.ph_lo) { __threadfence(); cg::this_grid().sync(); } else xcd_barrier(xbar); }
    }
}

extern "C" void kernel_launch(void* const* d_in, const int* in_sizes, int n_in, void* d_out, int out_size, void* d_ws, size_t ws_size, hipStream_t stream) {
    static int grid = 0;
    if (grid == 0) {
        if (n_in != 35 || ws_size < WS_END) { fprintf(stderr, "kernel_launch: unexpected n_in %d / ws %zu (need %zu)\n", n_in, ws_size, (size_t)WS_END); grid = -1; return; }
        int dev = 0, cus = 0, per_cu = 0;
        hipGetDevice(&dev); hipDeviceGetAttribute(&cus, hipDeviceAttributeMultiprocessorCount, dev);
        hipFuncSetAttribute((const void*)fwd_kernel, hipFuncAttributeMaxDynamicSharedMemorySize, LDS_BYTES);
        hipOccupancyMaxActiveBlocksPerMultiprocessor(&per_cu, (const void*)fwd_kernel, 512, LDS_BYTES);
        if (per_cu < 1) { fprintf(stderr, "kernel_launch: occupancy query says %d blocks/CU\n", per_cu); per_cu = 1; }
        (void)hipGetLastError();
        grid = cus * 1;
    }
    if (grid < 0) return;
    Args a{};
    for (int i = 0; i < 35; ++i) a.in[i] = (const float*)d_in[i];
    a.out = (float*)d_out; a.ws = (unsigned char*)d_ws;
#if MK_MULTI
    for (int ph = 0; ph < NPHASES; ++ph) { a.ph_lo = ph; a.ph_hi = ph + 1; hipLaunchKernelGGL(fwd_kernel, dim3(grid), dim3(512), LDS_BYTES, stream, a); }
#else
    a.ph_lo = 0; a.ph_hi = NPHASES;
    hipMemsetAsync((char*)d_ws + WS_BAR, 0, 16384, stream);
    void* args[] = {&a};
    hipError_t e = hipLaunchCooperativeKernel((const void*)fwd_kernel, dim3(grid), dim3(512), args, LDS_BYTES, stream);
    if (e != hipSuccess) fprintf(stderr, "cooperative launch failed: %s (grid %d)\n", hipGetErrorString(e), grid);
#endif
}
```

```cpp
#include <hip/hip_runtime.h>
#include <hip/hip_cooperative_groups.h>
#include <cstdio>
#include <cstdint>
namespace cg = cooperative_groups;

#ifndef MK_MULTI
#define MK_MULTI 0
#endif

#define DI __device__ __forceinline__
#define LAS __attribute__((address_space(3)))
typedef unsigned short bf16_t;
typedef short bf16x8 __attribute__((ext_vector_type(8)));
typedef float f32x4 __attribute__((ext_vector_type(4)));
typedef float f32x2 __attribute__((ext_vector_type(2)));
typedef float f32x16 __attribute__((ext_vector_type(16)));
typedef unsigned u32x4 __attribute__((ext_vector_type(4)));
typedef unsigned u32x2 __attribute__((ext_vector_type(2)));
typedef __bf16 bf16x2_t __attribute__((ext_vector_type(2)));

constexpr int DM = 1024, NB = 4, SEQ = 8192, CTX = 256, TPB = SEQ + CTX  , ROWS = NB * TPB  , FF = 2816;
constexpr int NRT = ROWS / 256;
constexpr float LN_EPS = 1e-6f, RMS_EPS = 1e-6f;
constexpr float DN_ALPHA = 1.41421356237f;
constexpr float LOG2E = 1.4426950408889634f;
constexpr float MLA_QSCALE = 0.10206207261596577f * LOG2E;
constexpr float DIFF_QSCALE = 0.125f * LOG2E;
constexpr float LAMBDA_INIT = 0.35550906f;

constexpr size_t MiB = 1u << 20;
constexpr size_t WS_MOD = 0;
constexpr size_t WS_TAB16 = 256 * 1024;
constexpr size_t WS_TAB8 = WS_TAB16 + 16384;
constexpr size_t WS_BAR = 512 * 1024;
constexpr size_t WS_XC = 1 * MiB;
constexpr size_t WS_W = 5 * MiB;
constexpr size_t W_IN0 = WS_W;
constexpr size_t W_UQ = W_IN0 + 1280 * 1024 * 2;
constexpr size_t W_KN = W_UQ + 768 * 256 * 2;
constexpr size_t W_V0 = W_KN + 512 * 256 * 2;
constexpr size_t W_OUT0 = W_V0 + 512 * 256 * 2;
constexpr size_t W_GU0 = W_OUT0 + 1024 * 1024 * 2;
constexpr size_t W_D0 = W_GU0 + 5632 * 1024 * 2;
constexpr size_t W_QK1 = W_D0 + 1024 * 2816 * 2;
constexpr size_t W_V1 = W_QK1 + 2048 * 1024 * 2;
constexpr size_t W_OUT1 = W_V1 + 1024 * 1024 * 2;
constexpr size_t W_GU1 = W_OUT1 + 1024 * 1024 * 2;
constexpr size_t W_D1 = W_GU1 + 5632 * 1024 * 2;
constexpr size_t W_DC = W_D1 + 1024 * 2816 * 2;
constexpr size_t W_D256 = W_DC + 256 * 128 * 2;
constexpr size_t W_END = W_D256 + 256 * 512 * 2;
static_assert(W_END <= 56 * MiB, "weights region");
constexpr size_t WS_DN = 56 * MiB;
constexpr size_t WS_R2 = 184 * MiB;
constexpr size_t WS_R3 = 250 * MiB;
constexpr size_t WS_R4 = WS_R3 + (size_t)ROWS * 1280 * 2;
constexpr size_t WS_CQN = WS_R4, WS_CKVN = WS_R4 + (size_t)ROWS * 256 * 2;
constexpr size_t WS_R5 = WS_R4 + (size_t)ROWS * 512 * 2;
constexpr size_t WS_Q = WS_R5;
constexpr size_t WS_KN = WS_Q + (size_t)ROWS * 768 * 2;
constexpr size_t WS_KR = WS_KN + (size_t)ROWS * 512 * 2;
constexpr size_t WS_VT0 = WS_KR + (size_t)ROWS * 32 * 2;
constexpr size_t WS_END = WS_VT0 + (size_t)512 * ROWS * 2;
constexpr size_t WS_Y0 = WS_R5;
constexpr size_t WS_PS = WS_R3 + (size_t)ROWS * DM * 2;
static_assert(WS_PS + (size_t)4 * 4096 * 512 * 2 <= WS_R4, "ps");
constexpr size_t WS_VT1 = WS_R3 + (size_t)ROWS * 2048 * 2;
static_assert(WS_END <= 512 * MiB, "workspace");
static_assert(WS_VT1 + (size_t)1024 * ROWS * 2 <= WS_END, "vt1");
static_assert(WS_R3 + (size_t)ROWS * FF * 2 <= WS_END, "hid");

DI int otid() { int t = threadIdx.x; asm volatile("" : "+v"(t)); return t; }
DI float wave_sum(float v) {
#pragma unroll
    for (int o = 1; o < 64; o <<= 1) v += __shfl_xor(v, o);
    return v;
}
DI unsigned cvtpk(float lo, float hi) { f32x2 v = {lo, hi}; bf16x2_t b = __builtin_convertvector(v, bf16x2_t); return __builtin_bit_cast(unsigned, b); }
DI float bf2f(unsigned short b) { return __uint_as_float(((unsigned)b) << 16); }
DI float bflo(unsigned w) { return __uint_as_float(w << 16); }
DI float bfhi(unsigned w) { return __uint_as_float(w & 0xffff0000u); }

namespace pg8 {
constexpr int BM = 256, BK = 64, HALF = 128, HTB = HALF * BK * 2, STAGE_BYTES = 8 * HTB, NXCD = 8, WGM = 8;
__host__ __device__ __forceinline__ int lds_byte(int r, int c) { const int st = (r >> 4) * 2 + (c >> 5), rr = r & 15, cc = c & 31, ob = rr * 64 + cc * 2; return st * 1024 + (ob ^ (((ob >> 9) & 1) << 5)); }
__host__ __device__ __forceinline__ void stage_rc(int b, int& R, int& C) { const int st = b / 1024, sb = b % 1024, swz = sb ^ (((sb >> 9) & 1) << 5); R = (st >> 1) * 16 + swz / 64; C = (st & 1) * 32 + (swz % 64) / 2; }
__host__ __device__ __forceinline__ int perm32(int rho) { const int n = rho >> 4, i = rho & 15; return 8 * (i >> 2) + 4 * n + (i & 3); }

struct Unit { int pm, pn, pb; };
struct Gemm {
    const bf16_t* A; const bf16_t* Bt; int nM, nN, nB, K, kseg;
    int a_rs, b_rs, a_seg, b_seg, a_bs, b_bs;
    int rot, skipctx;
};
struct StaticOrder {
    int nM, nN, nwg, tot, G, c, skipctx;
    DI void init(int nM_, int nN_, int nB_, int G_, int c_, int rot, int skip) { skipctx = skip; nM = nM_; nN = nN_; nwg = nM * nN; tot = nwg * nB_; G = G_; c = (c_ + G_ - (rot % G_)) % G_; }
    DI bool next(int i, Unit& u) const {
        const long L = (long)i * G + c; if (L >= tot) return false;
        u.pb = (int)(L / nwg); int wgid = (int)(L % nwg);
        { const int q = nwg / NXCD, r = nwg % NXCD, xcd = wgid % NXCD, off = wgid / NXCD; wgid = (xcd < r ? xcd * (q + 1) : r * (q + 1) + (xcd - r) * q) + off; }
        const int nig = WGM * nN, gid = wgid / nig, fm = gid * WGM, gsz = (nM - fm) < WGM ? (nM - fm) : WGM;
        u.pm = fm + ((wgid % nig) % gsz); u.pn = (wgid % nig) / gsz; if (skipctx) u.pm += (u.pm >> 5) + 1; return true;
    }
};

struct EpiStore {
    static constexpr bool PERM = true;
    bf16_t* O; int ldc, o_bs, ai_extra; float scale;
    DI void operator()(const f32x4 (&acc)[2][2][4][2], const Unit& u, int wr, int wc, int fr, int fq) const {
        const int row0 = u.pm * BM + wr * 64 + fr, col0 = u.pn * BM + wc * 32 + 8 * fq;
        bf16_t* base = O + (size_t)u.pb * o_bs;
#pragma unroll
        for (int ai = 0; ai < 2; ++ai)
#pragma unroll
            for (int m = 0; m < 4; ++m) { bf16_t* rowp = base + (size_t)(row0 + ai * HALF + m * 16) * ldc + (size_t)ai * ai_extra + col0;
#pragma unroll
                for (int bj = 0; bj < 2; ++bj) { const f32x4 v0 = acc[ai][bj][m][0] * scale, v1 = acc[ai][bj][m][1] * scale;
                    u32x4 w; w.x = cvtpk(v0[0], v0[1]); w.y = cvtpk(v0[2], v0[3]); w.z = cvtpk(v1[0], v1[1]); w.w = cvtpk(v1[2], v1[3]);
                    *(u32x4*)(rowp + bj * HALF) = w; } }
    }
};
struct EpiSwiglu {
    static constexpr bool PERM = true;
    bf16_t* O; int ldc;
    DI void operator()(const f32x4 (&acc)[2][2][4][2], const Unit& u, int wr, int wc, int fr, int fq) const {
        const int row0 = u.pm * BM + wr * 64 + fr, col0 = u.pn * HALF + wc * 32 + 8 * fq;
#pragma unroll
        for (int ai = 0; ai < 2; ++ai)
#pragma unroll
            for (int m = 0; m < 4; ++m) { bf16_t* rowp = O + (size_t)(row0 + ai * HALF + m * 16) * ldc + col0; float h[8];
#pragma unroll
                for (int n = 0; n < 2; ++n)
#pragma unroll
                    for (int i = 0; i < 4; ++i) { const float g = acc[ai][0][m][n][i], up = acc[ai][1][m][n][i];
                        h[n * 4 + i] = g * __builtin_amdgcn_rcpf(1.0f + __builtin_amdgcn_exp2f(-g * LOG2E)) * up; }
                u32x4 w; w.x = cvtpk(h[0], h[1]); w.y = cvtpk(h[2], h[3]); w.z = cvtpk(h[4], h[5]); w.w = cvtpk(h[6], h[7]);
                *(u32x4*)rowp = w; }
    }
};
template <int MODE> struct EpiRope {
    static constexpr bool PERM = false;
    bf16_t* O; int ldc; float qscale; int q_tiles, rope_from; const f32x2* tab;
    DI void operator()(const f32x4 (&acc)[2][2][4][2], const Unit& u, int wr, int wc, int fr, int fq) const {
        const float sc = u.pn < q_tiles ? qscale : 1.0f; const bool rope_tile = u.pn >= rope_from;
        const int col0 = u.pn * BM + wc * 32 + 4 * fq;
#pragma unroll
        for (int ai = 0; ai < 2; ++ai)
#pragma unroll
            for (int m = 0; m < 4; ++m) {
                const int row = u.pm * BM + ai * HALF + wr * 64 + m * 16 + fr; const int j = row % TPB; const int t = j - CTX;
                f32x4 cs0 = {1.f, 0.f, 1.f, 0.f}, cs1 = {1.f, 0.f, 1.f, 0.f};
                if (rope_tile && t >= 0) {
                    int pos, f0;
                    if (MODE == 16) { pos = (wc & 1) ? (t & 63) : (t >> 6); f0 = 4 * fq; } else { pos = (fq >> 1) ? (t & 63) : (t >> 6); f0 = 4 * (fq & 1); }
                    const f32x4* tp = (const f32x4*)(tab + pos * MODE + f0); cs0 = tp[0]; cs1 = tp[1];
                }
                const float c[4] = {cs0[0], cs0[2], cs1[0], cs1[2]}, s[4] = {cs0[1], cs0[3], cs1[1], cs1[3]};
                bf16_t* rowp = O + (size_t)row * ldc + col0;
#pragma unroll
                for (int bj = 0; bj < 2; ++bj) { const f32x4 x1 = acc[ai][bj][m][0] * sc, x2 = acc[ai][bj][m][1] * sc; float o1[4], o2[4];
#pragma unroll
                    for (int i = 0; i < 4; ++i) { o1[i] = x1[i] * c[i] - x2[i] * s[i]; o2[i] = x1[i] * s[i] + x2[i] * c[i]; }
                    u32x2 w1, w2; w1.x = cvtpk(o1[0], o1[1]); w1.y = cvtpk(o1[2], o1[3]); w2.x = cvtpk(o2[0], o2[1]); w2.y = cvtpk(o2[2], o2[3]);
                    *(u32x2*)(rowp + bj * HALF) = w1; *(u32x2*)(rowp + bj * HALF + 16) = w2; }
            }
    }
};

template <class Epi>
DI void gemm_phase(LAS unsigned char* lds, const Gemm g, const StaticOrder& S, const Epi& E) {
    const int tid = otid(), wid = __builtin_amdgcn_readfirstlane(tid >> 6), lane = tid & 63, wr = wid >> 2, wc = wid & 3, fr = lane & 15, fq = lane >> 4;
    const int nt = g.K / BK, kseg = g.kseg;
    unsigned voffA[2], voffB[2];
#pragma unroll
    for (int i = 0; i < 2; ++i) { int R, C; stage_rc(tid * 16 + i * 8192, R, C); const int Rb = Epi::PERM ? ((R & ~31) + perm32(R & 31)) : R;
        voffA[i] = (unsigned)(R * g.a_rs + C) * 2u; voffB[i] = (unsigned)(Rb * g.b_rs + C) * 2u; }
    const int kstep = BK * 2;
    const unsigned hstepA = (unsigned)HALF * g.a_rs * 2, hstepB = (unsigned)HALF * g.b_rs * 2;
    const unsigned tstepA = 2 * hstepA, tstepB = 2 * hstepB;
    const int segA = (g.a_seg - kseg * BK) * 2, segB = (g.b_seg - kseg * BK) * 2;
#define OFFA(t) ((t) * kstep + ((t) >= kseg ? segA : 0))
#define OFFB(t) ((t) * kstep + ((t) >= kseg ? segB : 0))
    const unsigned ldsw = (unsigned)wid * 1024u;
    const int aoff = lds_byte(wr * 64 + fr, fq * 8), boff = lds_byte(wc * 32 + fr, fq * 8);
#define PG8_SA(b, h) (((b) * 2 + (h)) * HTB)
#define PG8_SB(b, h) ((4 + (b) * 2 + (h)) * HTB)
#define PG8_STAGE(bufoff, gbase, voff) do { _Pragma("unroll") for (int _i = 0; _i < 2; ++_i) \
        __builtin_amdgcn_global_load_lds((const unsigned*)((const char*)(gbase) + (voff)[_i]), (LAS unsigned*)(lds + (bufoff) + ldsw + _i * 8192), 16, 0, 0); } while (0)
#define PG8_LDA(dst, b, h) do { _Pragma("unroll") for (int m = 0; m < 4; ++m) _Pragma("unroll") for (int k = 0; k < 2; ++k) dst[m][k] = *(const LAS bf16x8*)(lds + PG8_SA(b, h) + aoff + m * 2048 + k * 1024); } while (0)
#define PG8_LDB(dst, b, h) do { _Pragma("unroll") for (int n = 0; n < 2; ++n) _Pragma("unroll") for (int k = 0; k < 2; ++k) dst[n][k] = *(const LAS bf16x8*)(lds + PG8_SB(b, h) + boff + n * 2048 + k * 1024); } while (0)
#define PG8_MMA(ai, bj, At, Bt) do { __builtin_amdgcn_s_setprio(1); _Pragma("unroll") for (int m = 0; m < 4; ++m) _Pragma("unroll") for (int n = 0; n < 2; ++n) _Pragma("unroll") for (int k = 0; k < 2; ++k) \
        acc[ai][bj][m][n] = __builtin_amdgcn_mfma_f32_16x16x32_bf16(Bt[n][k], At[m][k], acc[ai][bj][m][n], 0, 0, 0); __builtin_amdgcn_s_setprio(0); } while (0)
#define PG8_WAIT_V(n) asm volatile("s_waitcnt vmcnt(" #n ")" ::: "memory")
#define PG8_WAIT_L(n) asm volatile("s_waitcnt lgkmcnt(" #n ")" ::: "memory")
#define PG8_BAR __builtin_amdgcn_s_barrier()
#define PG8_SCHED __builtin_amdgcn_sched_barrier(0)
    Unit cur, nxt; int ui = 0;
    if (!S.next(0, cur)) return;
    f32x4 acc[2][2][4][2];
#pragma unroll
    for (int a = 0; a < 2; ++a)
#pragma unroll
        for (int b = 0; b < 2; ++b)
#pragma unroll
            for (int m = 0; m < 4; ++m)
#pragma unroll
                for (int n = 0; n < 2; ++n) acc[a][b][m][n] = (f32x4){0.f, 0.f, 0.f, 0.f};
    bf16x8 At[4][2], B0[2][2], B1[2][2];
    const char* cA = (const char*)g.A + ((size_t)cur.pb * g.a_bs) * 2 + (size_t)cur.pm * tstepA;
    const char* cB = (const char*)g.Bt + ((size_t)cur.pb * g.b_bs) * 2 + (size_t)cur.pn * tstepB;
    {
        PG8_STAGE(PG8_SB(0, 0), cB, voffB); PG8_STAGE(PG8_SB(0, 1), cB + hstepB, voffB); PG8_STAGE(PG8_SA(0, 0), cA, voffA); PG8_STAGE(PG8_SA(0, 1), cA + hstepA, voffA);
        if (wr == 1) PG8_BAR;
        PG8_WAIT_V(2); PG8_BAR;
        PG8_STAGE(PG8_SB(1, 0), cB + OFFB(1), voffB); PG8_STAGE(PG8_SA(1, 0), cA + OFFA(1), voffA); PG8_STAGE(PG8_SB(1, 1), cB + hstepB + OFFB(1), voffB);
        PG8_WAIT_V(6); PG8_BAR;
    }
    for (;;) {
        const bool has_next = S.next(ui + 1, nxt);
        const char* nA = has_next ? (const char*)g.A + ((size_t)nxt.pb * g.a_bs) * 2 + (size_t)nxt.pm * tstepA : cA;
        const char* nB = has_next ? (const char*)g.Bt + ((size_t)nxt.pb * g.b_bs) * 2 + (size_t)nxt.pn * tstepB : cB;
        for (int t = 0; t < nt; t += 2) {
            const bool last = (t == nt - 2);
            const char* a1 = cA + OFFA(t + 1);
            const char* a2 = last ? nA : cA + OFFA(t + 2); const char* b2 = last ? nB : cB + OFFB(t + 2);
            const char* a3 = last ? nA + OFFA(1) : cA + OFFA(t + 3); const char* b3 = last ? nB + OFFB(1) : cB + OFFB(t + 3);
            PG8_LDB(B0, 0, 0); PG8_LDB(B1, 0, 1); PG8_SCHED; PG8_LDA(At, 0, 0); PG8_STAGE(PG8_SA(1, 1), a1 + hstepA, voffA);
            PG8_WAIT_V(8); PG8_WAIT_L(0); PG8_BAR; PG8_MMA(0, 0, At, B0); PG8_MMA(0, 1, At, B1); PG8_BAR; PG8_SCHED;
            PG8_LDA(At, 0, 1); PG8_STAGE(PG8_SB(0, 0), b2, voffB); PG8_STAGE(PG8_SB(0, 1), b2 + hstepB, voffB); PG8_STAGE(PG8_SA(0, 0), a2, voffA);
            PG8_WAIT_V(8); PG8_WAIT_L(0); PG8_BAR; PG8_MMA(1, 0, At, B0); PG8_MMA(1, 1, At, B1); PG8_BAR; PG8_SCHED;
            PG8_LDB(B0, 1, 0); PG8_LDB(B1, 1, 1); PG8_SCHED; PG8_LDA(At, 1, 0); PG8_STAGE(PG8_SA(0, 1), a2 + hstepA, voffA);
            PG8_WAIT_V(8); PG8_WAIT_L(0); PG8_BAR; PG8_MMA(0, 0, At, B0); PG8_MMA(0, 1, At, B1); PG8_BAR; PG8_SCHED;
            PG8_LDA(At, 1, 1); PG8_STAGE(PG8_SB(1, 0), b3, voffB); PG8_STAGE(PG8_SB(1, 1), b3 + hstepB, voffB); PG8_STAGE(PG8_SA(1, 0), a3, voffA);
            PG8_WAIT_V(8); PG8_WAIT_L(0); PG8_BAR; PG8_MMA(1, 0, At, B0); PG8_MMA(1, 1, At, B1); PG8_BAR; PG8_SCHED;
        }
        if (wr == 0) PG8_BAR;
        E(acc, cur, wr, wc, fr, fq);
        if (!has_next) break;
#pragma unroll
        for (int a = 0; a < 2; ++a)
#pragma unroll
            for (int b = 0; b < 2; ++b)
#pragma unroll
                for (int m = 0; m < 4; ++m)
#pragma unroll
                    for (int n = 0; n < 2; ++n) acc[a][b][m][n] = (f32x4){0.f, 0.f, 0.f, 0.f};
        cur = nxt; cA = nA; cB = nB; ++ui;
        if (wr == 1) PG8_BAR;
    }
    PG8_WAIT_V(0);
    PG8_BAR;
#undef OFFA
#undef OFFB
#undef PG8_SA
#undef PG8_SB
#undef PG8_STAGE
#undef PG8_LDA
#undef PG8_LDB
#undef PG8_MMA
#undef PG8_WAIT_V
#undef PG8_WAIT_L
#undef PG8_BAR
#undef PG8_SCHED
}
}

#define MFMA32(a, b, c) __builtin_amdgcn_mfma_f32_32x32x16_bf16((a), (b), (c), 0, 0, 0)
template <int D1, int D2, int DV>
DI void attn_core(f32x16 (&o)[DV / 32], float& l_out, LAS unsigned char* lds, const bf16_t* q1, const bf16_t* q2,
                  const bf16_t* k1, long ldk1, const bf16_t* k2, long ldk2, const bf16_t* vt, long ldv, int ntiles) {
    constexpr int DQK = D1 + D2, KROW = DQK * 2 + 16, VROW = 144, KT = 64 * KROW, VT = DV * VROW, BUF = KT + VT;
    constexpr int KCH = DQK / 8, NKC = 64 * KCH, NVC = DV * 8, KPT = (NKC + 511) / 512, VPT = NVC / 512;
    const int tid = otid(), lane = tid & 63, r = lane & 31, h = lane >> 5;
    bf16x8 qf[DQK / 16];
#pragma unroll
    for (int d0 = 0; d0 < DQK / 16; ++d0) qf[d0] = (16 * d0 < D1) ? *(const bf16x8*)(q1 + 16 * d0 + 8 * h) : *(const bf16x8*)(q2 + (16 * d0 - D1) + 8 * h);
    u32x4 kreg[KPT], vreg[VPT];
    auto gload = [&](int t) {
#pragma unroll
        for (int i = 0; i < KPT; ++i) { const int c = tid + i * 512; if (c < NKC) { const int row = c / KCH, cc = (c % KCH) * 8;
            kreg[i] = (cc < D1) ? *(const u32x4*)(k1 + (size_t)(t * 64 + row) * ldk1 + cc) : *(const u32x4*)(k2 + (size_t)(t * 64 + row) * ldk2 + (cc - D1)); } }
#pragma unroll
        for (int i = 0; i < VPT; ++i) { const int c = tid + i * 512; const int d = c >> 3, cc = (c & 7) * 8; vreg[i] = *(const u32x4*)(vt + (size_t)d * ldv + t * 64 + cc); }
    };
    auto sstore = [&](int b) {
        LAS unsigned char* kb = lds + b * BUF; LAS unsigned char* vb = kb + KT;
#pragma unroll
        for (int i = 0; i < KPT; ++i) { const int c = tid + i * 512; if (c < NKC) { const int row = c / KCH, cc = (c % KCH) * 8; *(LAS u32x4*)(kb + row * KROW + cc * 2) = kreg[i]; } }
#pragma unroll
        for (int i = 0; i < VPT; ++i) { const int c = tid + i * 512; const int d = c >> 3, cc = (c & 7) * 8; *(LAS u32x4*)(vb + d * VROW + cc * 2) = vreg[i]; }
    };
    const int pr = (r & ~12) | ((r & 4) << 1) | ((r & 8) >> 1);
    float mrun = 0.f, lrun = 0.f;
    f32x16 negm;
#pragma unroll
    for (int i = 0; i < 16; ++i) negm[i] = 0.f;
#pragma unroll
    for (int b = 0; b < DV / 32; ++b)
#pragma unroll
        for (int i = 0; i < 16; ++i) o[b][i] = 0.f;
    gload(0); sstore(0); if (ntiles > 1) { gload(1); sstore(1); } __syncthreads();
    for (int t = 0; t < ntiles; ++t) {
        if (t + 2 < ntiles) gload(t + 2);
        const LAS unsigned char* kb = lds + (t & 3) * BUF; const LAS unsigned char* vb = kb + KT;
        f32x16 p[2];
        {
            bf16x8 kf[2][DQK / 16];
#pragma unroll
            for (int hf = 0; hf < 2; ++hf)
#pragma unroll
                for (int d0 = 0; d0 < DQK / 16; ++d0) kf[hf][d0] = *(const LAS bf16x8*)(kb + (32 * hf + pr) * KROW + (16 * d0 + 8 * h) * 2);
            __builtin_amdgcn_sched_barrier(0);
            __builtin_amdgcn_s_setprio(1);
#pragma unroll
            for (int d0 = 0; d0 < DQK / 16; ++d0)
#pragma unroll
                for (int hf = 0; hf < 2; ++hf) p[hf] = MFMA32(kf[hf][d0], qf[d0], d0 == 0 ? negm : p[hf]);
            __builtin_amdgcn_s_setprio(0);
            __builtin_amdgcn_sched_barrier(0);
        }
        constexpr int NBLK = DV / 32;
        bf16x8 vk[2][NBLK];
#define LDVK(buf, ks) do { _Pragma("unroll") for (int b_ = 0; b_ < NBLK; ++b_) vk[buf][b_] = *(const LAS bf16x8*)(vb + (32 * b_ + r) * VROW + (16 * (ks) + 8 * h) * 2); } while (0)
        LDVK(0, 0);
        __builtin_amdgcn_sched_barrier(0);
        float ta = fmaxf(fmaxf(p[0][0], p[0][1]), p[1][0]), tb = fmaxf(fmaxf(p[0][2], p[0][3]), p[1][1]);
        ta = fmaxf(fmaxf(ta, p[1][2]), p[1][3]);
#pragma unroll
        for (int i = 4; i < 16; i += 4) { ta = fmaxf(fmaxf(ta, p[0][i]), p[0][i + 1]); tb = fmaxf(fmaxf(tb, p[0][i + 2]), p[0][i + 3]); ta = fmaxf(fmaxf(ta, p[1][i]), p[1][i + 1]); tb = fmaxf(fmaxf(tb, p[1][i + 2]), p[1][i + 3]); }
        float tm = fmaxf(ta, tb); tm = fmaxf(tm, __shfl_xor(tm, 32));
        if (__any(t == 0 || tm > 8.0f)) {
            const float dl = (t == 0 || tm > 0.f) ? tm : 0.f; mrun += dl;
            const float alpha = __builtin_amdgcn_exp2f(-dl); lrun *= alpha;
#pragma unroll
            for (int i = 0; i < 16; ++i) { p[0][i] -= dl; p[1][i] -= dl; negm[i] = -mrun; }
#pragma unroll
            for (int b = 0; b < DV / 32; ++b)
#pragma unroll
                for (int i = 0; i < 16; ++i) o[b][i] *= alpha;
        }
        bf16x8 pf[4]; float rs = 0.f; u32x4 wq;
#define EXPPART(ks, j) do { const int hf_ = (ks) >> 1, s8_ = ((ks) & 1) * 8; const float e0_ = __builtin_amdgcn_exp2f(p[hf_][s8_ + 2 * (j)]), e1_ = __builtin_amdgcn_exp2f(p[hf_][s8_ + 2 * (j) + 1]); \
        rs += e0_; rs += e1_; wq[j] = cvtpk(e0_, e1_); } while (0)
        EXPPART(0, 0); EXPPART(0, 1); EXPPART(0, 2); EXPPART(0, 3); pf[0] = __builtin_bit_cast(bf16x8, wq);
        __builtin_amdgcn_sched_barrier(0);
        __builtin_amdgcn_s_setprio(1);
#pragma unroll
        for (int ks = 0; ks < 4; ++ks) {
            if (ks < 3) LDVK((ks + 1) & 1, ks + 1);
            __builtin_amdgcn_sched_barrier(0);
#pragma unroll
            for (int b = 0; b < NBLK; ++b) {
                o[b] = MFMA32(vk[ks & 1][b], pf[ks], o[b]);
                if (ks < 3) {
#pragma unroll
                    for (int j = b * (4 / NBLK); j < (b + 1) * (4 / NBLK); ++j) {
                        if (ks == 0) EXPPART(1, j); else if (ks == 1) EXPPART(2, j); else EXPPART(3, j);
                    }
                }
                __builtin_amdgcn_sched_barrier(0);
            }
            if (ks < 3) pf[ks + 1] = __builtin_bit_cast(bf16x8, wq);
        }
        __builtin_amdgcn_s_setprio(0);
        lrun += rs;
#undef LDVK
#undef EXPPART
        if (t + 2 < ntiles) sstore((t + 2) & 3);
        if (t & 1) __syncthreads();
    }
    l_out = lrun + __shfl_xor(lrun, 32);
}
constexpr int ATTN_LDS = 2 * (64 * (96 * 2 + 16) + 128 * 144);


#define XB_TMO      128
#define XB_XCNT(j)  (256  + 64 * (j))
#define XB_XSUB(j)  (1280 + 64 * (j))
#define XB_XGEN(j)  (2304 + 64 * (j))
#define XB_TOP      3328
#define XB_TOPGEN   3392
#define XCD_BAR_WORDS 3456
#define XB_SPIN_CAP (1u << 18)
DI unsigned xb_ld(unsigned* p)              { return __hip_atomic_load(p, __ATOMIC_RELAXED, __HIP_MEMORY_SCOPE_AGENT); }
DI unsigned xb_add(unsigned* p, unsigned v) { return __hip_atomic_fetch_add(p, v, __ATOMIC_RELAXED, __HIP_MEMORY_SCOPE_AGENT); }
DI unsigned xb_xcc_id() { return (unsigned)__builtin_amdgcn_s_getreg((3 << 11) | 20) & 0xFu; }
#define XB_SPIN(cond, bar) do { unsigned _sp = 0; while (cond) { __builtin_amdgcn_s_sleep(1); \
    if ((++_sp & 255u) == 0u) { if (xb_ld(&(bar)[XB_TMO])) break; if (_sp > XB_SPIN_CAP) { atomicAdd(&(bar)[XB_TMO], 1u); break; } } } } while (0)
struct XcdBarrier { unsigned* bar; unsigned x; volatile LAS unsigned* st; };
DI XcdBarrier xcd_barrier_post(unsigned* bar, volatile LAS unsigned* st) {
    XcdBarrier b; b.bar = bar; b.x = xb_xcc_id(); b.st = st;
    if (threadIdx.x == 0) (void)xb_add(&bar[XB_XCNT(b.x)], 1u);
    return b;
}
DI void xcd_barrier_complete(unsigned* bar, unsigned x, unsigned& nloc, unsigned& nx) {
    const unsigned G = gridDim.x * gridDim.y * gridDim.z;
    unsigned sum, cnt, mine, sp = 0u;
    for (;;) {
        sum = 0u; cnt = 0u; mine = 0u;
#pragma unroll
        for (unsigned j = 0; j < 16; ++j) { const unsigned c = xb_ld(&bar[XB_XCNT(j)]); sum += c; cnt += (c > 0u) ? 1u : 0u; mine = (j == x) ? c : mine; }
        if (sum == G) break;
        __builtin_amdgcn_s_sleep(1);
        if ((++sp & 255u) == 0u) { if (xb_ld(&bar[XB_TMO])) break; if (sp > XB_SPIN_CAP) { atomicAdd(&bar[XB_TMO], 1u); break; } }
    }
    nloc = mine > 0u ? mine : 1u; nx = cnt > 0u ? cnt : 1u;
}
DI void xcd_barrier(const XcdBarrier& b) {
    asm volatile("s_waitcnt vmcnt(0)" ::: "memory");
    __syncthreads();
    if (threadIdx.x == 0) {
        unsigned* bar = b.bar;
        __builtin_amdgcn_s_waitcnt(0);
        unsigned nloc = b.st[0], nx = b.st[1];
        if (nloc == 0u) { xcd_barrier_complete(bar, b.x, nloc, nx); b.st[0] = nloc; b.st[1] = nx; }
        const unsigned old = xb_add(&bar[XB_XSUB(b.x)], 1u);
        const unsigned gen = old / nloc;
        if (old + 1u == (gen + 1u) * nloc) {
            __builtin_amdgcn_fence(__ATOMIC_RELEASE, "agent");
            asm volatile("s_waitcnt vmcnt(0)" ::: "memory");
            const unsigned og = xb_add(&bar[XB_TOP], 1u);
            const unsigned tg = og / nx;
            if (og + 1u == (tg + 1u) * nx) xb_add(&bar[XB_TOPGEN], 1u);
            else XB_SPIN(xb_ld(&bar[XB_TOPGEN]) == tg, bar);
            __builtin_amdgcn_fence(__ATOMIC_ACQUIRE, "agent");
            xb_add(&bar[XB_XGEN(b.x)], 1u);
            asm volatile("s_waitcnt vmcnt(0)" ::: "memory");
        } else {
            XB_SPIN(xb_ld(&bar[XB_XGEN(b.x)]) == gen, bar);
            __builtin_amdgcn_fence(__ATOMIC_ACQUIRE, "agent");
            asm volatile("s_waitcnt vmcnt(0)" ::: "memory");
        }
    }
    __syncthreads();
}

struct Args {
    const float* in[35]; float* out; unsigned char* ws; int ph_lo, ph_hi;
};
enum { I_X = 0, I_C, I_CTX, I_CCTX,
       I0_WMOD, I0_BMOD, I0_WIN, I0_QN, I0_WUQ, I0_KVN, I0_WUKV, I0_WOUT, I0_LN1G, I0_LN1B, I0_WG, I0_WU, I0_WD, I0_LN2G, I0_LN2B,
       I1_WMOD, I1_BMOD, I1_WIN, I1_LQ1, I1_LK1, I1_LQ2, I1_LK2, I1_SUBLN, I1_WOUT, I1_LN1G, I1_LN1B, I1_WG, I1_WU, I1_WD, I1_LN2G, I1_LN2B };

DI bf16_t* tr_dst(int job, int n, unsigned char* ws) {
    switch (job) {
    case 0: return (bf16_t*)(ws + W_IN0) + (size_t)n * 1024;
    case 1: { const int hd = n / 96, d = n % 96; int row; if (d < 64) row = hd * 64 + d; else { const int e = d - 64, t = e >> 3, f = e & 7; row = 512 + hd * 32 + 16 * (t & 1) + 8 * (t >> 1) + f; }
              return (bf16_t*)(ws + W_UQ) + (size_t)row * 256; }
    case 2: { const int hd = n >> 7, d = n & 127; return d < 64 ? (bf16_t*)(ws + W_KN) + (size_t)(hd * 64 + d) * 256 : (bf16_t*)(ws + W_V0) + (size_t)(hd * 64 + d - 64) * 256; }
    case 3: return (bf16_t*)(ws + W_OUT0) + (size_t)n * 1024;
    case 4: return (bf16_t*)(ws + W_GU0) + (size_t)(256 * (n >> 7) + (n & 127)) * 1024;
    case 5: return (bf16_t*)(ws + W_GU0) + (size_t)(256 * (n >> 7) + 128 + (n & 127)) * 1024;
    case 6: return (bf16_t*)(ws + W_D0) + (size_t)n * 2816;
    case 7: return n < 2048 ? (bf16_t*)(ws + W_QK1) + (size_t)n * 1024 : (bf16_t*)(ws + W_V1) + (size_t)(n - 2048) * 1024;
    case 8: return (bf16_t*)(ws + W_OUT1) + (size_t)n * 1024;
    case 9: return (bf16_t*)(ws + W_GU1) + (size_t)(256 * (n >> 7) + (n & 127)) * 1024;
    case 10: return (bf16_t*)(ws + W_GU1) + (size_t)(256 * (n >> 7) + 128 + (n & 127)) * 1024;
    default: return (bf16_t*)(ws + W_D1) + (size_t)n * 2816;
    }
}
DI void transpose_item(const float* W, int K, int N, int job, unsigned char* ws, LAS float* scr, int item, int lane) {
    const int nblk = N / 32, kb = item / nblk, nb = item % nblk, k0 = 64 * kb, n0 = 32 * nb;
#pragma unroll 8
    for (int i = 0; i < 32; ++i) { const int kk = 2 * i + (lane >> 5); scr[kk * 33 + (lane & 31)] = W[(size_t)(k0 + kk) * N + n0 + (lane & 31)]; }
    asm volatile("s_waitcnt lgkmcnt(0)" ::: "memory");
    const int c = lane & 7;
#pragma unroll
    for (int j = 0; j < 4; ++j) { const int n = (lane >> 3) + 8 * j; const LAS float* s = scr + (8 * c) * 33 + n;
        u32x4 o; o.x = cvtpk(s[0 * 33], s[1 * 33]); o.y = cvtpk(s[2 * 33], s[3 * 33]); o.z = cvtpk(s[4 * 33], s[5 * 33]); o.w = cvtpk(s[6 * 33], s[7 * 33]);
        bf16_t* dst = tr_dst(job, n0 + n, ws); *(u32x4*)(dst + k0 + 8 * c) = o; }
    asm volatile("s_waitcnt lgkmcnt(0)" ::: "memory");
}

DI void prologue(const Args& a, LAS unsigned char* lds) {
    unsigned char* ws = a.ws;
    const int tid = otid(), lane = tid & 63, wave = tid >> 6;
    const int G = gridDim.x, gw = blockIdx.x * 8 + wave, NGW = G * 8;
    const long gt = (long)blockIdx.x * 512 + tid, NGT = (long)G * 512;
    {
        LAS float* scr = (LAS float*)(lds + wave * 16384);
        const int jin[12] = {I0_WIN, I0_WUQ, I0_WUKV, I0_WOUT, I0_WG, I0_WU, I0_WD, I1_WIN, I1_WOUT, I1_WG, I1_WU, I1_WD};
        const int jK[12] = {1024, 256, 256, 1024, 1024, 1024, 2816, 1024, 1024, 1024, 1024, 2816};
        const int jN[12] = {1056, 768, 1024, 1024, 2816, 2816, 1024, 3072, 1024, 2816, 2816, 1024};
        int base = 0;
#pragma unroll
        for (int j = 0; j < 12; ++j) { const int items = (jK[j] / 64) * (jN[j] / 32);
            for (int it = gw; it < items; it += NGW) transpose_item(a.in[jin[j]], jK[j], jN[j], j, ws, scr, it, lane);
            base += items; }
        u32x4 z = {0u, 0u, 0u, 0u};
        for (long i = gt; i < (1280 - 1056) * 1024 / 8; i += NGT) ((u32x4*)((bf16_t*)(ws + W_IN0) + (size_t)1056 * 1024))[i] = z;
    }
    {
        const float sc = 0.011048543456039806f;
        for (long i = gt; i < (long)4096 * 2048; i += NGT) { const int k = (int)(i >> 11), c8 = (int)(i & 2047) * 8; const int part = c8 >> 13, n0 = c8 & 8191; float v[8];
#pragma unroll
            for (int e = 0; e < 8; ++e) { const float ph = (float)((k * (n0 + e)) & 8191) * (1.0f / 8192.0f); v[e] = (part ? __builtin_amdgcn_sinf(ph) : __builtin_amdgcn_cosf(ph)) * sc; }
            u32x4 o; o.x = cvtpk(v[0], v[1]); o.y = cvtpk(v[2], v[3]); o.z = cvtpk(v[4], v[5]); o.w = cvtpk(v[6], v[7]);
            *(u32x4*)((bf16_t*)(ws + WS_DN) + (size_t)k * 16384 + c8) = o; }
        for (long i = gt; i < 256 * 512; i += NGT) { const int k = (int)(i >> 9), c = (int)(i & 511), part = c >> 8, n = c & 255; const float ph = (float)((k * n) & 255) * (1.0f / 256.0f);
            const float v = (part ? __builtin_amdgcn_sinf(ph) : __builtin_amdgcn_cosf(ph)) * 0.0625f; ((bf16_t*)(ws + W_D256))[i] = (bf16_t)(cvtpk(v, 0.f) & 0xffffu); }
        for (long i = gt; i < 256 * 128; i += NGT) { const int rr = (int)(i >> 7), c = (int)(i & 127), part = rr >> 7, l = rr & 127; const float ph = (float)((l * c) & 127) * (1.0f / 128.0f);
            const float v = (part ? -__builtin_amdgcn_sinf(ph) : __builtin_amdgcn_cosf(ph)) * 0.08838834764831845f; ((bf16_t*)(ws + W_DC))[i] = (bf16_t)(cvtpk(v, 0.f) & 0xffffu); }
        for (long i = gt; i < 128 * 16; i += NGT) { const int pos = (int)(i >> 4), f = (int)(i & 15); const float inv = 1.0f / powf(10000.0f, (float)f / 16.0f); const float ang = (float)pos * inv;
            ((f32x2*)(ws + WS_TAB16))[i] = (f32x2){cosf(ang), sinf(ang)}; }
        for (long i = gt; i < 128 * 8; i += NGT) { const int pos = (int)(i >> 3), f = (int)(i & 7); const float inv = 1.0f / powf(10000.0f, (float)f / 8.0f); const float ang = (float)pos * inv;
            ((f32x2*)(ws + WS_TAB8))[i] = (f32x2){cosf(ang), sinf(ang)}; }
    }
    {
        LAS float* red = (LAS float*)lds;
        for (int it = blockIdx.x; it < 2 * 96; it += G) {
            __syncthreads();
            const int layer = it / 96, n = (it % 96) * 64 + lane; const float* w = a.in[layer ? I1_WMOD : I0_WMOD]; const float* bm = a.in[layer ? I1_BMOD : I0_BMOD];
            float acc[5] = {0.f, 0.f, 0.f, 0.f, 0.f};
            for (int kk = 0; kk < 128; ++kk) { const int k = wave * 128 + kk; const float wv = w[(size_t)k * 6144 + n];
#pragma unroll
                for (int cls = 0; cls < 5; ++cls) { const float cv = cls < 4 ? a.in[I_C][cls * 1024 + k] : a.in[I_CCTX][k]; const float sl = cv / (1.0f + __expf(-cv)); acc[cls] += sl * wv; } }
#pragma unroll
            for (int cls = 0; cls < 5; ++cls) red[(wave * 5 + cls) * 64 + lane] = acc[cls];
            __syncthreads();
            if (tid < 320) { const int cls = tid >> 6, l = tid & 63; float s = 0.f;
#pragma unroll
                for (int w8 = 0; w8 < 8; ++w8) s += red[(w8 * 5 + cls) * 64 + l];
                const int nn = (it % 96) * 64 + l; ((float*)(ws + WS_MOD))[(size_t)(layer * 5 + cls) * 6144 + nn] = s + bm[nn]; }
        }
        __syncthreads();
    }
}

struct RowPass {
    const float* xl; const float* xc;
    float* ol; float* oc;
    const bf16_t* Y;
    const float* mod;
    int gate_off; const float* lng; const float* lnb;
    const float* mod2; int sc_off, sh_off;
    bf16_t* H;
    int skipctx;
};
DI void ln_stats(const f32x4 (&v)[4], float& mean, float& rstd) {
    float s = 0.f;
#pragma unroll
    for (int j = 0; j < 4; ++j) s += (v[j][0] + v[j][1]) + (v[j][2] + v[j][3]);
    mean = wave_sum(s) * (1.0f / DM); float q = 0.f;
#pragma unroll
    for (int j = 0; j < 4; ++j) { const f32x4 d = v[j] - mean; q += (d[0] * d[0] + d[1] * d[1]) + (d[2] * d[2] + d[3] * d[3]); }
    rstd = 1.0f / sqrtf(wave_sum(q) * (1.0f / DM) + LN_EPS);
}
DI void row_pass(const RowPass& P, int m, int lane) {
    const int b = m / TPB, j = m % TPB; const bool isctx = j < CTX; const int cls = isctx ? 4 : b;
    if (P.skipctx && isctx) return;
    const size_t xoff = isctx ? (size_t)(b * CTX + j) * DM : (size_t)(b * SEQ + j - CTX) * DM;
    const float* xs = (isctx ? P.xc : P.xl) + xoff; float* xd = isctx ? P.oc : P.ol;
    f32x4 v[4];
#pragma unroll
    for (int jj = 0; jj < 4; ++jj) v[jj] = *(const f32x4*)(xs + 4 * lane + 256 * jj);
    if (P.Y) {
        const float* gate = P.mod + (size_t)cls * 6144 + P.gate_off;
#pragma unroll
        for (int jj = 0; jj < 4; ++jj) { const int c0 = 4 * lane + 256 * jj; const u32x2 yw = *(const u32x2*)(P.Y + (size_t)m * DM + c0); const f32x4 g = *(const f32x4*)(gate + c0);
            v[jj][0] = DN_ALPHA * v[jj][0] + g[0] * bflo(yw.x); v[jj][1] = DN_ALPHA * v[jj][1] + g[1] * bfhi(yw.x);
            v[jj][2] = DN_ALPHA * v[jj][2] + g[2] * bflo(yw.y); v[jj][3] = DN_ALPHA * v[jj][3] + g[3] * bfhi(yw.y); }
        float mean, rstd; ln_stats(v, mean, rstd);
#pragma unroll
        for (int jj = 0; jj < 4; ++jj) { const int c0 = 4 * lane + 256 * jj; const f32x4 g = *(const f32x4*)(P.lng + c0), bb = *(const f32x4*)(P.lnb + c0); v[jj] = (v[jj] - mean) * rstd * g + bb; }
        if (xd) {
#pragma unroll
            for (int jj = 0; jj < 4; ++jj) *(f32x4*)(xd + xoff + 4 * lane + 256 * jj) = v[jj];
        }
    }
    if (P.H) {
        float mean, rstd; ln_stats(v, mean, rstd);
        const float* sc = P.mod2 + (size_t)cls * 6144 + P.sc_off; const float* sh = P.mod2 + (size_t)cls * 6144 + P.sh_off;
#pragma unroll
        for (int jj = 0; jj < 4; ++jj) { const int c0 = 4 * lane + 256 * jj; const f32x4 s1 = *(const f32x4*)(sc + c0), s0 = *(const f32x4*)(sh + c0);
            const f32x4 hh = (v[jj] - mean) * rstd * (s1 + 1.0f) + s0; u32x2 w; w.x = cvtpk(hh[0], hh[1]); w.y = cvtpk(hh[2], hh[3]);
            *(u32x2*)(P.H + (size_t)m * DM + c0) = w; }
    }
}
DI void p3_row(const Args& a, int m, int lane) {
    unsigned char* ws = a.ws; const bf16_t* U = (const bf16_t*)(ws + WS_R3) + (size_t)m * 1280;
    const u32x2 qw = *(const u32x2*)(U + 512 + 4 * lane), kw = *(const u32x2*)(U + 768 + 4 * lane);
    float q[4] = {bflo(qw.x), bfhi(qw.x), bflo(qw.y), bfhi(qw.y)}, k[4] = {bflo(kw.x), bfhi(kw.x), bflo(kw.y), bfhi(kw.y)};
    const float qs = wave_sum(q[0] * q[0] + q[1] * q[1] + q[2] * q[2] + q[3] * q[3]), ks = wave_sum(k[0] * k[0] + k[1] * k[1] + k[2] * k[2] + k[3] * k[3]);
    const float qr = 1.0f / sqrtf(qs * (1.0f / 256.0f) + RMS_EPS), kr_ = 1.0f / sqrtf(ks * (1.0f / 256.0f) + RMS_EPS);
    const f32x4 qg = *(const f32x4*)(a.in[I0_QN] + 4 * lane), kg = *(const f32x4*)(a.in[I0_KVN] + 4 * lane);
    u32x2 w; w.x = cvtpk(q[0] * qr * qg[0], q[1] * qr * qg[1]); w.y = cvtpk(q[2] * qr * qg[2], q[3] * qr * qg[3]);
    *(u32x2*)((bf16_t*)(ws + WS_CQN) + (size_t)m * 256 + 4 * lane) = w;
    w.x = cvtpk(k[0] * kr_ * kg[0], k[1] * kr_ * kg[1]); w.y = cvtpk(k[2] * kr_ * kg[2], k[3] * kr_ * kg[3]);
    *(u32x2*)((bf16_t*)(ws + WS_CKVN) + (size_t)m * 256 + 4 * lane) = w;
    const int d = lane & 31, t = d >> 3, f = d & 7; const float val = bf2f(U[1024 + d]); const float par = __shfl_xor(val, 8);
    const int j = m % TPB, tt = j - CTX; float outv = val;
    if (tt >= 0) { const int pos = (t < 2) ? (tt >> 6) : (tt & 63); const f32x2 cs = ((const f32x2*)(ws + WS_TAB8))[pos * 8 + f];
        outv = (t & 1) ? (par * cs[1] + val * cs[0]) : (val * cs[0] - par * cs[1]); }
    if (lane < 32) ((bf16_t*)(ws + WS_KR))[(size_t)m * 32 + 16 * (t & 1) + 8 * (t >> 1) + f] = (bf16_t)(cvtpk(outv, 0.f) & 0xffffu);
}
DI void mirror_items(const Args& a, int gw, int NGW, int lane) {
    unsigned char* ws = a.ws; bf16_t* MIX = (bf16_t*)(ws + WS_R3); const bf16_t* At = (const bf16_t*)(ws + WS_R2);
    for (int it = gw; it < NB * 512; it += NGW) { const int b = it >> 9, ch = it & 511; const bf16_t* src = At + (size_t)ch * ROWS + b * TPB + CTX; float s = 0.f;
        for (int i = 0; i < 16; ++i) { const u32x4 w = *(const u32x4*)(src + (i * 64 + lane) * 8);
            s += (bflo(w.x) - bfhi(w.x)) + (bflo(w.y) - bfhi(w.y)) + (bflo(w.z) - bfhi(w.z)) + (bflo(w.w) - bfhi(w.w)); }
        s = wave_sum(s) * 0.011048543456039806f;
        if (lane == 0) MIX[(size_t)(b * TPB + CTX + 4096) * DM + ch] = (bf16_t)(cvtpk(s, 0.f) & 0xffffu); }
    const bf16_t* PS = (const bf16_t*)(ws + WS_PS);
    for (int it = gw; it < NB * 4096; it += NGW) { const int b = it >> 12, k = it & 4095;
        bf16_t* src = MIX + (size_t)(b * TPB + CTX + k) * DM + 8 * lane; const u32x4 pc = *(const u32x4*)src; const u32x4 ps = *(const u32x4*)(PS + ((size_t)(b * 4096 + k)) * 512 + 8 * lane);
        u32x4 sm, df;
        sm.x = cvtpk(bflo(pc.x) + bflo(ps.x), bfhi(pc.x) + bfhi(ps.x)); df.x = cvtpk(bflo(pc.x) - bflo(ps.x), bfhi(pc.x) - bfhi(ps.x));
        sm.y = cvtpk(bflo(pc.y) + bflo(ps.y), bfhi(pc.y) + bfhi(ps.y)); df.y = cvtpk(bflo(pc.y) - bflo(ps.y), bfhi(pc.y) - bfhi(ps.y));
        sm.z = cvtpk(bflo(pc.z) + bflo(ps.z), bfhi(pc.z) + bfhi(ps.z)); df.z = cvtpk(bflo(pc.z) - bflo(ps.z), bfhi(pc.z) - bfhi(ps.z));
        sm.w = cvtpk(bflo(pc.w) + bflo(ps.w), bfhi(pc.w) + bfhi(ps.w)); df.w = cvtpk(bflo(pc.w) - bflo(ps.w), bfhi(pc.w) - bfhi(ps.w));
        *(u32x4*)src = sm;
        if (k >= 1) *(u32x4*)(MIX + (size_t)(b * TPB + CTX + 8192 - k) * DM + 8 * lane) = df; }
}

DI bool attn_unit_map(int L, int nunits_big, int& bh, int& qb) {
    if (L < nunits_big) { const int i = L >> 8, c = L & 255; bh = 4 * (c & 7) + i; qb = 1 + (c >> 3); return true; }
    bh = L - nunits_big; qb = 0; return bh < 32;
}
DI void attn_mla_unit(const Args& a, LAS unsigned char* lds, int bh, int qb) {
    unsigned char* ws = a.ws; const int tid = otid(), lane = tid & 63, wave = tid >> 6, r = lane & 31, h = lane >> 5;
    const int b = bh >> 3, hd = bh & 7; const int m = b * TPB + qb * 256 + wave * 32 + r;
    const bf16_t* Q = (const bf16_t*)(ws + WS_Q) + (size_t)m * 768;
    const bf16_t* KN = (const bf16_t*)(ws + WS_KN) + (size_t)(b * TPB) * 512 + hd * 64;
    const bf16_t* KR = (const bf16_t*)(ws + WS_KR) + (size_t)(b * TPB) * 32;
    const bf16_t* VT = (const bf16_t*)(ws + WS_VT0) + (size_t)(hd * 64) * ROWS + b * TPB;
    f32x16 o[2]; float l;
    attn_core<64, 32, 64>(o, l, lds, Q + hd * 64, Q + 512 + hd * 32, KN, 512, KR, 32, VT, ROWS, qb == 0 ? CTX / 64 : TPB / 64);
    const float il = 1.0f / l; bf16_t* dst = (bf16_t*)(ws + WS_R3) + (size_t)m * DM + 512 + hd * 64;
#pragma unroll
    for (int blk = 0; blk < 2; ++blk)
#pragma unroll
        for (int g = 0; g < 4; ++g) { u32x2 w; w.x = cvtpk(o[blk][4 * g] * il, o[blk][4 * g + 1] * il); w.y = cvtpk(o[blk][4 * g + 2] * il, o[blk][4 * g + 3] * il);
            *(u32x2*)(dst + 32 * blk + 8 * g + 4 * h) = w; }
}
DI void attn_diff_unit(const Args& a, LAS unsigned char* lds, int bh, int qb, float lam) {
    unsigned char* ws = a.ws; const int tid = otid(), lane = tid & 63, wave = tid >> 6, r = lane & 31, h = lane >> 5;
    const int b = bh >> 3, hd = bh & 7; const int m = b * TPB + qb * 256 + wave * 32 + r;
    const bf16_t* QK = (const bf16_t*)(ws + WS_R3);
    const bf16_t* VT = (const bf16_t*)(ws + WS_VT1) + (size_t)(hd * 128) * ROWS + b * TPB;
    bf16_t* dst = (bf16_t*)(ws + WS_R2) + (size_t)m * DM + hd * 128;
    f32x16 o[4]; float l;
    {
        const bf16_t* q = QK + (size_t)m * 2048 + (hd * 2) * 64; const bf16_t* k = QK + (size_t)(b * TPB) * 2048 + 1024 + (hd * 2) * 64;
        attn_core<64, 0, 128>(o, l, lds, q, q, k, 2048, k, 2048, VT, ROWS, TPB / 64);
        const float il = 1.0f / l;
#pragma unroll
        for (int blk = 0; blk < 4; ++blk)
#pragma unroll
            for (int g = 0; g < 4; ++g) { u32x2 w; w.x = cvtpk(o[blk][4 * g] * il, o[blk][4 * g + 1] * il); w.y = cvtpk(o[blk][4 * g + 2] * il, o[blk][4 * g + 3] * il); *(u32x2*)(dst + 32 * blk + 8 * g + 4 * h) = w; }
    }
    {
        const bf16_t* q = QK + (size_t)m * 2048 + (hd * 2 + 1) * 64; const bf16_t* k = QK + (size_t)(b * TPB) * 2048 + 1024 + (hd * 2 + 1) * 64;
        attn_core<64, 0, 128>(o, l, lds, q, q, k, 2048, k, 2048, VT, ROWS, TPB / 64);
    }
    const float il = lam / l; float ss = 0.f;
#pragma unroll
    for (int blk = 0; blk < 4; ++blk)
#pragma unroll
        for (int g = 0; g < 4; ++g) { const u32x2 aw = *(const u32x2*)(dst + 32 * blk + 8 * g + 4 * h);
            const float x0 = bflo(aw.x) - o[blk][4 * g] * il, x1 = bfhi(aw.x) - o[blk][4 * g + 1] * il, x2 = bflo(aw.y) - o[blk][4 * g + 2] * il, x3 = bfhi(aw.y) - o[blk][4 * g + 3] * il;
            o[blk][4 * g] = x0; o[blk][4 * g + 1] = x1; o[blk][4 * g + 2] = x2; o[blk][4 * g + 3] = x3; ss += (x0 * x0 + x1 * x1) + (x2 * x2 + x3 * x3); }
    ss += __shfl_xor(ss, 32);
    const float rn = (1.0f - LAMBDA_INIT) / sqrtf(ss * (1.0f / 128.0f) + RMS_EPS);
    const float* sub = a.in[I1_SUBLN];
#pragma unroll
    for (int blk = 0; blk < 4; ++blk)
#pragma unroll
        for (int g = 0; g < 4; ++g) { const int d0 = 32 * blk + 8 * g + 4 * h; const f32x4 sg = *(const f32x4*)(sub + d0);
            u32x2 w; w.x = cvtpk(o[blk][4 * g] * rn * sg[0], o[blk][4 * g + 1] * rn * sg[1]); w.y = cvtpk(o[blk][4 * g + 2] * rn * sg[2], o[blk][4 * g + 3] * rn * sg[3]);
            *(u32x2*)(dst + d0) = w; }
}

constexpr int NPHASES = 18;
constexpr int LDS_BYTES = 147456;
struct GOp { int kind; pg8::Gemm g; bf16_t* O; int ldc, o_bs, ai_extra; float scale; int q_tiles, rope_from; };

DI bool get_gemm(int ph, int sub, const Args& a, GOp& op) {
    unsigned char* ws = a.ws;
    bf16_t* R2 = (bf16_t*)(ws + WS_R2); bf16_t* R3 = (bf16_t*)(ws + WS_R3);
    op.kind = 0; op.o_bs = 0; op.ai_extra = 0; op.scale = 1.0f; op.q_tiles = 0; op.rope_from = 0;
    pg8::Gemm& g = op.g; g.nB = 1; g.a_bs = 0; g.b_bs = 0; g.rot = 0; g.a_seg = 0; g.b_seg = 0; g.skipctx = 0;
#define SETK(k_) do { g.K = (k_); g.kseg = (k_) / 64; g.a_seg = (k_); g.b_seg = (k_); } while (0)
    switch (ph * 8 + sub) {
    case 2 * 8 + 0:
        g.A = R2; g.a_rs = 1024; g.nM = NRT; g.Bt = (const bf16_t*)(ws + W_IN0); g.b_rs = 1024; g.nN = 5; SETK(1024); op.O = R3; op.ldc = 1280; return true;
    case 3 * 8 + 0:
        g.A = (const bf16_t*)(ws + W_DC); g.a_rs = 128; g.nM = 1; g.Bt = R3; g.b_rs = 1280; g.nN = NRT; g.nB = 4; g.b_bs = 128; SETK(128);
        op.O = R2; op.ldc = ROWS; op.o_bs = 128 * ROWS; op.ai_extra = 384 * ROWS; return true;
    case 4 * 8 + 0:
        op.kind = 1; g.A = (const bf16_t*)(ws + WS_CQN); g.a_rs = 256; g.nM = NRT; g.Bt = (const bf16_t*)(ws + W_UQ); g.b_rs = 256; g.nN = 3; SETK(256);
        op.O = (bf16_t*)(ws + WS_Q); op.ldc = 768; op.scale = MLA_QSCALE; op.q_tiles = 3; op.rope_from = 2; return true;
    case 4 * 8 + 1:
        g.A = (const bf16_t*)(ws + WS_CKVN); g.a_rs = 256; g.nM = NRT; g.Bt = (const bf16_t*)(ws + W_KN); g.b_rs = 256; g.nN = 2; SETK(256); g.rot = 140;
        op.O = (bf16_t*)(ws + WS_KN); op.ldc = 512; return true;
    case 4 * 8 + 2:
        g.A = (const bf16_t*)(ws + W_V0); g.a_rs = 256; g.nM = 2; g.Bt = (const bf16_t*)(ws + WS_CKVN); g.b_rs = 256; g.nN = NRT; SETK(256); g.rot = 148;
        op.O = (bf16_t*)(ws + WS_VT0); op.ldc = ROWS; return true;
    case 4 * 8 + 3:
        g.A = (const bf16_t*)(ws + WS_DN); g.a_rs = 16384; g.nM = 16; g.Bt = R2 + CTX; g.b_rs = ROWS; g.nN = 2; g.nB = 4; g.b_bs = TPB; SETK(8192); g.rot = 152;
        op.O = R3 + (size_t)CTX * DM; op.ldc = DM; op.o_bs = TPB * DM; return true;
    case 4 * 8 + 4:
        g.A = (const bf16_t*)(ws + WS_DN) + 8192; g.a_rs = 16384; g.nM = 16; g.Bt = R2 + CTX + (size_t)512 * ROWS; g.b_rs = ROWS; g.nN = 2; g.nB = 4; g.b_bs = TPB; SETK(8192); g.rot = 24;
        op.O = (bf16_t*)(ws + WS_PS); op.ldc = 512; op.o_bs = 4096 * 512; return true;
    case 4 * 8 + 5:
        g.A = (const bf16_t*)(ws + W_D256); g.a_rs = 512; g.nM = 1; g.Bt = R2; g.b_rs = ROWS; g.nN = 2; g.nB = 4; g.b_bs = TPB; g.K = 512; g.kseg = 4; g.a_seg = 256; g.b_seg = 512 * ROWS; g.rot = 0;
        op.O = R3; op.ldc = DM; op.o_bs = TPB * DM; return true;
    case 6 * 8 + 0:
        g.A = R3; g.a_rs = 1024; g.nM = NRT; g.Bt = (const bf16_t*)(ws + W_OUT0); g.b_rs = 1024; g.nN = 4; SETK(1024); op.O = (bf16_t*)(ws + WS_Y0); op.ldc = DM; return true;
    case 8 * 8 + 0: case 15 * 8 + 0:
        op.kind = 3; g.A = R2; g.a_rs = 1024; g.nM = (ph == 8 ? NRT : 128); g.skipctx = (ph != 8); g.Bt = (const bf16_t*)(ws + (ph == 8 ? W_GU0 : W_GU1)); g.b_rs = 1024; g.nN = 22; SETK(1024); op.O = R3; op.ldc = FF; return true;
    case 9 * 8 + 0: case 16 * 8 + 0:
        g.A = R3; g.a_rs = FF; g.nM = (ph == 9 ? NRT : 128); g.skipctx = (ph != 9); g.Bt = (const bf16_t*)(ws + (ph == 9 ? W_D0 : W_D1)); g.b_rs = FF; g.nN = 4; SETK(FF); op.O = R2; op.ldc = DM; return true;
    case 11 * 8 + 0:
        op.kind = 2; g.A = R2; g.a_rs = 1024; g.nM = NRT; g.Bt = (const bf16_t*)(ws + W_QK1); g.b_rs = 1024; g.nN = 8; SETK(1024);
        op.O = R3; op.ldc = 2048; op.scale = DIFF_QSCALE; op.q_tiles = 4; op.rope_from = 0; return true;
    case 11 * 8 + 1:
        g.A = (const bf16_t*)(ws + W_V1); g.a_rs = 1024; g.nM = 4; g.Bt = R2; g.b_rs = 1024; g.nN = NRT; SETK(1024); g.rot = 32;
        op.O = (bf16_t*)(ws + WS_VT1); op.ldc = ROWS; return true;
    case 13 * 8 + 0:
        g.A = R2; g.a_rs = 1024; g.nM = 128; g.skipctx = 1; g.Bt = (const bf16_t*)(ws + W_OUT1); g.b_rs = 1024; g.nN = 4; SETK(1024); op.O = R3; op.ldc = DM; return true;
    default: return false;
    }
#undef SETK
}

DI bool get_rowpass(int ph, const Args& a, RowPass& P) {
    unsigned char* ws = a.ws; const float* MOD0 = (const float*)(ws + WS_MOD); const float* MOD1 = MOD0 + 5 * 6144;
    float* XC = (float*)(ws + WS_XC); bf16_t* R2 = (bf16_t*)(ws + WS_R2);
    switch (ph) {
    case 1:  P = RowPass{a.in[I_X], a.in[I_CTX], nullptr, nullptr, nullptr, MOD0, 0, nullptr, nullptr, MOD0, 1024, 0, R2, 0}; return true;
    case 7:  P = RowPass{a.in[I_X], a.in[I_CTX], a.out, XC, (const bf16_t*)(ws + WS_Y0), MOD0, 2048, a.in[I0_LN1G], a.in[I0_LN1B], MOD0, 4096, 3072, R2, 0}; return true;
    case 10: P = RowPass{a.out, XC, a.out, XC, R2, MOD0, 5120, a.in[I0_LN2G], a.in[I0_LN2B], MOD1, 1024, 0, R2, 0}; return true;
    case 14: P = RowPass{a.out, XC, a.out, XC, (const bf16_t*)(ws + WS_R3), MOD1, 2048, a.in[I1_LN1G], a.in[I1_LN1B], MOD1, 4096, 3072, R2, 1}; return true;
    case 17: P = RowPass{a.out, XC, a.out, XC, R2, MOD1, 5120, a.in[I1_LN2G], a.in[I1_LN2B], MOD1, 0, 0, nullptr, 1}; return true;
    default: return false;
    }
}

__global__ void __launch_bounds__(512, 2) fwd_kernel(Args a) {
    extern __shared__ __attribute__((aligned(16))) unsigned char lds_raw[];
    LAS unsigned char* lds = (LAS unsigned char*)lds_raw;
    const int G = gridDim.x;
    volatile LAS unsigned* bst = (volatile LAS unsigned*)(lds + LDS_BYTES - 64);
    if (threadIdx.x < 2) bst[threadIdx.x] = 0u;
    __syncthreads();
    XcdBarrier xbar = xcd_barrier_post((unsigned*)(a.ws + WS_BAR), bst);
    for (int ph = a.ph_lo; ph < a.ph_hi; ++ph) {
        const int tid = otid(), lane = tid & 63, wave = __builtin_amdgcn_readfirstlane(tid >> 6);
        const int gw = blockIdx.x * 8 + wave, NGW = G * 8;
#ifndef NO_PRO
        if (ph == 0) prologue(a, lds);
#endif
        RowPass P;
        if (get_rowpass(ph, a, P)) { for (int m = gw; m < ROWS; m += NGW) row_pass(P, m, lane); }
        if (ph == 3) { for (int m = gw; m < ROWS; m += NGW) p3_row(a, m, lane); }
#ifndef NO_MLA
        if (ph == 5) {
            mirror_items(a, gw, NGW, lane);
            for (int L = blockIdx.x; ; L += G) { int bh, qb; if (!attn_unit_map(L, 1024, bh, qb)) break; attn_mla_unit(a, lds, bh, qb); }
        }
#endif
#ifndef NO_DIFF
        if (ph == 12) {
            const float p1 = wave_sum(a.in[I1_LQ1][lane] * a.in[I1_LK1][lane]), p2 = wave_sum(a.in[I1_LQ2][lane] * a.in[I1_LK2][lane]);
            const float lam = expf(p1) - expf(p2) + LAMBDA_INIT;
            for (int L = blockIdx.x; L < 1024; L += G) { int bh, qb; attn_unit_map(L, 1024, bh, qb); attn_diff_unit(a, lds, bh, qb, lam); }
        }
#endif
#ifndef NO_GEMM
        for (int sub = 0; sub < 8; ++sub) {
            GOp op; if (!get_gemm(ph, sub, a, op)) break;
            pg8::StaticOrder S; S.init(op.g.nM, op.g.nN, op.g.nB, G, (int)blockIdx.x, op.g.rot, op.g.skipctx);
            if (op.kind == 0) { pg8::EpiStore E{op.O, op.ldc, op.o_bs, op.ai_extra, op.scale}; pg8::gemm_phase(lds, op.g, S, E); }
            else if (op.kind == 1) { pg8::EpiRope<8> E{op.O, op.ldc, op.scale, op.q_tiles, op.rope_from, (const f32x2*)(a.ws + WS_TAB8)}; pg8::gemm_phase(lds, op.g, S, E); }
            else if (op.kind == 2) { pg8::EpiRope<16> E{op.O, op.ldc, op.scale, op.q_tiles, op.rope_from, (const f32x2*)(a.ws + WS_TAB16)}; pg8::gemm_phase(lds, op.g, S, E); }
            else { pg8::EpiSwiglu E{op.O, op.ldc}; pg8::gemm_phase(lds, op.g, S, E); }
        }
#endif
        if (ph + 1 < a.ph_hi) { if (ph == a.ph_lo) { __threadfence(); cg::this_grid().sync(); } else xcd_barrier(xbar); }
    }
}

extern "C" void kernel_launch(void* const* d_in, const int* in_sizes, int n_in, void* d_out, int out_size, void* d_ws, size_t ws_size, hipStream_t stream) {
    static int grid = 0;
    if (grid == 0) {
        if (n_in != 35 || ws_size < WS_END) { fprintf(stderr, "kernel_launch: unexpected n_in %d / ws %zu (need %zu)\n", n_in, ws_size, (size_t)WS_END); grid = -1; return; }
        int dev = 0, cus = 0, per_cu = 0;
        hipGetDevice(&dev); hipDeviceGetAttribute(&cus, hipDeviceAttributeMultiprocessorCount, dev);
        hipFuncSetAttribute((const void*)fwd_kernel, hipFuncAttributeMaxDynamicSharedMemorySize, LDS_BYTES);
        hipOccupancyMaxActiveBlocksPerMultiprocessor(&per_cu, (const void*)fwd_kernel, 512, LDS_BYTES);
        if (per_cu < 1) { fprintf(stderr, "kernel_launch: occupancy query says %d blocks/CU\n", per_cu); per_cu = 1; }
        (void)hipGetLastError();
        grid = cus * 1;
    }
    if (grid < 0) return;
    Args a{};
    for (int i = 0; i < 35; ++i) a.in[i] = (const float*)d_in[i];
    a.out = (float*)d_out; a.ws = (unsigned char*)d_ws;
#if MK_MULTI
    for (int ph = 0; ph < NPHASES; ++ph) { a.ph_lo = ph; a.ph_hi = ph + 1; hipLaunchKernelGGL(fwd_kernel, dim3(grid), dim3(512), LDS_BYTES, stream, a); }
#else
    a.ph_lo = 0; a.ph_hi = NPHASES;
    hipMemsetAsync((char*)d_ws + WS_BAR, 0, 16384, stream);
    void* args[] = {&a};
    hipError_t e = hipLaunchCooperativeKernel((const void*)fwd_kernel, dim3(grid), dim3(512), args, LDS_BYTES, stream);
    if (e != hipSuccess) fprintf(stderr, "cooperative launch failed: %s (grid %d)\n", hipGetErrorString(e), grid);
#endif
}
```

```cpp
#include <hip/hip_runtime.h>
#include <hip/hip_cooperative_groups.h>
#include <cstdio>
#include <cstdint>
namespace cg = cooperative_groups;

#ifndef MK_MULTI
#define MK_MULTI 0
#endif

#define DI __device__ __forceinline__
#define LAS __attribute__((address_space(3)))
typedef unsigned short bf16_t;
typedef short bf16x8 __attribute__((ext_vector_type(8)));
typedef float f32x4 __attribute__((ext_vector_type(4)));
typedef float f32x2 __attribute__((ext_vector_type(2)));
typedef float f32x16 __attribute__((ext_vector_type(16)));
typedef unsigned u32x4 __attribute__((ext_vector_type(4)));
typedef unsigned u32x2 __attribute__((ext_vector_type(2)));
typedef __bf16 bf16x2_t __attribute__((ext_vector_type(2)));

constexpr int DM = 1024, NB = 4, SEQ = 8192, CTX = 256, TPB = SEQ + CTX  , ROWS = NB * TPB  , FF = 2816;
constexpr int NRT = ROWS / 256;
constexpr float LN_EPS = 1e-6f, RMS_EPS = 1e-6f;
constexpr float DN_ALPHA = 1.41421356237f;
constexpr float LOG2E = 1.4426950408889634f;
constexpr float MLA_QSCALE = 0.10206207261596577f * LOG2E;
constexpr float DIFF_QSCALE = 0.125f * LOG2E;
constexpr float LAMBDA_INIT = 0.35550906f;

constexpr size_t MiB = 1u << 20;
constexpr size_t WS_MOD = 0;
constexpr size_t WS_TAB16 = 256 * 1024;
constexpr size_t WS_TAB8 = WS_TAB16 + 16384;
constexpr size_t WS_BAR = 512 * 1024;
constexpr size_t WS_XC = 1 * MiB;
constexpr size_t WS_W = 5 * MiB;
constexpr size_t W_IN0 = WS_W;
constexpr size_t W_UQ = W_IN0 + 1280 * 1024 * 2;
constexpr size_t W_KN = W_UQ + 768 * 256 * 2;
constexpr size_t W_V0 = W_KN + 512 * 256 * 2;
constexpr size_t W_OUT0 = W_V0 + 512 * 256 * 2;
constexpr size_t W_GU0 = W_OUT0 + 1024 * 1024 * 2;
constexpr size_t W_D0 = W_GU0 + 5632 * 1024 * 2;
constexpr size_t W_QK1 = W_D0 + 1024 * 2816 * 2;
constexpr size_t W_V1 = W_QK1 + 2048 * 1024 * 2;
constexpr size_t W_OUT1 = W_V1 + 1024 * 1024 * 2;
constexpr size_t W_GU1 = W_OUT1 + 1024 * 1024 * 2;
constexpr size_t W_D1 = W_GU1 + 5632 * 1024 * 2;
constexpr size_t W_DC = W_D1 + 1024 * 2816 * 2;
constexpr size_t W_D256 = W_DC + 256 * 128 * 2;
constexpr size_t W_END = W_D256 + 256 * 512 * 2;
static_assert(W_END <= 56 * MiB, "weights region");
constexpr size_t WS_DN = 56 * MiB;
constexpr size_t WS_R2 = 184 * MiB;
constexpr size_t WS_R3 = 250 * MiB;
constexpr size_t WS_R4 = WS_R3 + (size_t)ROWS * 1280 * 2;
constexpr size_t WS_CQN = WS_R4, WS_CKVN = WS_R4 + (size_t)ROWS * 256 * 2;
constexpr size_t WS_R5 = WS_R4 + (size_t)ROWS * 512 * 2;
constexpr size_t WS_Q = WS_R5;
constexpr size_t WS_KN = WS_Q + (size_t)ROWS * 768 * 2;
constexpr size_t WS_KR = WS_KN + (size_t)ROWS * 512 * 2;
constexpr size_t WS_VT0 = WS_KR + (size_t)ROWS * 32 * 2;
constexpr size_t WS_END = WS_VT0 + (size_t)512 * ROWS * 2;
constexpr size_t WS_Y0 = WS_R5;
constexpr size_t WS_PS = WS_R3 + (size_t)ROWS * DM * 2;
static_assert(WS_PS + (size_t)4 * 4096 * 512 * 2 <= WS_R4, "ps");
constexpr size_t WS_VT1 = WS_R3 + (size_t)ROWS * 2048 * 2;
static_assert(WS_END <= 512 * MiB, "workspace");
static_assert(WS_VT1 + (size_t)1024 * ROWS * 2 <= WS_END, "vt1");
static_assert(WS_R3 + (size_t)ROWS * FF * 2 <= WS_END, "hid");

DI int otid() { int t = threadIdx.x; asm volatile("" : "+v"(t)); return t; }
DI float wave_sum(float v) {
#pragma unroll
    for (int o = 1; o < 64; o <<= 1) v += __shfl_xor(v, o);
    return v;
}
DI unsigned cvtpk(float lo, float hi) { f32x2 v = {lo, hi}; bf16x2_t b = __builtin_convertvector(v, bf16x2_t); return __builtin_bit_cast(unsigned, b); }
DI float bf2f(unsigned short b) { return __uint_as_float(((unsigned)b) << 16); }
DI float bflo(unsigned w) { return __uint_as_float(w << 16); }
DI float bfhi(unsigned w) { return __uint_as_float(w & 0xffff0000u); }

namespace pg8 {
constexpr int BM = 256, BK = 64, HALF = 128, HTB = HALF * BK * 2, STAGE_BYTES = 8 * HTB, NXCD = 8, WGM = 8;
__host__ __device__ __forceinline__ int lds_byte(int r, int c) { const int st = (r >> 4) * 2 + (c >> 5), rr = r & 15, cc = c & 31, ob = rr * 64 + cc * 2; return st * 1024 + (ob ^ (((ob >> 9) & 1) << 5)); }
__host__ __device__ __forceinline__ void stage_rc(int b, int& R, int& C) { const int st = b / 1024, sb = b % 1024, swz = sb ^ (((sb >> 9) & 1) << 5); R = (st >> 1) * 16 + swz / 64; C = (st & 1) * 32 + (swz % 64) / 2; }
__host__ __device__ __forceinline__ int perm32(int rho) { const int n = rho >> 4, i = rho & 15; return 8 * (i >> 2) + 4 * n + (i & 3); }

struct Unit { int pm, pn, pb; };
struct Gemm {
    const bf16_t* A; const bf16_t* Bt; int nM, nN, nB, K, kseg;
    int a_rs, b_rs, a_seg, b_seg, a_bs, b_bs;
    int rot, skipctx;
};
struct StaticOrder {
    int nM, nN, nwg, tot, G, c, skipctx;
    DI void init(int nM_, int nN_, int nB_, int G_, int c_, int rot, int skip) { skipctx = skip; nM = nM_; nN = nN_; nwg = nM * nN; tot = nwg * nB_; G = G_; c = (c_ + G_ - (rot % G_)) % G_; }
    DI bool next(int i, Unit& u) const {
        const long L = (long)i * G + c; if (L >= tot) return false;
        u.pb = (int)(L / nwg); int wgid = (int)(L % nwg);
        { const int q = nwg / NXCD, r = nwg % NXCD, xcd = wgid % NXCD, off = wgid / NXCD; wgid = (xcd < r ? xcd * (q + 1) : r * (q + 1) + (xcd - r) * q) + off; }
        const int nig = WGM * nN, gid = wgid / nig, fm = gid * WGM, gsz = (nM - fm) < WGM ? (nM - fm) : WGM;
        u.pm = fm + ((wgid % nig) % gsz); u.pn = (wgid % nig) / gsz; if (skipctx) u.pm += (u.pm >> 5) + 1; return true;
    }
};

struct EpiStore {
    static constexpr bool PERM = true;
    bf16_t* O; int ldc, o_bs, ai_extra; float scale;
    DI void operator()(const f32x4 (&acc)[2][2][4][2], const Unit& u, int wr, int wc, int fr, int fq) const {
        const int row0 = u.pm * BM + wr * 64 + fr, col0 = u.pn * BM + wc * 32 + 8 * fq;
        bf16_t* base = O + (size_t)u.pb * o_bs;
#pragma unroll
        for (int ai = 0; ai < 2; ++ai)
#pragma unroll
            for (int m = 0; m < 4; ++m) { bf16_t* rowp = base + (size_t)(row0 + ai * HALF + m * 16) * ldc + (size_t)ai * ai_extra + col0;
#pragma unroll
                for (int bj = 0; bj < 2; ++bj) { const f32x4 v0 = acc[ai][bj][m][0] * scale, v1 = acc[ai][bj][m][1] * scale;
                    u32x4 w; w.x = cvtpk(v0[0], v0[1]); w.y = cvtpk(v0[2], v0[3]); w.z = cvtpk(v1[0], v1[1]); w.w = cvtpk(v1[2], v1[3]);
                    *(u32x4*)(rowp + bj * HALF) = w; } }
    }
};
struct EpiSwiglu {
    static constexpr bool PERM = true;
    bf16_t* O; int ldc;
    DI void operator()(const f32x4 (&acc)[2][2][4][2], const Unit& u, int wr, int wc, int fr, int fq) const {
        const int row0 = u.pm * BM + wr * 64 + fr, col0 = u.pn * HALF + wc * 32 + 8 * fq;
#pragma unroll
        for (int ai = 0; ai < 2; ++ai)
#pragma unroll
            for (int m = 0; m < 4; ++m) { bf16_t* rowp = O + (size_t)(row0 + ai * HALF + m * 16) * ldc + col0; float h[8];
#pragma unroll
                for (int n = 0; n < 2; ++n)
#pragma unroll
                    for (int i = 0; i < 4; ++i) { const float g = acc[ai][0][m][n][i], up = acc[ai][1][m][n][i];
                        h[n * 4 + i] = g * __builtin_amdgcn_rcpf(1.0f + __builtin_amdgcn_exp2f(-g * LOG2E)) * up; }
                u32x4 w; w.x = cvtpk(h[0], h[1]); w.y = cvtpk(h[2], h[3]); w.z = cvtpk(h[4], h[5]); w.w = cvtpk(h[6], h[7]);
                *(u32x4*)rowp = w; }
    }
};
template <int MODE> struct EpiRope {
    static constexpr bool PERM = false;
    bf16_t* O; int ldc; float qscale; int q_tiles, rope_from; const f32x2* tab;
    DI void operator()(const f32x4 (&acc)[2][2][4][2], const Unit& u, int wr, int wc, int fr, int fq) const {
        const float sc = u.pn < q_tiles ? qscale : 1.0f; const bool rope_tile = u.pn >= rope_from;
        const int col0 = u.pn * BM + wc * 32 + 4 * fq;
#pragma unroll
        for (int ai = 0; ai < 2; ++ai)
#pragma unroll
            for (int m = 0; m < 4; ++m) {
                const int row = u.pm * BM + ai * HALF + wr * 64 + m * 16 + fr; const int j = row % TPB; const int t = j - CTX;
                f32x4 cs0 = {1.f, 0.f, 1.f, 0.f}, cs1 = {1.f, 0.f, 1.f, 0.f};
                if (rope_tile && t >= 0) {
                    int pos, f0;
                    if (MODE == 16) { pos = (wc & 1) ? (t & 63) : (t >> 6); f0 = 4 * fq; } else { pos = (fq >> 1) ? (t & 63) : (t >> 6); f0 = 4 * (fq & 1); }
                    const f32x4* tp = (const f32x4*)(tab + pos * MODE + f0); cs0 = tp[0]; cs1 = tp[1];
                }
                const float c[4] = {cs0[0], cs0[2], cs1[0], cs1[2]}, s[4] = {cs0[1], cs0[3], cs1[1], cs1[3]};
                bf16_t* rowp = O + (size_t)row * ldc + col0;
#pragma unroll
                for (int bj = 0; bj < 2; ++bj) { const f32x4 x1 = acc[ai][bj][m][0] * sc, x2 = acc[ai][bj][m][1] * sc; float o1[4], o2[4];
#pragma unroll
                    for (int i = 0; i < 4; ++i) { o1[i] = x1[i] * c[i] - x2[i] * s[i]; o2[i] = x1[i] * s[i] + x2[i] * c[i]; }
                    u32x2 w1, w2; w1.x = cvtpk(o1[0], o1[1]); w1.y = cvtpk(o1[2], o1[3]); w2.x = cvtpk(o2[0], o2[1]); w2.y = cvtpk(o2[2], o2[3]);
                    *(u32x2*)(rowp + bj * HALF) = w1; *(u32x2*)(rowp + bj * HALF + 16) = w2; }
            }
    }
};

template <class Epi>
DI void gemm_phase(LAS unsigned char* lds, const Gemm g, const StaticOrder& S, const Epi& E) {
    const int tid = otid(), wid = __builtin_amdgcn_readfirstlane(tid >> 6), lane = tid & 63, wr = wid >> 2, wc = wid & 3, fr = lane & 15, fq = lane >> 4;
    const int nt = g.K / BK, kseg = g.kseg;
    unsigned voffA[2], voffB[2];
#pragma unroll
    for (int i = 0; i < 2; ++i) { int R, C; stage_rc(tid * 16 + i * 8192, R, C); const int Rb = Epi::PERM ? ((R & ~31) + perm32(R & 31)) : R;
        voffA[i] = (unsigned)(R * g.a_rs + C) * 2u; voffB[i] = (unsigned)(Rb * g.b_rs + C) * 2u; }
    const int kstep = BK * 2;
    const unsigned hstepA = (unsigned)HALF * g.a_rs * 2, hstepB = (unsigned)HALF * g.b_rs * 2;
    const unsigned tstepA = 2 * hstepA, tstepB = 2 * hstepB;
    const int segA = (g.a_seg - kseg * BK) * 2, segB = (g.b_seg - kseg * BK) * 2;
#define OFFA(t) ((t) * kstep + ((t) >= kseg ? segA : 0))
#define OFFB(t) ((t) * kstep + ((t) >= kseg ? segB : 0))
    const unsigned ldsw = (unsigned)wid * 1024u;
    const int aoff = lds_byte(wr * 64 + fr, fq * 8), boff = lds_byte(wc * 32 + fr, fq * 8);
#define PG8_SA(b, h) (((b) * 2 + (h)) * HTB)
#define PG8_SB(b, h) ((4 + (b) * 2 + (h)) * HTB)
#define PG8_STAGE(bufoff, gbase, voff) do { _Pragma("unroll") for (int _i = 0; _i < 2; ++_i) \
        __builtin_amdgcn_global_load_lds((const unsigned*)((const char*)(gbase) + (voff)[_i]), (LAS unsigned*)(lds + (bufoff) + ldsw + _i * 8192), 16, 0, 0); } while (0)
#define PG8_LDA(dst, b, h) do { _Pragma("unroll") for (int m = 0; m < 4; ++m) _Pragma("unroll") for (int k = 0; k < 2; ++k) dst[m][k] = *(const LAS bf16x8*)(lds + PG8_SA(b, h) + aoff + m * 2048 + k * 1024); } while (0)
#define PG8_LDB(dst, b, h) do { _Pragma("unroll") for (int n = 0; n < 2; ++n) _Pragma("unroll") for (int k = 0; k < 2; ++k) dst[n][k] = *(const LAS bf16x8*)(lds + PG8_SB(b, h) + boff + n * 2048 + k * 1024); } while (0)
#define PG8_MMA(ai, bj, At, Bt) do { __builtin_amdgcn_s_setprio(1); _Pragma("unroll") for (int m = 0; m < 4; ++m) _Pragma("unroll") for (int n = 0; n < 2; ++n) _Pragma("unroll") for (int k = 0; k < 2; ++k) \
        acc[ai][bj][m][n] = __builtin_amdgcn_mfma_f32_16x16x32_bf16(Bt[n][k], At[m][k], acc[ai][bj][m][n], 0, 0, 0); __builtin_amdgcn_s_setprio(0); } while (0)
#define PG8_WAIT_V(n) asm volatile("s_waitcnt vmcnt(" #n ")" ::: "memory")
#define PG8_WAIT_L(n) asm volatile("s_waitcnt lgkmcnt(" #n ")" ::: "memory")
#define PG8_BAR __builtin_amdgcn_s_barrier()
#define PG8_SCHED __builtin_amdgcn_sched_barrier(0)
    Unit cur, nxt; int ui = 0;
    if (!S.next(0, cur)) return;
    f32x4 acc[2][2][4][2];
#pragma unroll
    for (int a = 0; a < 2; ++a)
#pragma unroll
        for (int b = 0; b < 2; ++b)
#pragma unroll
            for (int m = 0; m < 4; ++m)
#pragma unroll
                for (int n = 0; n < 2; ++n) acc[a][b][m][n] = (f32x4){0.f, 0.f, 0.f, 0.f};
    bf16x8 At[4][2], B0[2][2], B1[2][2];
    const char* cA = (const char*)g.A + ((size_t)cur.pb * g.a_bs) * 2 + (size_t)cur.pm * tstepA;
    const char* cB = (const char*)g.Bt + ((size_t)cur.pb * g.b_bs) * 2 + (size_t)cur.pn * tstepB;
    {
        PG8_STAGE(PG8_SB(0, 0), cB, voffB); PG8_STAGE(PG8_SB(0, 1), cB + hstepB, voffB); PG8_STAGE(PG8_SA(0, 0), cA, voffA); PG8_STAGE(PG8_SA(0, 1), cA + hstepA, voffA);
        if (wr == 1) PG8_BAR;
        PG8_WAIT_V(2); PG8_BAR;
        PG8_STAGE(PG8_SB(1, 0), cB + OFFB(1), voffB); PG8_STAGE(PG8_SA(1, 0), cA + OFFA(1), voffA); PG8_STAGE(PG8_SB(1, 1), cB + hstepB + OFFB(1), voffB);
        PG8_WAIT_V(6); PG8_BAR;
    }
    for (;;) {
        const bool has_next = S.next(ui + 1, nxt);
        const char* nA = has_next ? (const char*)g.A + ((size_t)nxt.pb * g.a_bs) * 2 + (size_t)nxt.pm * tstepA : cA;
        const char* nB = has_next ? (const char*)g.Bt + ((size_t)nxt.pb * g.b_bs) * 2 + (size_t)nxt.pn * tstepB : cB;
        for (int t = 0; t < nt; t += 2) {
            const bool last = (t == nt - 2);
            const char* a1 = cA + OFFA(t + 1);
            const char* a2 = last ? nA : cA + OFFA(t + 2); const char* b2 = last ? nB : cB + OFFB(t + 2);
            const char* a3 = last ? nA + OFFA(1) : cA + OFFA(t + 3); const char* b3 = last ? nB + OFFB(1) : cB + OFFB(t + 3);
            PG8_LDB(B0, 0, 0); PG8_LDB(B1, 0, 1); PG8_SCHED; PG8_LDA(At, 0, 0); PG8_STAGE(PG8_SA(1, 1), a1 + hstepA, voffA);
            PG8_WAIT_V(8); PG8_WAIT_L(0); PG8_BAR; PG8_MMA(0, 0, At, B0); PG8_MMA(0, 1, At, B1); PG8_BAR; PG8_SCHED;
            PG8_LDA(At, 0, 1); PG8_STAGE(PG8_SB(0, 0), b2, voffB); PG8_STAGE(PG8_SB(0, 1), b2 + hstepB, voffB); PG8_STAGE(PG8_SA(0, 0), a2, voffA);
            PG8_WAIT_V(8); PG8_WAIT_L(0); PG8_BAR; PG8_MMA(1, 0, At, B0); PG8_MMA(1, 1, At, B1); PG8_BAR; PG8_SCHED;
            PG8_LDB(B0, 1, 0); PG8_LDB(B1, 1, 1); PG8_SCHED; PG8_LDA(At, 1, 0); PG8_STAGE(PG8_SA(0, 1), a2 + hstepA, voffA);
            PG8_WAIT_V(8); PG8_WAIT_L(0); PG8_BAR; PG8_MMA(0, 0, At, B0); PG8_MMA(0, 1, At, B1); PG8_BAR; PG8_SCHED;
            PG8_LDA(At, 1, 1); PG8_STAGE(PG8_SB(1, 0), b3, voffB); PG8_STAGE(PG8_SB(1, 1), b3 + hstepB, voffB); PG8_STAGE(PG8_SA(1, 0), a3, voffA);
            PG8_WAIT_V(8); PG8_WAIT_L(0); PG8_BAR; PG8_MMA(1, 0, At, B0); PG8_MMA(1, 1, At, B1); PG8_BAR; PG8_SCHED;
        }
        if (wr == 0) PG8_BAR;
        E(acc, cur, wr, wc, fr, fq);
        if (!has_next) break;
#pragma unroll
        for (int a = 0; a < 2; ++a)
#pragma unroll
            for (int b = 0; b < 2; ++b)
#pragma unroll
                for (int m = 0; m < 4; ++m)
#pragma unroll
                    for (int n = 0; n < 2; ++n) acc[a][b][m][n] = (f32x4){0.f, 0.f, 0.f, 0.f};
        cur = nxt; cA = nA; cB = nB; ++ui;
        if (wr == 1) PG8_BAR;
    }
    PG8_WAIT_V(0);
    PG8_BAR;
#undef OFFA
#undef OFFB
#undef PG8_SA
#undef PG8_SB
#undef PG8_STAGE
#undef PG8_LDA
#undef PG8_LDB
#undef PG8_MMA
#undef PG8_WAIT_V
#undef PG8_WAIT_L
#undef PG8_BAR
#undef PG8_SCHED
}
}

#define MFMA32(a, b, c) __builtin_amdgcn_mfma_f32_32x32x16_bf16((a), (b), (c), 0, 0, 0)
template <int D1, int D2, int DV>
DI void attn_core(f32x16 (&o)[DV / 32], float& l_out, LAS unsigned char* lds, const bf16_t* q1, const bf16_t* q2,
                  const bf16_t* k1, long ldk1, const bf16_t* k2, long ldk2, const bf16_t* vt, long ldv, int ntiles) {
    constexpr int DQK = D1 + D2, KROW = DQK * 2 + 16, VROW = 144, KT = 64 * KROW, VT = DV * VROW, BUF = KT + VT;
    constexpr int KCH = DQK / 8, NKC = 64 * KCH, NVC = DV * 8, KPT = (NKC + 511) / 512, VPT = NVC / 512;
    const int tid = otid(), lane = tid & 63, r = lane & 31, h = lane >> 5;
    bf16x8 qf[DQK / 16];
#pragma unroll
    for (int d0 = 0; d0 < DQK / 16; ++d0) qf[d0] = (16 * d0 < D1) ? *(const bf16x8*)(q1 + 16 * d0 + 8 * h) : *(const bf16x8*)(q2 + (16 * d0 - D1) + 8 * h);
    u32x4 kreg[KPT], vreg[VPT];
    auto gload = [&](int t) {
#pragma unroll
        for (int i = 0; i < KPT; ++i) { const int c = tid + i * 512; if (c < NKC) { const int row = c / KCH, cc = (c % KCH) * 8;
            kreg[i] = (cc < D1) ? *(const u32x4*)(k1 + (size_t)(t * 64 + row) * ldk1 + cc) : *(const u32x4*)(k2 + (size_t)(t * 64 + row) * ldk2 + (cc - D1)); } }
#pragma unroll
        for (int i = 0; i < VPT; ++i) { const int c = tid + i * 512; const int d = c >> 3, cc = (c & 7) * 8; vreg[i] = *(const u32x4*)(vt + (size_t)d * ldv + t * 64 + cc); }
    };
    auto sstore = [&](int b) {
        LAS unsigned char* kb = lds + b * BUF; LAS unsigned char* vb = kb + KT;
#pragma unroll
        for (int i = 0; i < KPT; ++i) { const int c = tid + i * 512; if (c < NKC) { const int row = c / KCH, cc = (c % KCH) * 8; *(LAS u32x4*)(kb + row * KROW + cc * 2) = kreg[i]; } }
#pragma unroll
        for (int i = 0; i < VPT; ++i) { const int c = tid + i * 512; const int d = c >> 3, cc = (c & 7) * 8; *(LAS u32x4*)(vb + d * VROW + cc * 2) = vreg[i]; }
    };
    const int pr = (r & ~12) | ((r & 4) << 1) | ((r & 8) >> 1);
    float mrun = 0.f, lrun = 0.f;
    f32x16 negm;
#pragma unroll
    for (int i = 0; i < 16; ++i) negm[i] = 0.f;
#pragma unroll
    for (int b = 0; b < DV / 32; ++b)
#pragma unroll
        for (int i = 0; i < 16; ++i) o[b][i] = 0.f;
    gload(0); sstore(0); if (ntiles > 1) { gload(1); sstore(1); } __syncthreads();
    for (int t = 0; t < ntiles; ++t) {
        if (t + 2 < ntiles) gload(t + 2);
        const LAS unsigned char* kb = lds + (t & 3) * BUF; const LAS unsigned char* vb = kb + KT;
        f32x16 p[2];
        {
            bf16x8 kf[2][DQK / 16];
#pragma unroll
            for (int hf = 0; hf < 2; ++hf)
#pragma unroll
                for (int d0 = 0; d0 < DQK / 16; ++d0) kf[hf][d0] = *(const LAS bf16x8*)(kb + (32 * hf + pr) * KROW + (16 * d0 + 8 * h) * 2);
            __builtin_amdgcn_sched_barrier(0);
            __builtin_amdgcn_s_setprio(1);
#pragma unroll
            for (int d0 = 0; d0 < DQK / 16; ++d0)
#pragma unroll
                for (int hf = 0; hf < 2; ++hf) p[hf] = MFMA32(kf[hf][d0], qf[d0], d0 == 0 ? negm : p[hf]);
            __builtin_amdgcn_sched_barrier(0);
        }
        constexpr int NBLK = DV / 32;
        bf16x8 vk[2][NBLK];
#define LDVK(buf, ks) do { _Pragma("unroll") for (int b_ = 0; b_ < NBLK; ++b_) vk[buf][b_] = *(const LAS bf16x8*)(vb + (32 * b_ + r) * VROW + (16 * (ks) + 8 * h) * 2); } while (0)
        LDVK(0, 0);
        __builtin_amdgcn_sched_barrier(0);
        float ta = fmaxf(fmaxf(p[0][0], p[0][1]), p[1][0]), tb = fmaxf(fmaxf(p[0][2], p[0][3]), p[1][1]);
        ta = fmaxf(fmaxf(ta, p[1][2]), p[1][3]);
#pragma unroll
        for (int i = 4; i < 16; i += 4) { ta = fmaxf(fmaxf(ta, p[0][i]), p[0][i + 1]); tb = fmaxf(fmaxf(tb, p[0][i + 2]), p[0][i + 3]); ta = fmaxf(fmaxf(ta, p[1][i]), p[1][i + 1]); tb = fmaxf(fmaxf(tb, p[1][i + 2]), p[1][i + 3]); }
        float tm = fmaxf(ta, tb); tm = fmaxf(tm, __shfl_xor(tm, 32));
        if (__any(t == 0 || tm > 8.0f)) {
            const float dl = (t == 0 || tm > 0.f) ? tm : 0.f; mrun += dl;
            const float alpha = __builtin_amdgcn_exp2f(-dl); lrun *= alpha;
#pragma unroll
            for (int i = 0; i < 16; ++i) { p[0][i] -= dl; p[1][i] -= dl; negm[i] = -mrun; }
#pragma unroll
            for (int b = 0; b < DV / 32; ++b)
#pragma unroll
                for (int i = 0; i < 16; ++i) o[b][i] *= alpha;
        }
        bf16x8 pf[4]; float rs = 0.f; u32x4 wq;
#define EXPPART(ks, j) do { const int hf_ = (ks) >> 1, s8_ = ((ks) & 1) * 8; const float e0_ = __builtin_amdgcn_exp2f(p[hf_][s8_ + 2 * (j)]), e1_ = __builtin_amdgcn_exp2f(p[hf_][s8_ + 2 * (j) + 1]); \
        rs += e0_; rs += e1_; wq[j] = cvtpk(e0_, e1_); } while (0)
        EXPPART(0, 0); EXPPART(0, 1); EXPPART(0, 2); EXPPART(0, 3); pf[0] = __builtin_bit_cast(bf16x8, wq);
        __builtin_amdgcn_sched_barrier(0);
#pragma unroll
        for (int ks = 0; ks < 4; ++ks) {
            if (ks < 3) LDVK((ks + 1) & 1, ks + 1);
            __builtin_amdgcn_sched_barrier(0);
#pragma unroll
            for (int b = 0; b < NBLK; ++b) {
                o[b] = MFMA32(vk[ks & 1][b], pf[ks], o[b]);
                if (ks < 3) {
#pragma unroll
                    for (int j = b * (4 / NBLK); j < (b + 1) * (4 / NBLK); ++j) {
                        if (ks == 0) EXPPART(1, j); else if (ks == 1) EXPPART(2, j); else EXPPART(3, j);
                    }
                }
                __builtin_amdgcn_sched_barrier(0);
            }
            if (ks < 3) pf[ks + 1] = __builtin_bit_cast(bf16x8, wq);
        }
        __builtin_amdgcn_s_setprio(0);
        lrun += rs;
#undef LDVK
#undef EXPPART
        if (t + 2 < ntiles) sstore((t + 2) & 3);
        if (t & 1) __syncthreads();
    }
    l_out = lrun + __shfl_xor(lrun, 32);
}
constexpr int ATTN_LDS = 2 * (64 * (96 * 2 + 16) + 128 * 144);


#define XB_TMO      128
#define XB_XCNT(j)  (256  + 64 * (j))
#define XB_XSUB(j)  (1280 + 64 * (j))
#define XB_XGEN(j)  (2304 + 64 * (j))
#define XB_TOP      3328
#define XB_TOPGEN   3392
#define XCD_BAR_WORDS 3456
#define XB_SPIN_CAP (1u << 18)
DI unsigned xb_ld(unsigned* p)              { return __hip_atomic_load(p, __ATOMIC_RELAXED, __HIP_MEMORY_SCOPE_AGENT); }
DI unsigned xb_add(unsigned* p, unsigned v) { return __hip_atomic_fetch_add(p, v, __ATOMIC_RELAXED, __HIP_MEMORY_SCOPE_AGENT); }
DI unsigned xb_xcc_id() { return (unsigned)__builtin_amdgcn_s_getreg((3 << 11) | 20) & 0xFu; }
#define XB_SPIN(cond, bar) do { unsigned _sp = 0; while (cond) { __builtin_amdgcn_s_sleep(1); \
    if ((++_sp & 255u) == 0u) { if (xb_ld(&(bar)[XB_TMO])) break; if (_sp > XB_SPIN_CAP) { atomicAdd(&(bar)[XB_TMO], 1u); break; } } } } while (0)
struct XcdBarrier { unsigned* bar; unsigned x; volatile LAS unsigned* st; };
DI XcdBarrier xcd_barrier_post(unsigned* bar, volatile LAS unsigned* st) {
    XcdBarrier b; b.bar = bar; b.x = xb_xcc_id(); b.st = st;
    if (threadIdx.x == 0) (void)xb_add(&bar[XB_XCNT(b.x)], 1u);
    return b;
}
DI void xcd_barrier_complete(unsigned* bar, unsigned x, unsigned& nloc, unsigned& nx) {
    const unsigned G = gridDim.x * gridDim.y * gridDim.z;
    unsigned sum, cnt, mine, sp = 0u;
    for (;;) {
        sum = 0u; cnt = 0u; mine = 0u;
#pragma unroll
        for (unsigned j = 0; j < 16; ++j) { const unsigned c = xb_ld(&bar[XB_XCNT(j)]); sum += c; cnt += (c > 0u) ? 1u : 0u; mine = (j == x) ? c : mine; }
        if (sum == G) break;
        __builtin_amdgcn_s_sleep(1);
        if ((++sp & 255u) == 0u) { if (xb_ld(&bar[XB_TMO])) break; if (sp > XB_SPIN_CAP) { atomicAdd(&bar[XB_TMO], 1u); break; } }
    }
    nloc = mine > 0u ? mine : 1u; nx = cnt > 0u ? cnt : 1u;
}
DI void xcd_barrier(const XcdBarrier& b) {
    asm volatile("s_waitcnt vmcnt(0)" ::: "memory");
    __syncthreads();
    if (threadIdx.x == 0) {
        unsigned* bar = b.bar;
        __builtin_amdgcn_s_waitcnt(0);
        unsigned nloc = b.st[0], nx = b.st[1];
        if (nloc == 0u) { xcd_barrier_complete(bar, b.x, nloc, nx); b.st[0] = nloc; b.st[1] = nx; }
        const unsigned old = xb_add(&bar[XB_XSUB(b.x)], 1u);
        const unsigned gen = old / nloc;
        if (old + 1u == (gen + 1u) * nloc) {
            __builtin_amdgcn_fence(__ATOMIC_RELEASE, "agent");
            asm volatile("s_waitcnt vmcnt(0)" ::: "memory");
            const unsigned og = xb_add(&bar[XB_TOP], 1u);
            const unsigned tg = og / nx;
            if (og + 1u == (tg + 1u) * nx) xb_add(&bar[XB_TOPGEN], 1u);
            else XB_SPIN(xb_ld(&bar[XB_TOPGEN]) == tg, bar);
            __builtin_amdgcn_fence(__ATOMIC_ACQUIRE, "agent");
            xb_add(&bar[XB_XGEN(b.x)], 1u);
            asm volatile("s_waitcnt vmcnt(0)" ::: "memory");
        } else {
            XB_SPIN(xb_ld(&bar[XB_XGEN(b.x)]) == gen, bar);
            __builtin_amdgcn_fence(__ATOMIC_ACQUIRE, "agent");
            asm volatile("s_waitcnt vmcnt(0)" ::: "memory");
        }
    }
    __syncthreads();
}

struct Args {
    const float* in[35]; float* out; unsigned char* ws; int ph_lo, ph_hi;
};
enum { I_X = 0, I_C, I_CTX, I_CCTX,
       I0_WMOD, I0_BMOD, I0_WIN, I0_QN, I0_WUQ, I0_KVN, I0_WUKV, I0_WOUT, I0_LN1G, I0_LN1B, I0_WG, I0_WU, I0_WD, I0_LN2G, I0_LN2B,
       I1_WMOD, I1_BMOD, I1_WIN, I1_LQ1, I1_LK1, I1_LQ2, I1_LK2, I1_SUBLN, I1_WOUT, I1_LN1G, I1_LN1B, I1_WG, I1_WU, I1_WD, I1_LN2G, I1_LN2B };

DI bf16_t* tr_dst(int job, int n, unsigned char* ws) {
    switch (job) {
    case 0: return (bf16_t*)(ws + W_IN0) + (size_t)n * 1024;
    case 1: { const int hd = n / 96, d = n % 96; int row; if (d < 64) row = hd * 64 + d; else { const int e = d - 64, t = e >> 3, f = e & 7; row = 512 + hd * 32 + 16 * (t & 1) + 8 * (t >> 1) + f; }
              return (bf16_t*)(ws + W_UQ) + (size_t)row * 256; }
    case 2: { const int hd = n >> 7, d = n & 127; return d < 64 ? (bf16_t*)(ws + W_KN) + (size_t)(hd * 64 + d) * 256 : (bf16_t*)(ws + W_V0) + (size_t)(hd * 64 + d - 64) * 256; }
    case 3: return (bf16_t*)(ws + W_OUT0) + (size_t)n * 1024;
    case 4: return (bf16_t*)(ws + W_GU0) + (size_t)(256 * (n >> 7) + (n & 127)) * 1024;
    case 5: return (bf16_t*)(ws + W_GU0) + (size_t)(256 * (n >> 7) + 128 + (n & 127)) * 1024;
    case 6: return (bf16_t*)(ws + W_D0) + (size_t)n * 2816;
    case 7: return n < 2048 ? (bf16_t*)(ws + W_QK1) + (size_t)n * 1024 : (bf16_t*)(ws + W_V1) + (size_t)(n - 2048) * 1024;
    case 8: return (bf16_t*)(ws + W_OUT1) + (size_t)n * 1024;
    case 9: return (bf16_t*)(ws + W_GU1) + (size_t)(256 * (n >> 7) + (n & 127)) * 1024;
    case 10: return (bf16_t*)(ws + W_GU1) + (size_t)(256 * (n >> 7) + 128 + (n & 127)) * 1024;
    default: return (bf16_t*)(ws + W_D1) + (size_t)n * 2816;
    }
}
DI void transpose_item(const float* W, int K, int N, int job, unsigned char* ws, LAS float* scr, int item, int lane) {
    const int nblk = N / 32, kb = item / nblk, nb = item % nblk, k0 = 64 * kb, n0 = 32 * nb;
#pragma unroll 8
    for (int i = 0; i < 32; ++i) { const int kk = 2 * i + (lane >> 5); scr[kk * 33 + (lane & 31)] = W[(size_t)(k0 + kk) * N + n0 + (lane & 31)]; }
    asm volatile("s_waitcnt lgkmcnt(0)" ::: "memory");
    const int c = lane & 7;
#pragma unroll
    for (int j = 0; j < 4; ++j) { const int n = (lane >> 3) + 8 * j; const LAS float* s = scr + (8 * c) * 33 + n;
        u32x4 o; o.x = cvtpk(s[0 * 33], s[1 * 33]); o.y = cvtpk(s[2 * 33], s[3 * 33]); o.z = cvtpk(s[4 * 33], s[5 * 33]); o.w = cvtpk(s[6 * 33], s[7 * 33]);
        bf16_t* dst = tr_dst(job, n0 + n, ws); *(u32x4*)(dst + k0 + 8 * c) = o; }
    asm volatile("s_waitcnt lgkmcnt(0)" ::: "memory");
}

DI void prologue(const Args& a, LAS unsigned char* lds) {
    unsigned char* ws = a.ws;
    const int tid = otid(), lane = tid & 63, wave = tid >> 6;
    const int G = gridDim.x, gw = blockIdx.x * 8 + wave, NGW = G * 8;
    const long gt = (long)blockIdx.x * 512 + tid, NGT = (long)G * 512;
    {
        LAS float* scr = (LAS float*)(lds + wave * 16384);
        const int jin[12] = {I0_WIN, I0_WUQ, I0_WUKV, I0_WOUT, I0_WG, I0_WU, I0_WD, I1_WIN, I1_WOUT, I1_WG, I1_WU, I1_WD};
        const int jK[12] = {1024, 256, 256, 1024, 1024, 1024, 2816, 1024, 1024, 1024, 1024, 2816};
        const int jN[12] = {1056, 768, 1024, 1024, 2816, 2816, 1024, 3072, 1024, 2816, 2816, 1024};
        int base = 0;
#pragma unroll
        for (int j = 0; j < 12; ++j) { const int items = (jK[j] / 64) * (jN[j] / 32);
            for (int it = gw; it < items; it += NGW) transpose_item(a.in[jin[j]], jK[j], jN[j], j, ws, scr, it, lane);
            base += items; }
        u32x4 z = {0u, 0u, 0u, 0u};
        for (long i = gt; i < (1280 - 1056) * 1024 / 8; i += NGT) ((u32x4*)((bf16_t*)(ws + W_IN0) + (size_t)1056 * 1024))[i] = z;
    }
    {
        const float sc = 0.011048543456039806f;
        for (long i = gt; i < (long)4096 * 2048; i += NGT) { const int k = (int)(i >> 11), c8 = (int)(i & 2047) * 8; const int part = c8 >> 13, n0 = c8 & 8191; float v[8];
#pragma unroll
            for (int e = 0; e < 8; ++e) { const float ph = (float)((k * (n0 + e)) & 8191) * (1.0f / 8192.0f); v[e] = (part ? __builtin_amdgcn_sinf(ph) : __builtin_amdgcn_cosf(ph)) * sc; }
            u32x4 o; o.x = cvtpk(v[0], v[1]); o.y = cvtpk(v[2], v[3]); o.z = cvtpk(v[4], v[5]); o.w = cvtpk(v[6], v[7]);
            *(u32x4*)((bf16_t*)(ws + WS_DN) + (size_t)k * 16384 + c8) = o; }
        for (long i = gt; i < 256 * 512; i += NGT) { const int k = (int)(i >> 9), c = (int)(i & 511), part = c >> 8, n = c & 255; const float ph = (float)((k * n) & 255) * (1.0f / 256.0f);
            const float v = (part ? __builtin_amdgcn_sinf(ph) : __builtin_amdgcn_cosf(ph)) * 0.0625f; ((bf16_t*)(ws + W_D256))[i] = (bf16_t)(cvtpk(v, 0.f) & 0xffffu); }
        for (long i = gt; i < 256 * 128; i += NGT) { const int rr = (int)(i >> 7), c = (int)(i & 127), part = rr >> 7, l = rr & 127; const float ph = (float)((l * c) & 127) * (1.0f / 128.0f);
            const float v = (part ? -__builtin_amdgcn_sinf(ph) : __builtin_amdgcn_cosf(ph)) * 0.08838834764831845f; ((bf16_t*)(ws + W_DC))[i] = (bf16_t)(cvtpk(v, 0.f) & 0xffffu); }
        for (long i = gt; i < 128 * 16; i += NGT) { const int pos = (int)(i >> 4), f = (int)(i & 15); const float inv = 1.0f / powf(10000.0f, (float)f / 16.0f); const float ang = (float)pos * inv;
            ((f32x2*)(ws + WS_TAB16))[i] = (f32x2){cosf(ang), sinf(ang)}; }
        for (long i = gt; i < 128 * 8; i += NGT) { const int pos = (int)(i >> 3), f = (int)(i & 7); const float inv = 1.0f / powf(10000.0f, (float)f / 8.0f); const float ang = (float)pos * inv;
            ((f32x2*)(ws + WS_TAB8))[i] = (f32x2){cosf(ang), sinf(ang)}; }
    }
    {
        LAS float* red = (LAS float*)lds;
        for (int it = blockIdx.x; it < 2 * 96; it += G) {
            __syncthreads();
            const int layer = it / 96, n = (it % 96) * 64 + lane; const float* w = a.in[layer ? I1_WMOD : I0_WMOD]; const float* bm = a.in[layer ? I1_BMOD : I0_BMOD];
            float acc[5] = {0.f, 0.f, 0.f, 0.f, 0.f};
            for (int kk = 0; kk < 128; ++kk) { const int k = wave * 128 + kk; const float wv = w[(size_t)k * 6144 + n];
#pragma unroll
                for (int cls = 0; cls < 5; ++cls) { const float cv = cls < 4 ? a.in[I_C][cls * 1024 + k] : a.in[I_CCTX][k]; const float sl = cv / (1.0f + __expf(-cv)); acc[cls] += sl * wv; } }
#pragma unroll
            for (int cls = 0; cls < 5; ++cls) red[(wave * 5 + cls) * 64 + lane] = acc[cls];
            __syncthreads();
            if (tid < 320) { const int cls = tid >> 6, l = tid & 63; float s = 0.f;
#pragma unroll
                for (int w8 = 0; w8 < 8; ++w8) s += red[(w8 * 5 + cls) * 64 + l];
                const int nn = (it % 96) * 64 + l; ((float*)(ws + WS_MOD))[(size_t)(layer * 5 + cls) * 6144 + nn] = s + bm[nn]; }
        }
        __syncthreads();
    }
}

struct RowPass {
    const float* xl; const float* xc;
    float* ol; float* oc;
    const bf16_t* Y;
    const float* mod;
    int gate_off; const float* lng; const float* lnb;
    const float* mod2; int sc_off, sh_off;
    bf16_t* H;
    int skipctx;
};
DI void ln_stats(const f32x4 (&v)[4], float& mean, float& rstd) {
    float s = 0.f;
#pragma unroll
    for (int j = 0; j < 4; ++j) s += (v[j][0] + v[j][1]) + (v[j][2] + v[j][3]);
    mean = wave_sum(s) * (1.0f / DM); float q = 0.f;
#pragma unroll
    for (int j = 0; j < 4; ++j) { const f32x4 d = v[j] - mean; q += (d[0] * d[0] + d[1] * d[1]) + (d[2] * d[2] + d[3] * d[3]); }
    rstd = 1.0f / sqrtf(wave_sum(q) * (1.0f / DM) + LN_EPS);
}
DI void row_pass(const RowPass& P, int m, int lane) {
    const int b = m / TPB, j = m % TPB; const bool isctx = j < CTX; const int cls = isctx ? 4 : b;
    if (P.skipctx && isctx) return;
    const size_t xoff = isctx ? (size_t)(b * CTX + j) * DM : (size_t)(b * SEQ + j - CTX) * DM;
    const float* xs = (isctx ? P.xc : P.xl) + xoff; float* xd = isctx ? P.oc : P.ol;
    f32x4 v[4];
#pragma unroll
    for (int jj = 0; jj < 4; ++jj) v[jj] = *(const f32x4*)(xs + 4 * lane + 256 * jj);
    if (P.Y) {
        const float* gate = P.mod + (size_t)cls * 6144 + P.gate_off;
#pragma unroll
        for (int jj = 0; jj < 4; ++jj) { const int c0 = 4 * lane + 256 * jj; const u32x2 yw = *(const u32x2*)(P.Y + (size_t)m * DM + c0); const f32x4 g = *(const f32x4*)(gate + c0);
            v[jj][0] = DN_ALPHA * v[jj][0] + g[0] * bflo(yw.x); v[jj][1] = DN_ALPHA * v[jj][1] + g[1] * bfhi(yw.x);
            v[jj][2] = DN_ALPHA * v[jj][2] + g[2] * bflo(yw.y); v[jj][3] = DN_ALPHA * v[jj][3] + g[3] * bfhi(yw.y); }
        float mean, rstd; ln_stats(v, mean, rstd);
#pragma unroll
        for (int jj = 0; jj < 4; ++jj) { const int c0 = 4 * lane + 256 * jj; const f32x4 g = *(const f32x4*)(P.lng + c0), bb = *(const f32x4*)(P.lnb + c0); v[jj] = (v[jj] - mean) * rstd * g + bb; }
        if (xd) {
#pragma unroll
            for (int jj = 0; jj < 4; ++jj) *(f32x4*)(xd + xoff + 4 * lane + 256 * jj) = v[jj];
        }
    }
    if (P.H) {
        float mean, rstd; ln_stats(v, mean, rstd);
        const float* sc = P.mod2 + (size_t)cls * 6144 + P.sc_off; const float* sh = P.mod2 + (size_t)cls * 6144 + P.sh_off;
#pragma unroll
        for (int jj = 0; jj < 4; ++jj) { const int c0 = 4 * lane + 256 * jj; const f32x4 s1 = *(const f32x4*)(sc + c0), s0 = *(const f32x4*)(sh + c0);
            const f32x4 hh = (v[jj] - mean) * rstd * (s1 + 1.0f) + s0; u32x2 w; w.x = cvtpk(hh[0], hh[1]); w.y = cvtpk(hh[2], hh[3]);
            *(u32x2*)(P.H + (size_t)m * DM + c0) = w; }
    }
}
DI void p3_row(const Args& a, int m, int lane) {
    unsigned char* ws = a.ws; const bf16_t* U = (const bf16_t*)(ws + WS_R3) + (size_t)m * 1280;
    const u32x2 qw = *(const u32x2*)(U + 512 + 4 * lane), kw = *(const u32x2*)(U + 768 + 4 * lane);
    float q[4] = {bflo(qw.x), bfhi(qw.x), bflo(qw.y), bfhi(qw.y)}, k[4] = {bflo(kw.x), bfhi(kw.x), bflo(kw.y), bfhi(kw.y)};
    const float qs = wave_sum(q[0] * q[0] + q[1] * q[1] + q[2] * q[2] + q[3] * q[3]), ks = wave_sum(k[0] * k[0] + k[1] * k[1] + k[2] * k[2] + k[3] * k[3]);
    const float qr = 1.0f / sqrtf(qs * (1.0f / 256.0f) + RMS_EPS), kr_ = 1.0f / sqrtf(ks * (1.0f / 256.0f) + RMS_EPS);
    const f32x4 qg = *(const f32x4*)(a.in[I0_QN] + 4 * lane), kg = *(const f32x4*)(a.in[I0_KVN] + 4 * lane);
    u32x2 w; w.x = cvtpk(q[0] * qr * qg[0], q[1] * qr * qg[1]); w.y = cvtpk(q[2] * qr * qg[2], q[3] * qr * qg[3]);
    *(u32x2*)((bf16_t*)(ws + WS_CQN) + (size_t)m * 256 + 4 * lane) = w;
    w.x = cvtpk(k[0] * kr_ * kg[0], k[1] * kr_ * kg[1]); w.y = cvtpk(k[2] * kr_ * kg[2], k[3] * kr_ * kg[3]);
    *(u32x2*)((bf16_t*)(ws + WS_CKVN) + (size_t)m * 256 + 4 * lane) = w;
    const int d = lane & 31, t = d >> 3, f = d & 7; const float val = bf2f(U[1024 + d]); const float par = __shfl_xor(val, 8);
    const int j = m % TPB, tt = j - CTX; float outv = val;
    if (tt >= 0) { const int pos = (t < 2) ? (tt >> 6) : (tt & 63); const f32x2 cs = ((const f32x2*)(ws + WS_TAB8))[pos * 8 + f];
        outv = (t & 1) ? (par * cs[1] + val * cs[0]) : (val * cs[0] - par * cs[1]); }
    if (lane < 32) ((bf16_t*)(ws + WS_KR))[(size_t)m * 32 + 16 * (t & 1) + 8 * (t >> 1) + f] = (bf16_t)(cvtpk(outv, 0.f) & 0xffffu);
}
DI void mirror_items(const Args& a, int gw, int NGW, int lane) {
    unsigned char* ws = a.ws; bf16_t* MIX = (bf16_t*)(ws + WS_R3); const bf16_t* At = (const bf16_t*)(ws + WS_R2);
    for (int it = gw; it < NB * 512; it += NGW) { const int b = it >> 9, ch = it & 511; const bf16_t* src = At + (size_t)ch * ROWS + b * TPB + CTX; float s = 0.f;
        for (int i = 0; i < 16; ++i) { const u32x4 w = *(const u32x4*)(src + (i * 64 + lane) * 8);
            s += (bflo(w.x) - bfhi(w.x)) + (bflo(w.y) - bfhi(w.y)) + (bflo(w.z) - bfhi(w.z)) + (bflo(w.w) - bfhi(w.w)); }
        s = wave_sum(s) * 0.011048543456039806f;
        if (lane == 0) MIX[(size_t)(b * TPB + CTX + 4096) * DM + ch] = (bf16_t)(cvtpk(s, 0.f) & 0xffffu); }
    const bf16_t* PS = (const bf16_t*)(ws + WS_PS);
    for (int it = gw; it < NB * 4096; it += NGW) { const int b = it >> 12, k = it & 4095;
        bf16_t* src = MIX + (size_t)(b * TPB + CTX + k) * DM + 8 * lane; const u32x4 pc = *(const u32x4*)src; const u32x4 ps = *(const u32x4*)(PS + ((size_t)(b * 4096 + k)) * 512 + 8 * lane);
        u32x4 sm, df;
        sm.x = cvtpk(bflo(pc.x) + bflo(ps.x), bfhi(pc.x) + bfhi(ps.x)); df.x = cvtpk(bflo(pc.x) - bflo(ps.x), bfhi(pc.x) - bfhi(ps.x));
        sm.y = cvtpk(bflo(pc.y) + bflo(ps.y), bfhi(pc.y) + bfhi(ps.y)); df.y = cvtpk(bflo(pc.y) - bflo(ps.y), bfhi(pc.y) - bfhi(ps.y));
        sm.z = cvtpk(bflo(pc.z) + bflo(ps.z), bfhi(pc.z) + bfhi(ps.z)); df.z = cvtpk(bflo(pc.z) - bflo(ps.z), bfhi(pc.z) - bfhi(ps.z));
        sm.w = cvtpk(bflo(pc.w) + bflo(ps.w), bfhi(pc.w) + bfhi(ps.w)); df.w = cvtpk(bflo(pc.w) - bflo(ps.w), bfhi(pc.w) - bfhi(ps.w));
        *(u32x4*)src = sm;
        if (k >= 1) *(u32x4*)(MIX + (size_t)(b * TPB + CTX + 8192 - k) * DM + 8 * lane) = df; }
}

DI bool attn_unit_map(int L, int nunits_big, int& bh, int& qb) {
    if (L < nunits_big) { const int i = L >> 8, c = L & 255; bh = 4 * (c & 7) + i; qb = 1 + (c >> 3); return true; }
    bh = L - nunits_big; qb = 0; return bh < 32;
}
DI void attn_mla_unit(const Args& a, LAS unsigned char* lds, int bh, int qb) {
    unsigned char* ws = a.ws; const int tid = otid(), lane = tid & 63, wave = tid >> 6, r = lane & 31, h = lane >> 5;
    const int b = bh >> 3, hd = bh & 7; const int m = b * TPB + qb * 256 + wave * 32 + r;
    const bf16_t* Q = (const bf16_t*)(ws + WS_Q) + (size_t)m * 768;
    const bf16_t* KN = (const bf16_t*)(ws + WS_KN) + (size_t)(b * TPB) * 512 + hd * 64;
    const bf16_t* KR = (const bf16_t*)(ws + WS_KR) + (size_t)(b * TPB) * 32;
    const bf16_t* VT = (const bf16_t*)(ws + WS_VT0) + (size_t)(hd * 64) * ROWS + b * TPB;
    f32x16 o[2]; float l;
    attn_core<64, 32, 64>(o, l, lds, Q + hd * 64, Q + 512 + hd * 32, KN, 512, KR, 32, VT, ROWS, qb == 0 ? CTX / 64 : TPB / 64);
    const float il = 1.0f / l; bf16_t* dst = (bf16_t*)(ws + WS_R3) + (size_t)m * DM + 512 + hd * 64;
#pragma unroll
    for (int blk = 0; blk < 2; ++blk)
#pragma unroll
        for (int g = 0; g < 4; ++g) { u32x2 w; w.x = cvtpk(o[blk][4 * g] * il, o[blk][4 * g + 1] * il); w.y = cvtpk(o[blk][4 * g + 2] * il, o[blk][4 * g + 3] * il);
            *(u32x2*)(dst + 32 * blk + 8 * g + 4 * h) = w; }
}
DI void attn_diff_unit(const Args& a, LAS unsigned char* lds, int bh, int qb, float lam) {
    unsigned char* ws = a.ws; const int tid = otid(), lane = tid & 63, wave = tid >> 6, r = lane & 31, h = lane >> 5;
    const int b = bh >> 3, hd = bh & 7; const int m = b * TPB + qb * 256 + wave * 32 + r;
    const bf16_t* QK = (const bf16_t*)(ws + WS_R3);
    const bf16_t* VT = (const bf16_t*)(ws + WS_VT1) + (size_t)(hd * 128) * ROWS + b * TPB;
    bf16_t* dst = (bf16_t*)(ws + WS_R2) + (size_t)m * DM + hd * 128;
    f32x16 o[4]; float l;
    {
        const bf16_t* q = QK + (size_t)m * 2048 + (hd * 2) * 64; const bf16_t* k = QK + (size_t)(b * TPB) * 2048 + 1024 + (hd * 2) * 64;
        attn_core<64, 0, 128>(o, l, lds, q, q, k, 2048, k, 2048, VT, ROWS, TPB / 64);
        const float il = 1.0f / l;
#pragma unroll
        for (int blk = 0; blk < 4; ++blk)
#pragma unroll
            for (int g = 0; g < 4; ++g) { u32x2 w; w.x = cvtpk(o[blk][4 * g] * il, o[blk][4 * g + 1] * il); w.y = cvtpk(o[blk][4 * g + 2] * il, o[blk][4 * g + 3] * il); *(u32x2*)(dst + 32 * blk + 8 * g + 4 * h) = w; }
    }
    {
        const bf16_t* q = QK + (size_t)m * 2048 + (hd * 2 + 1) * 64; const bf16_t* k = QK + (size_t)(b * TPB) * 2048 + 1024 + (hd * 2 + 1) * 64;
        attn_core<64, 0, 128>(o, l, lds, q, q, k, 2048, k, 2048, VT, ROWS, TPB / 64);
    }
    const float il = lam / l; float ss = 0.f;
#pragma unroll
    for (int blk = 0; blk < 4; ++blk)
#pragma unroll
        for (int g = 0; g < 4; ++g) { const u32x2 aw = *(const u32x2*)(dst + 32 * blk + 8 * g + 4 * h);
            const float x0 = bflo(aw.x) - o[blk][4 * g] * il, x1 = bfhi(aw.x) - o[blk][4 * g + 1] * il, x2 = bflo(aw.y) - o[blk][4 * g + 2] * il, x3 = bfhi(aw.y) - o[blk][4 * g + 3] * il;
            o[blk][4 * g] = x0; o[blk][4 * g + 1] = x1; o[blk][4 * g + 2] = x2; o[blk][4 * g + 3] = x3; ss += (x0 * x0 + x1 * x1) + (x2 * x2 + x3 * x3); }
    ss += __shfl_xor(ss, 32);
    const float rn = (1.0f - LAMBDA_INIT) / sqrtf(ss * (1.0f / 128.0f) + RMS_EPS);
    const float* sub = a.in[I1_SUBLN];
#pragma unroll
    for (int blk = 0; blk < 4; ++blk)
#pragma unroll
        for (int g = 0; g < 4; ++g) { const int d0 = 32 * blk + 8 * g + 4 * h; const f32x4 sg = *(const f32x4*)(sub + d0);
            u32x2 w; w.x = cvtpk(o[blk][4 * g] * rn * sg[0], o[blk][4 * g + 1] * rn * sg[1]); w.y = cvtpk(o[blk][4 * g + 2] * rn * sg[2], o[blk][4 * g + 3] * rn * sg[3]);
            *(u32x2*)(dst + d0) = w; }
}

constexpr int NPHASES = 18;
constexpr int LDS_BYTES = 147456;
struct GOp { int kind; pg8::Gemm g; bf16_t* O; int ldc, o_bs, ai_extra; float scale; int q_tiles, rope_from; };

DI bool get_gemm(int ph, int sub, const Args& a, GOp& op) {
    unsigned char* ws = a.ws;
    bf16_t* R2 = (bf16_t*)(ws + WS_R2); bf16_t* R3 = (bf16_t*)(ws + WS_R3);
    op.kind = 0; op.o_bs = 0; op.ai_extra = 0; op.scale = 1.0f; op.q_tiles = 0; op.rope_from = 0;
    pg8::Gemm& g = op.g; g.nB = 1; g.a_bs = 0; g.b_bs = 0; g.rot = 0; g.a_seg = 0; g.b_seg = 0; g.skipctx = 0;
#define SETK(k_) do { g.K = (k_); g.kseg = (k_) / 64; g.a_seg = (k_); g.b_seg = (k_); } while (0)
    switch (ph * 8 + sub) {
    case 2 * 8 + 0:
        g.A = R2; g.a_rs = 1024; g.nM = NRT; g.Bt = (const bf16_t*)(ws + W_IN0); g.b_rs = 1024; g.nN = 5; SETK(1024); op.O = R3; op.ldc = 1280; return true;
    case 3 * 8 + 0:
        g.A = (const bf16_t*)(ws + W_DC); g.a_rs = 128; g.nM = 1; g.Bt = R3; g.b_rs = 1280; g.nN = NRT; g.nB = 4; g.b_bs = 128; SETK(128);
        op.O = R2; op.ldc = ROWS; op.o_bs = 128 * ROWS; op.ai_extra = 384 * ROWS; return true;
    case 4 * 8 + 0:
        op.kind = 1; g.A = (const bf16_t*)(ws + WS_CQN); g.a_rs = 256; g.nM = NRT; g.Bt = (const bf16_t*)(ws + W_UQ); g.b_rs = 256; g.nN = 3; SETK(256);
        op.O = (bf16_t*)(ws + WS_Q); op.ldc = 768; op.scale = MLA_QSCALE; op.q_tiles = 3; op.rope_from = 2; return true;
    case 4 * 8 + 1:
        g.A = (const bf16_t*)(ws + WS_CKVN); g.a_rs = 256; g.nM = NRT; g.Bt = (const bf16_t*)(ws + W_KN); g.b_rs = 256; g.nN = 2; SETK(256); g.rot = 140;
        op.O = (bf16_t*)(ws + WS_KN); op.ldc = 512; return true;
    case 4 * 8 + 2:
        g.A = (const bf16_t*)(ws + W_V0); g.a_rs = 256; g.nM = 2; g.Bt = (const bf16_t*)(ws + WS_CKVN); g.b_rs = 256; g.nN = NRT; SETK(256); g.rot = 148;
        op.O = (bf16_t*)(ws + WS_VT0); op.ldc = ROWS; return true;
    case 4 * 8 + 3:
        g.A = (const bf16_t*)(ws + WS_DN); g.a_rs = 16384; g.nM = 16; g.Bt = R2 + CTX; g.b_rs = ROWS; g.nN = 2; g.nB = 4; g.b_bs = TPB; SETK(8192); g.rot = 152;
        op.O = R3 + (size_t)CTX * DM; op.ldc = DM; op.o_bs = TPB * DM; return true;
    case 4 * 8 + 4:
        g.A = (const bf16_t*)(ws + WS_DN) + 8192; g.a_rs = 16384; g.nM = 16; g.Bt = R2 + CTX + (size_t)512 * ROWS; g.b_rs = ROWS; g.nN = 2; g.nB = 4; g.b_bs = TPB; SETK(8192); g.rot = 24;
        op.O = (bf16_t*)(ws + WS_PS); op.ldc = 512; op.o_bs = 4096 * 512; return true;
    case 4 * 8 + 5:
        g.A = (const bf16_t*)(ws + W_D256); g.a_rs = 512; g.nM = 1; g.Bt = R2; g.b_rs = ROWS; g.nN = 2; g.nB = 4; g.b_bs = TPB; g.K = 512; g.kseg = 4; g.a_seg = 256; g.b_seg = 512 * ROWS; g.rot = 0;
        op.O = R3; op.ldc = DM; op.o_bs = TPB * DM; return true;
    case 6 * 8 + 0:
        g.A = R3; g.a_rs = 1024; g.nM = NRT; g.Bt = (const bf16_t*)(ws + W_OUT0); g.b_rs = 1024; g.nN = 4; SETK(1024); op.O = (bf16_t*)(ws + WS_Y0); op.ldc = DM; return true;
    case 8 * 8 + 0: case 15 * 8 + 0:
        op.kind = 3; g.A = R2; g.a_rs = 1024; g.nM = (ph == 8 ? NRT : 128); g.skipctx = (ph != 8); g.Bt = (const bf16_t*)(ws + (ph == 8 ? W_GU0 : W_GU1)); g.b_rs = 1024; g.nN = 22; SETK(1024); op.O = R3; op.ldc = FF; return true;
    case 9 * 8 + 0: case 16 * 8 + 0:
        g.A = R3; g.a_rs = FF; g.nM = (ph == 9 ? NRT : 128); g.skipctx = (ph != 9); g.Bt = (const bf16_t*)(ws + (ph == 9 ? W_D0 : W_D1)); g.b_rs = FF; g.nN = 4; SETK(FF); op.O = R2; op.ldc = DM; return true;
    case 11 * 8 + 0:
        op.kind = 2; g.A = R2; g.a_rs = 1024; g.nM = NRT; g.Bt = (const bf16_t*)(ws + W_QK1); g.b_rs = 1024; g.nN = 8; SETK(1024);
        op.O = R3; op.ldc = 2048; op.scale = DIFF_QSCALE; op.q_tiles = 4; op.rope_from = 0; return true;
    case 11 * 8 + 1:
        g.A = (const bf16_t*)(ws + W_V1); g.a_rs = 1024; g.nM = 4; g.Bt = R2; g.b_rs = 1024; g.nN = NRT; SETK(1024); g.rot = 32;
        op.O = (bf16_t*)(ws + WS_VT1); op.ldc = ROWS; return true;
    case 13 * 8 + 0:
        g.A = R2; g.a_rs = 1024; g.nM = 128; g.skipctx = 1; g.Bt = (const bf16_t*)(ws + W_OUT1); g.b_rs = 1024; g.nN = 4; SETK(1024); op.O = R3; op.ldc = DM; return true;
    default: return false;
    }
#undef SETK
}

DI bool get_rowpass(int ph, const Args& a, RowPass& P) {
    unsigned char* ws = a.ws; const float* MOD0 = (const float*)(ws + WS_MOD); const float* MOD1 = MOD0 + 5 * 6144;
    float* XC = (float*)(ws + WS_XC); bf16_t* R2 = (bf16_t*)(ws + WS_R2);
    switch (ph) {
    case 1:  P = RowPass{a.in[I_X], a.in[I_CTX], nullptr, nullptr, nullptr, MOD0, 0, nullptr, nullptr, MOD0, 1024, 0, R2, 0}; return true;
    case 7:  P = RowPass{a.in[I_X], a.in[I_CTX], a.out, XC, (const bf16_t*)(ws + WS_Y0), MOD0, 2048, a.in[I0_LN1G], a.in[I0_LN1B], MOD0, 4096, 3072, R2, 0}; return true;
    case 10: P = RowPass{a.out, XC, a.out, XC, R2, MOD0, 5120, a.in[I0_LN2G], a.in[I0_LN2B], MOD1, 1024, 0, R2, 0}; return true;
    case 14: P = RowPass{a.out, XC, a.out, XC, (const bf16_t*)(ws + WS_R3), MOD1, 2048, a.in[I1_LN1G], a.in[I1_LN1B], MOD1, 4096, 3072, R2, 1}; return true;
    case 17: P = RowPass{a.out, XC, a.out, XC, R2, MOD1, 5120, a.in[I1_LN2G], a.in[I1_LN2B], MOD1, 0, 0, nullptr, 1}; return true;
    default: return false;
    }
}

__global__ void __launch_bounds__(512, 2) fwd_kernel(Args a) {
    extern __shared__ __attribute__((aligned(16))) unsigned char lds_raw[];
    LAS unsigned char* lds = (LAS unsigned char*)lds_raw;
    const int G = gridDim.x;
    volatile LAS unsigned* bst = (volatile LAS unsigned*)(lds + LDS_BYTES - 64);
    if (threadIdx.x < 2) bst[threadIdx.x] = 0u;
    __syncthreads();
    XcdBarrier xbar = xcd_barrier_post((unsigned*)(a.ws + WS_BAR), bst);
    for (int ph = a.ph_lo; ph < a.ph_hi; ++ph) {
        const int tid = otid(), lane = tid & 63, wave = __builtin_amdgcn_readfirstlane(tid >> 6);
        const int gw = blockIdx.x * 8 + wave, NGW = G * 8;
#ifndef NO_PRO
        if (ph == 0) prologue(a, lds);
#endif
        RowPass P;
        if (get_rowpass(ph, a, P)) { for (int m = gw; m < ROWS; m += NGW) row_pass(P, m, lane); }
        if (ph == 3) { for (int m = gw; m < ROWS; m += NGW) p3_row(a, m, lane); }
#ifndef NO_MLA
        if (ph == 5) {
            mirror_items(a, gw, NGW, lane);
            for (int L = blockIdx.x; ; L += G) { int bh, qb; if (!attn_unit_map(L, 1024, bh, qb)) break; attn_mla_unit(a, lds, bh, qb); }
        }
#endif
#ifndef NO_DIFF
        if (ph == 12) {
            const float p1 = wave_sum(a.in[I1_LQ1][lane] * a.in[I1_LK1][lane]), p2 = wave_sum(a.in[I1_LQ2][lane] * a.in[I1_LK2][lane]);
            const float lam = expf(p1) - expf(p2) + LAMBDA_INIT;
            for (int L = blockIdx.x; L < 1024; L += G) { int bh, qb; attn_unit_map(L, 1024, bh, qb); attn_diff_unit(a, lds, bh, qb, lam); }
        }
#endif
#ifndef NO_GEMM
        for (int sub = 0; sub < 8; ++sub) {
            GOp op; if (!get_gemm(ph, sub, a, op)) break;
            pg8::StaticOrder S; S.init(op.g.nM, op.g.nN, op.g.nB, G, (int)blockIdx.x, op.g.rot, op.g.skipctx);
            if (op.kind == 0) { pg8::EpiStore E{op.O, op.ldc, op.o_bs, op.ai_extra, op.scale}; pg8::gemm_phase(lds, op.g, S, E); }
            else if (op.kind == 1) { pg8::EpiRope<8> E{op.O, op.ldc, op.scale, op.q_tiles, op.rope_from, (const f32x2*)(a.ws + WS_TAB8)}; pg8::gemm_phase(lds, op.g, S, E); }
            else if (op.kind == 2) { pg8::EpiRope<16> E{op.O, op.ldc, op.scale, op.q_tiles, op.rope_from, (const f32x2*)(a.ws + WS_TAB16)}; pg8::gemm_phase(lds, op.g, S, E); }
            else { pg8::EpiSwiglu E{op.O, op.ldc}; pg8::gemm_phase(lds, op.g, S, E); }
        }
#endif
        if (ph + 1 < a.ph_hi) { if (ph == a.ph_lo) { __threadfence(); cg::this_grid().sync(); } else xcd_barrier(xbar); }
    }
}

extern "C" void kernel_launch(void* const* d_in, const int* in_sizes, int n_in, void* d_out, int out_size, void* d_ws, size_t ws_size, hipStream_t stream) {
    static int grid = 0;
    if (grid == 0) {
        if (n_in != 35 || ws_size < WS_END) { fprintf(stderr, "kernel_launch: unexpected n_in %d / ws %zu (need %zu)\n", n_in, ws_size, (size_t)WS_END); grid = -1; return; }
        int dev = 0, cus = 0, per_cu = 0;
        hipGetDevice(&dev); hipDeviceGetAttribute(&cus, hipDeviceAttributeMultiprocessorCount, dev);
        hipFuncSetAttribute((const void*)fwd_kernel, hipFuncAttributeMaxDynamicSharedMemorySize, LDS_BYTES);
        hipOccupancyMaxActiveBlocksPerMultiprocessor(&per_cu, (const void*)fwd_kernel, 512, LDS_BYTES);
        if (per_cu < 1) { fprintf(stderr, "kernel_launch: occupancy query says %d blocks/CU\n", per_cu); per_cu = 1; }
        (void)hipGetLastError();
        grid = cus * 1;
    }
    if (grid < 0) return;
    Args a{};
    for (int i = 0; i < 35; ++i) a.in[i] = (const float*)d_in[i];
    a.out = (float*)d_out; a.ws = (unsigned char*)d_ws;
#if MK_MULTI
    for (int ph = 0; ph < NPHASES; ++ph) { a.ph_lo = ph; a.ph_hi = ph + 1; hipLaunchKernelGGL(fwd_kernel, dim3(grid), dim3(512), LDS_BYTES, stream, a); }
#else
    a.ph_lo = 0; a.ph_hi = NPHASES;
    hipMemsetAsync((char*)d_ws + WS_BAR, 0, 16384, stream);
    void* args[] = {&a};
    hipError_t e = hipLaunchCooperativeKernel((const void*)fwd_kernel, dim3(grid), dim3(512), args, LDS_BYTES, stream);
    if (e != hipSuccess) fprintf(stderr, "cooperative launch failed: %s (grid %d)\n", hipGetErrorString(e), grid);
#endif
}
```

```cpp
#include <hip/hip_runtime.h>
#include <hip/hip_cooperative_groups.h>
#include <cstdio>
#include <cstdint>
namespace cg = cooperative_groups;

#ifndef MK_MULTI
#define MK_MULTI 0
#endif

#define DI __device__ __forceinline__
#define LAS __attribute__((address_space(3)))
typedef unsigned short bf16_t;
typedef short bf16x8 __attribute__((ext_vector_type(8)));
typedef float f32x4 __attribute__((ext_vector_type(4)));
typedef float f32x2 __attribute__((ext_vector_type(2)));
typedef float f32x16 __attribute__((ext_vector_type(16)));
typedef unsigned u32x4 __attribute__((ext_vector_type(4)));
typedef unsigned u32x2 __attribute__((ext_vector_type(2)));
typedef __bf16 bf16x2_t __attribute__((ext_vector_type(2)));

constexpr int DM = 1024, NB = 4, SEQ = 8192, CTX = 256, TPB = SEQ + CTX  , ROWS = NB * TPB  , FF = 2816;
constexpr int NRT = ROWS / 256;
constexpr float LN_EPS = 1e-6f, RMS_EPS = 1e-6f;
constexpr float DN_ALPHA = 1.41421356237f;
constexpr float LOG2E = 1.4426950408889634f;
constexpr float MLA_QSCALE = 0.10206207261596577f * LOG2E;
constexpr float DIFF_QSCALE = 0.125f * LOG2E;
constexpr float LAMBDA_INIT = 0.35550906f;

constexpr size_t MiB = 1u << 20;
constexpr size_t WS_MOD = 0;
constexpr size_t WS_TAB16 = 256 * 1024;
constexpr size_t WS_TAB8 = WS_TAB16 + 16384;
constexpr size_t WS_BAR = 512 * 1024;
constexpr size_t WS_XC = 1 * MiB;
constexpr size_t WS_W = 5 * MiB;
constexpr size_t W_IN0 = WS_W;
constexpr size_t W_UQ = W_IN0 + 1280 * 1024 * 2;
constexpr size_t W_KN = W_UQ + 768 * 256 * 2;
constexpr size_t W_V0 = W_KN + 512 * 256 * 2;
constexpr size_t W_OUT0 = W_V0 + 512 * 256 * 2;
constexpr size_t W_GU0 = W_OUT0 + 1024 * 1024 * 2;
constexpr size_t W_D0 = W_GU0 + 5632 * 1024 * 2;
constexpr size_t W_QK1 = W_D0 + 1024 * 2816 * 2;
constexpr size_t W_V1 = W_QK1 + 2048 * 1024 * 2;
constexpr size_t W_OUT1 = W_V1 + 1024 * 1024 * 2;
constexpr size_t W_GU1 = W_OUT1 + 1024 * 1024 * 2;
constexpr size_t W_D1 = W_GU1 + 5632 * 1024 * 2;
constexpr size_t W_DC = W_D1 + 1024 * 2816 * 2;
constexpr size_t W_D256 = W_DC + 256 * 128 * 2;
constexpr size_t W_END = W_D256 + 256 * 512 * 2;
static_assert(W_END <= 56 * MiB, "weights region");
constexpr size_t WS_DN = 56 * MiB;
constexpr size_t WS_AT4 = 88 * MiB;
constexpr size_t WS_R2 = 184 * MiB;
constexpr size_t WS_R3 = 250 * MiB;
constexpr size_t WS_R4 = WS_R3 + (size_t)ROWS * 1280 * 2;
constexpr size_t WS_CQN = WS_R4, WS_CKVN = WS_R4 + (size_t)ROWS * 256 * 2;
constexpr size_t WS_R5 = WS_R4 + (size_t)ROWS * 512 * 2;
constexpr size_t WS_Q = WS_R5;
constexpr size_t WS_KN = WS_Q + (size_t)ROWS * 768 * 2;
constexpr size_t WS_KR = WS_KN + (size_t)ROWS * 512 * 2;
constexpr size_t WS_VT0 = WS_KR + (size_t)ROWS * 32 * 2;
constexpr size_t WS_END = WS_VT0 + (size_t)512 * ROWS * 2;
constexpr size_t WS_Y0 = WS_R5;
constexpr size_t WS_PS = WS_R3 + (size_t)ROWS * DM * 2;
static_assert(WS_PS + (size_t)4 * 4096 * 512 * 2 <= WS_R4, "ps");
constexpr size_t WS_VT1 = WS_R3 + (size_t)ROWS * 2048 * 2;
static_assert(WS_END <= 512 * MiB, "workspace");
static_assert(WS_VT1 + (size_t)1024 * ROWS * 2 <= WS_END, "vt1");
static_assert(WS_R3 + (size_t)ROWS * FF * 2 <= WS_END, "hid");

DI int otid() { int t = threadIdx.x; asm volatile("" : "+v"(t)); return t; }
DI float wave_sum(float v) {
#pragma unroll
    for (int o = 1; o < 64; o <<= 1) v += __shfl_xor(v, o);
    return v;
}
DI unsigned cvtpk(float lo, float hi) { f32x2 v = {lo, hi}; bf16x2_t b = __builtin_convertvector(v, bf16x2_t); return __builtin_bit_cast(unsigned, b); }
DI float bf2f(unsigned short b) { return __uint_as_float(((unsigned)b) << 16); }
DI float bflo(unsigned w) { return __uint_as_float(w << 16); }
DI float bfhi(unsigned w) { return __uint_as_float(w & 0xffff0000u); }

namespace pg8 {
constexpr int BM = 256, BK = 64, HALF = 128, HTB = HALF * BK * 2, STAGE_BYTES = 8 * HTB, NXCD = 8, WGM = 8;
__host__ __device__ __forceinline__ int lds_byte(int r, int c) { const int st = (r >> 4) * 2 + (c >> 5), rr = r & 15, cc = c & 31, ob = rr * 64 + cc * 2; return st * 1024 + (ob ^ (((ob >> 9) & 1) << 5)); }
__host__ __device__ __forceinline__ void stage_rc(int b, int& R, int& C) { const int st = b / 1024, sb = b % 1024, swz = sb ^ (((sb >> 9) & 1) << 5); R = (st >> 1) * 16 + swz / 64; C = (st & 1) * 32 + (swz % 64) / 2; }
__host__ __device__ __forceinline__ int perm32(int rho) { const int n = rho >> 4, i = rho & 15; return 8 * (i >> 2) + 4 * n + (i & 3); }

struct Unit { int pm, pn, pb; };
struct Gemm {
    const bf16_t* A; const bf16_t* Bt; int nM, nN, nB, K, kseg;
    int a_rs, b_rs, a_seg, b_seg, a_bs, b_bs;
    int rot, skipctx;
};
struct StaticOrder {
    int nM, nN, nwg, tot, G, c, skipctx;
    DI void init(int nM_, int nN_, int nB_, int G_, int c_, int rot, int skip) { skipctx = skip; nM = nM_; nN = nN_; nwg = nM * nN; tot = nwg * nB_; G = G_; c = (c_ + G_ - (rot % G_)) % G_; }
    DI bool next(int i, Unit& u) const {
        const long L = (long)i * G + c; if (L >= tot) return false;
        u.pb = (int)(L / nwg); int wgid = (int)(L % nwg);
        { const int q = nwg / NXCD, r = nwg % NXCD, xcd = wgid % NXCD, off = wgid / NXCD; wgid = (xcd < r ? xcd * (q + 1) : r * (q + 1) + (xcd - r) * q) + off; }
        const int nig = WGM * nN, gid = wgid / nig, fm = gid * WGM, gsz = (nM - fm) < WGM ? (nM - fm) : WGM;
        u.pm = fm + ((wgid % nig) % gsz); u.pn = (wgid % nig) / gsz; if (skipctx) u.pm += (u.pm >> 5) + 1; return true;
    }
};

struct EpiStore {
    static constexpr bool PERM = true;
    bf16_t* O; int ldc, o_bs, ai_extra; float scale;
    DI void operator()(const f32x4 (&acc)[2][2][4][2], const Unit& u, int wr, int wc, int fr, int fq) const {
        const int row0 = u.pm * BM + wr * 64 + fr, col0 = u.pn * BM + wc * 32 + 8 * fq;
        bf16_t* base = O + (size_t)u.pb * o_bs;
#pragma unroll
        for (int ai = 0; ai < 2; ++ai)
#pragma unroll
            for (int m = 0; m < 4; ++m) { bf16_t* rowp = base + (size_t)(row0 + ai * HALF + m * 16) * ldc + (size_t)ai * ai_extra + col0;
#pragma unroll
                for (int bj = 0; bj < 2; ++bj) { const f32x4 v0 = acc[ai][bj][m][0] * scale, v1 = acc[ai][bj][m][1] * scale;
                    u32x4 w; w.x = cvtpk(v0[0], v0[1]); w.y = cvtpk(v0[2], v0[3]); w.z = cvtpk(v1[0], v1[1]); w.w = cvtpk(v1[2], v1[3]);
                    *(u32x4*)(rowp + bj * HALF) = w; } }
    }
};
struct EpiSwiglu {
    static constexpr bool PERM = true;
    bf16_t* O; int ldc;
    DI void operator()(const f32x4 (&acc)[2][2][4][2], const Unit& u, int wr, int wc, int fr, int fq) const {
        const int row0 = u.pm * BM + wr * 64 + fr, col0 = u.pn * HALF + wc * 32 + 8 * fq;
#pragma unroll
        for (int ai = 0; ai < 2; ++ai)
#pragma unroll
            for (int m = 0; m < 4; ++m) { bf16_t* rowp = O + (size_t)(row0 + ai * HALF + m * 16) * ldc + col0; float h[8];
#pragma unroll
                for (int n = 0; n < 2; ++n)
#pragma unroll
                    for (int i = 0; i < 4; ++i) { const float g = acc[ai][0][m][n][i], up = acc[ai][1][m][n][i];
                        h[n * 4 + i] = g * __builtin_amdgcn_rcpf(1.0f + __builtin_amdgcn_exp2f(-g * LOG2E)) * up; }
                u32x4 w; w.x = cvtpk(h[0], h[1]); w.y = cvtpk(h[2], h[3]); w.z = cvtpk(h[4], h[5]); w.w = cvtpk(h[6], h[7]);
                *(u32x4*)rowp = w; }
    }
};
template <int MODE> struct EpiRope {
    static constexpr bool PERM = false;
    bf16_t* O; int ldc; float qscale; int q_tiles, rope_from; const f32x2* tab;
    DI void operator()(const f32x4 (&acc)[2][2][4][2], const Unit& u, int wr, int wc, int fr, int fq) const {
        const float sc = u.pn < q_tiles ? qscale : 1.0f; const bool rope_tile = u.pn >= rope_from;
        const int col0 = u.pn * BM + wc * 32 + 4 * fq;
#pragma unroll
        for (int ai = 0; ai < 2; ++ai)
#pragma unroll
            for (int m = 0; m < 4; ++m) {
                const int row = u.pm * BM + ai * HALF + wr * 64 + m * 16 + fr; const int j = row % TPB; const int t = j - CTX;
                f32x4 cs0 = {1.f, 0.f, 1.f, 0.f}, cs1 = {1.f, 0.f, 1.f, 0.f};
                if (rope_tile && t >= 0) {
                    int pos, f0;
                    if (MODE == 16) { pos = (wc & 1) ? (t & 63) : (t >> 6); f0 = 4 * fq; } else { pos = (fq >> 1) ? (t & 63) : (t >> 6); f0 = 4 * (fq & 1); }
                    const f32x4* tp = (const f32x4*)(tab + pos * MODE + f0); cs0 = tp[0]; cs1 = tp[1];
                }
                const float c[4] = {cs0[0], cs0[2], cs1[0], cs1[2]}, s[4] = {cs0[1], cs0[3], cs1[1], cs1[3]};
                bf16_t* rowp = O + (size_t)row * ldc + col0;
#pragma unroll
                for (int bj = 0; bj < 2; ++bj) { const f32x4 x1 = acc[ai][bj][m][0] * sc, x2 = acc[ai][bj][m][1] * sc; float o1[4], o2[4];
#pragma unroll
                    for (int i = 0; i < 4; ++i) { o1[i] = x1[i] * c[i] - x2[i] * s[i]; o2[i] = x1[i] * s[i] + x2[i] * c[i]; }
                    u32x2 w1, w2; w1.x = cvtpk(o1[0], o1[1]); w1.y = cvtpk(o1[2], o1[3]); w2.x = cvtpk(o2[0], o2[1]); w2.y = cvtpk(o2[2], o2[3]);
                    *(u32x2*)(rowp + bj * HALF) = w1; *(u32x2*)(rowp + bj * HALF + 16) = w2; }
            }
    }
};

template <class Epi>
DI void gemm_phase(LAS unsigned char* lds, const Gemm g, const StaticOrder& S, const Epi& E) {
    const int tid = otid(), wid = __builtin_amdgcn_readfirstlane(tid >> 6), lane = tid & 63, wr = wid >> 2, wc = wid & 3, fr = lane & 15, fq = lane >> 4;
    const int nt = g.K / BK, kseg = g.kseg;
    unsigned voffA[2], voffB[2];
#pragma unroll
    for (int i = 0; i < 2; ++i) { int R, C; stage_rc(tid * 16 + i * 8192, R, C); const int Rb = Epi::PERM ? ((R & ~31) + perm32(R & 31)) : R;
        voffA[i] = (unsigned)(R * g.a_rs + C) * 2u; voffB[i] = (unsigned)(Rb * g.b_rs + C) * 2u; }
    const int kstep = BK * 2;
    const unsigned hstepA = (unsigned)HALF * g.a_rs * 2, hstepB = (unsigned)HALF * g.b_rs * 2;
    const unsigned tstepA = 2 * hstepA, tstepB = 2 * hstepB;
    const int segA = (g.a_seg - kseg * BK) * 2, segB = (g.b_seg - kseg * BK) * 2;
#define OFFA(t) ((t) * kstep + ((t) >= kseg ? segA : 0))
#define OFFB(t) ((t) * kstep + ((t) >= kseg ? segB : 0))
    const unsigned ldsw = (unsigned)wid * 1024u;
    const int aoff = lds_byte(wr * 64 + fr, fq * 8), boff = lds_byte(wc * 32 + fr, fq * 8);
#define PG8_SA(b, h) (((b) * 2 + (h)) * HTB)
#define PG8_SB(b, h) ((4 + (b) * 2 + (h)) * HTB)
#define PG8_STAGE(bufoff, gbase, voff) do { _Pragma("unroll") for (int _i = 0; _i < 2; ++_i) \
        __builtin_amdgcn_global_load_lds((const unsigned*)((const char*)(gbase) + (voff)[_i]), (LAS unsigned*)(lds + (bufoff) + ldsw + _i * 8192), 16, 0, 0); } while (0)
#define PG8_LDA(dst, b, h) do { _Pragma("unroll") for (int m = 0; m < 4; ++m) _Pragma("unroll") for (int k = 0; k < 2; ++k) dst[m][k] = *(const LAS bf16x8*)(lds + PG8_SA(b, h) + aoff + m * 2048 + k * 1024); } while (0)
#define PG8_LDB(dst, b, h) do { _Pragma("unroll") for (int n = 0; n < 2; ++n) _Pragma("unroll") for (int k = 0; k < 2; ++k) dst[n][k] = *(const LAS bf16x8*)(lds + PG8_SB(b, h) + boff + n * 2048 + k * 1024); } while (0)
#define PG8_MMA(ai, bj, At, Bt) do { __builtin_amdgcn_s_setprio(1); _Pragma("unroll") for (int m = 0; m < 4; ++m) _Pragma("unroll") for (int n = 0; n < 2; ++n) _Pragma("unroll") for (int k = 0; k < 2; ++k) \
        acc[ai][bj][m][n] = __builtin_amdgcn_mfma_f32_16x16x32_bf16(Bt[n][k], At[m][k], acc[ai][bj][m][n], 0, 0, 0); __builtin_amdgcn_s_setprio(0); } while (0)
#define PG8_WAIT_V(n) asm volatile("s_waitcnt vmcnt(" #n ")" ::: "memory")
#define PG8_WAIT_L(n) asm volatile("s_waitcnt lgkmcnt(" #n ")" ::: "memory")
#define PG8_BAR __builtin_amdgcn_s_barrier()
#define PG8_SCHED __builtin_amdgcn_sched_barrier(0)
    Unit cur, nxt; int ui = 0;
    if (!S.next(0, cur)) return;
    f32x4 acc[2][2][4][2];
#pragma unroll
    for (int a = 0; a < 2; ++a)
#pragma unroll
        for (int b = 0; b < 2; ++b)
#pragma unroll
            for (int m = 0; m < 4; ++m)
#pragma unroll
                for (int n = 0; n < 2; ++n) acc[a][b][m][n] = (f32x4){0.f, 0.f, 0.f, 0.f};
    bf16x8 At[4][2], B0[2][2], B1[2][2];
    const char* cA = (const char*)g.A + ((size_t)cur.pb * g.a_bs) * 2 + (size_t)cur.pm * tstepA;
    const char* cB = (const char*)g.Bt + ((size_t)cur.pb * g.b_bs) * 2 + (size_t)cur.pn * tstepB;
    {
        PG8_STAGE(PG8_SB(0, 0), cB, voffB); PG8_STAGE(PG8_SB(0, 1), cB + hstepB, voffB); PG8_STAGE(PG8_SA(0, 0), cA, voffA); PG8_STAGE(PG8_SA(0, 1), cA + hstepA, voffA);
        if (wr == 1) PG8_BAR;
        PG8_WAIT_V(2); PG8_BAR;
        PG8_STAGE(PG8_SB(1, 0), cB + OFFB(1), voffB); PG8_STAGE(PG8_SA(1, 0), cA + OFFA(1), voffA); PG8_STAGE(PG8_SB(1, 1), cB + hstepB + OFFB(1), voffB);
        PG8_WAIT_V(6); PG8_BAR;
    }
    for (;;) {
        const bool has_next = S.next(ui + 1, nxt);
        const char* nA = has_next ? (const char*)g.A + ((size_t)nxt.pb * g.a_bs) * 2 + (size_t)nxt.pm * tstepA : cA;
        const char* nB = has_next ? (const char*)g.Bt + ((size_t)nxt.pb * g.b_bs) * 2 + (size_t)nxt.pn * tstepB : cB;
        for (int t = 0; t < nt; t += 2) {
            const bool last = (t == nt - 2);
            const char* a1 = cA + OFFA(t + 1);
            const char* a2 = last ? nA : cA + OFFA(t + 2); const char* b2 = last ? nB : cB + OFFB(t + 2);
            const char* a3 = last ? nA + OFFA(1) : cA + OFFA(t + 3); const char* b3 = last ? nB + OFFB(1) : cB + OFFB(t + 3);
            PG8_LDB(B0, 0, 0); PG8_LDB(B1, 0, 1); PG8_SCHED; PG8_LDA(At, 0, 0); PG8_STAGE(PG8_SA(1, 1), a1 + hstepA, voffA);
            PG8_WAIT_V(8); PG8_WAIT_L(0); PG8_BAR; PG8_MMA(0, 0, At, B0); PG8_MMA(0, 1, At, B1); PG8_BAR; PG8_SCHED;
            PG8_LDA(At, 0, 1); PG8_STAGE(PG8_SB(0, 0), b2, voffB); PG8_STAGE(PG8_SB(0, 1), b2 + hstepB, voffB); PG8_STAGE(PG8_SA(0, 0), a2, voffA);
            PG8_WAIT_V(8); PG8_WAIT_L(0); PG8_BAR; PG8_MMA(1, 0, At, B0); PG8_MMA(1, 1, At, B1); PG8_BAR; PG8_SCHED;
            PG8_LDB(B0, 1, 0); PG8_LDB(B1, 1, 1); PG8_SCHED; PG8_LDA(At, 1, 0); PG8_STAGE(PG8_SA(0, 1), a2 + hstepA, voffA);
            PG8_WAIT_V(8); PG8_WAIT_L(0); PG8_BAR; PG8_MMA(0, 0, At, B0); PG8_MMA(0, 1, At, B1); PG8_BAR; PG8_SCHED;
            PG8_LDA(At, 1, 1); PG8_STAGE(PG8_SB(1, 0), b3, voffB); PG8_STAGE(PG8_SB(1, 1), b3 + hstepB, voffB); PG8_STAGE(PG8_SA(1, 0), a3, voffA);
            PG8_WAIT_V(8); PG8_WAIT_L(0); PG8_BAR; PG8_MMA(1, 0, At, B0); PG8_MMA(1, 1, At, B1); PG8_BAR; PG8_SCHED;
        }
        if (wr == 0) PG8_BAR;
        E(acc, cur, wr, wc, fr, fq);
        if (!has_next) break;
#pragma unroll
        for (int a = 0; a < 2; ++a)
#pragma unroll
            for (int b = 0; b < 2; ++b)
#pragma unroll
                for (int m = 0; m < 4; ++m)
#pragma unroll
                    for (int n = 0; n < 2; ++n) acc[a][b][m][n] = (f32x4){0.f, 0.f, 0.f, 0.f};
        cur = nxt; cA = nA; cB = nB; ++ui;
        if (wr == 1) PG8_BAR;
    }
    PG8_WAIT_V(0);
    PG8_BAR;
#undef OFFA
#undef OFFB
#undef PG8_SA
#undef PG8_SB
#undef PG8_STAGE
#undef PG8_LDA
#undef PG8_LDB
#undef PG8_MMA
#undef PG8_WAIT_V
#undef PG8_WAIT_L
#undef PG8_BAR
#undef PG8_SCHED
}
}

#define MFMA32(a, b, c) __builtin_amdgcn_mfma_f32_32x32x16_bf16((a), (b), (c), 0, 0, 0)
template <int D1, int D2, int DV>
DI void attn_core(f32x16 (&o)[DV / 32], float& l_out, LAS unsigned char* lds, const bf16_t* q1, const bf16_t* q2,
                  const bf16_t* k1, long ldk1, const bf16_t* k2, long ldk2, const bf16_t* vt, long ldv, int ntiles) {
    constexpr int DQK = D1 + D2, KROW = DQK * 2 + 16, VROW = 144, KT = 64 * KROW, VT = DV * VROW, BUF = KT + VT;
    constexpr int KCH = DQK / 8, NKC = 64 * KCH, NVC = DV * 8, KPT = (NKC + 511) / 512, VPT = NVC / 512;
    const int tid = otid(), lane = tid & 63, r = lane & 31, h = lane >> 5;
    bf16x8 qf[DQK / 16];
#pragma unroll
    for (int d0 = 0; d0 < DQK / 16; ++d0) qf[d0] = (16 * d0 < D1) ? *(const bf16x8*)(q1 + 16 * d0 + 8 * h) : *(const bf16x8*)(q2 + (16 * d0 - D1) + 8 * h);
    u32x4 kreg[KPT], vreg[VPT];
    auto gload = [&](int t) {
#pragma unroll
        for (int i = 0; i < KPT; ++i) { const int c = tid + i * 512; if (c < NKC) { const int row = c / KCH, cc = (c % KCH) * 8;
            kreg[i] = (cc < D1) ? *(const u32x4*)(k1 + (size_t)(t * 64 + row) * ldk1 + cc) : *(const u32x4*)(k2 + (size_t)(t * 64 + row) * ldk2 + (cc - D1)); } }
#pragma unroll
        for (int i = 0; i < VPT; ++i) { const int c = tid + i * 512; const int d = c >> 3, cc = (c & 7) * 8; vreg[i] = *(const u32x4*)(vt + (size_t)d * ldv + t * 64 + cc); }
    };
    auto sstore = [&](int b) {
        LAS unsigned char* kb = lds + b * BUF; LAS unsigned char* vb = kb + KT;
#pragma unroll
        for (int i = 0; i < KPT; ++i) { const int c = tid + i * 512; if (c < NKC) { const int row = c / KCH, cc = (c % KCH) * 8; *(LAS u32x4*)(kb + row * KROW + cc * 2) = kreg[i]; } }
#pragma unroll
        for (int i = 0; i < VPT; ++i) { const int c = tid + i * 512; const int d = c >> 3, cc = (c & 7) * 8; *(LAS u32x4*)(vb + d * VROW + cc * 2) = vreg[i]; }
    };
    const int pr = (r & ~12) | ((r & 4) << 1) | ((r & 8) >> 1);
    float mrun = 0.f, lrun = 0.f;
    f32x16 negm;
#pragma unroll
    for (int i = 0; i < 16; ++i) negm[i] = 0.f;
#pragma unroll
    for (int b = 0; b < DV / 32; ++b)
#pragma unroll
        for (int i = 0; i < 16; ++i) o[b][i] = 0.f;
    gload(0); sstore(0); if (ntiles > 1) { gload(1); sstore(1); } __syncthreads();
    for (int t = 0; t < ntiles; ++t) {
        if (t + 2 < ntiles) gload(t + 2);
        const LAS unsigned char* kb = lds + (t & 3) * BUF; const LAS unsigned char* vb = kb + KT;
        f32x16 p[2];
        {
            bf16x8 kf[2][DQK / 16];
#pragma unroll
            for (int hf = 0; hf < 2; ++hf)
#pragma unroll
                for (int d0 = 0; d0 < DQK / 16; ++d0) kf[hf][d0] = *(const LAS bf16x8*)(kb + (32 * hf + pr) * KROW + (16 * d0 + 8 * h) * 2);
            __builtin_amdgcn_sched_barrier(0);
            __builtin_amdgcn_s_setprio(1);
#pragma unroll
            for (int d0 = 0; d0 < DQK / 16; ++d0)
#pragma unroll
                for (int hf = 0; hf < 2; ++hf) p[hf] = MFMA32(kf[hf][d0], qf[d0], d0 == 0 ? negm : p[hf]);
            __builtin_amdgcn_sched_barrier(0);
        }
        constexpr int NBLK = DV / 32;
        bf16x8 vk[2][NBLK];
#define LDVK(buf, ks) do { _Pragma("unroll") for (int b_ = 0; b_ < NBLK; ++b_) vk[buf][b_] = *(const LAS bf16x8*)(vb + (32 * b_ + r) * VROW + (16 * (ks) + 8 * h) * 2); } while (0)
        LDVK(0, 0);
        __builtin_amdgcn_sched_barrier(0);
        float ta = fmaxf(fmaxf(p[0][0], p[0][1]), p[1][0]), tb = fmaxf(fmaxf(p[0][2], p[0][3]), p[1][1]);
        ta = fmaxf(fmaxf(ta, p[1][2]), p[1][3]);
#pragma unroll
        for (int i = 4; i < 16; i += 4) { ta = fmaxf(fmaxf(ta, p[0][i]), p[0][i + 1]); tb = fmaxf(fmaxf(tb, p[0][i + 2]), p[0][i + 3]); ta = fmaxf(fmaxf(ta, p[1][i]), p[1][i + 1]); tb = fmaxf(fmaxf(tb, p[1][i + 2]), p[1][i + 3]); }
        float tm = fmaxf(ta, tb); tm = fmaxf(tm, __shfl_xor(tm, 32));
        if (__any(t == 0 || tm > 8.0f)) {
            const float dl = (t == 0 || tm > 0.f) ? tm : 0.f; mrun += dl;
            const float alpha = __builtin_amdgcn_exp2f(-dl); lrun *= alpha;
#pragma unroll
            for (int i = 0; i < 16; ++i) { p[0][i] -= dl; p[1][i] -= dl; negm[i] = -mrun; }
#pragma unroll
            for (int b = 0; b < DV / 32; ++b)
#pragma unroll
                for (int i = 0; i < 16; ++i) o[b][i] *= alpha;
        }
        bf16x8 pf[4]; float rs = 0.f; u32x4 wq;
#define EXPPART(ks, j) do { const int hf_ = (ks) >> 1, s8_ = ((ks) & 1) * 8; const float e0_ = __builtin_amdgcn_exp2f(p[hf_][s8_ + 2 * (j)]), e1_ = __builtin_amdgcn_exp2f(p[hf_][s8_ + 2 * (j) + 1]); \
        rs += e0_; rs += e1_; wq[j] = cvtpk(e0_, e1_); } while (0)
        EXPPART(0, 0); EXPPART(0, 1); EXPPART(0, 2); EXPPART(0, 3); pf[0] = __builtin_bit_cast(bf16x8, wq);
        __builtin_amdgcn_sched_barrier(0);
#pragma unroll
        for (int ks = 0; ks < 4; ++ks) {
            if (ks < 3) LDVK((ks + 1) & 1, ks + 1);
            __builtin_amdgcn_sched_barrier(0);
#pragma unroll
            for (int b = 0; b < NBLK; ++b) {
                o[b] = MFMA32(vk[ks & 1][b], pf[ks], o[b]);
                if (ks < 3) {
#pragma unroll
                    for (int j = b * (4 / NBLK); j < (b + 1) * (4 / NBLK); ++j) {
                        if (ks == 0) EXPPART(1, j); else if (ks == 1) EXPPART(2, j); else EXPPART(3, j);
                    }
                }
                __builtin_amdgcn_sched_barrier(0);
            }
            if (ks < 3) pf[ks + 1] = __builtin_bit_cast(bf16x8, wq);
        }
        __builtin_amdgcn_s_setprio(0);
        lrun += rs;
#undef LDVK
#undef EXPPART
        if (t + 2 < ntiles) sstore((t + 2) & 3);
        if (t & 1) __syncthreads();
    }
    l_out = lrun + __shfl_xor(lrun, 32);
}
constexpr int ATTN_LDS = 2 * (64 * (96 * 2 + 16) + 128 * 144);


#define XB_TMO      128
#define XB_XCNT(j)  (256  + 64 * (j))
#define XB_XSUB(j)  (1280 + 64 * (j))
#define XB_XGEN(j)  (2304 + 64 * (j))
#define XB_TOP      3328
#define XB_TOPGEN   3392
#define XCD_BAR_WORDS 3456
#define XB_SPIN_CAP (1u << 18)
DI unsigned xb_ld(unsigned* p)              { return __hip_atomic_load(p, __ATOMIC_RELAXED, __HIP_MEMORY_SCOPE_AGENT); }
DI unsigned xb_add(unsigned* p, unsigned v) { return __hip_atomic_fetch_add(p, v, __ATOMIC_RELAXED, __HIP_MEMORY_SCOPE_AGENT); }
DI unsigned xb_xcc_id() { return (unsigned)__builtin_amdgcn_s_getreg((3 << 11) | 20) & 0xFu; }
#define XB_SPIN(cond, bar) do { unsigned _sp = 0; while (cond) { __builtin_amdgcn_s_sleep(1); \
    if ((++_sp & 255u) == 0u) { if (xb_ld(&(bar)[XB_TMO])) break; if (_sp > XB_SPIN_CAP) { atomicAdd(&(bar)[XB_TMO], 1u); break; } } } } while (0)
struct XcdBarrier { unsigned* bar; unsigned x; volatile LAS unsigned* st; };
DI XcdBarrier xcd_barrier_post(unsigned* bar, volatile LAS unsigned* st) {
    XcdBarrier b; b.bar = bar; b.x = xb_xcc_id(); b.st = st;
    if (threadIdx.x == 0) (void)xb_add(&bar[XB_XCNT(b.x)], 1u);
    return b;
}
DI void xcd_barrier_complete(unsigned* bar, unsigned x, unsigned& nloc, unsigned& nx) {
    const unsigned G = gridDim.x * gridDim.y * gridDim.z;
    unsigned sum, cnt, mine, sp = 0u;
    for (;;) {
        sum = 0u; cnt = 0u; mine = 0u;
#pragma unroll
        for (unsigned j = 0; j < 16; ++j) { const unsigned c = xb_ld(&bar[XB_XCNT(j)]); sum += c; cnt += (c > 0u) ? 1u : 0u; mine = (j == x) ? c : mine; }
        if (sum == G) break;
        __builtin_amdgcn_s_sleep(1);
        if ((++sp & 255u) == 0u) { if (xb_ld(&bar[XB_TMO])) break; if (sp > XB_SPIN_CAP) { atomicAdd(&bar[XB_TMO], 1u); break; } }
    }
    nloc = mine > 0u ? mine : 1u; nx = cnt > 0u ? cnt : 1u;
}
DI void xcd_barrier(const XcdBarrier& b) {
    asm volatile("s_waitcnt vmcnt(0)" ::: "memory");
    __syncthreads();
    if (threadIdx.x == 0) {
        unsigned* bar = b.bar;
        __builtin_amdgcn_s_waitcnt(0);
        unsigned nloc = b.st[0], nx = b.st[1];
        if (nloc == 0u) { xcd_barrier_complete(bar, b.x, nloc, nx); b.st[0] = nloc; b.st[1] = nx; }
        const unsigned old = xb_add(&bar[XB_XSUB(b.x)], 1u);
        const unsigned gen = old / nloc;
        if (old + 1u == (gen + 1u) * nloc) {
            __builtin_amdgcn_fence(__ATOMIC_RELEASE, "agent");
            asm volatile("s_waitcnt vmcnt(0)" ::: "memory");
            const unsigned og = xb_add(&bar[XB_TOP], 1u);
            const unsigned tg = og / nx;
            if (og + 1u == (tg + 1u) * nx) xb_add(&bar[XB_TOPGEN], 1u);
            else XB_SPIN(xb_ld(&bar[XB_TOPGEN]) == tg, bar);
            __builtin_amdgcn_fence(__ATOMIC_ACQUIRE, "agent");
            xb_add(&bar[XB_XGEN(b.x)], 1u);
            asm volatile("s_waitcnt vmcnt(0)" ::: "memory");
        } else {
            XB_SPIN(xb_ld(&bar[XB_XGEN(b.x)]) == gen, bar);
            __builtin_amdgcn_fence(__ATOMIC_ACQUIRE, "agent");
            asm volatile("s_waitcnt vmcnt(0)" ::: "memory");
        }
    }
    __syncthreads();
}

struct Args {
    const float* in[35]; float* out; unsigned char* ws; int ph_lo, ph_hi;
};
enum { I_X = 0, I_C, I_CTX, I_CCTX,
       I0_WMOD, I0_BMOD, I0_WIN, I0_QN, I0_WUQ, I0_KVN, I0_WUKV, I0_WOUT, I0_LN1G, I0_LN1B, I0_WG, I0_WU, I0_WD, I0_LN2G, I0_LN2B,
       I1_WMOD, I1_BMOD, I1_WIN, I1_LQ1, I1_LK1, I1_LQ2, I1_LK2, I1_SUBLN, I1_WOUT, I1_LN1G, I1_LN1B, I1_WG, I1_WU, I1_WD, I1_LN2G, I1_LN2B };

DI bf16_t* tr_dst(int job, int n, unsigned char* ws) {
    switch (job) {
    case 0: return (bf16_t*)(ws + W_IN0) + (size_t)n * 1024;
    case 1: { const int hd = n / 96, d = n % 96; int row; if (d < 64) row = hd * 64 + d; else { const int e = d - 64, t = e >> 3, f = e & 7; row = 512 + hd * 32 + 16 * (t & 1) + 8 * (t >> 1) + f; }
              return (bf16_t*)(ws + W_UQ) + (size_t)row * 256; }
    case 2: { const int hd = n >> 7, d = n & 127; return d < 64 ? (bf16_t*)(ws + W_KN) + (size_t)(hd * 64 + d) * 256 : (bf16_t*)(ws + W_V0) + (size_t)(hd * 64 + d - 64) * 256; }
    case 3: return (bf16_t*)(ws + W_OUT0) + (size_t)n * 1024;
    case 4: return (bf16_t*)(ws + W_GU0) + (size_t)(256 * (n >> 7) + (n & 127)) * 1024;
    case 5: return (bf16_t*)(ws + W_GU0) + (size_t)(256 * (n >> 7) + 128 + (n & 127)) * 1024;
    case 6: return (bf16_t*)(ws + W_D0) + (size_t)n * 2816;
    case 7: return n < 2048 ? (bf16_t*)(ws + W_QK1) + (size_t)n * 1024 : (bf16_t*)(ws + W_V1) + (size_t)(n - 2048) * 1024;
    case 8: return (bf16_t*)(ws + W_OUT1) + (size_t)n * 1024;
    case 9: return (bf16_t*)(ws + W_GU1) + (size_t)(256 * (n >> 7) + (n & 127)) * 1024;
    case 10: return (bf16_t*)(ws + W_GU1) + (size_t)(256 * (n >> 7) + 128 + (n & 127)) * 1024;
    default: return (bf16_t*)(ws + W_D1) + (size_t)n * 2816;
    }
}
DI void transpose_item(const float* W, int K, int N, int job, unsigned char* ws, LAS float* scr, int item, int lane) {
    const int nblk = N / 32, kb = item / nblk, nb = item % nblk, k0 = 64 * kb, n0 = 32 * nb;
#pragma unroll 8
    for (int i = 0; i < 32; ++i) { const int kk = 2 * i + (lane >> 5); scr[kk * 33 + (lane & 31)] = W[(size_t)(k0 + kk) * N + n0 + (lane & 31)]; }
    asm volatile("s_waitcnt lgkmcnt(0)" ::: "memory");
    const int c = lane & 7;
#pragma unroll
    for (int j = 0; j < 4; ++j) { const int n = (lane >> 3) + 8 * j; const LAS float* s = scr + (8 * c) * 33 + n;
        u32x4 o; o.x = cvtpk(s[0 * 33], s[1 * 33]); o.y = cvtpk(s[2 * 33], s[3 * 33]); o.z = cvtpk(s[4 * 33], s[5 * 33]); o.w = cvtpk(s[6 * 33], s[7 * 33]);
        bf16_t* dst = tr_dst(job, n0 + n, ws); *(u32x4*)(dst + k0 + 8 * c) = o; }
    asm volatile("s_waitcnt lgkmcnt(0)" ::: "memory");
}

DI void prologue(const Args& a, LAS unsigned char* lds) {
    unsigned char* ws = a.ws;
    const int tid = otid(), lane = tid & 63, wave = tid >> 6;
    const int G = gridDim.x, gw = blockIdx.x * 8 + wave, NGW = G * 8;
    const long gt = (long)blockIdx.x * 512 + tid, NGT = (long)G * 512;
    {
        LAS float* scr = (LAS float*)(lds + wave * 16384);
        const int jin[12] = {I0_WIN, I0_WUQ, I0_WUKV, I0_WOUT, I0_WG, I0_WU, I0_WD, I1_WIN, I1_WOUT, I1_WG, I1_WU, I1_WD};
        const int jK[12] = {1024, 256, 256, 1024, 1024, 1024, 2816, 1024, 1024, 1024, 1024, 2816};
        const int jN[12] = {1056, 768, 1024, 1024, 2816, 2816, 1024, 3072, 1024, 2816, 2816, 1024};
        int base = 0;
#pragma unroll
        for (int j = 0; j < 12; ++j) { const int items = (jK[j] / 64) * (jN[j] / 32);
            for (int it = gw; it < items; it += NGW) transpose_item(a.in[jin[j]], jK[j], jN[j], j, ws, scr, it, lane);
            base += items; }
        u32x4 z = {0u, 0u, 0u, 0u};
        for (long i = gt; i < (1280 - 1056) * 1024 / 8; i += NGT) ((u32x4*)((bf16_t*)(ws + W_IN0) + (size_t)1056 * 1024))[i] = z;
    }
    {
        const float sc = 0.011048543456039806f;
        for (long i = gt; i < (long)4 * 2 * 1024 * 256; i += NGT) { const long idx = i * 8; const int n0 = (int)(idx & 2047), kq = (int)(idx >> 11) & 1023, part = (int)(idx >> 21) & 1, rr = (int)(idx >> 22); const int k = 4 * kq + rr; float v[8];
#pragma unroll
            for (int e = 0; e < 8; ++e) { const float ph = (float)((k * (n0 + e)) & 8191) * (1.0f / 8192.0f); v[e] = (part ? __builtin_amdgcn_sinf(ph) : __builtin_amdgcn_cosf(ph)) * ((part && rr == 3) ? -sc : sc); }
            u32x4 o; o.x = cvtpk(v[0], v[1]); o.y = cvtpk(v[2], v[3]); o.z = cvtpk(v[4], v[5]); o.w = cvtpk(v[6], v[7]);
            *(u32x4*)((bf16_t*)(ws + WS_DN) + idx) = o; }
        for (long i = gt; i < 256 * 512; i += NGT) { const int k = (int)(i >> 9), c = (int)(i & 511), part = c >> 8, n = c & 255; const float ph = (float)((k * n) & 255) * (1.0f / 256.0f);
            const float v = (part ? __builtin_amdgcn_sinf(ph) : __builtin_amdgcn_cosf(ph)) * 0.0625f; ((bf16_t*)(ws + W_D256))[i] = (bf16_t)(cvtpk(v, 0.f) & 0xffffu); }
        for (long i = gt; i < 256 * 128; i += NGT) { const int rr = (int)(i >> 7), c = (int)(i & 127), part = rr >> 7, l = rr & 127; const float ph = (float)((l * c) & 127) * (1.0f / 128.0f);
            const float v = (part ? -__builtin_amdgcn_sinf(ph) : __builtin_amdgcn_cosf(ph)) * 0.08838834764831845f; ((bf16_t*)(ws + W_DC))[i] = (bf16_t)(cvtpk(v, 0.f) & 0xffffu); }
        for (long i = gt; i < 128 * 16; i += NGT) { const int pos = (int)(i >> 4), f = (int)(i & 15); const float inv = 1.0f / powf(10000.0f, (float)f / 16.0f); const float ang = (float)pos * inv;
            ((f32x2*)(ws + WS_TAB16))[i] = (f32x2){cosf(ang), sinf(ang)}; }
        for (long i = gt; i < 128 * 8; i += NGT) { const int pos = (int)(i >> 3), f = (int)(i & 7); const float inv = 1.0f / powf(10000.0f, (float)f / 8.0f); const float ang = (float)pos * inv;
            ((f32x2*)(ws + WS_TAB8))[i] = (f32x2){cosf(ang), sinf(ang)}; }
    }
    {
        LAS float* red = (LAS float*)lds;
        for (int it = blockIdx.x; it < 2 * 96; it += G) {
            __syncthreads();
            const int layer = it / 96, n = (it % 96) * 64 + lane; const float* w = a.in[layer ? I1_WMOD : I0_WMOD]; const float* bm = a.in[layer ? I1_BMOD : I0_BMOD];
            float acc[5] = {0.f, 0.f, 0.f, 0.f, 0.f};
            for (int kk = 0; kk < 128; ++kk) { const int k = wave * 128 + kk; const float wv = w[(size_t)k * 6144 + n];
#pragma unroll
                for (int cls = 0; cls < 5; ++cls) { const float cv = cls < 4 ? a.in[I_C][cls * 1024 + k] : a.in[I_CCTX][k]; const float sl = cv / (1.0f + __expf(-cv)); acc[cls] += sl * wv; } }
#pragma unroll
            for (int cls = 0; cls < 5; ++cls) red[(wave * 5 + cls) * 64 + lane] = acc[cls];
            __syncthreads();
            if (tid < 320) { const int cls = tid >> 6, l = tid & 63; float s = 0.f;
#pragma unroll
                for (int w8 = 0; w8 < 8; ++w8) s += red[(w8 * 5 + cls) * 64 + l];
                const int nn = (it % 96) * 64 + l; ((float*)(ws + WS_MOD))[(size_t)(layer * 5 + cls) * 6144 + nn] = s + bm[nn]; }
        }
        __syncthreads();
    }
}

struct RowPass {
    const float* xl; const float* xc;
    float* ol; float* oc;
    const bf16_t* Y;
    const float* mod;
    int gate_off; const float* lng; const float* lnb;
    const float* mod2; int sc_off, sh_off;
    bf16_t* H;
    int skipctx;
};
DI void ln_stats(const f32x4 (&v)[4], float& mean, float& rstd) {
    float s = 0.f;
#pragma unroll
    for (int j = 0; j < 4; ++j) s += (v[j][0] + v[j][1]) + (v[j][2] + v[j][3]);
    mean = wave_sum(s) * (1.0f / DM); float q = 0.f;
#pragma unroll
    for (int j = 0; j < 4; ++j) { const f32x4 d = v[j] - mean; q += (d[0] * d[0] + d[1] * d[1]) + (d[2] * d[2] + d[3] * d[3]); }
    rstd = 1.0f / sqrtf(wave_sum(q) * (1.0f / DM) + LN_EPS);
}
DI void row_pass(const RowPass& P, int m, int lane) {
    const int b = m / TPB, j = m % TPB; const bool isctx = j < CTX; const int cls = isctx ? 4 : b;
    if (P.skipctx && isctx) return;
    const size_t xoff = isctx ? (size_t)(b * CTX + j) * DM : (size_t)(b * SEQ + j - CTX) * DM;
    const float* xs = (isctx ? P.xc : P.xl) + xoff; float* xd = isctx ? P.oc : P.ol;
    f32x4 v[4];
#pragma unroll
    for (int jj = 0; jj < 4; ++jj) v[jj] = *(const f32x4*)(xs + 4 * lane + 256 * jj);
    if (P.Y) {
        const float* gate = P.mod + (size_t)cls * 6144 + P.gate_off;
#pragma unroll
        for (int jj = 0; jj < 4; ++jj) { const int c0 = 4 * lane + 256 * jj; const u32x2 yw = *(const u32x2*)(P.Y + (size_t)m * DM + c0); const f32x4 g = *(const f32x4*)(gate + c0);
            v[jj][0] = DN_ALPHA * v[jj][0] + g[0] * bflo(yw.x); v[jj][1] = DN_ALPHA * v[jj][1] + g[1] * bfhi(yw.x);
            v[jj][2] = DN_ALPHA * v[jj][2] + g[2] * bflo(yw.y); v[jj][3] = DN_ALPHA * v[jj][3] + g[3] * bfhi(yw.y); }
        float mean, rstd; ln_stats(v, mean, rstd);
#pragma unroll
        for (int jj = 0; jj < 4; ++jj) { const int c0 = 4 * lane + 256 * jj; const f32x4 g = *(const f32x4*)(P.lng + c0), bb = *(const f32x4*)(P.lnb + c0); v[jj] = (v[jj] - mean) * rstd * g + bb; }
        if (xd) {
#pragma unroll
            for (int jj = 0; jj < 4; ++jj) *(f32x4*)(xd + xoff + 4 * lane + 256 * jj) = v[jj];
        }
    }
    if (P.H) {
        float mean, rstd; ln_stats(v, mean, rstd);
        const float* sc = P.mod2 + (size_t)cls * 6144 + P.sc_off; const float* sh = P.mod2 + (size_t)cls * 6144 + P.sh_off;
#pragma unroll
        for (int jj = 0; jj < 4; ++jj) { const int c0 = 4 * lane + 256 * jj; const f32x4 s1 = *(const f32x4*)(sc + c0), s0 = *(const f32x4*)(sh + c0);
            const f32x4 hh = (v[jj] - mean) * rstd * (s1 + 1.0f) + s0; u32x2 w; w.x = cvtpk(hh[0], hh[1]); w.y = cvtpk(hh[2], hh[3]);
            *(u32x2*)(P.H + (size_t)m * DM + c0) = w; }
    }
}
DI void p3_row(const Args& a, int m, int lane) {
    unsigned char* ws = a.ws; const bf16_t* U = (const bf16_t*)(ws + WS_R3) + (size_t)m * 1280;
    const u32x2 qw = *(const u32x2*)(U + 512 + 4 * lane), kw = *(const u32x2*)(U + 768 + 4 * lane);
    float q[4] = {bflo(qw.x), bfhi(qw.x), bflo(qw.y), bfhi(qw.y)}, k[4] = {bflo(kw.x), bfhi(kw.x), bflo(kw.y), bfhi(kw.y)};
    const float qs = wave_sum(q[0] * q[0] + q[1] * q[1] + q[2] * q[2] + q[3] * q[3]), ks = wave_sum(k[0] * k[0] + k[1] * k[1] + k[2] * k[2] + k[3] * k[3]);
    const float qr = 1.0f / sqrtf(qs * (1.0f / 256.0f) + RMS_EPS), kr_ = 1.0f / sqrtf(ks * (1.0f / 256.0f) + RMS_EPS);
    const f32x4 qg = *(const f32x4*)(a.in[I0_QN] + 4 * lane), kg = *(const f32x4*)(a.in[I0_KVN] + 4 * lane);
    u32x2 w; w.x = cvtpk(q[0] * qr * qg[0], q[1] * qr * qg[1]); w.y = cvtpk(q[2] * qr * qg[2], q[3] * qr * qg[3]);
    *(u32x2*)((bf16_t*)(ws + WS_CQN) + (size_t)m * 256 + 4 * lane) = w;
    w.x = cvtpk(k[0] * kr_ * kg[0], k[1] * kr_ * kg[1]); w.y = cvtpk(k[2] * kr_ * kg[2], k[3] * kr_ * kg[3]);
    *(u32x2*)((bf16_t*)(ws + WS_CKVN) + (size_t)m * 256 + 4 * lane) = w;
    const int d = lane & 31, t = d >> 3, f = d & 7; const float val = bf2f(U[1024 + d]); const float par = __shfl_xor(val, 8);
    const int j = m % TPB, tt = j - CTX; float outv = val;
    if (tt >= 0) { const int pos = (t < 2) ? (tt >> 6) : (tt & 63); const f32x2 cs = ((const f32x2*)(ws + WS_TAB8))[pos * 8 + f];
        outv = (t & 1) ? (par * cs[1] + val * cs[0]) : (val * cs[0] - par * cs[1]); }
    if (lane < 32) ((bf16_t*)(ws + WS_KR))[(size_t)m * 32 + 16 * (t & 1) + 8 * (t >> 1) + f] = (bf16_t)(cvtpk(outv, 0.f) & 0xffffu);
}

DI void fold_items(const Args& a, int gw, int NGW, int lane) {
    unsigned char* ws = a.ws; const bf16_t* At = (const bf16_t*)(ws + WS_R2); bf16_t* At4 = (bf16_t*)(ws + WS_AT4);
    for (int it = gw; it < 512 * NB; it += NGW) { const int gl = it >> 2, b = it & 3;
        const bf16_t* sx = At + (size_t)gl * ROWS + b * TPB + CTX; const bf16_t* sy = sx + (size_t)512 * ROWS;
        for (int i = 0; i < 4; ++i) { const int n = (i * 64 + lane) * 8; u32x4 xw[4], yw[4];
#pragma unroll
            for (int j = 0; j < 4; ++j) { xw[j] = *(const u32x4*)(sx + n + 2048 * j); yw[j] = *(const u32x4*)(sy + n + 2048 * j); }
            u32x4 o[4][2];
#pragma unroll
            for (int q = 0; q < 4; ++q) {
                float cr[4][2], ci[4][2];
#pragma unroll
                for (int e = 0; e < 2; ++e) { float x[4], y[4];
#pragma unroll
                    for (int j = 0; j < 4; ++j) { x[j] = e ? bfhi(xw[j][q]) : bflo(xw[j][q]); y[j] = e ? bfhi(yw[j][q]) : bflo(yw[j][q]); }
                    const float sx02 = x[0] + x[2], dx02 = x[0] - x[2], sx13 = x[1] + x[3], dx13 = x[1] - x[3];
                    const float sy02 = y[0] + y[2], dy02 = y[0] - y[2], sy13 = y[1] + y[3], dy13 = y[1] - y[3];
                    cr[0][e] = sx02 + sx13; ci[0][e] = sy02 + sy13;
                    cr[1][e] = dx02; ci[1][e] = -dx13;
                    cr[2][e] = sx02 - sx13; ci[2][e] = sy02 - sy13;
                    cr[3][e] = dy13; ci[3][e] = dy02; }
#pragma unroll
                for (int r = 0; r < 4; ++r) { o[r][0][q] = cvtpk(cr[r][0], cr[r][1]); o[r][1][q] = cvtpk(ci[r][0], ci[r][1]); }
            }
#pragma unroll
            for (int r = 0; r < 4; ++r)
#pragma unroll
                for (int p = 0; p < 2; ++p) *(u32x4*)(At4 + ((size_t)((r * 2 + p) * 512 + gl)) * 8192 + b * 2048 + n) = o[r][p];
        }
    }
}
DI void mirror_items(const Args& a, int gw, int NGW, int lane) {
    unsigned char* ws = a.ws; bf16_t* MIX = (bf16_t*)(ws + WS_R3); const bf16_t* At = (const bf16_t*)(ws + WS_R2);
    for (int it = gw; it < NB * 512; it += NGW) { const int b = it >> 9, ch = it & 511; const bf16_t* src = (const bf16_t*)(ws + WS_AT4) + (size_t)ch * 8192 + b * 2048; float s = 0.f;
        for (int i = 0; i < 4; ++i) { const u32x4 w = *(const u32x4*)(src + (i * 64 + lane) * 8);
            s += (bflo(w.x) - bfhi(w.x)) + (bflo(w.y) - bfhi(w.y)) + (bflo(w.z) - bfhi(w.z)) + (bflo(w.w) - bfhi(w.w)); }
        s = wave_sum(s) * 0.011048543456039806f;
        if (lane == 0) MIX[(size_t)(b * TPB + CTX + 4096) * DM + ch] = (bf16_t)(cvtpk(s, 0.f) & 0xffffu); }
    const bf16_t* PS = (const bf16_t*)(ws + WS_PS);
    for (int it = gw; it < NB * 4096; it += NGW) { const int b = it >> 12, k = it & 4095;
        bf16_t* src = MIX + (size_t)(b * TPB + CTX + k) * DM + 8 * lane; const u32x4 pc = *(const u32x4*)src; const u32x4 ps = *(const u32x4*)(PS + ((size_t)(b * 4096 + k)) * 512 + 8 * lane);
        u32x4 sm, df;
        sm.x = cvtpk(bflo(pc.x) + bflo(ps.x), bfhi(pc.x) + bfhi(ps.x)); df.x = cvtpk(bflo(pc.x) - bflo(ps.x), bfhi(pc.x) - bfhi(ps.x));
        sm.y = cvtpk(bflo(pc.y) + bflo(ps.y), bfhi(pc.y) + bfhi(ps.y)); df.y = cvtpk(bflo(pc.y) - bflo(ps.y), bfhi(pc.y) - bfhi(ps.y));
        sm.z = cvtpk(bflo(pc.z) + bflo(ps.z), bfhi(pc.z) + bfhi(ps.z)); df.z = cvtpk(bflo(pc.z) - bflo(ps.z), bfhi(pc.z) - bfhi(ps.z));
        sm.w = cvtpk(bflo(pc.w) + bflo(ps.w), bfhi(pc.w) + bfhi(ps.w)); df.w = cvtpk(bflo(pc.w) - bflo(ps.w), bfhi(pc.w) - bfhi(ps.w));
        *(u32x4*)src = sm;
        if (k >= 1) *(u32x4*)(MIX + (size_t)(b * TPB + CTX + 8192 - k) * DM + 8 * lane) = df; }
}

DI bool attn_unit_map(int L, int nunits_big, int& bh, int& qb) {
    if (L < nunits_big) { const int i = L >> 8, c = L & 255; bh = 4 * (c & 7) + i; qb = 1 + (c >> 3); return true; }
    bh = L - nunits_big; qb = 0; return bh < 32;
}
DI void attn_mla_unit(const Args& a, LAS unsigned char* lds, int bh, int qb) {
    unsigned char* ws = a.ws; const int tid = otid(), lane = tid & 63, wave = tid >> 6, r = lane & 31, h = lane >> 5;
    const int b = bh >> 3, hd = bh & 7; const int m = b * TPB + qb * 256 + wave * 32 + r;
    const bf16_t* Q = (const bf16_t*)(ws + WS_Q) + (size_t)m * 768;
    const bf16_t* KN = (const bf16_t*)(ws + WS_KN) + (size_t)(b * TPB) * 512 + hd * 64;
    const bf16_t* KR = (const bf16_t*)(ws + WS_KR) + (size_t)(b * TPB) * 32;
    const bf16_t* VT = (const bf16_t*)(ws + WS_VT0) + (size_t)(hd * 64) * ROWS + b * TPB;
    f32x16 o[2]; float l;
    attn_core<64, 32, 64>(o, l, lds, Q + hd * 64, Q + 512 + hd * 32, KN, 512, KR, 32, VT, ROWS, qb == 0 ? CTX / 64 : TPB / 64);
    const float il = 1.0f / l; bf16_t* dst = (bf16_t*)(ws + WS_R3) + (size_t)m * DM + 512 + hd * 64;
#pragma unroll
    for (int blk = 0; blk < 2; ++blk)
#pragma unroll
        for (int g = 0; g < 4; ++g) { u32x2 w; w.x = cvtpk(o[blk][4 * g] * il, o[blk][4 * g + 1] * il); w.y = cvtpk(o[blk][4 * g + 2] * il, o[blk][4 * g + 3] * il);
            *(u32x2*)(dst + 32 * blk + 8 * g + 4 * h) = w; }
}
DI void attn_diff_unit(const Args& a, LAS unsigned char* lds, int bh, int qb, float lam) {
    unsigned char* ws = a.ws; const int tid = otid(), lane = tid & 63, wave = tid >> 6, r = lane & 31, h = lane >> 5;
    const int b = bh >> 3, hd = bh & 7; const int m = b * TPB + qb * 256 + wave * 32 + r;
    const bf16_t* QK = (const bf16_t*)(ws + WS_R3);
    const bf16_t* VT = (const bf16_t*)(ws + WS_VT1) + (size_t)(hd * 128) * ROWS + b * TPB;
    bf16_t* dst = (bf16_t*)(ws + WS_R2) + (size_t)m * DM + hd * 128;
    f32x16 o[4]; float l;
    {
        const bf16_t* q = QK + (size_t)m * 2048 + (hd * 2) * 64; const bf16_t* k = QK + (size_t)(b * TPB) * 2048 + 1024 + (hd * 2) * 64;
        attn_core<64, 0, 128>(o, l, lds, q, q, k, 2048, k, 2048, VT, ROWS, TPB / 64);
        const float il = 1.0f / l;
#pragma unroll
        for (int blk = 0; blk < 4; ++blk)
#pragma unroll
            for (int g = 0; g < 4; ++g) { u32x2 w; w.x = cvtpk(o[blk][4 * g] * il, o[blk][4 * g + 1] * il); w.y = cvtpk(o[blk][4 * g + 2] * il, o[blk][4 * g + 3] * il); *(u32x2*)(dst + 32 * blk + 8 * g + 4 * h) = w; }
    }
    {
        const bf16_t* q = QK + (size_t)m * 2048 + (hd * 2 + 1) * 64; const bf16_t* k = QK + (size_t)(b * TPB) * 2048 + 1024 + (hd * 2 + 1) * 64;
        attn_core<64, 0, 128>(o, l, lds, q, q, k, 2048, k, 2048, VT, ROWS, TPB / 64);
    }
    const float il = lam / l; float ss = 0.f;
#pragma unroll
    for (int blk = 0; blk < 4; ++blk)
#pragma unroll
        for (int g = 0; g < 4; ++g) { const u32x2 aw = *(const u32x2*)(dst + 32 * blk + 8 * g + 4 * h);
            const float x0 = bflo(aw.x) - o[blk][4 * g] * il, x1 = bfhi(aw.x) - o[blk][4 * g + 1] * il, x2 = bflo(aw.y) - o[blk][4 * g + 2] * il, x3 = bfhi(aw.y) - o[blk][4 * g + 3] * il;
            o[blk][4 * g] = x0; o[blk][4 * g + 1] = x1; o[blk][4 * g + 2] = x2; o[blk][4 * g + 3] = x3; ss += (x0 * x0 + x1 * x1) + (x2 * x2 + x3 * x3); }
    ss += __shfl_xor(ss, 32);
    const float rn = (1.0f - LAMBDA_INIT) / sqrtf(ss * (1.0f / 128.0f) + RMS_EPS);
    const float* sub = a.in[I1_SUBLN];
#pragma unroll
    for (int blk = 0; blk < 4; ++blk)
#pragma unroll
        for (int g = 0; g < 4; ++g) { const int d0 = 32 * blk + 8 * g + 4 * h; const f32x4 sg = *(const f32x4*)(sub + d0);
            u32x2 w; w.x = cvtpk(o[blk][4 * g] * rn * sg[0], o[blk][4 * g + 1] * rn * sg[1]); w.y = cvtpk(o[blk][4 * g + 2] * rn * sg[2], o[blk][4 * g + 3] * rn * sg[3]);
            *(u32x2*)(dst + d0) = w; }
}

constexpr int NPHASES = 19;
constexpr int LDS_BYTES = 147456;
struct GOp { int kind; pg8::Gemm g; bf16_t* O; int ldc, o_bs, ai_extra; float scale; int q_tiles, rope_from; };

DI bool get_gemm(int ph, int sub, const Args& a, GOp& op) {
    unsigned char* ws = a.ws;
    bf16_t* R2 = (bf16_t*)(ws + WS_R2); bf16_t* R3 = (bf16_t*)(ws + WS_R3);
    op.kind = 0; op.o_bs = 0; op.ai_extra = 0; op.scale = 1.0f; op.q_tiles = 0; op.rope_from = 0;
    pg8::Gemm& g = op.g; g.nB = 1; g.a_bs = 0; g.b_bs = 0; g.rot = 0; g.a_seg = 0; g.b_seg = 0; g.skipctx = 0;
#define SETK(k_) do { g.K = (k_); g.kseg = (k_) / 64; g.a_seg = (k_); g.b_seg = (k_); } while (0)
    switch (ph * 16 + sub) {
    case 2 * 16 + 0:
        g.A = R2; g.a_rs = 1024; g.nM = NRT; g.Bt = (const bf16_t*)(ws + W_IN0); g.b_rs = 1024; g.nN = 5; SETK(1024); op.O = R3; op.ldc = 1280; return true;
    case 3 * 16 + 0:
        g.A = (const bf16_t*)(ws + W_DC); g.a_rs = 128; g.nM = 1; g.Bt = R3; g.b_rs = 1280; g.nN = NRT; g.nB = 4; g.b_bs = 128; SETK(128);
        op.O = R2; op.ldc = ROWS; op.o_bs = 128 * ROWS; op.ai_extra = 384 * ROWS; return true;
    case 4 * 16 + 0:
        op.kind = 1; g.A = (const bf16_t*)(ws + WS_CQN); g.a_rs = 256; g.nM = NRT; g.Bt = (const bf16_t*)(ws + W_UQ); g.b_rs = 256; g.nN = 3; SETK(256);
        op.O = (bf16_t*)(ws + WS_Q); op.ldc = 768; op.scale = MLA_QSCALE; op.q_tiles = 3; op.rope_from = 2; return true;
    case 4 * 16 + 1:
        g.A = (const bf16_t*)(ws + WS_CKVN); g.a_rs = 256; g.nM = NRT; g.Bt = (const bf16_t*)(ws + W_KN); g.b_rs = 256; g.nN = 2; SETK(256); g.rot = 140;
        op.O = (bf16_t*)(ws + WS_KN); op.ldc = 512; return true;
    case 4 * 16 + 2:
        g.A = (const bf16_t*)(ws + W_V0); g.a_rs = 256; g.nM = 2; g.Bt = (const bf16_t*)(ws + WS_CKVN); g.b_rs = 256; g.nN = NRT; SETK(256); g.rot = 148;
        op.O = (bf16_t*)(ws + WS_VT0); op.ldc = ROWS; return true;
    case 4 * 16 + 3: case 4 * 16 + 4: case 4 * 16 + 5: case 4 * 16 + 6: case 4 * 16 + 7: case 4 * 16 + 8: case 4 * 16 + 9: case 4 * 16 + 10: {
        const int rp = sub - 3, rr = rp >> 1, part = rp & 1;
        g.a_rs = 2048; g.nM = 4; g.b_rs = 8192; g.nN = 2; g.nB = 4; g.b_bs = 2048;
        if ((rr & 1) == 0) {
            g.A = (const bf16_t*)(ws + WS_DN) + (size_t)rp * 1024 * 2048; g.Bt = (const bf16_t*)(ws + WS_AT4) + (size_t)rp * 512 * 8192; SETK(2048);
        } else {
            g.A = (const bf16_t*)(ws + WS_DN) + (size_t)(rr * 2) * 1024 * 2048; g.Bt = (const bf16_t*)(ws + WS_AT4) + (size_t)((part ? 3 : 1) * 2) * 512 * 8192;
            g.K = 4096; g.kseg = 32; g.a_seg = 1024 * 2048; g.b_seg = 512 * 8192; if (rr == 3 && part == 1) op.scale = -1.0f;
        }
        g.rot = (152 + 32 * rp) & 255;
        if (part == 0) { op.O = R3 + (size_t)(CTX + rr) * DM; op.ldc = 4 * DM; op.o_bs = TPB * DM; }
        else { op.O = (bf16_t*)(ws + WS_PS) + rr * 512; op.ldc = 4 * 512; op.o_bs = 4096 * 512; }
        return true; }
    case 4 * 16 + 11:
        g.A = (const bf16_t*)(ws + W_D256); g.a_rs = 512; g.nM = 1; g.Bt = R2; g.b_rs = ROWS; g.nN = 2; g.nB = 4; g.b_bs = TPB; g.K = 512; g.kseg = 4; g.a_seg = 256; g.b_seg = 512 * ROWS; g.rot = 0;
        op.O = R3; op.ldc = DM; op.o_bs = TPB * DM; return true;
    case 6 * 16 + 0:
        g.A = R3; g.a_rs = 1024; g.nM = NRT; g.Bt = (const bf16_t*)(ws + W_OUT0); g.b_rs = 1024; g.nN = 4; SETK(1024); op.O = (bf16_t*)(ws + WS_Y0); op.ldc = DM; return true;
    case 8 * 16 + 0: case 15 * 16 + 0:
        op.kind = 3; g.A = R2; g.a_rs = 1024; g.nM = (ph == 8 ? NRT : 128); g.skipctx = (ph != 8); g.Bt = (const bf16_t*)(ws + (ph == 8 ? W_GU0 : W_GU1)); g.b_rs = 1024; g.nN = 22; SETK(1024); op.O = R3; op.ldc = FF; return true;
    case 9 * 16 + 0: case 16 * 16 + 0:
        g.A = R3; g.a_rs = FF; g.nM = (ph == 9 ? NRT : 128); g.skipctx = (ph != 9); g.Bt = (const bf16_t*)(ws + (ph == 9 ? W_D0 : W_D1)); g.b_rs = FF; g.nN = 4; SETK(FF); op.O = R2; op.ldc = DM; return true;
    case 11 * 16 + 0:
        op.kind = 2; g.A = R2; g.a_rs = 1024; g.nM = NRT; g.Bt = (const bf16_t*)(ws + W_QK1); g.b_rs = 1024; g.nN = 8; SETK(1024);
        op.O = R3; op.ldc = 2048; op.scale = DIFF_QSCALE; op.q_tiles = 4; op.rope_from = 0; return true;
    case 11 * 16 + 1:
        g.A = (const bf16_t*)(ws + W_V1); g.a_rs = 1024; g.nM = 4; g.Bt = R2; g.b_rs = 1024; g.nN = NRT; SETK(1024); g.rot = 32;
        op.O = (bf16_t*)(ws + WS_VT1); op.ldc = ROWS; return true;
    case 13 * 16 + 0:
        g.A = R2; g.a_rs = 1024; g.nM = 128; g.skipctx = 1; g.Bt = (const bf16_t*)(ws + W_OUT1); g.b_rs = 1024; g.nN = 4; SETK(1024); op.O = R3; op.ldc = DM; return true;
    default: return false;
    }
#undef SETK
}

DI bool get_rowpass(int ph, const Args& a, RowPass& P) {
    unsigned char* ws = a.ws; const float* MOD0 = (const float*)(ws + WS_MOD); const float* MOD1 = MOD0 + 5 * 6144;
    float* XC = (float*)(ws + WS_XC); bf16_t* R2 = (bf16_t*)(ws + WS_R2);
    switch (ph) {
    case 1:  P = RowPass{a.in[I_X], a.in[I_CTX], nullptr, nullptr, nullptr, MOD0, 0, nullptr, nullptr, MOD0, 1024, 0, R2, 0}; return true;
    case 7:  P = RowPass{a.in[I_X], a.in[I_CTX], a.out, XC, (const bf16_t*)(ws + WS_Y0), MOD0, 2048, a.in[I0_LN1G], a.in[I0_LN1B], MOD0, 4096, 3072, R2, 0}; return true;
    case 10: P = RowPass{a.out, XC, a.out, XC, R2, MOD0, 5120, a.in[I0_LN2G], a.in[I0_LN2B], MOD1, 1024, 0, R2, 0}; return true;
    case 14: P = RowPass{a.out, XC, a.out, XC, (const bf16_t*)(ws + WS_R3), MOD1, 2048, a.in[I1_LN1G], a.in[I1_LN1B], MOD1, 4096, 3072, R2, 1}; return true;
    case 17: P = RowPass{a.out, XC, a.out, XC, R2, MOD1, 5120, a.in[I1_LN2G], a.in[I1_LN2B], MOD1, 0, 0, nullptr, 1}; return true;
    default: return false;
    }
}

__global__ void __launch_bounds__(512, 2) fwd_kernel(Args a) {
    extern __shared__ __attribute__((aligned(16))) unsigned char lds_raw[];
    LAS unsigned char* lds = (LAS unsigned char*)lds_raw;
    const int G = gridDim.x;
    volatile LAS unsigned* bst = (volatile LAS unsigned*)(lds + LDS_BYTES - 64);
    if (threadIdx.x < 2) bst[threadIdx.x] = 0u;
    __syncthreads();
    XcdBarrier xbar = xcd_barrier_post((unsigned*)(a.ws + WS_BAR), bst);
    for (int pos = a.ph_lo; pos < a.ph_hi; ++pos) {
        const int ph = pos <= 3 ? pos : (pos == 4 ? 18 : pos - 1);
        const int tid = otid(), lane = tid & 63, wave = __builtin_amdgcn_readfirstlane(tid >> 6);
        const int gw = blockIdx.x * 8 + wave, NGW = G * 8;
#ifndef NO_PRO
        if (ph == 0) prologue(a, lds);
#endif
        RowPass P;
        if (get_rowpass(ph, a, P)) { for (int m = gw; m < ROWS; m += NGW) row_pass(P, m, lane); }
        if (ph == 3) { for (int m = gw; m < ROWS; m += NGW) p3_row(a, m, lane); }
        if (ph == 18) fold_items(a, gw, NGW, lane);
#ifndef NO_MLA
        if (ph == 5) {
            mirror_items(a, gw, NGW, lane);
            for (int L = blockIdx.x; ; L += G) { int bh, qb; if (!attn_unit_map(L, 1024, bh, qb)) break; attn_mla_unit(a, lds, bh, qb); }
        }
#endif
#ifndef NO_DIFF
        if (ph == 12) {
            const float p1 = wave_sum(a.in[I1_LQ1][lane] * a.in[I1_LK1][lane]), p2 = wave_sum(a.in[I1_LQ2][lane] * a.in[I1_LK2][lane]);
            const float lam = expf(p1) - expf(p2) + LAMBDA_INIT;
            for (int L = blockIdx.x; L < 1024; L += G) { int bh, qb; attn_unit_map(L, 1024, bh, qb); attn_diff_unit(a, lds, bh, qb, lam); }
        }
#endif
#ifndef NO_GEMM
        for (int sub = 0; sub < 16; ++sub) {
            GOp op; if (!get_gemm(ph, sub, a, op)) break;
            pg8::StaticOrder S; S.init(op.g.nM, op.g.nN, op.g.nB, G, (int)blockIdx.x, op.g.rot, op.g.skipctx);
            if (op.kind == 0) { pg8::EpiStore E{op.O, op.ldc, op.o_bs, op.ai_extra, op.scale}; pg8::gemm_phase(lds, op.g, S, E); }
            else if (op.kind == 1) { pg8::EpiRope<8> E{op.O, op.ldc, op.scale, op.q_tiles, op.rope_from, (const f32x2*)(a.ws + WS_TAB8)}; pg8::gemm_phase(lds, op.g, S, E); }
            else if (op.kind == 2) { pg8::EpiRope<16> E{op.O, op.ldc, op.scale, op.q_tiles, op.rope_from, (const f32x2*)(a.ws + WS_TAB16)}; pg8::gemm_phase(lds, op.g, S, E); }
            else { pg8::EpiSwiglu E{op.O, op.ldc}; pg8::gemm_phase(lds, op.g, S, E); }
        }
#endif
        if (pos + 1 < a.ph_hi) { if (pos == a.ph_lo) { __threadfence(); cg::this_grid().sync(); } else xcd_barrier(xbar); }
    }
}

extern "C" void kernel_launch(void* const* d_in, const int* in_sizes, int n_in, void* d_out, int out_size, void* d_ws, size_t ws_size, hipStream_t stream) {
    static int grid = 0;
    if (grid == 0) {
        if (n_in != 35 || ws_size < WS_END) { fprintf(stderr, "kernel_launch: unexpected n_in %d / ws %zu (need %zu)\n", n_in, ws_size, (size_t)WS_END); grid = -1; return; }
        int dev = 0, cus = 0, per_cu = 0;
        hipGetDevice(&dev); hipDeviceGetAttribute(&cus, hipDeviceAttributeMultiprocessorCount, dev);
        hipFuncSetAttribute((const void*)fwd_kernel, hipFuncAttributeMaxDynamicSharedMemorySize, LDS_BYTES);
        hipOccupancyMaxActiveBlocksPerMultiprocessor(&per_cu, (const void*)fwd_kernel, 512, LDS_BYTES);
        if (per_cu < 1) { fprintf(stderr, "kernel_launch: occupancy query says %d blocks/CU\n", per_cu); per_cu = 1; }
        (void)hipGetLastError();
        grid = cus * 1;
    }
    if (grid < 0) return;
    Args a{};
    for (int i = 0; i < 35; ++i) a.in[i] = (const float*)d_in[i];
    a.out = (float*)d_out; a.ws = (unsigned char*)d_ws;
#if MK_MULTI
    for (int ph = 0; ph < NPHASES; ++ph) { a.ph_lo = ph; a.ph_hi = ph + 1; hipLaunchKernelGGL(fwd_kernel, dim3(grid), dim3(512), LDS_BYTES, stream, a); }
#else
    a.ph_lo = 0; a.ph_hi = NPHASES;
    hipMemsetAsync((char*)d_ws + WS_BAR, 0, 16384, stream);
    void* args[] = {&a};
    hipError_t e = hipLaunchCooperativeKernel((const void*)fwd_kernel, dim3(grid), dim3(512), args, LDS_BYTES, stream);
    if (e != hipSuccess) fprintf(stderr, "cooperative launch failed: %s (grid %d)\n", hipGetErrorString(e), grid);
#endif
}
```

```cpp
#include <hip/hip_runtime.h>
#include <hip/hip_cooperative_groups.h>
#include <cstdio>
#include <cstdint>
namespace cg = cooperative_groups;

#ifndef MK_MULTI
#define MK_MULTI 0
#endif

#define DI __device__ __forceinline__
#define LAS __attribute__((address_space(3)))
typedef unsigned short bf16_t;
typedef short bf16x8 __attribute__((ext_vector_type(8)));
typedef float f32x4 __attribute__((ext_vector_type(4)));
typedef float f32x2 __attribute__((ext_vector_type(2)));
typedef float f32x16 __attribute__((ext_vector_type(16)));
typedef unsigned u32x4 __attribute__((ext_vector_type(4)));
typedef unsigned u32x2 __attribute__((ext_vector_type(2)));
typedef __bf16 bf16x2_t __attribute__((ext_vector_type(2)));

constexpr int DM = 1024, NB = 4, SEQ = 8192, CTX = 256, TPB = SEQ + CTX  , ROWS = NB * TPB  , FF = 2816;
constexpr int NRT = ROWS / 256;
constexpr float LN_EPS = 1e-6f, RMS_EPS = 1e-6f;
constexpr float DN_ALPHA = 1.41421356237f;
constexpr float LOG2E = 1.4426950408889634f;
constexpr float MLA_QSCALE = 0.10206207261596577f * LOG2E;
constexpr float DIFF_QSCALE = 0.125f * LOG2E;
constexpr float LAMBDA_INIT = 0.35550906f;

constexpr size_t MiB = 1u << 20;
constexpr size_t WS_MOD = 0;
constexpr size_t WS_TAB16 = 256 * 1024;
constexpr size_t WS_TAB8 = WS_TAB16 + 16384;
constexpr size_t WS_BAR = 512 * 1024;
constexpr size_t WS_XC = 1 * MiB;
constexpr size_t WS_W = 5 * MiB;
constexpr size_t W_IN0 = WS_W;
constexpr size_t W_UQ = W_IN0 + 1280 * 1024 * 2;
constexpr size_t W_KN = W_UQ + 768 * 256 * 2;
constexpr size_t W_V0 = W_KN + 512 * 256 * 2;
constexpr size_t W_OUT0 = W_V0 + 512 * 256 * 2;
constexpr size_t W_GU0 = W_OUT0 + 1024 * 1024 * 2;
constexpr size_t W_D0 = W_GU0 + 5632 * 1024 * 2;
constexpr size_t W_QK1 = W_D0 + 1024 * 2816 * 2;
constexpr size_t W_V1 = W_QK1 + 2048 * 1024 * 2;
constexpr size_t W_OUT1 = W_V1 + 1024 * 1024 * 2;
constexpr size_t W_GU1 = W_OUT1 + 1024 * 1024 * 2;
constexpr size_t W_D1 = W_GU1 + 5632 * 1024 * 2;
constexpr size_t W_DC = W_D1 + 1024 * 2816 * 2;
constexpr size_t W_D256 = W_DC + 256 * 128 * 2;
constexpr size_t W_END = W_D256 + 256 * 512 * 2;
static_assert(W_END <= 56 * MiB, "weights region");
constexpr size_t WS_DN = 56 * MiB;
constexpr size_t WS_AT4 = 88 * MiB;
constexpr size_t WS_R2 = 184 * MiB;
constexpr size_t WS_R3 = 250 * MiB;
constexpr size_t WS_R4 = WS_R3 + (size_t)ROWS * 1280 * 2;
constexpr size_t WS_CQN = WS_R4, WS_CKVN = WS_R4 + (size_t)ROWS * 256 * 2;
constexpr size_t WS_R5 = WS_R4 + (size_t)ROWS * 512 * 2;
constexpr size_t WS_Q = WS_R5;
constexpr size_t WS_KN = WS_Q + (size_t)ROWS * 768 * 2;
constexpr size_t WS_KR = WS_KN + (size_t)ROWS * 512 * 2;
constexpr size_t WS_VT0 = WS_KR + (size_t)ROWS * 32 * 2;
constexpr size_t WS_END = WS_VT0 + (size_t)512 * ROWS * 2;
constexpr size_t WS_Y0 = WS_R5;
constexpr size_t WS_PS = WS_R3 + (size_t)ROWS * DM * 2;
static_assert(WS_PS + (size_t)4 * 4096 * 512 * 2 <= WS_R4, "ps");
constexpr size_t WS_VT1 = WS_R3 + (size_t)ROWS * 2048 * 2;
static_assert(WS_END <= 512 * MiB, "workspace");
static_assert(WS_VT1 + (size_t)1024 * ROWS * 2 <= WS_END, "vt1");
static_assert(WS_R3 + (size_t)ROWS * FF * 2 <= WS_END, "hid");

DI int otid() { int t = threadIdx.x; asm volatile("" : "+v"(t)); return t; }
DI float wave_sum(float v) {
#pragma unroll
    for (int o = 1; o < 64; o <<= 1) v += __shfl_xor(v, o);
    return v;
}
DI unsigned cvtpk(float lo, float hi) { f32x2 v = {lo, hi}; bf16x2_t b = __builtin_convertvector(v, bf16x2_t); return __builtin_bit_cast(unsigned, b); }
DI float bf2f(unsigned short b) { return __uint_as_float(((unsigned)b) << 16); }
DI float bflo(unsigned w) { return __uint_as_float(w << 16); }
DI float bfhi(unsigned w) { return __uint_as_float(w & 0xffff0000u); }

namespace pg8 {
constexpr int BM = 256, BK = 64, HALF = 128, HTB = HALF * BK * 2, STAGE_BYTES = 8 * HTB, NXCD = 8, WGM = 8;
__host__ __device__ __forceinline__ int lds_byte(int r, int c) { const int st = (r >> 4) * 2 + (c >> 5), rr = r & 15, cc = c & 31, ob = rr * 64 + cc * 2; return st * 1024 + (ob ^ (((ob >> 9) & 1) << 5)); }
__host__ __device__ __forceinline__ void stage_rc(int b, int& R, int& C) { const int st = b / 1024, sb = b % 1024, swz = sb ^ (((sb >> 9) & 1) << 5); R = (st >> 1) * 16 + swz / 64; C = (st & 1) * 32 + (swz % 64) / 2; }
__host__ __device__ __forceinline__ int perm32(int rho) { const int n = rho >> 4, i = rho & 15; return 8 * (i >> 2) + 4 * n + (i & 3); }

struct Unit { int pm, pn, pb; };
struct Gemm {
    const bf16_t* A; const bf16_t* Bt; int nM, nN, nB, K, kseg;
    int a_rs, b_rs, a_seg, b_seg, a_bs, b_bs;
    int rot, skipctx;
};
struct StaticOrder {
    int nM, nN, nwg, tot, G, c, skipctx;
    DI void init(int nM_, int nN_, int nB_, int G_, int c_, int rot, int skip) { skipctx = skip; nM = nM_; nN = nN_; nwg = nM * nN; tot = nwg * nB_; G = G_; c = (c_ + G_ - (rot % G_)) % G_; }
    DI bool next(int i, Unit& u) const {
        const long L = (long)i * G + c; if (L >= tot) return false;
        u.pb = (int)(L / nwg); int wgid = (int)(L % nwg);
        { const int q = nwg / NXCD, r = nwg % NXCD, xcd = wgid % NXCD, off = wgid / NXCD; wgid = (xcd < r ? xcd * (q + 1) : r * (q + 1) + (xcd - r) * q) + off; }
        const int nig = WGM * nN, gid = wgid / nig, fm = gid * WGM, gsz = (nM - fm) < WGM ? (nM - fm) : WGM;
        u.pm = fm + ((wgid % nig) % gsz); u.pn = (wgid % nig) / gsz; if (skipctx) u.pm += (u.pm >> 5) + 1; return true;
    }
};

struct EpiStore {
    static constexpr bool PERM = true;
    bf16_t* O; int ldc, o_bs, ai_extra; float scale;
    DI void operator()(const f32x4 (&acc)[2][2][4][2], const Unit& u, int wr, int wc, int fr, int fq) const {
        const int row0 = u.pm * BM + wr * 64 + fr, col0 = u.pn * BM + wc * 32 + 8 * fq;
        bf16_t* base = O + (size_t)u.pb * o_bs;
#pragma unroll
        for (int ai = 0; ai < 2; ++ai)
#pragma unroll
            for (int m = 0; m < 4; ++m) { bf16_t* rowp = base + (size_t)(row0 + ai * HALF + m * 16) * ldc + (size_t)ai * ai_extra + col0;
#pragma unroll
                for (int bj = 0; bj < 2; ++bj) { const f32x4 v0 = acc[ai][bj][m][0] * scale, v1 = acc[ai][bj][m][1] * scale;
                    u32x4 w; w.x = cvtpk(v0[0], v0[1]); w.y = cvtpk(v0[2], v0[3]); w.z = cvtpk(v1[0], v1[1]); w.w = cvtpk(v1[2], v1[3]);
                    *(u32x4*)(rowp + bj * HALF) = w; } }
    }
};
struct EpiSwiglu {
    static constexpr bool PERM = true;
    bf16_t* O; int ldc;
    DI void operator()(const f32x4 (&acc)[2][2][4][2], const Unit& u, int wr, int wc, int fr, int fq) const {
        const int row0 = u.pm * BM + wr * 64 + fr, col0 = u.pn * HALF + wc * 32 + 8 * fq;
#pragma unroll
        for (int ai = 0; ai < 2; ++ai)
#pragma unroll
            for (int m = 0; m < 4; ++m) { bf16_t* rowp = O + (size_t)(row0 + ai * HALF + m * 16) * ldc + col0; float h[8];
#pragma unroll
                for (int n = 0; n < 2; ++n)
#pragma unroll
                    for (int i = 0; i < 4; ++i) { const float g = acc[ai][0][m][n][i], up = acc[ai][1][m][n][i];
                        h[n * 4 + i] = g * __builtin_amdgcn_rcpf(1.0f + __builtin_amdgcn_exp2f(-g * LOG2E)) * up; }
                u32x4 w; w.x = cvtpk(h[0], h[1]); w.y = cvtpk(h[2], h[3]); w.z = cvtpk(h[4], h[5]); w.w = cvtpk(h[6], h[7]);
                *(u32x4*)rowp = w; }
    }
};
template <int MODE> struct EpiRope {
    static constexpr bool PERM = false;
    bf16_t* O; int ldc; float qscale; int q_tiles, rope_from; const f32x2* tab;
    DI void operator()(const f32x4 (&acc)[2][2][4][2], const Unit& u, int wr, int wc, int fr, int fq) const {
        const float sc = u.pn < q_tiles ? qscale : 1.0f; const bool rope_tile = u.pn >= rope_from;
        const int col0 = u.pn * BM + wc * 32 + 4 * fq;
#pragma unroll
        for (int ai = 0; ai < 2; ++ai)
#pragma unroll
            for (int m = 0; m < 4; ++m) {
                const int row = u.pm * BM + ai * HALF + wr * 64 + m * 16 + fr; const int j = row % TPB; const int t = j - CTX;
                f32x4 cs0 = {1.f, 0.f, 1.f, 0.f}, cs1 = {1.f, 0.f, 1.f, 0.f};
                if (rope_tile && t >= 0) {
                    int pos, f0;
                    if (MODE == 16) { pos = (wc & 1) ? (t & 63) : (t >> 6); f0 = 4 * fq; } else { pos = (fq >> 1) ? (t & 63) : (t >> 6); f0 = 4 * (fq & 1); }
                    const f32x4* tp = (const f32x4*)(tab + pos * MODE + f0); cs0 = tp[0]; cs1 = tp[1];
                }
                const float c[4] = {cs0[0], cs0[2], cs1[0], cs1[2]}, s[4] = {cs0[1], cs0[3], cs1[1], cs1[3]};
                bf16_t* rowp = O + (size_t)row * ldc + col0;
#pragma unroll
                for (int bj = 0; bj < 2; ++bj) { const f32x4 x1 = acc[ai][bj][m][0] * sc, x2 = acc[ai][bj][m][1] * sc; float o1[4], o2[4];
#pragma unroll
                    for (int i = 0; i < 4; ++i) { o1[i] = x1[i] * c[i] - x2[i] * s[i]; o2[i] = x1[i] * s[i] + x2[i] * c[i]; }
                    u32x2 w1, w2; w1.x = cvtpk(o1[0], o1[1]); w1.y = cvtpk(o1[2], o1[3]); w2.x = cvtpk(o2[0], o2[1]); w2.y = cvtpk(o2[2], o2[3]);
                    *(u32x2*)(rowp + bj * HALF) = w1; *(u32x2*)(rowp + bj * HALF + 16) = w2; }
            }
    }
};

template <class Epi>
DI void gemm_phase(LAS unsigned char* lds, const Gemm g, const StaticOrder& S, const Epi& E) {
    const int tid = otid(), wid = __builtin_amdgcn_readfirstlane(tid >> 6), lane = tid & 63, wr = wid >> 2, wc = wid & 3, fr = lane & 15, fq = lane >> 4;
    const int nt = g.K / BK, kseg = g.kseg;
    unsigned voffA[2], voffB[2];
#pragma unroll
    for (int i = 0; i < 2; ++i) { int R, C; stage_rc(tid * 16 + i * 8192, R, C); const int Rb = Epi::PERM ? ((R & ~31) + perm32(R & 31)) : R;
        voffA[i] = (unsigned)(R * g.a_rs + C) * 2u; voffB[i] = (unsigned)(Rb * g.b_rs + C) * 2u; }
    const int kstep = BK * 2;
    const unsigned hstepA = (unsigned)HALF * g.a_rs * 2, hstepB = (unsigned)HALF * g.b_rs * 2;
    const unsigned tstepA = 2 * hstepA, tstepB = 2 * hstepB;
    const int segA = (g.a_seg - kseg * BK) * 2, segB = (g.b_seg - kseg * BK) * 2;
#define OFFA(t) ((t) * kstep + ((t) >= kseg ? segA : 0))
#define OFFB(t) ((t) * kstep + ((t) >= kseg ? segB : 0))
    const unsigned ldsw = (unsigned)wid * 1024u;
    const int aoff = lds_byte(wr * 64 + fr, fq * 8), boff = lds_byte(wc * 32 + fr, fq * 8);
#define PG8_SA(b, h) (((b) * 2 + (h)) * HTB)
#define PG8_SB(b, h) ((4 + (b) * 2 + (h)) * HTB)
#define PG8_STAGE(bufoff, gbase, voff) do { _Pragma("unroll") for (int _i = 0; _i < 2; ++_i) \
        __builtin_amdgcn_global_load_lds((const unsigned*)((const char*)(gbase) + (voff)[_i]), (LAS unsigned*)(lds + (bufoff) + ldsw + _i * 8192), 16, 0, 0); } while (0)
#define PG8_LDA(dst, b, h) do { _Pragma("unroll") for (int m = 0; m < 4; ++m) _Pragma("unroll") for (int k = 0; k < 2; ++k) dst[m][k] = *(const LAS bf16x8*)(lds + PG8_SA(b, h) + aoff + m * 2048 + k * 1024); } while (0)
#define PG8_LDB(dst, b, h) do { _Pragma("unroll") for (int n = 0; n < 2; ++n) _Pragma("unroll") for (int k = 0; k < 2; ++k) dst[n][k] = *(const LAS bf16x8*)(lds + PG8_SB(b, h) + boff + n * 2048 + k * 1024); } while (0)
#define PG8_MMA(ai, bj, At, Bt) do { __builtin_amdgcn_s_setprio(1); _Pragma("unroll") for (int m = 0; m < 4; ++m) _Pragma("unroll") for (int n = 0; n < 2; ++n) _Pragma("unroll") for (int k = 0; k < 2; ++k) \
        acc[ai][bj][m][n] = __builtin_amdgcn_mfma_f32_16x16x32_bf16(Bt[n][k], At[m][k], acc[ai][bj][m][n], 0, 0, 0); __builtin_amdgcn_s_setprio(0); } while (0)
#define PG8_WAIT_V(n) asm volatile("s_waitcnt vmcnt(" #n ")" ::: "memory")
#define PG8_WAIT_L(n) asm volatile("s_waitcnt lgkmcnt(" #n ")" ::: "memory")
#define PG8_BAR __builtin_amdgcn_s_barrier()
#define PG8_SCHED __builtin_amdgcn_sched_barrier(0)
    Unit cur, nxt; int ui = 0;
    if (!S.next(0, cur)) return;
    f32x4 acc[2][2][4][2];
#pragma unroll
    for (int a = 0; a < 2; ++a)
#pragma unroll
        for (int b = 0; b < 2; ++b)
#pragma unroll
            for (int m = 0; m < 4; ++m)
#pragma unroll
                for (int n = 0; n < 2; ++n) acc[a][b][m][n] = (f32x4){0.f, 0.f, 0.f, 0.f};
    bf16x8 At[4][2], B0[2][2], B1[2][2];
    const char* cA = (const char*)g.A + ((size_t)cur.pb * g.a_bs) * 2 + (size_t)cur.pm * tstepA;
    const char* cB = (const char*)g.Bt + ((size_t)cur.pb * g.b_bs) * 2 + (size_t)cur.pn * tstepB;
    {
        PG8_STAGE(PG8_SB(0, 0), cB, voffB); PG8_STAGE(PG8_SB(0, 1), cB + hstepB, voffB); PG8_STAGE(PG8_SA(0, 0), cA, voffA); PG8_STAGE(PG8_SA(0, 1), cA + hstepA, voffA);
        if (wr == 1) PG8_BAR;
        PG8_WAIT_V(2); PG8_BAR;
        PG8_STAGE(PG8_SB(1, 0), cB + OFFB(1), voffB); PG8_STAGE(PG8_SA(1, 0), cA + OFFA(1), voffA); PG8_STAGE(PG8_SB(1, 1), cB + hstepB + OFFB(1), voffB);
        PG8_WAIT_V(6); PG8_BAR;
    }
    for (;;) {
        const bool has_next = S.next(ui + 1, nxt);
        const char* nA = has_next ? (const char*)g.A + ((size_t)nxt.pb * g.a_bs) * 2 + (size_t)nxt.pm * tstepA : cA;
        const char* nB = has_next ? (const char*)g.Bt + ((size_t)nxt.pb * g.b_bs) * 2 + (size_t)nxt.pn * tstepB : cB;
        for (int t = 0; t < nt; t += 2) {
            const bool last = (t == nt - 2);
            const char* a1 = cA + OFFA(t + 1);
            const char* a2 = last ? nA : cA + OFFA(t + 2); const char* b2 = last ? nB : cB + OFFB(t + 2);
            const char* a3 = last ? nA + OFFA(1) : cA + OFFA(t + 3); const char* b3 = last ? nB + OFFB(1) : cB + OFFB(t + 3);
            PG8_LDB(B0, 0, 0); PG8_LDB(B1, 0, 1); PG8_SCHED; PG8_LDA(At, 0, 0); PG8_STAGE(PG8_SA(1, 1), a1 + hstepA, voffA);
            PG8_WAIT_V(8); PG8_WAIT_L(0); PG8_BAR; PG8_MMA(0, 0, At, B0); PG8_MMA(0, 1, At, B1); PG8_BAR; PG8_SCHED;
            PG8_LDA(At, 0, 1); PG8_STAGE(PG8_SB(0, 0), b2, voffB); PG8_STAGE(PG8_SB(0, 1), b2 + hstepB, voffB); PG8_STAGE(PG8_SA(0, 0), a2, voffA);
            PG8_WAIT_V(8); PG8_WAIT_L(0); PG8_BAR; PG8_MMA(1, 0, At, B0); PG8_MMA(1, 1, At, B1); PG8_BAR; PG8_SCHED;
            PG8_LDB(B0, 1, 0); PG8_LDB(B1, 1, 1); PG8_SCHED; PG8_LDA(At, 1, 0); PG8_STAGE(PG8_SA(0, 1), a2 + hstepA, voffA);
            PG8_WAIT_V(8); PG8_WAIT_L(0); PG8_BAR; PG8_MMA(0, 0, At, B0); PG8_MMA(0, 1, At, B1); PG8_BAR; PG8_SCHED;
            PG8_LDA(At, 1, 1); PG8_STAGE(PG8_SB(1, 0), b3, voffB); PG8_STAGE(PG8_SB(1, 1), b3 + hstepB, voffB); PG8_STAGE(PG8_SA(1, 0), a3, voffA);
            PG8_WAIT_V(8); PG8_WAIT_L(0); PG8_BAR; PG8_MMA(1, 0, At, B0); PG8_MMA(1, 1, At, B1); PG8_BAR; PG8_SCHED;
        }
        if (wr == 0) PG8_BAR;
        E(acc, cur, wr, wc, fr, fq);
        if (!has_next) break;
#pragma unroll
        for (int a = 0; a < 2; ++a)
#pragma unroll
            for (int b = 0; b < 2; ++b)
#pragma unroll
                for (int m = 0; m < 4; ++m)
#pragma unroll
                    for (int n = 0; n < 2; ++n) acc[a][b][m][n] = (f32x4){0.f, 0.f, 0.f, 0.f};
        cur = nxt; cA = nA; cB = nB; ++ui;
        if (wr == 1) PG8_BAR;
    }
    PG8_WAIT_V(0);
    PG8_BAR;
#undef OFFA
#undef OFFB
#undef PG8_SA
#undef PG8_SB
#undef PG8_STAGE
#undef PG8_LDA
#undef PG8_LDB
#undef PG8_MMA
#undef PG8_WAIT_V
#undef PG8_WAIT_L
#undef PG8_BAR
#undef PG8_SCHED
}
}

#define MFMA32(a, b, c) __builtin_amdgcn_mfma_f32_32x32x16_bf16((a), (b), (c), 0, 0, 0)
template <int D1, int D2, int DV>
DI void attn_core(f32x16 (&o)[DV / 32], float& l_out, LAS unsigned char* lds, const bf16_t* q1, const bf16_t* q2,
                  const bf16_t* k1, long ldk1, const bf16_t* k2, long ldk2, const bf16_t* vt, long ldv, int ntiles) {
    constexpr int DQK = D1 + D2, KROW = DQK * 2 + 16, VROW = 144, KT = 64 * KROW, VT = DV * VROW, BUF = KT + VT;
    constexpr int KCH = DQK / 8, NKC = 64 * KCH, NVC = DV * 8, KPT = (NKC + 511) / 512, VPT = NVC / 512;
    const int tid = otid(), lane = tid & 63, r = lane & 31, h = lane >> 5;
    bf16x8 qf[DQK / 16];
#pragma unroll
    for (int d0 = 0; d0 < DQK / 16; ++d0) qf[d0] = (16 * d0 < D1) ? *(const bf16x8*)(q1 + 16 * d0 + 8 * h) : *(const bf16x8*)(q2 + (16 * d0 - D1) + 8 * h);
    u32x4 kreg[KPT], vreg[VPT];
    auto gload = [&](int t) {
#pragma unroll
        for (int i = 0; i < KPT; ++i) { const int c = tid + i * 512; if (c < NKC) { const int row = c / KCH, cc = (c % KCH) * 8;
            kreg[i] = (cc < D1) ? *(const u32x4*)(k1 + (size_t)(t * 64 + row) * ldk1 + cc) : *(const u32x4*)(k2 + (size_t)(t * 64 + row) * ldk2 + (cc - D1)); } }
#pragma unroll
        for (int i = 0; i < VPT; ++i) { const int c = tid + i * 512; const int d = c >> 3, cc = (c & 7) * 8; vreg[i] = *(const u32x4*)(vt + (size_t)d * ldv + t * 64 + cc); }
    };
    auto sstore = [&](int b) {
        LAS unsigned char* kb = lds + b * BUF; LAS unsigned char* vb = kb + KT;
#pragma unroll
        for (int i = 0; i < KPT; ++i) { const int c = tid + i * 512; if (c < NKC) { const int row = c / KCH, cc = (c % KCH) * 8; *(LAS u32x4*)(kb + row * KROW + cc * 2) = kreg[i]; } }
#pragma unroll
        for (int i = 0; i < VPT; ++i) { const int c = tid + i * 512; const int d = c >> 3, cc = (c & 7) * 8; *(LAS u32x4*)(vb + d * VROW + cc * 2) = vreg[i]; }
    };
    const int pr = (r & ~12) | ((r & 4) << 1) | ((r & 8) >> 1);
    float mrun = 0.f, lrun = 0.f;
    f32x16 negm;
#pragma unroll
    for (int i = 0; i < 16; ++i) negm[i] = 0.f;
#pragma unroll
    for (int b = 0; b < DV / 32; ++b)
#pragma unroll
        for (int i = 0; i < 16; ++i) o[b][i] = 0.f;
    gload(0); sstore(0); if (ntiles > 1) { gload(1); sstore(1); } __syncthreads();
    for (int t = 0; t < ntiles; ++t) {
        if (t + 2 < ntiles) gload(t + 2);
        const LAS unsigned char* kb = lds + (t & 3) * BUF; const LAS unsigned char* vb = kb + KT;
        f32x16 p[2];
        {
            bf16x8 kf[2][DQK / 16];
#pragma unroll
            for (int hf = 0; hf < 2; ++hf)
#pragma unroll
                for (int d0 = 0; d0 < DQK / 16; ++d0) kf[hf][d0] = *(const LAS bf16x8*)(kb + (32 * hf + pr) * KROW + (16 * d0 + 8 * h) * 2);
            __builtin_amdgcn_sched_barrier(0);
            __builtin_amdgcn_s_setprio(1);
#pragma unroll
            for (int d0 = 0; d0 < DQK / 16; ++d0)
#pragma unroll
                for (int hf = 0; hf < 2; ++hf) p[hf] = MFMA32(kf[hf][d0], qf[d0], d0 == 0 ? negm : p[hf]);
            __builtin_amdgcn_sched_barrier(0);
        }
        constexpr int NBLK = DV / 32;
        bf16x8 vk[2][NBLK];
#define LDVK(buf, ks) do { _Pragma("unroll") for (int b_ = 0; b_ < NBLK; ++b_) vk[buf][b_] = *(const LAS bf16x8*)(vb + (32 * b_ + r) * VROW + (16 * (ks) + 8 * h) * 2); } while (0)
        LDVK(0, 0);
        __builtin_amdgcn_sched_barrier(0);
        float ta = fmaxf(fmaxf(p[0][0], p[0][1]), p[1][0]), tb = fmaxf(fmaxf(p[0][2], p[0][3]), p[1][1]);
        ta = fmaxf(fmaxf(ta, p[1][2]), p[1][3]);
#pragma unroll
        for (int i = 4; i < 16; i += 4) { ta = fmaxf(fmaxf(ta, p[0][i]), p[0][i + 1]); tb = fmaxf(fmaxf(tb, p[0][i + 2]), p[0][i + 3]); ta = fmaxf(fmaxf(ta, p[1][i]), p[1][i + 1]); tb = fmaxf(fmaxf(tb, p[1][i + 2]), p[1][i + 3]); }
        float tm = fmaxf(ta, tb);
        if (__any(t == 0 || tm > 8.0f)) {
            tm = fmaxf(tm, __shfl_xor(tm, 32));
            const float dl = (t == 0 || tm > 0.f) ? tm : 0.f; mrun += dl;
            const float alpha = __builtin_amdgcn_exp2f(-dl); lrun *= alpha;
#pragma unroll
            for (int i = 0; i < 16; ++i) { p[0][i] -= dl; p[1][i] -= dl; negm[i] = -mrun; }
#pragma unroll
            for (int b = 0; b < DV / 32; ++b)
#pragma unroll
                for (int i = 0; i < 16; ++i) o[b][i] *= alpha;
        }
        bf16x8 pf[4]; float rs = 0.f; u32x4 wq;
#define EXPPART(ks, j) do { const int hf_ = (ks) >> 1, s8_ = ((ks) & 1) * 8; const float e0_ = __builtin_amdgcn_exp2f(p[hf_][s8_ + 2 * (j)]), e1_ = __builtin_amdgcn_exp2f(p[hf_][s8_ + 2 * (j) + 1]); \
        rs += e0_; rs += e1_; wq[j] = cvtpk(e0_, e1_); } while (0)
        EXPPART(0, 0); EXPPART(0, 1); EXPPART(0, 2); EXPPART(0, 3); pf[0] = __builtin_bit_cast(bf16x8, wq);
        __builtin_amdgcn_sched_barrier(0);
#pragma unroll
        for (int ks = 0; ks < 4; ++ks) {
            if (ks < 3) LDVK((ks + 1) & 1, ks + 1);
            __builtin_amdgcn_sched_barrier(0);
#pragma unroll
            for (int b = 0; b < NBLK; ++b) {
                o[b] = MFMA32(vk[ks & 1][b], pf[ks], o[b]);
                if (ks < 3) {
#pragma unroll
                    for (int j = b * (4 / NBLK); j < (b + 1) * (4 / NBLK); ++j) {
                        if (ks == 0) EXPPART(1, j); else if (ks == 1) EXPPART(2, j); else EXPPART(3, j);
                    }
                }
                __builtin_amdgcn_sched_barrier(0);
            }
            if (ks < 3) pf[ks + 1] = __builtin_bit_cast(bf16x8, wq);
        }
        __builtin_amdgcn_s_setprio(0);
        lrun += rs;
#undef LDVK
#undef EXPPART
        if (t + 2 < ntiles) sstore((t + 2) & 3);
        if (t & 1) __syncthreads();
    }
    l_out = lrun + __shfl_xor(lrun, 32);
}
constexpr int ATTN_LDS = 2 * (64 * (96 * 2 + 16) + 128 * 144);


#define XB_TMO      128
#define XB_XCNT(j)  (256  + 64 * (j))
#define XB_XSUB(j)  (1280 + 64 * (j))
#define XB_XGEN(j)  (2304 + 64 * (j))
#define XB_TOP      3328
#define XB_TOPGEN   3392
#define XCD_BAR_WORDS 3456
#define XB_SPIN_CAP (1u << 18)
DI unsigned xb_ld(unsigned* p)              { return __hip_atomic_load(p, __ATOMIC_RELAXED, __HIP_MEMORY_SCOPE_AGENT); }
DI unsigned xb_add(unsigned* p, unsigned v) { return __hip_atomic_fetch_add(p, v, __ATOMIC_RELAXED, __HIP_MEMORY_SCOPE_AGENT); }
DI unsigned xb_xcc_id() { return (unsigned)__builtin_amdgcn_s_getreg((3 << 11) | 20) & 0xFu; }
#define XB_SPIN(cond, bar) do { unsigned _sp = 0; while (cond) { __builtin_amdgcn_s_sleep(1); \
    if ((++_sp & 255u) == 0u) { if (xb_ld(&(bar)[XB_TMO])) break; if (_sp > XB_SPIN_CAP) { atomicAdd(&(bar)[XB_TMO], 1u); break; } } } } while (0)
struct XcdBarrier { unsigned* bar; unsigned x; volatile LAS unsigned* st; };
DI XcdBarrier xcd_barrier_post(unsigned* bar, volatile LAS unsigned* st) {
    XcdBarrier b; b.bar = bar; b.x = xb_xcc_id(); b.st = st;
    if (threadIdx.x == 0) (void)xb_add(&bar[XB_XCNT(b.x)], 1u);
    return b;
}
DI void xcd_barrier_complete(unsigned* bar, unsigned x, unsigned& nloc, unsigned& nx) {
    const unsigned G = gridDim.x * gridDim.y * gridDim.z;
    unsigned sum, cnt, mine, sp = 0u;
    for (;;) {
        sum = 0u; cnt = 0u; mine = 0u;
#pragma unroll
        for (unsigned j = 0; j < 16; ++j) { const unsigned c = xb_ld(&bar[XB_XCNT(j)]); sum += c; cnt += (c > 0u) ? 1u : 0u; mine = (j == x) ? c : mine; }
        if (sum == G) break;
        __builtin_amdgcn_s_sleep(1);
        if ((++sp & 255u) == 0u) { if (xb_ld(&bar[XB_TMO])) break; if (sp > XB_SPIN_CAP) { atomicAdd(&bar[XB_TMO], 1u); break; } }
    }
    nloc = mine > 0u ? mine : 1u; nx = cnt > 0u ? cnt : 1u;
}
DI void xcd_barrier(const XcdBarrier& b) {
    asm volatile("s_waitcnt vmcnt(0)" ::: "memory");
    __syncthreads();
    if (threadIdx.x == 0) {
        unsigned* bar = b.bar;
        __builtin_amdgcn_s_waitcnt(0);
        unsigned nloc = b.st[0], nx = b.st[1];
        if (nloc == 0u) { xcd_barrier_complete(bar, b.x, nloc, nx); b.st[0] = nloc; b.st[1] = nx; }
        const unsigned old = xb_add(&bar[XB_XSUB(b.x)], 1u);
        const unsigned gen = old / nloc;
        if (old + 1u == (gen + 1u) * nloc) {
            __builtin_amdgcn_fence(__ATOMIC_RELEASE, "agent");
            asm volatile("s_waitcnt vmcnt(0)" ::: "memory");
            const unsigned og = xb_add(&bar[XB_TOP], 1u);
            const unsigned tg = og / nx;
            if (og + 1u == (tg + 1u) * nx) xb_add(&bar[XB_TOPGEN], 1u);
            else XB_SPIN(xb_ld(&bar[XB_TOPGEN]) == tg, bar);
            __builtin_amdgcn_fence(__ATOMIC_ACQUIRE, "agent");
            xb_add(&bar[XB_XGEN(b.x)], 1u);
            asm volatile("s_waitcnt vmcnt(0)" ::: "memory");
        } else {
            XB_SPIN(xb_ld(&bar[XB_XGEN(b.x)]) == gen, bar);
            __builtin_amdgcn_fence(__ATOMIC_ACQUIRE, "agent");
            asm volatile("s_waitcnt vmcnt(0)" ::: "memory");
        }
    }
    __syncthreads();
}

struct Args {
    const float* in[35]; float* out; unsigned char* ws; int ph_lo, ph_hi;
};
enum { I_X = 0, I_C, I_CTX, I_CCTX,
       I0_WMOD, I0_BMOD, I0_WIN, I0_QN, I0_WUQ, I0_KVN, I0_WUKV, I0_WOUT, I0_LN1G, I0_LN1B, I0_WG, I0_WU, I0_WD, I0_LN2G, I0_LN2B,
       I1_WMOD, I1_BMOD, I1_WIN, I1_LQ1, I1_LK1, I1_LQ2, I1_LK2, I1_SUBLN, I1_WOUT, I1_LN1G, I1_LN1B, I1_WG, I1_WU, I1_WD, I1_LN2G, I1_LN2B };

DI bf16_t* tr_dst(int job, int n, unsigned char* ws) {
    switch (job) {
    case 0: return (bf16_t*)(ws + W_IN0) + (size_t)n * 1024;
    case 1: { const int hd = n / 96, d = n % 96; int row; if (d < 64) row = hd * 64 + d; else { const int e = d - 64, t = e >> 3, f = e & 7; row = 512 + hd * 32 + 16 * (t & 1) + 8 * (t >> 1) + f; }
              return (bf16_t*)(ws + W_UQ) + (size_t)row * 256; }
    case 2: { const int hd = n >> 7, d = n & 127; return d < 64 ? (bf16_t*)(ws + W_KN) + (size_t)(hd * 64 + d) * 256 : (bf16_t*)(ws + W_V0) + (size_t)(hd * 64 + d - 64) * 256; }
    case 3: return (bf16_t*)(ws + W_OUT0) + (size_t)n * 1024;
    case 4: return (bf16_t*)(ws + W_GU0) + (size_t)(256 * (n >> 7) + (n & 127)) * 1024;
    case 5: return (bf16_t*)(ws + W_GU0) + (size_t)(256 * (n >> 7) + 128 + (n & 127)) * 1024;
    case 6: return (bf16_t*)(ws + W_D0) + (size_t)n * 2816;
    case 7: return n < 2048 ? (bf16_t*)(ws + W_QK1) + (size_t)n * 1024 : (bf16_t*)(ws + W_V1) + (size_t)(n - 2048) * 1024;
    case 8: return (bf16_t*)(ws + W_OUT1) + (size_t)n * 1024;
    case 9: return (bf16_t*)(ws + W_GU1) + (size_t)(256 * (n >> 7) + (n & 127)) * 1024;
    case 10: return (bf16_t*)(ws + W_GU1) + (size_t)(256 * (n >> 7) + 128 + (n & 127)) * 1024;
    default: return (bf16_t*)(ws + W_D1) + (size_t)n * 2816;
    }
}
DI void transpose_item(const float* W, int K, int N, int job, unsigned char* ws, LAS float* scr, int item, int lane) {
    const int nblk = N / 32, kb = item / nblk, nb = item % nblk, k0 = 64 * kb, n0 = 32 * nb;
#pragma unroll 8
    for (int i = 0; i < 32; ++i) { const int kk = 2 * i + (lane >> 5); scr[kk * 33 + (lane & 31)] = W[(size_t)(k0 + kk) * N + n0 + (lane & 31)]; }
    asm volatile("s_waitcnt lgkmcnt(0)" ::: "memory");
    const int c = lane & 7;
#pragma unroll
    for (int j = 0; j < 4; ++j) { const int n = (lane >> 3) + 8 * j; const LAS float* s = scr + (8 * c) * 33 + n;
        u32x4 o; o.x = cvtpk(s[0 * 33], s[1 * 33]); o.y = cvtpk(s[2 * 33], s[3 * 33]); o.z = cvtpk(s[4 * 33], s[5 * 33]); o.w = cvtpk(s[6 * 33], s[7 * 33]);
        bf16_t* dst = tr_dst(job, n0 + n, ws); *(u32x4*)(dst + k0 + 8 * c) = o; }
    asm volatile("s_waitcnt lgkmcnt(0)" ::: "memory");
}

DI void prologue(const Args& a, LAS unsigned char* lds) {
    unsigned char* ws = a.ws;
    const int tid = otid(), lane = tid & 63, wave = tid >> 6;
    const int G = gridDim.x, gw = blockIdx.x * 8 + wave, NGW = G * 8;
    const long gt = (long)blockIdx.x * 512 + tid, NGT = (long)G * 512;
    {
        LAS float* scr = (LAS float*)(lds + wave * 16384);
        const int jin[12] = {I0_WIN, I0_WUQ, I0_WUKV, I0_WOUT, I0_WG, I0_WU, I0_WD, I1_WIN, I1_WOUT, I1_WG, I1_WU, I1_WD};
        const int jK[12] = {1024, 256, 256, 1024, 1024, 1024, 2816, 1024, 1024, 1024, 1024, 2816};
        const int jN[12] = {1056, 768, 1024, 1024, 2816, 2816, 1024, 3072, 1024, 2816, 2816, 1024};
        int base = 0;
#pragma unroll
        for (int j = 0; j < 12; ++j) { const int items = (jK[j] / 64) * (jN[j] / 32);
            for (int it = gw; it < items; it += NGW) transpose_item(a.in[jin[j]], jK[j], jN[j], j, ws, scr, it, lane);
            base += items; }
        u32x4 z = {0u, 0u, 0u, 0u};
        for (long i = gt; i < (1280 - 1056) * 1024 / 8; i += NGT) ((u32x4*)((bf16_t*)(ws + W_IN0) + (size_t)1056 * 1024))[i] = z;
    }
    {
        const float sc = 0.011048543456039806f;
        for (long i = gt; i < (long)4 * 2 * 1024 * 256; i += NGT) { const long idx = i * 8; const int n0 = (int)(idx & 2047), kq = (int)(idx >> 11) & 1023, part = (int)(idx >> 21) & 1, rr = (int)(idx >> 22); const int k = 4 * kq + rr; float v[8];
#pragma unroll
            for (int e = 0; e < 8; ++e) { const float ph = (float)((k * (n0 + e)) & 8191) * (1.0f / 8192.0f); v[e] = (part ? __builtin_amdgcn_sinf(ph) : __builtin_amdgcn_cosf(ph)) * ((part && rr == 3) ? -sc : sc); }
            u32x4 o; o.x = cvtpk(v[0], v[1]); o.y = cvtpk(v[2], v[3]); o.z = cvtpk(v[4], v[5]); o.w = cvtpk(v[6], v[7]);
            *(u32x4*)((bf16_t*)(ws + WS_DN) + idx) = o; }
        for (long i = gt; i < 256 * 512; i += NGT) { const int k = (int)(i >> 9), c = (int)(i & 511), part = c >> 8, n = c & 255; const float ph = (float)((k * n) & 255) * (1.0f / 256.0f);
            const float v = (part ? __builtin_amdgcn_sinf(ph) : __builtin_amdgcn_cosf(ph)) * 0.0625f; ((bf16_t*)(ws + W_D256))[i] = (bf16_t)(cvtpk(v, 0.f) & 0xffffu); }
        for (long i = gt; i < 256 * 128; i += NGT) { const int rr = (int)(i >> 7), c = (int)(i & 127), part = rr >> 7, l = rr & 127; const float ph = (float)((l * c) & 127) * (1.0f / 128.0f);
            const float v = (part ? -__builtin_amdgcn_sinf(ph) : __builtin_amdgcn_cosf(ph)) * 0.08838834764831845f; ((bf16_t*)(ws + W_DC))[i] = (bf16_t)(cvtpk(v, 0.f) & 0xffffu); }
        for (long i = gt; i < 128 * 16; i += NGT) { const int pos = (int)(i >> 4), f = (int)(i & 15); const float inv = 1.0f / powf(10000.0f, (float)f / 16.0f); const float ang = (float)pos * inv;
            ((f32x2*)(ws + WS_TAB16))[i] = (f32x2){cosf(ang), sinf(ang)}; }
        for (long i = gt; i < 128 * 8; i += NGT) { const int pos = (int)(i >> 3), f = (int)(i & 7); const float inv = 1.0f / powf(10000.0f, (float)f / 8.0f); const float ang = (float)pos * inv;
            ((f32x2*)(ws + WS_TAB8))[i] = (f32x2){cosf(ang), sinf(ang)}; }
    }
    {
        LAS float* red = (LAS float*)lds;
        LAS float* sl = (LAS float*)(lds + 16384);
        __syncthreads();
        if (blockIdx.x < 2 * 96) {
            for (int i = tid; i < 5 * 1024; i += 512) { const int cls = i >> 10, k = i & 1023; const float cv = cls < 4 ? a.in[I_C][cls * 1024 + k] : a.in[I_CCTX][k]; sl[i] = cv / (1.0f + __expf(-cv)); }
        }
        __syncthreads();
        for (int it = blockIdx.x; it < 2 * 96; it += G) {
            const int layer = it / 96, n = (it % 96) * 64 + lane; const float* w = a.in[layer ? I1_WMOD : I0_WMOD] + (size_t)(wave * 128) * 6144 + n; const float* bm = a.in[layer ? I1_BMOD : I0_BMOD];
            float acc[5] = {0.f, 0.f, 0.f, 0.f, 0.f};
            for (int k0 = 0; k0 < 128; k0 += 16) { float wv[16];
#pragma unroll
                for (int u = 0; u < 16; ++u) wv[u] = w[(size_t)(k0 + u) * 6144];
#pragma unroll
                for (int u = 0; u < 16; ++u)
#pragma unroll
                    for (int cls = 0; cls < 5; ++cls) acc[cls] += sl[cls * 1024 + wave * 128 + k0 + u] * wv[u]; }
#pragma unroll
            for (int cls = 0; cls < 5; ++cls) red[(wave * 5 + cls) * 64 + lane] = acc[cls];
            __syncthreads();
            if (tid < 320) { const int cls = tid >> 6, l = tid & 63; float s_ = 0.f;
#pragma unroll
                for (int w8 = 0; w8 < 8; ++w8) s_ += red[(w8 * 5 + cls) * 64 + l];
                const int nn = (it % 96) * 64 + l; ((float*)(ws + WS_MOD))[(size_t)(layer * 5 + cls) * 6144 + nn] = s_ + bm[nn]; }
            __syncthreads();
        }
    }
}

struct RowPass {
    const float* xl; const float* xc;
    float* ol; float* oc;
    const bf16_t* Y;
    const float* mod;
    int gate_off; const float* lng; const float* lnb;
    const float* mod2; int sc_off, sh_off;
    bf16_t* H;
    int skipctx;
};
DI void ln_stats(const f32x4 (&v)[4], float& mean, float& rstd) {
    float s = 0.f;
#pragma unroll
    for (int j = 0; j < 4; ++j) s += (v[j][0] + v[j][1]) + (v[j][2] + v[j][3]);
    mean = wave_sum(s) * (1.0f / DM); float q = 0.f;
#pragma unroll
    for (int j = 0; j < 4; ++j) { const f32x4 d = v[j] - mean; q += (d[0] * d[0] + d[1] * d[1]) + (d[2] * d[2] + d[3] * d[3]); }
    rstd = 1.0f / sqrtf(wave_sum(q) * (1.0f / DM) + LN_EPS);
}
DI void row_pass(const RowPass& P, int m, int lane) {
    const int b = m / TPB, j = m % TPB; const bool isctx = j < CTX; const int cls = isctx ? 4 : b;
    if (P.skipctx && isctx) return;
    const size_t xoff = isctx ? (size_t)(b * CTX + j) * DM : (size_t)(b * SEQ + j - CTX) * DM;
    const float* xs = (isctx ? P.xc : P.xl) + xoff; float* xd = isctx ? P.oc : P.ol;
    f32x4 v[4];
#pragma unroll
    for (int jj = 0; jj < 4; ++jj) v[jj] = *(const f32x4*)(xs + 4 * lane + 256 * jj);
    if (P.Y) {
        const float* gate = P.mod + (size_t)cls * 6144 + P.gate_off;
#pragma unroll
        for (int jj = 0; jj < 4; ++jj) { const int c0 = 4 * lane + 256 * jj; const u32x2 yw = *(const u32x2*)(P.Y + (size_t)m * DM + c0); const f32x4 g = *(const f32x4*)(gate + c0);
            v[jj][0] = DN_ALPHA * v[jj][0] + g[0] * bflo(yw.x); v[jj][1] = DN_ALPHA * v[jj][1] + g[1] * bfhi(yw.x);
            v[jj][2] = DN_ALPHA * v[jj][2] + g[2] * bflo(yw.y); v[jj][3] = DN_ALPHA * v[jj][3] + g[3] * bfhi(yw.y); }
        float mean, rstd; ln_stats(v, mean, rstd);
#pragma unroll
        for (int jj = 0; jj < 4; ++jj) { const int c0 = 4 * lane + 256 * jj; const f32x4 g = *(const f32x4*)(P.lng + c0), bb = *(const f32x4*)(P.lnb + c0); v[jj] = (v[jj] - mean) * rstd * g + bb; }
        if (xd) {
#pragma unroll
            for (int jj = 0; jj < 4; ++jj) *(f32x4*)(xd + xoff + 4 * lane + 256 * jj) = v[jj];
        }
    }
    if (P.H) {
        float mean, rstd; ln_stats(v, mean, rstd);
        const float* sc = P.mod2 + (size_t)cls * 6144 + P.sc_off; const float* sh = P.mod2 + (size_t)cls * 6144 + P.sh_off;
#pragma unroll
        for (int jj = 0; jj < 4; ++jj) { const int c0 = 4 * lane + 256 * jj; const f32x4 s1 = *(const f32x4*)(sc + c0), s0 = *(const f32x4*)(sh + c0);
            const f32x4 hh = (v[jj] - mean) * rstd * (s1 + 1.0f) + s0; u32x2 w; w.x = cvtpk(hh[0], hh[1]); w.y = cvtpk(hh[2], hh[3]);
            *(u32x2*)(P.H + (size_t)m * DM + c0) = w; }
    }
}
DI void p3_row(const Args& a, int m, int lane) {
    unsigned char* ws = a.ws; const bf16_t* U = (const bf16_t*)(ws + WS_R3) + (size_t)m * 1280;
    const u32x2 qw = *(const u32x2*)(U + 512 + 4 * lane), kw = *(const u32x2*)(U + 768 + 4 * lane);
    float q[4] = {bflo(qw.x), bfhi(qw.x), bflo(qw.y), bfhi(qw.y)}, k[4] = {bflo(kw.x), bfhi(kw.x), bflo(kw.y), bfhi(kw.y)};
    const float qs = wave_sum(q[0] * q[0] + q[1] * q[1] + q[2] * q[2] + q[3] * q[3]), ks = wave_sum(k[0] * k[0] + k[1] * k[1] + k[2] * k[2] + k[3] * k[3]);
    const float qr = 1.0f / sqrtf(qs * (1.0f / 256.0f) + RMS_EPS), kr_ = 1.0f / sqrtf(ks * (1.0f / 256.0f) + RMS_EPS);
    const f32x4 qg = *(const f32x4*)(a.in[I0_QN] + 4 * lane), kg = *(const f32x4*)(a.in[I0_KVN] + 4 * lane);
    u32x2 w; w.x = cvtpk(q[0] * qr * qg[0], q[1] * qr * qg[1]); w.y = cvtpk(q[2] * qr * qg[2], q[3] * qr * qg[3]);
    *(u32x2*)((bf16_t*)(ws + WS_CQN) + (size_t)m * 256 + 4 * lane) = w;
    w.x = cvtpk(k[0] * kr_ * kg[0], k[1] * kr_ * kg[1]); w.y = cvtpk(k[2] * kr_ * kg[2], k[3] * kr_ * kg[3]);
    *(u32x2*)((bf16_t*)(ws + WS_CKVN) + (size_t)m * 256 + 4 * lane) = w;
    const int d = lane & 31, t = d >> 3, f = d & 7; const float val = bf2f(U[1024 + d]); const float par = __shfl_xor(val, 8);
    const int j = m % TPB, tt = j - CTX; float outv = val;
    if (tt >= 0) { const int pos = (t < 2) ? (tt >> 6) : (tt & 63); const f32x2 cs = ((const f32x2*)(ws + WS_TAB8))[pos * 8 + f];
        outv = (t & 1) ? (par * cs[1] + val * cs[0]) : (val * cs[0] - par * cs[1]); }
    if (lane < 32) ((bf16_t*)(ws + WS_KR))[(size_t)m * 32 + 16 * (t & 1) + 8 * (t >> 1) + f] = (bf16_t)(cvtpk(outv, 0.f) & 0xffffu);
}

DI void fold_items(const Args& a, int gw, int NGW, int lane) {
    unsigned char* ws = a.ws; const bf16_t* At = (const bf16_t*)(ws + WS_R2); bf16_t* At4 = (bf16_t*)(ws + WS_AT4);
    for (int it = gw; it < 512 * NB; it += NGW) { const int gl = it >> 2, b = it & 3;
        const bf16_t* sx = At + (size_t)gl * ROWS + b * TPB + CTX; const bf16_t* sy = sx + (size_t)512 * ROWS;
        for (int i = 0; i < 4; ++i) { const int n = (i * 64 + lane) * 8; u32x4 xw[4], yw[4];
#pragma unroll
            for (int j = 0; j < 4; ++j) { xw[j] = *(const u32x4*)(sx + n + 2048 * j); yw[j] = *(const u32x4*)(sy + n + 2048 * j); }
            u32x4 o[4][2];
#pragma unroll
            for (int q = 0; q < 4; ++q) {
                float cr[4][2], ci[4][2];
#pragma unroll
                for (int e = 0; e < 2; ++e) { float x[4], y[4];
#pragma unroll
                    for (int j = 0; j < 4; ++j) { x[j] = e ? bfhi(xw[j][q]) : bflo(xw[j][q]); y[j] = e ? bfhi(yw[j][q]) : bflo(yw[j][q]); }
                    const float sx02 = x[0] + x[2], dx02 = x[0] - x[2], sx13 = x[1] + x[3], dx13 = x[1] - x[3];
                    const float sy02 = y[0] + y[2], dy02 = y[0] - y[2], sy13 = y[1] + y[3], dy13 = y[1] - y[3];
                    cr[0][e] = sx02 + sx13; ci[0][e] = sy02 + sy13;
                    cr[1][e] = dx02; ci[1][e] = -dx13;
                    cr[2][e] = sx02 - sx13; ci[2][e] = sy02 - sy13;
                    cr[3][e] = dy13; ci[3][e] = dy02; }
#pragma unroll
                for (int r = 0; r < 4; ++r) { o[r][0][q] = cvtpk(cr[r][0], cr[r][1]); o[r][1][q] = cvtpk(ci[r][0], ci[r][1]); }
            }
#pragma unroll
            for (int r = 0; r < 4; ++r)
#pragma unroll
                for (int p = 0; p < 2; ++p) *(u32x4*)(At4 + ((size_t)((r * 2 + p) * 512 + gl)) * 8192 + b * 2048 + n) = o[r][p];
        }
    }
}
DI void mirror_items(const Args& a, int gw, int NGW, int lane) {
    unsigned char* ws = a.ws; bf16_t* MIX = (bf16_t*)(ws + WS_R3); const bf16_t* At = (const bf16_t*)(ws + WS_R2);
    for (int it = gw; it < NB * 512; it += NGW) { const int b = it >> 9, ch = it & 511; const bf16_t* src = (const bf16_t*)(ws + WS_AT4) + (size_t)ch * 8192 + b * 2048; float s = 0.f;
        for (int i = 0; i < 4; ++i) { const u32x4 w = *(const u32x4*)(src + (i * 64 + lane) * 8);
            s += (bflo(w.x) - bfhi(w.x)) + (bflo(w.y) - bfhi(w.y)) + (bflo(w.z) - bfhi(w.z)) + (bflo(w.w) - bfhi(w.w)); }
        s = wave_sum(s) * 0.011048543456039806f;
        if (lane == 0) MIX[(size_t)(b * TPB + CTX + 4096) * DM + ch] = (bf16_t)(cvtpk(s, 0.f) & 0xffffu); }
    const bf16_t* PS = (const bf16_t*)(ws + WS_PS);
    for (int it = gw; it < NB * 4096; it += NGW) { const int b = it >> 12, k = it & 4095;
        bf16_t* src = MIX + (size_t)(b * TPB + CTX + k) * DM + 8 * lane; const u32x4 pc = *(const u32x4*)src; const u32x4 ps = *(const u32x4*)(PS + ((size_t)(b * 4096 + k)) * 512 + 8 * lane);
        u32x4 sm, df;
        sm.x = cvtpk(bflo(pc.x) + bflo(ps.x), bfhi(pc.x) + bfhi(ps.x)); df.x = cvtpk(bflo(pc.x) - bflo(ps.x), bfhi(pc.x) - bfhi(ps.x));
        sm.y = cvtpk(bflo(pc.y) + bflo(ps.y), bfhi(pc.y) + bfhi(ps.y)); df.y = cvtpk(bflo(pc.y) - bflo(ps.y), bfhi(pc.y) - bfhi(ps.y));
        sm.z = cvtpk(bflo(pc.z) + bflo(ps.z), bfhi(pc.z) + bfhi(ps.z)); df.z = cvtpk(bflo(pc.z) - bflo(ps.z), bfhi(pc.z) - bfhi(ps.z));
        sm.w = cvtpk(bflo(pc.w) + bflo(ps.w), bfhi(pc.w) + bfhi(ps.w)); df.w = cvtpk(bflo(pc.w) - bflo(ps.w), bfhi(pc.w) - bfhi(ps.w));
        *(u32x4*)src = sm;
        if (k >= 1) *(u32x4*)(MIX + (size_t)(b * TPB + CTX + 8192 - k) * DM + 8 * lane) = df; }
}

DI bool attn_unit_map(int L, int nunits_big, int& bh, int& qb) {
    if (L < nunits_big) { const int i = L >> 8, c = L & 255; bh = 4 * (c & 7) + i; qb = 1 + (c >> 3); return true; }
    bh = L - nunits_big; qb = 0; return bh < 32;
}
DI void attn_mla_unit(const Args& a, LAS unsigned char* lds, int bh, int qb) {
    unsigned char* ws = a.ws; const int tid = otid(), lane = tid & 63, wave = tid >> 6, r = lane & 31, h = lane >> 5;
    const int b = bh >> 3, hd = bh & 7; const int m = b * TPB + qb * 256 + wave * 32 + r;
    const bf16_t* Q = (const bf16_t*)(ws + WS_Q) + (size_t)m * 768;
    const bf16_t* KN = (const bf16_t*)(ws + WS_KN) + (size_t)(b * TPB) * 512 + hd * 64;
    const bf16_t* KR = (const bf16_t*)(ws + WS_KR) + (size_t)(b * TPB) * 32;
    const bf16_t* VT = (const bf16_t*)(ws + WS_VT0) + (size_t)(hd * 64) * ROWS + b * TPB;
    f32x16 o[2]; float l;
    attn_core<64, 32, 64>(o, l, lds, Q + hd * 64, Q + 512 + hd * 32, KN, 512, KR, 32, VT, ROWS, qb == 0 ? CTX / 64 : TPB / 64);
    const float il = 1.0f / l; bf16_t* dst = (bf16_t*)(ws + WS_R3) + (size_t)m * DM + 512 + hd * 64;
#pragma unroll
    for (int blk = 0; blk < 2; ++blk)
#pragma unroll
        for (int g = 0; g < 4; ++g) { u32x2 w; w.x = cvtpk(o[blk][4 * g] * il, o[blk][4 * g + 1] * il); w.y = cvtpk(o[blk][4 * g + 2] * il, o[blk][4 * g + 3] * il);
            *(u32x2*)(dst + 32 * blk + 8 * g + 4 * h) = w; }
}
DI void attn_diff_unit(const Args& a, LAS unsigned char* lds, int bh, int qb, float lam) {
    unsigned char* ws = a.ws; const int tid = otid(), lane = tid & 63, wave = tid >> 6, r = lane & 31, h = lane >> 5;
    const int b = bh >> 3, hd = bh & 7; const int m = b * TPB + qb * 256 + wave * 32 + r;
    const bf16_t* QK = (const bf16_t*)(ws + WS_R3);
    const bf16_t* VT = (const bf16_t*)(ws + WS_VT1) + (size_t)(hd * 128) * ROWS + b * TPB;
    bf16_t* dst = (bf16_t*)(ws + WS_R2) + (size_t)m * DM + hd * 128;
    f32x16 o[4]; float l;
    {
        const bf16_t* q = QK + (size_t)m * 2048 + (hd * 2) * 64; const bf16_t* k = QK + (size_t)(b * TPB) * 2048 + 1024 + (hd * 2) * 64;
        attn_core<64, 0, 128>(o, l, lds, q, q, k, 2048, k, 2048, VT, ROWS, TPB / 64);
        const float il = 1.0f / l;
#pragma unroll
        for (int blk = 0; blk < 4; ++blk)
#pragma unroll
            for (int g = 0; g < 4; ++g) { u32x2 w; w.x = cvtpk(o[blk][4 * g] * il, o[blk][4 * g + 1] * il); w.y = cvtpk(o[blk][4 * g + 2] * il, o[blk][4 * g + 3] * il); *(u32x2*)(dst + 32 * blk + 8 * g + 4 * h) = w; }
    }
    {
        const bf16_t* q = QK + (size_t)m * 2048 + (hd * 2 + 1) * 64; const bf16_t* k = QK + (size_t)(b * TPB) * 2048 + 1024 + (hd * 2 + 1) * 64;
        attn_core<64, 0, 128>(o, l, lds, q, q, k, 2048, k, 2048, VT, ROWS, TPB / 64);
    }
    const float il = lam / l; float ss = 0.f;
#pragma unroll
    for (int blk = 0; blk < 4; ++blk)
#pragma unroll
        for (int g = 0; g < 4; ++g) { const u32x2 aw = *(const u32x2*)(dst + 32 * blk + 8 * g + 4 * h);
            const float x0 = bflo(aw.x) - o[blk][4 * g] * il, x1 = bfhi(aw.x) - o[blk][4 * g + 1] * il, x2 = bflo(aw.y) - o[blk][4 * g + 2] * il, x3 = bfhi(aw.y) - o[blk][4 * g + 3] * il;
            o[blk][4 * g] = x0; o[blk][4 * g + 1] = x1; o[blk][4 * g + 2] = x2; o[blk][4 * g + 3] = x3; ss += (x0 * x0 + x1 * x1) + (x2 * x2 + x3 * x3); }
    ss += __shfl_xor(ss, 32);
    const float rn = (1.0f - LAMBDA_INIT) / sqrtf(ss * (1.0f / 128.0f) + RMS_EPS);
    const float* sub = a.in[I1_SUBLN];
#pragma unroll
    for (int blk = 0; blk < 4; ++blk)
#pragma unroll
        for (int g = 0; g < 4; ++g) { const int d0 = 32 * blk + 8 * g + 4 * h; const f32x4 sg = *(const f32x4*)(sub + d0);
            u32x2 w; w.x = cvtpk(o[blk][4 * g] * rn * sg[0], o[blk][4 * g + 1] * rn * sg[1]); w.y = cvtpk(o[blk][4 * g + 2] * rn * sg[2], o[blk][4 * g + 3] * rn * sg[3]);
            *(u32x2*)(dst + d0) = w; }
}

constexpr int NPHASES = 19;
constexpr int LDS_BYTES = 147456;
struct GOp { int kind; pg8::Gemm g; bf16_t* O; int ldc, o_bs, ai_extra; float scale; int q_tiles, rope_from; };

DI bool get_gemm(int ph, int sub, const Args& a, GOp& op) {
    unsigned char* ws = a.ws;
    bf16_t* R2 = (bf16_t*)(ws + WS_R2); bf16_t* R3 = (bf16_t*)(ws + WS_R3);
    op.kind = 0; op.o_bs = 0; op.ai_extra = 0; op.scale = 1.0f; op.q_tiles = 0; op.rope_from = 0;
    pg8::Gemm& g = op.g; g.nB = 1; g.a_bs = 0; g.b_bs = 0; g.rot = 0; g.a_seg = 0; g.b_seg = 0; g.skipctx = 0;
#define SETK(k_) do { g.K = (k_); g.kseg = (k_) / 64; g.a_seg = (k_); g.b_seg = (k_); } while (0)
    switch (ph * 16 + sub) {
    case 2 * 16 + 0:
        g.A = R2; g.a_rs = 1024; g.nM = NRT; g.Bt = (const bf16_t*)(ws + W_IN0); g.b_rs = 1024; g.nN = 5; SETK(1024); op.O = R3; op.ldc = 1280; return true;
    case 3 * 16 + 0:
        g.A = (const bf16_t*)(ws + W_DC); g.a_rs = 128; g.nM = 1; g.Bt = R3; g.b_rs = 1280; g.nN = NRT; g.nB = 4; g.b_bs = 128; SETK(128);
        op.O = R2; op.ldc = ROWS; op.o_bs = 128 * ROWS; op.ai_extra = 384 * ROWS; return true;
    case 4 * 16 + 0:
        op.kind = 1; g.A = (const bf16_t*)(ws + WS_CQN); g.a_rs = 256; g.nM = NRT; g.Bt = (const bf16_t*)(ws + W_UQ); g.b_rs = 256; g.nN = 3; SETK(256);
        op.O = (bf16_t*)(ws + WS_Q); op.ldc = 768; op.scale = MLA_QSCALE; op.q_tiles = 3; op.rope_from = 2; return true;
    case 4 * 16 + 1:
        g.A = (const bf16_t*)(ws + WS_CKVN); g.a_rs = 256; g.nM = NRT; g.Bt = (const bf16_t*)(ws + W_KN); g.b_rs = 256; g.nN = 2; SETK(256); g.rot = 140;
        op.O = (bf16_t*)(ws + WS_KN); op.ldc = 512; return true;
    case 4 * 16 + 2:
        g.A = (const bf16_t*)(ws + W_V0); g.a_rs = 256; g.nM = 2; g.Bt = (const bf16_t*)(ws + WS_CKVN); g.b_rs = 256; g.nN = NRT; SETK(256); g.rot = 148;
        op.O = (bf16_t*)(ws + WS_VT0); op.ldc = ROWS; return true;
    case 4 * 16 + 3: case 4 * 16 + 4: case 4 * 16 + 5: case 4 * 16 + 6: case 4 * 16 + 7: case 4 * 16 + 8: case 4 * 16 + 9: case 4 * 16 + 10: {
        const int rp = sub - 3, rr = rp >> 1, part = rp & 1;
        g.a_rs = 2048; g.nM = 4; g.b_rs = 8192; g.nN = 2; g.nB = 4; g.b_bs = 2048;
        if ((rr & 1) == 0) {
            g.A = (const bf16_t*)(ws + WS_DN) + (size_t)rp * 1024 * 2048; g.Bt = (const bf16_t*)(ws + WS_AT4) + (size_t)rp * 512 * 8192; SETK(2048);
        } else {
            g.A = (const bf16_t*)(ws + WS_DN) + (size_t)(rr * 2) * 1024 * 2048; g.Bt = (const bf16_t*)(ws + WS_AT4) + (size_t)((part ? 3 : 1) * 2) * 512 * 8192;
            g.K = 4096; g.kseg = 32; g.a_seg = 1024 * 2048; g.b_seg = 512 * 8192; if (rr == 3 && part == 1) op.scale = -1.0f;
        }
        g.rot = (152 + 32 * rp) & 255;
        if (part == 0) { op.O = R3 + (size_t)(CTX + rr) * DM; op.ldc = 4 * DM; op.o_bs = TPB * DM; }
        else { op.O = (bf16_t*)(ws + WS_PS) + rr * 512; op.ldc = 4 * 512; op.o_bs = 4096 * 512; }
        return true; }
    case 4 * 16 + 11:
        g.A = (const bf16_t*)(ws + W_D256); g.a_rs = 512; g.nM = 1; g.Bt = R2; g.b_rs = ROWS; g.nN = 2; g.nB = 4; g.b_bs = TPB; g.K = 512; g.kseg = 4; g.a_seg = 256; g.b_seg = 512 * ROWS; g.rot = 0;
        op.O = R3; op.ldc = DM; op.o_bs = TPB * DM; return true;
    case 6 * 16 + 0:
        g.A = R3; g.a_rs = 1024; g.nM = NRT; g.Bt = (const bf16_t*)(ws + W_OUT0); g.b_rs = 1024; g.nN = 4; SETK(1024); op.O = (bf16_t*)(ws + WS_Y0); op.ldc = DM; return true;
    case 8 * 16 + 0: case 15 * 16 + 0:
        op.kind = 3; g.A = R2; g.a_rs = 1024; g.nM = (ph == 8 ? NRT : 128); g.skipctx = (ph != 8); g.Bt = (const bf16_t*)(ws + (ph == 8 ? W_GU0 : W_GU1)); g.b_rs = 1024; g.nN = 22; SETK(1024); op.O = R3; op.ldc = FF; return true;
    case 9 * 16 + 0: case 16 * 16 + 0:
        g.A = R3; g.a_rs = FF; g.nM = (ph == 9 ? NRT : 128); g.skipctx = (ph != 9); g.Bt = (const bf16_t*)(ws + (ph == 9 ? W_D0 : W_D1)); g.b_rs = FF; g.nN = 4; SETK(FF); op.O = R2; op.ldc = DM; return true;
    case 11 * 16 + 0:
        op.kind = 2; g.A = R2; g.a_rs = 1024; g.nM = NRT; g.Bt = (const bf16_t*)(ws + W_QK1); g.b_rs = 1024; g.nN = 8; SETK(1024);
        op.O = R3; op.ldc = 2048; op.scale = DIFF_QSCALE; op.q_tiles = 4; op.rope_from = 0; return true;
    case 11 * 16 + 1:
        g.A = (const bf16_t*)(ws + W_V1); g.a_rs = 1024; g.nM = 4; g.Bt = R2; g.b_rs = 1024; g.nN = NRT; SETK(1024); g.rot = 32;
        op.O = (bf16_t*)(ws + WS_VT1); op.ldc = ROWS; return true;
    case 13 * 16 + 0:
        g.A = R2; g.a_rs = 1024; g.nM = 128; g.skipctx = 1; g.Bt = (const bf16_t*)(ws + W_OUT1); g.b_rs = 1024; g.nN = 4; SETK(1024); op.O = R3; op.ldc = DM; return true;
    default: return false;
    }
#undef SETK
}

DI bool get_rowpass(int ph, const Args& a, RowPass& P) {
    unsigned char* ws = a.ws; const float* MOD0 = (const float*)(ws + WS_MOD); const float* MOD1 = MOD0 + 5 * 6144;
    float* XC = (float*)(ws + WS_XC); bf16_t* R2 = (bf16_t*)(ws + WS_R2);
    switch (ph) {
    case 1:  P = RowPass{a.in[I_X], a.in[I_CTX], nullptr, nullptr, nullptr, MOD0, 0, nullptr, nullptr, MOD0, 1024, 0, R2, 0}; return true;
    case 7:  P = RowPass{a.in[I_X], a.in[I_CTX], a.out, XC, (const bf16_t*)(ws + WS_Y0), MOD0, 2048, a.in[I0_LN1G], a.in[I0_LN1B], MOD0, 4096, 3072, R2, 0}; return true;
    case 10: P = RowPass{a.out, XC, a.out, XC, R2, MOD0, 5120, a.in[I0_LN2G], a.in[I0_LN2B], MOD1, 1024, 0, R2, 0}; return true;
    case 14: P = RowPass{a.out, XC, a.out, XC, (const bf16_t*)(ws + WS_R3), MOD1, 2048, a.in[I1_LN1G], a.in[I1_LN1B], MOD1, 4096, 3072, R2, 1}; return true;
    case 17: P = RowPass{a.out, XC, a.out, XC, R2, MOD1, 5120, a.in[I1_LN2G], a.in[I1_LN2B], MOD1, 0, 0, nullptr, 1}; return true;
    default: return false;
    }
}

__global__ void __launch_bounds__(512, 2) fwd_kernel(Args a) {
    extern __shared__ __attribute__((aligned(16))) unsigned char lds_raw[];
    LAS unsigned char* lds = (LAS unsigned char*)lds_raw;
    const int G = gridDim.x;
    volatile LAS unsigned* bst = (volatile LAS unsigned*)(lds + LDS_BYTES - 64);
    if (threadIdx.x < 2) bst[threadIdx.x] = 0u;
    __syncthreads();
    XcdBarrier xbar = xcd_barrier_post((unsigned*)(a.ws + WS_BAR), bst);
    for (int pos = a.ph_lo; pos < a.ph_hi; ++pos) {
        const int ph = pos <= 3 ? pos : (pos == 4 ? 18 : pos - 1);
        const int tid = otid(), lane = tid & 63, wave = __builtin_amdgcn_readfirstlane(tid >> 6);
        const int gw = blockIdx.x * 8 + wave, NGW = G * 8;
#ifndef NO_PRO
        if (ph == 0) prologue(a, lds);
#endif
        RowPass P;
        if (get_rowpass(ph, a, P)) { for (int m = gw; m < ROWS; m += NGW) row_pass(P, m, lane); }
        if (ph == 3) { for (int m = gw; m < ROWS; m += NGW) p3_row(a, m, lane); }
        if (ph == 18) fold_items(a, gw, NGW, lane);
#ifndef NO_MLA
        if (ph == 5) {
            mirror_items(a, gw, NGW, lane);
            for (int L = blockIdx.x; ; L += G) { int bh, qb; if (!attn_unit_map(L, 1024, bh, qb)) break; attn_mla_unit(a, lds, bh, qb); }
        }
#endif
#ifndef NO_DIFF
        if (ph == 12) {
            const float p1 = wave_sum(a.in[I1_LQ1][lane] * a.in[I1_LK1][lane]), p2 = wave_sum(a.in[I1_LQ2][lane] * a.in[I1_LK2][lane]);
            const float lam = expf(p1) - expf(p2) + LAMBDA_INIT;
            for (int L = blockIdx.x; L < 1024; L += G) { int bh, qb; attn_unit_map(L, 1024, bh, qb); attn_diff_unit(a, lds, bh, qb, lam); }
        }
#endif
#ifndef NO_GEMM
        for (int sub = 0; sub < 16; ++sub) {
            GOp op; if (!get_gemm(ph, sub, a, op)) break;
            pg8::StaticOrder S; S.init(op.g.nM, op.g.nN, op.g.nB, G, (int)blockIdx.x, op.g.rot, op.g.skipctx);
            if (op.kind == 0) { pg8::EpiStore E{op.O, op.ldc, op.o_bs, op.ai_extra, op.scale}; pg8::gemm_phase(lds, op.g, S, E); }
            else if (op.kind == 1) { pg8::EpiRope<8> E{op.O, op.ldc, op.scale, op.q_tiles, op.rope_from, (const f32x2*)(a.ws + WS_TAB8)}; pg8::gemm_phase(lds, op.g, S, E); }
            else if (op.kind == 2) { pg8::EpiRope<16> E{op.O, op.ldc, op.scale, op.q_tiles, op.rope_from, (const f32x2*)(a.ws + WS_TAB16)}; pg8::gemm_phase(lds, op.g, S, E); }
            else { pg8::EpiSwiglu E{op.O, op.ldc}; pg8::gemm_phase(lds, op.g, S, E); }
        }
#endif
        if (pos + 1 < a.ph_hi) { if (pos == a.ph_lo) { __threadfence(); cg::this_grid().sync(); } else xcd_barrier(xbar); }
    }
}

extern "C" void kernel_launch(void* const* d_in, const int* in_sizes, int n_in, void* d_out, int out_size, void* d_ws, size_t ws_size, hipStream_t stream) {
    static int grid = 0;
    if (grid == 0) {
        if (n_in != 35 || ws_size < WS_END) { fprintf(stderr, "kernel_launch: unexpected n_in %d / ws %zu (need %zu)\n", n_in, ws_size, (size_t)WS_END); grid = -1; return; }
        int dev = 0, cus = 0, per_cu = 0;
        hipGetDevice(&dev); hipDeviceGetAttribute(&cus, hipDeviceAttributeMultiprocessorCount, dev);
        hipFuncSetAttribute((const void*)fwd_kernel, hipFuncAttributeMaxDynamicSharedMemorySize, LDS_BYTES);
        hipOccupancyMaxActiveBlocksPerMultiprocessor(&per_cu, (const void*)fwd_kernel, 512, LDS_BYTES);
        if (per_cu < 1) { fprintf(stderr, "kernel_launch: occupancy query says %d blocks/CU\n", per_cu); per_cu = 1; }
        (void)hipGetLastError();
        grid = cus * 1;
    }
    if (grid < 0) return;
    Args a{};
    for (int i = 0; i < 35; ++i) a.in[i] = (const float*)d_in[i];
    a.out = (float*)d_out; a.ws = (unsigned char*)d_ws;
#if MK_MULTI
    for (int ph = 0; ph < NPHASES; ++ph) { a.ph_lo = ph; a.ph_hi = ph + 1; hipLaunchKernelGGL(fwd_kernel, dim3(grid), dim3(512), LDS_BYTES, stream, a); }
#else
    a.ph_lo = 0; a.ph_hi = NPHASES;
    hipMemsetAsync((char*)d_ws + WS_BAR, 0, 16384, stream);
    void* args[] = {&a};
    hipError_t e = hipLaunchCooperativeKernel((const void*)fwd_kernel, dim3(grid), dim3(512), args, LDS_BYTES, stream);
    if (e != hipSuccess) fprintf(stderr, "cooperative launch failed: %s (grid %d)\n", hipGetErrorString(e), grid);
#endif
}
```

```cpp
#include <hip/hip_runtime.h>
#include <hip/hip_cooperative_groups.h>
#include <cstdio>
#include <cstdint>
namespace cg = cooperative_groups;

#ifndef MK_MULTI
#define MK_MULTI 0
#endif

#define DI __device__ __forceinline__
#define LAS __attribute__((address_space(3)))
typedef unsigned short bf16_t;
typedef short bf16x8 __attribute__((ext_vector_type(8)));
typedef float f32x4 __attribute__((ext_vector_type(4)));
typedef float f32x2 __attribute__((ext_vector_type(2)));
typedef float f32x16 __attribute__((ext_vector_type(16)));
typedef unsigned u32x4 __attribute__((ext_vector_type(4)));
typedef unsigned u32x2 __attribute__((ext_vector_type(2)));
typedef __bf16 bf16x2_t __attribute__((ext_vector_type(2)));

constexpr int DM = 1024, NB = 4, SEQ = 8192, CTX = 256, TPB = SEQ + CTX  , ROWS = NB * TPB  , FF = 2816;
constexpr int NRT = ROWS / 256;
constexpr float LN_EPS = 1e-6f, RMS_EPS = 1e-6f;
constexpr float DN_ALPHA = 1.41421356237f;
constexpr float LOG2E = 1.4426950408889634f;
constexpr float MLA_QSCALE = 0.10206207261596577f * LOG2E;
constexpr float DIFF_QSCALE = 0.125f * LOG2E;
constexpr float LAMBDA_INIT = 0.35550906f;

constexpr size_t MiB = 1u << 20;
constexpr size_t WS_MOD = 0;
constexpr size_t WS_TAB16 = 256 * 1024;
constexpr size_t WS_TAB8 = WS_TAB16 + 16384;
constexpr size_t WS_BAR = 512 * 1024;
constexpr size_t WS_XC = 1 * MiB;
constexpr size_t WS_W = 5 * MiB;
constexpr size_t W_IN0 = WS_W;
constexpr size_t W_UQ = W_IN0 + 1280 * 1024 * 2;
constexpr size_t W_KN = W_UQ + 768 * 256 * 2;
constexpr size_t W_V0 = W_KN + 512 * 256 * 2;
constexpr size_t W_OUT0 = W_V0 + 512 * 256 * 2;
constexpr size_t W_GU0 = W_OUT0 + 1024 * 1024 * 2;
constexpr size_t W_D0 = W_GU0 + 5632 * 1024 * 2;
constexpr size_t W_QK1 = W_D0 + 1024 * 2816 * 2;
constexpr size_t W_V1 = W_QK1 + 2048 * 1024 * 2;
constexpr size_t W_OUT1 = W_V1 + 1024 * 1024 * 2;
constexpr size_t W_GU1 = W_OUT1 + 1024 * 1024 * 2;
constexpr size_t W_D1 = W_GU1 + 5632 * 1024 * 2;
constexpr size_t W_DC = W_D1 + 1024 * 2816 * 2;
constexpr size_t W_D256 = W_DC + 256 * 128 * 2;
constexpr size_t W_END = W_D256 + 256 * 512 * 2;
static_assert(W_END <= 56 * MiB, "weights region");
constexpr size_t WS_DN = 56 * MiB;
constexpr size_t WS_AT4 = 88 * MiB;
constexpr size_t WS_R2 = 184 * MiB;
constexpr size_t WS_R3 = 250 * MiB;
constexpr size_t WS_R4 = WS_R3 + (size_t)ROWS * 1280 * 2;
constexpr size_t WS_CQN = WS_R4, WS_CKVN = WS_R4 + (size_t)ROWS * 256 * 2;
constexpr size_t WS_R5 = WS_R4 + (size_t)ROWS * 512 * 2;
constexpr size_t WS_Q = WS_R5;
constexpr size_t WS_KN = WS_Q + (size_t)ROWS * 768 * 2;
constexpr size_t WS_KR = WS_KN + (size_t)ROWS * 512 * 2;
constexpr size_t WS_VT0 = WS_KR + (size_t)ROWS * 32 * 2;
constexpr size_t WS_END = WS_VT0 + (size_t)512 * ROWS * 2;
constexpr size_t WS_Y0 = WS_R5;
constexpr size_t WS_PS = WS_R3 + (size_t)ROWS * DM * 2;
static_assert(WS_PS + (size_t)4 * 4096 * 512 * 2 <= WS_R4, "ps");
constexpr size_t WS_VT1 = WS_R3 + (size_t)ROWS * 2048 * 2;
static_assert(WS_END <= 512 * MiB, "workspace");
static_assert(WS_VT1 + (size_t)1024 * ROWS * 2 <= WS_END, "vt1");
static_assert(WS_R3 + (size_t)ROWS * FF * 2 <= WS_END, "hid");

DI int otid() { int t = threadIdx.x; asm volatile("" : "+v"(t)); return t; }
DI float wave_sum(float v) {
#pragma unroll
    for (int o = 1; o < 64; o <<= 1) v += __shfl_xor(v, o);
    return v;
}
DI unsigned cvtpk(float lo, float hi) { f32x2 v = {lo, hi}; bf16x2_t b = __builtin_convertvector(v, bf16x2_t); return __builtin_bit_cast(unsigned, b); }
DI float bf2f(unsigned short b) { return __uint_as_float(((unsigned)b) << 16); }
DI float bflo(unsigned w) { return __uint_as_float(w << 16); }
DI float bfhi(unsigned w) { return __uint_as_float(w & 0xffff0000u); }

namespace pg8 {
constexpr int BM = 256, BK = 64, HALF = 128, HTB = HALF * BK * 2, STAGE_BYTES = 8 * HTB, NXCD = 8, WGM = 8;
__host__ __device__ __forceinline__ int lds_byte(int r, int c) { const int st = (r >> 4) * 2 + (c >> 5), rr = r & 15, cc = c & 31, ob = rr * 64 + cc * 2; return st * 1024 + (ob ^ (((ob >> 9) & 1) << 5)); }
__host__ __device__ __forceinline__ void stage_rc(int b, int& R, int& C) { const int st = b / 1024, sb = b % 1024, swz = sb ^ (((sb >> 9) & 1) << 5); R = (st >> 1) * 16 + swz / 64; C = (st & 1) * 32 + (swz % 64) / 2; }
__host__ __device__ __forceinline__ int perm32(int rho) { const int n = rho >> 4, i = rho & 15; return 8 * (i >> 2) + 4 * n + (i & 3); }

struct Unit { int pm, pn, pb; };
struct Gemm {
    const bf16_t* A; const bf16_t* Bt; int nM, nN, nB, K, kseg;
    int a_rs, b_rs, a_seg, b_seg, a_bs, b_bs;
    int rot, skipctx;
};
struct StaticOrder {
    int nM, nN, nwg, tot, G, c, skipctx;
    DI void init(int nM_, int nN_, int nB_, int G_, int c_, int rot, int skip) { skipctx = skip; nM = nM_; nN = nN_; nwg = nM * nN; tot = nwg * nB_; G = G_; c = (c_ + G_ - (rot % G_)) % G_; }
    DI bool next(int i, Unit& u) const {
        const long L = (long)i * G + c; if (L >= tot) return false;
        u.pb = (int)(L / nwg); int wgid = (int)(L % nwg);
        { const int q = nwg / NXCD, r = nwg % NXCD, xcd = wgid % NXCD, off = wgid / NXCD; wgid = (xcd < r ? xcd * (q + 1) : r * (q + 1) + (xcd - r) * q) + off; }
        const int nig = WGM * nN, gid = wgid / nig, fm = gid * WGM, gsz = (nM - fm) < WGM ? (nM - fm) : WGM;
        u.pm = fm + ((wgid % nig) % gsz); u.pn = (wgid % nig) / gsz; if (skipctx) u.pm += (u.pm >> 5) + 1; return true;
    }
};

struct EpiStore {
    static constexpr bool PERM = true;
    bf16_t* O; int ldc, o_bs, ai_extra; float scale;
    DI void operator()(const f32x4 (&acc)[2][2][4][2], const Unit& u, int wr, int wc, int fr, int fq) const {
        const int row0 = u.pm * BM + wr * 64 + fr, col0 = u.pn * BM + wc * 32 + 8 * fq;
        bf16_t* base = O + (size_t)u.pb * o_bs;
#pragma unroll
        for (int ai = 0; ai < 2; ++ai)
#pragma unroll
            for (int m = 0; m < 4; ++m) { bf16_t* rowp = base + (size_t)(row0 + ai * HALF + m * 16) * ldc + (size_t)ai * ai_extra + col0;
#pragma unroll
                for (int bj = 0; bj < 2; ++bj) { const f32x4 v0 = acc[ai][bj][m][0] * scale, v1 = acc[ai][bj][m][1] * scale;
                    u32x4 w; w.x = cvtpk(v0[0], v0[1]); w.y = cvtpk(v0[2], v0[3]); w.z = cvtpk(v1[0], v1[1]); w.w = cvtpk(v1[2], v1[3]);
                    *(u32x4*)(rowp + bj * HALF) = w; } }
    }
};
struct EpiSwiglu {
    static constexpr bool PERM = true;
    bf16_t* O; int ldc;
    DI void operator()(const f32x4 (&acc)[2][2][4][2], const Unit& u, int wr, int wc, int fr, int fq) const {
        const int row0 = u.pm * BM + wr * 64 + fr, col0 = u.pn * HALF + wc * 32 + 8 * fq;
#pragma unroll
        for (int ai = 0; ai < 2; ++ai)
#pragma unroll
            for (int m = 0; m < 4; ++m) { bf16_t* rowp = O + (size_t)(row0 + ai * HALF + m * 16) * ldc + col0; float h[8];
#pragma unroll
                for (int n = 0; n < 2; ++n)
#pragma unroll
                    for (int i = 0; i < 4; ++i) { const float g = acc[ai][0][m][n][i], up = acc[ai][1][m][n][i];
                        h[n * 4 + i] = g * __builtin_amdgcn_rcpf(1.0f + __builtin_amdgcn_exp2f(-g * LOG2E)) * up; }
                u32x4 w; w.x = cvtpk(h[0], h[1]); w.y = cvtpk(h[2], h[3]); w.z = cvtpk(h[4], h[5]); w.w = cvtpk(h[6], h[7]);
                *(u32x4*)rowp = w; }
    }
};
template <int MODE> struct EpiRope {
    static constexpr bool PERM = false;
    bf16_t* O; int ldc; float qscale; int q_tiles, rope_from; const f32x2* tab;
    DI void operator()(const f32x4 (&acc)[2][2][4][2], const Unit& u, int wr, int wc, int fr, int fq) const {
        const float sc = u.pn < q_tiles ? qscale : 1.0f; const bool rope_tile = u.pn >= rope_from;
        const int col0 = u.pn * BM + wc * 32 + 4 * fq;
#pragma unroll
        for (int ai = 0; ai < 2; ++ai)
#pragma unroll
            for (int m = 0; m < 4; ++m) {
                const int row = u.pm * BM + ai * HALF + wr * 64 + m * 16 + fr; const int j = row % TPB; const int t = j - CTX;
                f32x4 cs0 = {1.f, 0.f, 1.f, 0.f}, cs1 = {1.f, 0.f, 1.f, 0.f};
                if (rope_tile && t >= 0) {
                    int pos, f0;
                    if (MODE == 16) { pos = (wc & 1) ? (t & 63) : (t >> 6); f0 = 4 * fq; } else { pos = (fq >> 1) ? (t & 63) : (t >> 6); f0 = 4 * (fq & 1); }
                    const f32x4* tp = (const f32x4*)(tab + pos * MODE + f0); cs0 = tp[0]; cs1 = tp[1];
                }
                const float c[4] = {cs0[0], cs0[2], cs1[0], cs1[2]}, s[4] = {cs0[1], cs0[3], cs1[1], cs1[3]};
                bf16_t* rowp = O + (size_t)row * ldc + col0;
#pragma unroll
                for (int bj = 0; bj < 2; ++bj) { const f32x4 x1 = acc[ai][bj][m][0] * sc, x2 = acc[ai][bj][m][1] * sc; float o1[4], o2[4];
#pragma unroll
                    for (int i = 0; i < 4; ++i) { o1[i] = x1[i] * c[i] - x2[i] * s[i]; o2[i] = x1[i] * s[i] + x2[i] * c[i]; }
                    u32x2 w1, w2; w1.x = cvtpk(o1[0], o1[1]); w1.y = cvtpk(o1[2], o1[3]); w2.x = cvtpk(o2[0], o2[1]); w2.y = cvtpk(o2[2], o2[3]);
                    *(u32x2*)(rowp + bj * HALF) = w1; *(u32x2*)(rowp + bj * HALF + 16) = w2; }
            }
    }
};

template <class Epi>
DI void gemm_phase(LAS unsigned char* lds, const Gemm g, const StaticOrder& S, const Epi& E) {
    const int tid = otid(), wid = __builtin_amdgcn_readfirstlane(tid >> 6), lane = tid & 63, wr = wid >> 2, wc = wid & 3, fr = lane & 15, fq = lane >> 4;
    const int nt = g.K / BK, kseg = g.kseg;
    unsigned voffA[2], voffB[2];
#pragma unroll
    for (int i = 0; i < 2; ++i) { int R, C; stage_rc(tid * 16 + i * 8192, R, C); const int Rb = Epi::PERM ? ((R & ~31) + perm32(R & 31)) : R;
        voffA[i] = (unsigned)(R * g.a_rs + C) * 2u; voffB[i] = (unsigned)(Rb * g.b_rs + C) * 2u; }
    const int kstep = BK * 2;
    const unsigned hstepA = (unsigned)HALF * g.a_rs * 2, hstepB = (unsigned)HALF * g.b_rs * 2;
    const unsigned tstepA = 2 * hstepA, tstepB = 2 * hstepB;
    const int segA = (g.a_seg - kseg * BK) * 2, segB = (g.b_seg - kseg * BK) * 2;
#define OFFA(t) ((t) * kstep + ((t) >= kseg ? segA : 0))
#define OFFB(t) ((t) * kstep + ((t) >= kseg ? segB : 0))
    const unsigned ldsw = (unsigned)wid * 1024u;
    const int aoff = lds_byte(wr * 64 + fr, fq * 8), boff = lds_byte(wc * 32 + fr, fq * 8);
#define PG8_SA(b, h) (((b) * 2 + (h)) * HTB)
#define PG8_SB(b, h) ((4 + (b) * 2 + (h)) * HTB)
#define PG8_STAGE(bufoff, gbase, voff) do { _Pragma("unroll") for (int _i = 0; _i < 2; ++_i) \
        __builtin_amdgcn_global_load_lds((const unsigned*)((const char*)(gbase) + (voff)[_i]), (LAS unsigned*)(lds + (bufoff) + ldsw + _i * 8192), 16, 0, 0); } while (0)
#define PG8_LDA(dst, b, h) do { _Pragma("unroll") for (int m = 0; m < 4; ++m) _Pragma("unroll") for (int k = 0; k < 2; ++k) dst[m][k] = *(const LAS bf16x8*)(lds + PG8_SA(b, h) + aoff + m * 2048 + k * 1024); } while (0)
#define PG8_LDB(dst, b, h) do { _Pragma("unroll") for (int n = 0; n < 2; ++n) _Pragma("unroll") for (int k = 0; k < 2; ++k) dst[n][k] = *(const LAS bf16x8*)(lds + PG8_SB(b, h) + boff + n * 2048 + k * 1024); } while (0)
#define PG8_MMA(ai, bj, At, Bt) do { __builtin_amdgcn_s_setprio(1); _Pragma("unroll") for (int m = 0; m < 4; ++m) _Pragma("unroll") for (int n = 0; n < 2; ++n) _Pragma("unroll") for (int k = 0; k < 2; ++k) \
        acc[ai][bj][m][n] = __builtin_amdgcn_mfma_f32_16x16x32_bf16(Bt[n][k], At[m][k], acc[ai][bj][m][n], 0, 0, 0); __builtin_amdgcn_s_setprio(0); } while (0)
#define PG8_WAIT_V(n) asm volatile("s_waitcnt vmcnt(" #n ")" ::: "memory")
#define PG8_WAIT_L(n) asm volatile("s_waitcnt lgkmcnt(" #n ")" ::: "memory")
#define PG8_BAR __builtin_amdgcn_s_barrier()
#define PG8_SCHED __builtin_amdgcn_sched_barrier(0)
    Unit cur, nxt; int ui = 0;
    if (!S.next(0, cur)) return;
    f32x4 acc[2][2][4][2];
#pragma unroll
    for (int a = 0; a < 2; ++a)
#pragma unroll
        for (int b = 0; b < 2; ++b)
#pragma unroll
            for (int m = 0; m < 4; ++m)
#pragma unroll
                for (int n = 0; n < 2; ++n) acc[a][b][m][n] = (f32x4){0.f, 0.f, 0.f, 0.f};
    bf16x8 At[4][2], B0[2][2], B1[2][2];
    const char* cA = (const char*)g.A + ((size_t)cur.pb * g.a_bs) * 2 + (size_t)cur.pm * tstepA;
    const char* cB = (const char*)g.Bt + ((size_t)cur.pb * g.b_bs) * 2 + (size_t)cur.pn * tstepB;
    {
        PG8_STAGE(PG8_SB(0, 0), cB, voffB); PG8_STAGE(PG8_SB(0, 1), cB + hstepB, voffB); PG8_STAGE(PG8_SA(0, 0), cA, voffA); PG8_STAGE(PG8_SA(0, 1), cA + hstepA, voffA);
        if (wr == 1) PG8_BAR;
        PG8_WAIT_V(2); PG8_BAR;
        PG8_STAGE(PG8_SB(1, 0), cB + OFFB(1), voffB); PG8_STAGE(PG8_SA(1, 0), cA + OFFA(1), voffA); PG8_STAGE(PG8_SB(1, 1), cB + hstepB + OFFB(1), voffB);
        PG8_WAIT_V(6); PG8_BAR;
    }
    for (;;) {
        const bool has_next = S.next(ui + 1, nxt);
        const char* nA = has_next ? (const char*)g.A + ((size_t)nxt.pb * g.a_bs) * 2 + (size_t)nxt.pm * tstepA : cA;
        const char* nB = has_next ? (const char*)g.Bt + ((size_t)nxt.pb * g.b_bs) * 2 + (size_t)nxt.pn * tstepB : cB;
        for (int t = 0; t < nt; t += 2) {
            const bool last = (t == nt - 2);
            const char* a1 = cA + OFFA(t + 1);
            const char* a2 = last ? nA : cA + OFFA(t + 2); const char* b2 = last ? nB : cB + OFFB(t + 2);
            const char* a3 = last ? nA + OFFA(1) : cA + OFFA(t + 3); const char* b3 = last ? nB + OFFB(1) : cB + OFFB(t + 3);
            PG8_LDB(B0, 0, 0); PG8_LDB(B1, 0, 1); PG8_SCHED; PG8_LDA(At, 0, 0); PG8_STAGE(PG8_SA(1, 1), a1 + hstepA, voffA);
            PG8_WAIT_V(8); PG8_WAIT_L(0); PG8_BAR; PG8_MMA(0, 0, At, B0); PG8_MMA(0, 1, At, B1); PG8_BAR; PG8_SCHED;
            PG8_LDA(At, 0, 1); PG8_STAGE(PG8_SB(0, 0), b2, voffB); PG8_STAGE(PG8_SB(0, 1), b2 + hstepB, voffB); PG8_STAGE(PG8_SA(0, 0), a2, voffA);
            PG8_WAIT_V(8); PG8_WAIT_L(0); PG8_BAR; PG8_MMA(1, 0, At, B0); PG8_MMA(1, 1, At, B1); PG8_BAR; PG8_SCHED;
            PG8_LDB(B0, 1, 0); PG8_LDB(B1, 1, 1); PG8_SCHED; PG8_LDA(At, 1, 0); PG8_STAGE(PG8_SA(0, 1), a2 + hstepA, voffA);
            PG8_WAIT_V(8); PG8_WAIT_L(0); PG8_BAR; PG8_MMA(0, 0, At, B0); PG8_MMA(0, 1, At, B1); PG8_BAR; PG8_SCHED;
            PG8_LDA(At, 1, 1); PG8_STAGE(PG8_SB(1, 0), b3, voffB); PG8_STAGE(PG8_SB(1, 1), b3 + hstepB, voffB); PG8_STAGE(PG8_SA(1, 0), a3, voffA);
            PG8_WAIT_V(8); PG8_WAIT_L(0); PG8_BAR; PG8_MMA(1, 0, At, B0); PG8_MMA(1, 1, At, B1); PG8_BAR; PG8_SCHED;
        }
        if (wr == 0) PG8_BAR;
        E(acc, cur, wr, wc, fr, fq);
        if (!has_next) break;
#pragma unroll
        for (int a = 0; a < 2; ++a)
#pragma unroll
            for (int b = 0; b < 2; ++b)
#pragma unroll
                for (int m = 0; m < 4; ++m)
#pragma unroll
                    for (int n = 0; n < 2; ++n) acc[a][b][m][n] = (f32x4){0.f, 0.f, 0.f, 0.f};
        cur = nxt; cA = nA; cB = nB; ++ui;
        if (wr == 1) PG8_BAR;
    }
    PG8_WAIT_V(0);
    PG8_BAR;
#undef OFFA
#undef OFFB
#undef PG8_SA
#undef PG8_SB
#undef PG8_STAGE
#undef PG8_LDA
#undef PG8_LDB
#undef PG8_MMA
#undef PG8_WAIT_V
#undef PG8_WAIT_L
#undef PG8_BAR
#undef PG8_SCHED
}
}

#define MFMA32(a, b, c) __builtin_amdgcn_mfma_f32_32x32x16_bf16((a), (b), (c), 0, 0, 0)
template <int D1, int D2, int DV>
DI void attn_core(f32x16 (&o)[DV / 32], float& l_out, LAS unsigned char* lds, const bf16_t* q1, const bf16_t* q2,
                  const bf16_t* k1, long ldk1, const bf16_t* k2, long ldk2, const bf16_t* vt, long ldv, int ntiles) {
    constexpr int DQK = D1 + D2, KROW = DQK * 2 + 16, VROW = 144, KT = 64 * KROW, VT = DV * VROW, BUF = KT + VT;
    constexpr int KCH = DQK / 8, NKC = 64 * KCH, NVC = DV * 8, KPT = (NKC + 511) / 512, VPT = NVC / 512;
    const int tid = otid(), lane = tid & 63, r = lane & 31, h = lane >> 5;
    bf16x8 qf[DQK / 16];
#pragma unroll
    for (int d0 = 0; d0 < DQK / 16; ++d0) qf[d0] = (16 * d0 < D1) ? *(const bf16x8*)(q1 + 16 * d0 + 8 * h) : *(const bf16x8*)(q2 + (16 * d0 - D1) + 8 * h);
    u32x4 kreg[KPT], vreg[VPT];
    auto gload = [&](int t) {
#pragma unroll
        for (int i = 0; i < KPT; ++i) { const int c = tid + i * 512; if (c < NKC) { const int row = c / KCH, cc = (c % KCH) * 8;
            kreg[i] = (cc < D1) ? *(const u32x4*)(k1 + (size_t)(t * 64 + row) * ldk1 + cc) : *(const u32x4*)(k2 + (size_t)(t * 64 + row) * ldk2 + (cc - D1)); } }
#pragma unroll
        for (int i = 0; i < VPT; ++i) { const int c = tid + i * 512; const int d = c >> 3, cc = (c & 7) * 8; vreg[i] = *(const u32x4*)(vt + (size_t)d * ldv + t * 64 + cc); }
    };
    auto sstore = [&](int b) {
        LAS unsigned char* kb = lds + b * BUF; LAS unsigned char* vb = kb + KT;
#pragma unroll
        for (int i = 0; i < KPT; ++i) { const int c = tid + i * 512; if (c < NKC) { const int row = c / KCH, cc = (c % KCH) * 8; *(LAS u32x4*)(kb + row * KROW + cc * 2) = kreg[i]; } }
#pragma unroll
        for (int i = 0; i < VPT; ++i) { const int c = tid + i * 512; const int d = c >> 3, cc = (c & 7) * 8; *(LAS u32x4*)(vb + d * VROW + cc * 2) = vreg[i]; }
    };
    const int pr = (r & ~12) | ((r & 4) << 1) | ((r & 8) >> 1);
    float mrun = 0.f, lrun = 0.f;
    f32x16 negm;
#pragma unroll
    for (int i = 0; i < 16; ++i) negm[i] = 0.f;
#pragma unroll
    for (int b = 0; b < DV / 32; ++b)
#pragma unroll
        for (int i = 0; i < 16; ++i) o[b][i] = 0.f;
    gload(0); sstore(0); if (ntiles > 1) { gload(1); sstore(1); } __syncthreads();
    for (int t = 0; t < ntiles; ++t) {
        if (t + 2 < ntiles) gload(t + 2);
        const LAS unsigned char* kb = lds + (t & 3) * BUF; const LAS unsigned char* vb = kb + KT;
        f32x16 p[2];
        {
            bf16x8 kf[2][DQK / 16];
#pragma unroll
            for (int hf = 0; hf < 2; ++hf)
#pragma unroll
                for (int d0 = 0; d0 < DQK / 16; ++d0) kf[hf][d0] = *(const LAS bf16x8*)(kb + (32 * hf + pr) * KROW + (16 * d0 + 8 * h) * 2);
            __builtin_amdgcn_sched_barrier(0);
            __builtin_amdgcn_s_setprio(1);
#pragma unroll
            for (int d0 = 0; d0 < DQK / 16; ++d0)
#pragma unroll
                for (int hf = 0; hf < 2; ++hf) p[hf] = MFMA32(kf[hf][d0], qf[d0], d0 == 0 ? negm : p[hf]);
            __builtin_amdgcn_sched_barrier(0);
        }
        constexpr int NBLK = DV / 32;
        bf16x8 vk[2][NBLK];
#define LDVK(buf, ks) do { _Pragma("unroll") for (int b_ = 0; b_ < NBLK; ++b_) vk[buf][b_] = *(const LAS bf16x8*)(vb + (32 * b_ + r) * VROW + (16 * (ks) + 8 * h) * 2); } while (0)
        LDVK(0, 0);
        __builtin_amdgcn_sched_barrier(0);
        float ta = fmaxf(fmaxf(p[0][0], p[0][1]), p[1][0]), tb = fmaxf(fmaxf(p[0][2], p[0][3]), p[1][1]);
        ta = fmaxf(fmaxf(ta, p[1][2]), p[1][3]);
#pragma unroll
        for (int i = 4; i < 16; i += 4) { ta = fmaxf(fmaxf(ta, p[0][i]), p[0][i + 1]); tb = fmaxf(fmaxf(tb, p[0][i + 2]), p[0][i + 3]); ta = fmaxf(fmaxf(ta, p[1][i]), p[1][i + 1]); tb = fmaxf(fmaxf(tb, p[1][i + 2]), p[1][i + 3]); }
        float tm = fmaxf(ta, tb);
        if (__any(t == 0 || tm > 8.0f)) {
            tm = fmaxf(tm, __shfl_xor(tm, 32));
            const float dl = (t == 0 || tm > 0.f) ? tm : 0.f; mrun += dl;
            const float alpha = __builtin_amdgcn_exp2f(-dl); lrun *= alpha;
#pragma unroll
            for (int i = 0; i < 16; ++i) { p[0][i] -= dl; p[1][i] -= dl; negm[i] = -mrun; }
#pragma unroll
            for (int b = 0; b < DV / 32; ++b)
#pragma unroll
                for (int i = 0; i < 16; ++i) o[b][i] *= alpha;
        }
        bf16x8 pf[4]; float rs = 0.f; u32x4 wq;
#define EXPPART(ks, j) do { const int hf_ = (ks) >> 1, s8_ = ((ks) & 1) * 8; const float e0_ = __builtin_amdgcn_exp2f(p[hf_][s8_ + 2 * (j)]), e1_ = __builtin_amdgcn_exp2f(p[hf_][s8_ + 2 * (j) + 1]); \
        rs += e0_; rs += e1_; wq[j] = cvtpk(e0_, e1_); } while (0)
        EXPPART(0, 0); EXPPART(0, 1); EXPPART(0, 2); EXPPART(0, 3); pf[0] = __builtin_bit_cast(bf16x8, wq);
        __builtin_amdgcn_sched_barrier(0);
#pragma unroll
        for (int ks = 0; ks < 4; ++ks) {
            if (ks < 3) LDVK((ks + 1) & 1, ks + 1);
            __builtin_amdgcn_sched_barrier(0);
#pragma unroll
            for (int b = 0; b < NBLK; ++b) {
                o[b] = MFMA32(vk[ks & 1][b], pf[ks], o[b]);
                if (ks < 3) {
#pragma unroll
                    for (int j = b * (4 / NBLK); j < (b + 1) * (4 / NBLK); ++j) {
                        if (ks == 0) EXPPART(1, j); else if (ks == 1) EXPPART(2, j); else EXPPART(3, j);
                    }
                }
                __builtin_amdgcn_sched_barrier(0);
            }
            if (ks < 3) pf[ks + 1] = __builtin_bit_cast(bf16x8, wq);
        }
        __builtin_amdgcn_s_setprio(0);
        lrun += rs;
#undef LDVK
#undef EXPPART
        if (t + 2 < ntiles) sstore((t + 2) & 3);
        if (t & 1) __syncthreads();
    }
    l_out = lrun + __shfl_xor(lrun, 32);
}
constexpr int ATTN_LDS = 2 * (64 * (96 * 2 + 16) + 128 * 144);


#define XB_TMO      128
#define XB_XCNT(j)  (256  + 64 * (j))
#define XB_XSUB(j)  (1280 + 64 * (j))
#define XB_XGEN(j)  (2304 + 64 * (j))
#define XB_TOP      3328
#define XB_TOPGEN   3392
#define XCD_BAR_WORDS 3456
#define XB_SPIN_CAP (1u << 18)
DI unsigned xb_ld(unsigned* p)              { return __hip_atomic_load(p, __ATOMIC_RELAXED, __HIP_MEMORY_SCOPE_AGENT); }
DI unsigned xb_add(unsigned* p, unsigned v) { return __hip_atomic_fetch_add(p, v, __ATOMIC_RELAXED, __HIP_MEMORY_SCOPE_AGENT); }
DI unsigned xb_xcc_id() { return (unsigned)__builtin_amdgcn_s_getreg((3 << 11) | 20) & 0xFu; }
#define XB_SPIN(cond, bar) do { unsigned _sp = 0; while (cond) { __builtin_amdgcn_s_sleep(1); \
    if ((++_sp & 255u) == 0u) { if (xb_ld(&(bar)[XB_TMO])) break; if (_sp > XB_SPIN_CAP) { atomicAdd(&(bar)[XB_TMO], 1u); break; } } } } while (0)
struct XcdBarrier { unsigned* bar; unsigned x; volatile LAS unsigned* st; };
DI XcdBarrier xcd_barrier_post(unsigned* bar, volatile LAS unsigned* st) {
    XcdBarrier b; b.bar = bar; b.x = xb_xcc_id(); b.st = st;
    if (threadIdx.x == 0) (void)xb_add(&bar[XB_XCNT(b.x)], 1u);
    return b;
}
DI void xcd_barrier_complete(unsigned* bar, unsigned x, unsigned& nloc, unsigned& nx) {
    const unsigned G = gridDim.x * gridDim.y * gridDim.z;
    unsigned sum, cnt, mine, sp = 0u;
    for (;;) {
        sum = 0u; cnt = 0u; mine = 0u;
#pragma unroll
        for (unsigned j = 0; j < 16; ++j) { const unsigned c = xb_ld(&bar[XB_XCNT(j)]); sum += c; cnt += (c > 0u) ? 1u : 0u; mine = (j == x) ? c : mine; }
        if (sum == G) break;
        __builtin_amdgcn_s_sleep(1);
        if ((++sp & 255u) == 0u) { if (xb_ld(&bar[XB_TMO])) break; if (sp > XB_SPIN_CAP) { atomicAdd(&bar[XB_TMO], 1u); break; } }
    }
    nloc = mine > 0u ? mine : 1u; nx = cnt > 0u ? cnt : 1u;
}
DI void xcd_barrier(const XcdBarrier& b) {
    asm volatile("s_waitcnt vmcnt(0)" ::: "memory");
    __syncthreads();
    if (threadIdx.x == 0) {
        unsigned* bar = b.bar;
        __builtin_amdgcn_s_waitcnt(0);
        unsigned nloc = b.st[0], nx = b.st[1];
        if (nloc == 0u) { xcd_barrier_complete(bar, b.x, nloc, nx); b.st[0] = nloc; b.st[1] = nx; }
        const unsigned old = xb_add(&bar[XB_XSUB(b.x)], 1u);
        const unsigned gen = old / nloc;
        if (old + 1u == (gen + 1u) * nloc) {
            __builtin_amdgcn_fence(__ATOMIC_RELEASE, "agent");
            asm volatile("s_waitcnt vmcnt(0)" ::: "memory");
            const unsigned og = xb_add(&bar[XB_TOP], 1u);
            const unsigned tg = og / nx;
            if (og + 1u == (tg + 1u) * nx) xb_add(&bar[XB_TOPGEN], 1u);
            else XB_SPIN(xb_ld(&bar[XB_TOPGEN]) == tg, bar);
            __builtin_amdgcn_fence(__ATOMIC_ACQUIRE, "agent");
            xb_add(&bar[XB_XGEN(b.x)], 1u);
            asm volatile("s_waitcnt vmcnt(0)" ::: "memory");
        } else {
            XB_SPIN(xb_ld(&bar[XB_XGEN(b.x)]) == gen, bar);
            __builtin_amdgcn_fence(__ATOMIC_ACQUIRE, "agent");
            asm volatile("s_waitcnt vmcnt(0)" ::: "memory");
        }
    }
    __syncthreads();
}

struct Args {
    const float* in[35]; float* out; unsigned char* ws; int ph_lo, ph_hi, use_cg, pad;
};
enum { I_X = 0, I_C, I_CTX, I_CCTX,
       I0_WMOD, I0_BMOD, I0_WIN, I0_QN, I0_WUQ, I0_KVN, I0_WUKV, I0_WOUT, I0_LN1G, I0_LN1B, I0_WG, I0_WU, I0_WD, I0_LN2G, I0_LN2B,
       I1_WMOD, I1_BMOD, I1_WIN, I1_LQ1, I1_LK1, I1_LQ2, I1_LK2, I1_SUBLN, I1_WOUT, I1_LN1G, I1_LN1B, I1_WG, I1_WU, I1_WD, I1_LN2G, I1_LN2B };

DI bf16_t* tr_dst(int job, int n, unsigned char* ws) {
    switch (job) {
    case 0: return (bf16_t*)(ws + W_IN0) + (size_t)n * 1024;
    case 1: { const int hd = n / 96, d = n % 96; int row; if (d < 64) row = hd * 64 + d; else { const int e = d - 64, t = e >> 3, f = e & 7; row = 512 + hd * 32 + 16 * (t & 1) + 8 * (t >> 1) + f; }
              return (bf16_t*)(ws + W_UQ) + (size_t)row * 256; }
    case 2: { const int hd = n >> 7, d = n & 127; return d < 64 ? (bf16_t*)(ws + W_KN) + (size_t)(hd * 64 + d) * 256 : (bf16_t*)(ws + W_V0) + (size_t)(hd * 64 + d - 64) * 256; }
    case 3: return (bf16_t*)(ws + W_OUT0) + (size_t)n * 1024;
    case 4: return (bf16_t*)(ws + W_GU0) + (size_t)(256 * (n >> 7) + (n & 127)) * 1024;
    case 5: return (bf16_t*)(ws + W_GU0) + (size_t)(256 * (n >> 7) + 128 + (n & 127)) * 1024;
    case 6: return (bf16_t*)(ws + W_D0) + (size_t)n * 2816;
    case 7: return n < 2048 ? (bf16_t*)(ws + W_QK1) + (size_t)n * 1024 : (bf16_t*)(ws + W_V1) + (size_t)(n - 2048) * 1024;
    case 8: return (bf16_t*)(ws + W_OUT1) + (size_t)n * 1024;
    case 9: return (bf16_t*)(ws + W_GU1) + (size_t)(256 * (n >> 7) + (n & 127)) * 1024;
    case 10: return (bf16_t*)(ws + W_GU1) + (size_t)(256 * (n >> 7) + 128 + (n & 127)) * 1024;
    default: return (bf16_t*)(ws + W_D1) + (size_t)n * 2816;
    }
}
DI void transpose_item(const float* W, int K, int N, int job, unsigned char* ws, LAS float* scr, int item, int lane) {
    const int nblk = N / 32, kb = item / nblk, nb = item % nblk, k0 = 64 * kb, n0 = 32 * nb;
#pragma unroll 8
    for (int i = 0; i < 32; ++i) { const int kk = 2 * i + (lane >> 5); scr[kk * 33 + (lane & 31)] = W[(size_t)(k0 + kk) * N + n0 + (lane & 31)]; }
    asm volatile("s_waitcnt lgkmcnt(0)" ::: "memory");
    const int c = lane & 7;
#pragma unroll
    for (int j = 0; j < 4; ++j) { const int n = (lane >> 3) + 8 * j; const LAS float* s = scr + (8 * c) * 33 + n;
        u32x4 o; o.x = cvtpk(s[0 * 33], s[1 * 33]); o.y = cvtpk(s[2 * 33], s[3 * 33]); o.z = cvtpk(s[4 * 33], s[5 * 33]); o.w = cvtpk(s[6 * 33], s[7 * 33]);
        bf16_t* dst = tr_dst(job, n0 + n, ws); *(u32x4*)(dst + k0 + 8 * c) = o; }
    asm volatile("s_waitcnt lgkmcnt(0)" ::: "memory");
}

DI void prologue(const Args& a, LAS unsigned char* lds) {
    unsigned char* ws = a.ws;
    const int tid = otid(), lane = tid & 63, wave = tid >> 6;
    const int G = gridDim.x, gw = blockIdx.x * 8 + wave, NGW = G * 8;
    const long gt = (long)blockIdx.x * 512 + tid, NGT = (long)G * 512;
    {
        LAS float* scr = (LAS float*)(lds + wave * 16384);
        const int jin[12] = {I0_WIN, I0_WUQ, I0_WUKV, I0_WOUT, I0_WG, I0_WU, I0_WD, I1_WIN, I1_WOUT, I1_WG, I1_WU, I1_WD};
        const int jK[12] = {1024, 256, 256, 1024, 1024, 1024, 2816, 1024, 1024, 1024, 1024, 2816};
        const int jN[12] = {1056, 768, 1024, 1024, 2816, 2816, 1024, 3072, 1024, 2816, 2816, 1024};
        int base = 0;
#pragma unroll
        for (int j = 0; j < 12; ++j) { const int items = (jK[j] / 64) * (jN[j] / 32);
            for (int it = gw; it < items; it += NGW) transpose_item(a.in[jin[j]], jK[j], jN[j], j, ws, scr, it, lane);
            base += items; }
        u32x4 z = {0u, 0u, 0u, 0u};
        for (long i = gt; i < (1280 - 1056) * 1024 / 8; i += NGT) ((u32x4*)((bf16_t*)(ws + W_IN0) + (size_t)1056 * 1024))[i] = z;
    }
    {
        const float sc = 0.011048543456039806f;
        for (long i = gt; i < (long)4 * 2 * 1024 * 256; i += NGT) { const long idx = i * 8; const int n0 = (int)(idx & 2047), kq = (int)(idx >> 11) & 1023, part = (int)(idx >> 21) & 1, rr = (int)(idx >> 22); const int k = 4 * kq + rr; float v[8];
#pragma unroll
            for (int e = 0; e < 8; ++e) { const float ph = (float)((k * (n0 + e)) & 8191) * (1.0f / 8192.0f); v[e] = (part ? __builtin_amdgcn_sinf(ph) : __builtin_amdgcn_cosf(ph)) * ((part && rr == 3) ? -sc : sc); }
            u32x4 o; o.x = cvtpk(v[0], v[1]); o.y = cvtpk(v[2], v[3]); o.z = cvtpk(v[4], v[5]); o.w = cvtpk(v[6], v[7]);
            *(u32x4*)((bf16_t*)(ws + WS_DN) + idx) = o; }
        for (long i = gt; i < 256 * 512; i += NGT) { const int k = (int)(i >> 9), c = (int)(i & 511), part = c >> 8, n = c & 255; const float ph = (float)((k * n) & 255) * (1.0f / 256.0f);
            const float v = (part ? __builtin_amdgcn_sinf(ph) : __builtin_amdgcn_cosf(ph)) * 0.0625f; ((bf16_t*)(ws + W_D256))[i] = (bf16_t)(cvtpk(v, 0.f) & 0xffffu); }
        for (long i = gt; i < 256 * 128; i += NGT) { const int rr = (int)(i >> 7), c = (int)(i & 127), part = rr >> 7, l = rr & 127; const float ph = (float)((l * c) & 127) * (1.0f / 128.0f);
            const float v = (part ? -__builtin_amdgcn_sinf(ph) : __builtin_amdgcn_cosf(ph)) * 0.08838834764831845f; ((bf16_t*)(ws + W_DC))[i] = (bf16_t)(cvtpk(v, 0.f) & 0xffffu); }
        for (long i = gt; i < 128 * 16; i += NGT) { const int pos = (int)(i >> 4), f = (int)(i & 15); const float inv = 1.0f / powf(10000.0f, (float)f / 16.0f); const float ang = (float)pos * inv;
            ((f32x2*)(ws + WS_TAB16))[i] = (f32x2){cosf(ang), sinf(ang)}; }
        for (long i = gt; i < 128 * 8; i += NGT) { const int pos = (int)(i >> 3), f = (int)(i & 7); const float inv = 1.0f / powf(10000.0f, (float)f / 8.0f); const float ang = (float)pos * inv;
            ((f32x2*)(ws + WS_TAB8))[i] = (f32x2){cosf(ang), sinf(ang)}; }
    }
    {
        LAS float* red = (LAS float*)lds;
        LAS float* sl = (LAS float*)(lds + 16384);
        __syncthreads();
        if (blockIdx.x < 2 * 96) {
            for (int i = tid; i < 5 * 1024; i += 512) { const int cls = i >> 10, k = i & 1023; const float cv = cls < 4 ? a.in[I_C][cls * 1024 + k] : a.in[I_CCTX][k]; sl[i] = cv / (1.0f + __expf(-cv)); }
        }
        __syncthreads();
        for (int it = blockIdx.x; it < 2 * 96; it += G) {
            const int layer = it / 96, n = (it % 96) * 64 + lane; const float* w = a.in[layer ? I1_WMOD : I0_WMOD] + (size_t)(wave * 128) * 6144 + n; const float* bm = a.in[layer ? I1_BMOD : I0_BMOD];
            float acc[5] = {0.f, 0.f, 0.f, 0.f, 0.f};
            for (int k0 = 0; k0 < 128; k0 += 16) { float wv[16];
#pragma unroll
                for (int u = 0; u < 16; ++u) wv[u] = w[(size_t)(k0 + u) * 6144];
#pragma unroll
                for (int u = 0; u < 16; ++u)
#pragma unroll
                    for (int cls = 0; cls < 5; ++cls) acc[cls] += sl[cls * 1024 + wave * 128 + k0 + u] * wv[u]; }
#pragma unroll
            for (int cls = 0; cls < 5; ++cls) red[(wave * 5 + cls) * 64 + lane] = acc[cls];
            __syncthreads();
            if (tid < 320) { const int cls = tid >> 6, l = tid & 63; float s_ = 0.f;
#pragma unroll
                for (int w8 = 0; w8 < 8; ++w8) s_ += red[(w8 * 5 + cls) * 64 + l];
                const int nn = (it % 96) * 64 + l; ((float*)(ws + WS_MOD))[(size_t)(layer * 5 + cls) * 6144 + nn] = s_ + bm[nn]; }
            __syncthreads();
        }
    }
}

struct RowPass {
    const float* xl; const float* xc;
    float* ol; float* oc;
    const bf16_t* Y;
    const float* mod;
    int gate_off; const float* lng; const float* lnb;
    const float* mod2; int sc_off, sh_off;
    bf16_t* H;
    int skipctx;
};
DI void ln_stats(const f32x4 (&v)[4], float& mean, float& rstd) {
    float s = 0.f;
#pragma unroll
    for (int j = 0; j < 4; ++j) s += (v[j][0] + v[j][1]) + (v[j][2] + v[j][3]);
    mean = wave_sum(s) * (1.0f / DM); float q = 0.f;
#pragma unroll
    for (int j = 0; j < 4; ++j) { const f32x4 d = v[j] - mean; q += (d[0] * d[0] + d[1] * d[1]) + (d[2] * d[2] + d[3] * d[3]); }
    rstd = 1.0f / sqrtf(wave_sum(q) * (1.0f / DM) + LN_EPS);
}
DI void row_pass(const RowPass& P, int m, int lane) {
    const int b = m / TPB, j = m % TPB; const bool isctx = j < CTX; const int cls = isctx ? 4 : b;
    if (P.skipctx && isctx) return;
    const size_t xoff = isctx ? (size_t)(b * CTX + j) * DM : (size_t)(b * SEQ + j - CTX) * DM;
    const float* xs = (isctx ? P.xc : P.xl) + xoff; float* xd = isctx ? P.oc : P.ol;
    f32x4 v[4];
#pragma unroll
    for (int jj = 0; jj < 4; ++jj) v[jj] = *(const f32x4*)(xs + 4 * lane + 256 * jj);
    if (P.Y) {
        const float* gate = P.mod + (size_t)cls * 6144 + P.gate_off;
#pragma unroll
        for (int jj = 0; jj < 4; ++jj) { const int c0 = 4 * lane + 256 * jj; const u32x2 yw = *(const u32x2*)(P.Y + (size_t)m * DM + c0); const f32x4 g = *(const f32x4*)(gate + c0);
            v[jj][0] = DN_ALPHA * v[jj][0] + g[0] * bflo(yw.x); v[jj][1] = DN_ALPHA * v[jj][1] + g[1] * bfhi(yw.x);
            v[jj][2] = DN_ALPHA * v[jj][2] + g[2] * bflo(yw.y); v[jj][3] = DN_ALPHA * v[jj][3] + g[3] * bfhi(yw.y); }
        float mean, rstd; ln_stats(v, mean, rstd);
#pragma unroll
        for (int jj = 0; jj < 4; ++jj) { const int c0 = 4 * lane + 256 * jj; const f32x4 g = *(const f32x4*)(P.lng + c0), bb = *(const f32x4*)(P.lnb + c0); v[jj] = (v[jj] - mean) * rstd * g + bb; }
        if (xd) {
#pragma unroll
            for (int jj = 0; jj < 4; ++jj) *(f32x4*)(xd + xoff + 4 * lane + 256 * jj) = v[jj];
        }
    }
    if (P.H) {
        float mean, rstd; ln_stats(v, mean, rstd);
        const float* sc = P.mod2 + (size_t)cls * 6144 + P.sc_off; const float* sh = P.mod2 + (size_t)cls * 6144 + P.sh_off;
#pragma unroll
        for (int jj = 0; jj < 4; ++jj) { const int c0 = 4 * lane + 256 * jj; const f32x4 s1 = *(const f32x4*)(sc + c0), s0 = *(const f32x4*)(sh + c0);
            const f32x4 hh = (v[jj] - mean) * rstd * (s1 + 1.0f) + s0; u32x2 w; w.x = cvtpk(hh[0], hh[1]); w.y = cvtpk(hh[2], hh[3]);
            *(u32x2*)(P.H + (size_t)m * DM + c0) = w; }
    }
}
DI void p3_row(const Args& a, int m, int lane) {
    unsigned char* ws = a.ws; const bf16_t* U = (const bf16_t*)(ws + WS_R3) + (size_t)m * 1280;
    const u32x2 qw = *(const u32x2*)(U + 512 + 4 * lane), kw = *(const u32x2*)(U + 768 + 4 * lane);
    float q[4] = {bflo(qw.x), bfhi(qw.x), bflo(qw.y), bfhi(qw.y)}, k[4] = {bflo(kw.x), bfhi(kw.x), bflo(kw.y), bfhi(kw.y)};
    const float qs = wave_sum(q[0] * q[0] + q[1] * q[1] + q[2] * q[2] + q[3] * q[3]), ks = wave_sum(k[0] * k[0] + k[1] * k[1] + k[2] * k[2] + k[3] * k[3]);
    const float qr = 1.0f / sqrtf(qs * (1.0f / 256.0f) + RMS_EPS), kr_ = 1.0f / sqrtf(ks * (1.0f / 256.0f) + RMS_EPS);
    const f32x4 qg = *(const f32x4*)(a.in[I0_QN] + 4 * lane), kg = *(const f32x4*)(a.in[I0_KVN] + 4 * lane);
    u32x2 w; w.x = cvtpk(q[0] * qr * qg[0], q[1] * qr * qg[1]); w.y = cvtpk(q[2] * qr * qg[2], q[3] * qr * qg[3]);
    *(u32x2*)((bf16_t*)(ws + WS_CQN) + (size_t)m * 256 + 4 * lane) = w;
    w.x = cvtpk(k[0] * kr_ * kg[0], k[1] * kr_ * kg[1]); w.y = cvtpk(k[2] * kr_ * kg[2], k[3] * kr_ * kg[3]);
    *(u32x2*)((bf16_t*)(ws + WS_CKVN) + (size_t)m * 256 + 4 * lane) = w;
    const int d = lane & 31, t = d >> 3, f = d & 7; const float val = bf2f(U[1024 + d]); const float par = __shfl_xor(val, 8);
    const int j = m % TPB, tt = j - CTX; float outv = val;
    if (tt >= 0) { const int pos = (t < 2) ? (tt >> 6) : (tt & 63); const f32x2 cs = ((const f32x2*)(ws + WS_TAB8))[pos * 8 + f];
        outv = (t & 1) ? (par * cs[1] + val * cs[0]) : (val * cs[0] - par * cs[1]); }
    if (lane < 32) ((bf16_t*)(ws + WS_KR))[(size_t)m * 32 + 16 * (t & 1) + 8 * (t >> 1) + f] = (bf16_t)(cvtpk(outv, 0.f) & 0xffffu);
}

DI void fold_items(const Args& a, int gw, int NGW, int lane) {
    unsigned char* ws = a.ws; const bf16_t* At = (const bf16_t*)(ws + WS_R2); bf16_t* At4 = (bf16_t*)(ws + WS_AT4);
    for (int it = gw; it < 512 * NB; it += NGW) { const int gl = it >> 2, b = it & 3;
        const bf16_t* sx = At + (size_t)gl * ROWS + b * TPB + CTX; const bf16_t* sy = sx + (size_t)512 * ROWS;
        for (int i = 0; i < 4; ++i) { const int n = (i * 64 + lane) * 8; u32x4 xw[4], yw[4];
#pragma unroll
            for (int j = 0; j < 4; ++j) { xw[j] = *(const u32x4*)(sx + n + 2048 * j); yw[j] = *(const u32x4*)(sy + n + 2048 * j); }
            u32x4 o[4][2];
#pragma unroll
            for (int q = 0; q < 4; ++q) {
                float cr[4][2], ci[4][2];
#pragma unroll
                for (int e = 0; e < 2; ++e) { float x[4], y[4];
#pragma unroll
                    for (int j = 0; j < 4; ++j) { x[j] = e ? bfhi(xw[j][q]) : bflo(xw[j][q]); y[j] = e ? bfhi(yw[j][q]) : bflo(yw[j][q]); }
                    const float sx02 = x[0] + x[2], dx02 = x[0] - x[2], sx13 = x[1] + x[3], dx13 = x[1] - x[3];
                    const float sy02 = y[0] + y[2], dy02 = y[0] - y[2], sy13 = y[1] + y[3], dy13 = y[1] - y[3];
                    cr[0][e] = sx02 + sx13; ci[0][e] = sy02 + sy13;
                    cr[1][e] = dx02; ci[1][e] = -dx13;
                    cr[2][e] = sx02 - sx13; ci[2][e] = sy02 - sy13;
                    cr[3][e] = dy13; ci[3][e] = dy02; }
#pragma unroll
                for (int r = 0; r < 4; ++r) { o[r][0][q] = cvtpk(cr[r][0], cr[r][1]); o[r][1][q] = cvtpk(ci[r][0], ci[r][1]); }
            }
#pragma unroll
            for (int r = 0; r < 4; ++r)
#pragma unroll
                for (int p = 0; p < 2; ++p) *(u32x4*)(At4 + ((size_t)((r * 2 + p) * 512 + gl)) * 8192 + b * 2048 + n) = o[r][p];
        }
    }
}
DI void mirror_items(const Args& a, int gw, int NGW, int lane) {
    unsigned char* ws = a.ws; bf16_t* MIX = (bf16_t*)(ws + WS_R3); const bf16_t* At = (const bf16_t*)(ws + WS_R2);
    for (int it = gw; it < NB * 512; it += NGW) { const int b = it >> 9, ch = it & 511; const bf16_t* src = (const bf16_t*)(ws + WS_AT4) + (size_t)ch * 8192 + b * 2048; float s = 0.f;
        for (int i = 0; i < 4; ++i) { const u32x4 w = *(const u32x4*)(src + (i * 64 + lane) * 8);
            s += (bflo(w.x) - bfhi(w.x)) + (bflo(w.y) - bfhi(w.y)) + (bflo(w.z) - bfhi(w.z)) + (bflo(w.w) - bfhi(w.w)); }
        s = wave_sum(s) * 0.011048543456039806f;
        if (lane == 0) MIX[(size_t)(b * TPB + CTX + 4096) * DM + ch] = (bf16_t)(cvtpk(s, 0.f) & 0xffffu); }
    const bf16_t* PS = (const bf16_t*)(ws + WS_PS);
    for (int it = gw; it < NB * 4096; it += NGW) { const int b = it >> 12, k = it & 4095;
        bf16_t* src = MIX + (size_t)(b * TPB + CTX + k) * DM + 8 * lane; const u32x4 pc = *(const u32x4*)src; const u32x4 ps = *(const u32x4*)(PS + ((size_t)(b * 4096 + k)) * 512 + 8 * lane);
        u32x4 sm, df;
        sm.x = cvtpk(bflo(pc.x) + bflo(ps.x), bfhi(pc.x) + bfhi(ps.x)); df.x = cvtpk(bflo(pc.x) - bflo(ps.x), bfhi(pc.x) - bfhi(ps.x));
        sm.y = cvtpk(bflo(pc.y) + bflo(ps.y), bfhi(pc.y) + bfhi(ps.y)); df.y = cvtpk(bflo(pc.y) - bflo(ps.y), bfhi(pc.y) - bfhi(ps.y));
        sm.z = cvtpk(bflo(pc.z) + bflo(ps.z), bfhi(pc.z) + bfhi(ps.z)); df.z = cvtpk(bflo(pc.z) - bflo(ps.z), bfhi(pc.z) - bfhi(ps.z));
        sm.w = cvtpk(bflo(pc.w) + bflo(ps.w), bfhi(pc.w) + bfhi(ps.w)); df.w = cvtpk(bflo(pc.w) - bflo(ps.w), bfhi(pc.w) - bfhi(ps.w));
        *(u32x4*)src = sm;
        if (k >= 1) *(u32x4*)(MIX + (size_t)(b * TPB + CTX + 8192 - k) * DM + 8 * lane) = df; }
}

DI bool attn_unit_map(int L, int nunits_big, int& bh, int& qb) {
    if (L < nunits_big) { const int i = L >> 8, c = L & 255; bh = 4 * (c & 7) + i; qb = 1 + (c >> 3); return true; }
    bh = L - nunits_big; qb = 0; return bh < 32;
}
DI void attn_mla_unit(const Args& a, LAS unsigned char* lds, int bh, int qb) {
    unsigned char* ws = a.ws; const int tid = otid(), lane = tid & 63, wave = tid >> 6, r = lane & 31, h = lane >> 5;
    const int b = bh >> 3, hd = bh & 7; const int m = b * TPB + qb * 256 + wave * 32 + r;
    const bf16_t* Q = (const bf16_t*)(ws + WS_Q) + (size_t)m * 768;
    const bf16_t* KN = (const bf16_t*)(ws + WS_KN) + (size_t)(b * TPB) * 512 + hd * 64;
    const bf16_t* KR = (const bf16_t*)(ws + WS_KR) + (size_t)(b * TPB) * 32;
    const bf16_t* VT = (const bf16_t*)(ws + WS_VT0) + (size_t)(hd * 64) * ROWS + b * TPB;
    f32x16 o[2]; float l;
    attn_core<64, 32, 64>(o, l, lds, Q + hd * 64, Q + 512 + hd * 32, KN, 512, KR, 32, VT, ROWS, qb == 0 ? CTX / 64 : TPB / 64);
    const float il = 1.0f / l; bf16_t* dst = (bf16_t*)(ws + WS_R3) + (size_t)m * DM + 512 + hd * 64;
#pragma unroll
    for (int blk = 0; blk < 2; ++blk)
#pragma unroll
        for (int g = 0; g < 4; ++g) { u32x2 w; w.x = cvtpk(o[blk][4 * g] * il, o[blk][4 * g + 1] * il); w.y = cvtpk(o[blk][4 * g + 2] * il, o[blk][4 * g + 3] * il);
            *(u32x2*)(dst + 32 * blk + 8 * g + 4 * h) = w; }
}
DI void attn_diff_unit(const Args& a, LAS unsigned char* lds, int bh, int qb, float lam) {
    unsigned char* ws = a.ws; const int tid = otid(), lane = tid & 63, wave = tid >> 6, r = lane & 31, h = lane >> 5;
    const int b = bh >> 3, hd = bh & 7; const int m = b * TPB + qb * 256 + wave * 32 + r;
    const bf16_t* QK = (const bf16_t*)(ws + WS_R3);
    const bf16_t* VT = (const bf16_t*)(ws + WS_VT1) + (size_t)(hd * 128) * ROWS + b * TPB;
    bf16_t* dst = (bf16_t*)(ws + WS_R2) + (size_t)m * DM + hd * 128;
    f32x16 o[4]; float l;
    {
        const bf16_t* q = QK + (size_t)m * 2048 + (hd * 2) * 64; const bf16_t* k = QK + (size_t)(b * TPB) * 2048 + 1024 + (hd * 2) * 64;
        attn_core<64, 0, 128>(o, l, lds, q, q, k, 2048, k, 2048, VT, ROWS, TPB / 64);
        const float il = 1.0f / l;
#pragma unroll
        for (int blk = 0; blk < 4; ++blk)
#pragma unroll
            for (int g = 0; g < 4; ++g) { u32x2 w; w.x = cvtpk(o[blk][4 * g] * il, o[blk][4 * g + 1] * il); w.y = cvtpk(o[blk][4 * g + 2] * il, o[blk][4 * g + 3] * il); *(u32x2*)(dst + 32 * blk + 8 * g + 4 * h) = w; }
    }
    {
        const bf16_t* q = QK + (size_t)m * 2048 + (hd * 2 + 1) * 64; const bf16_t* k = QK + (size_t)(b * TPB) * 2048 + 1024 + (hd * 2 + 1) * 64;
        attn_core<64, 0, 128>(o, l, lds, q, q, k, 2048, k, 2048, VT, ROWS, TPB / 64);
    }
    const float il = lam / l; float ss = 0.f;
#pragma unroll
    for (int blk = 0; blk < 4; ++blk)
#pragma unroll
        for (int g = 0; g < 4; ++g) { const u32x2 aw = *(const u32x2*)(dst + 32 * blk + 8 * g + 4 * h);
            const float x0 = bflo(aw.x) - o[blk][4 * g] * il, x1 = bfhi(aw.x) - o[blk][4 * g + 1] * il, x2 = bflo(aw.y) - o[blk][4 * g + 2] * il, x3 = bfhi(aw.y) - o[blk][4 * g + 3] * il;
            o[blk][4 * g] = x0; o[blk][4 * g + 1] = x1; o[blk][4 * g + 2] = x2; o[blk][4 * g + 3] = x3; ss += (x0 * x0 + x1 * x1) + (x2 * x2 + x3 * x3); }
    ss += __shfl_xor(ss, 32);
    const float rn = (1.0f - LAMBDA_INIT) / sqrtf(ss * (1.0f / 128.0f) + RMS_EPS);
    const float* sub = a.in[I1_SUBLN];
#pragma unroll
    for (int blk = 0; blk < 4; ++blk)
#pragma unroll
        for (int g = 0; g < 4; ++g) { const int d0 = 32 * blk + 8 * g + 4 * h; const f32x4 sg = *(const f32x4*)(sub + d0);
            u32x2 w; w.x = cvtpk(o[blk][4 * g] * rn * sg[0], o[blk][4 * g + 1] * rn * sg[1]); w.y = cvtpk(o[blk][4 * g + 2] * rn * sg[2], o[blk][4 * g + 3] * rn * sg[3]);
            *(u32x2*)(dst + d0) = w; }
}

constexpr int NPHASES = 19;
constexpr int LDS_BYTES = 147456;
struct GOp { int kind; pg8::Gemm g; bf16_t* O; int ldc, o_bs, ai_extra; float scale; int q_tiles, rope_from; };

DI bool get_gemm(int ph, int sub, const Args& a, GOp& op) {
    unsigned char* ws = a.ws;
    bf16_t* R2 = (bf16_t*)(ws + WS_R2); bf16_t* R3 = (bf16_t*)(ws + WS_R3);
    op.kind = 0; op.o_bs = 0; op.ai_extra = 0; op.scale = 1.0f; op.q_tiles = 0; op.rope_from = 0;
    pg8::Gemm& g = op.g; g.nB = 1; g.a_bs = 0; g.b_bs = 0; g.rot = 0; g.a_seg = 0; g.b_seg = 0; g.skipctx = 0;
#define SETK(k_) do { g.K = (k_); g.kseg = (k_) / 64; g.a_seg = (k_); g.b_seg = (k_); } while (0)
    switch (ph * 16 + sub) {
    case 2 * 16 + 0:
        g.A = R2; g.a_rs = 1024; g.nM = NRT; g.Bt = (const bf16_t*)(ws + W_IN0); g.b_rs = 1024; g.nN = 5; SETK(1024); op.O = R3; op.ldc = 1280; return true;
    case 3 * 16 + 0:
        g.A = (const bf16_t*)(ws + W_DC); g.a_rs = 128; g.nM = 1; g.Bt = R3; g.b_rs = 1280; g.nN = NRT; g.nB = 4; g.b_bs = 128; SETK(128);
        op.O = R2; op.ldc = ROWS; op.o_bs = 128 * ROWS; op.ai_extra = 384 * ROWS; return true;
    case 4 * 16 + 0:
        op.kind = 1; g.A = (const bf16_t*)(ws + WS_CQN); g.a_rs = 256; g.nM = NRT; g.Bt = (const bf16_t*)(ws + W_UQ); g.b_rs = 256; g.nN = 3; SETK(256);
        op.O = (bf16_t*)(ws + WS_Q); op.ldc = 768; op.scale = MLA_QSCALE; op.q_tiles = 3; op.rope_from = 2; return true;
    case 4 * 16 + 1:
        g.A = (const bf16_t*)(ws + WS_CKVN); g.a_rs = 256; g.nM = NRT; g.Bt = (const bf16_t*)(ws + W_KN); g.b_rs = 256; g.nN = 2; SETK(256); g.rot = 140;
        op.O = (bf16_t*)(ws + WS_KN); op.ldc = 512; return true;
    case 4 * 16 + 2:
        g.A = (const bf16_t*)(ws + W_V0); g.a_rs = 256; g.nM = 2; g.Bt = (const bf16_t*)(ws + WS_CKVN); g.b_rs = 256; g.nN = NRT; SETK(256); g.rot = 148;
        op.O = (bf16_t*)(ws + WS_VT0); op.ldc = ROWS; return true;
    case 4 * 16 + 3: case 4 * 16 + 4: case 4 * 16 + 5: case 4 * 16 + 6: case 4 * 16 + 7: case 4 * 16 + 8: case 4 * 16 + 9: case 4 * 16 + 10: {
        const int rp = sub - 3, rr = rp >> 1, part = rp & 1;
        g.a_rs = 2048; g.nM = 4; g.b_rs = 8192; g.nN = 2; g.nB = 4; g.b_bs = 2048;
        if ((rr & 1) == 0) {
            g.A = (const bf16_t*)(ws + WS_DN) + (size_t)rp * 1024 * 2048; g.Bt = (const bf16_t*)(ws + WS_AT4) + (size_t)rp * 512 * 8192; SETK(2048);
        } else {
            g.A = (const bf16_t*)(ws + WS_DN) + (size_t)(rr * 2) * 1024 * 2048; g.Bt = (const bf16_t*)(ws + WS_AT4) + (size_t)((part ? 3 : 1) * 2) * 512 * 8192;
            g.K = 4096; g.kseg = 32; g.a_seg = 1024 * 2048; g.b_seg = 512 * 8192; if (rr == 3 && part == 1) op.scale = -1.0f;
        }
        g.rot = (152 + 32 * rp) & 255;
        if (part == 0) { op.O = R3 + (size_t)(CTX + rr) * DM; op.ldc = 4 * DM; op.o_bs = TPB * DM; }
        else { op.O = (bf16_t*)(ws + WS_PS) + rr * 512; op.ldc = 4 * 512; op.o_bs = 4096 * 512; }
        return true; }
    case 4 * 16 + 11:
        g.A = (const bf16_t*)(ws + W_D256); g.a_rs = 512; g.nM = 1; g.Bt = R2; g.b_rs = ROWS; g.nN = 2; g.nB = 4; g.b_bs = TPB; g.K = 512; g.kseg = 4; g.a_seg = 256; g.b_seg = 512 * ROWS; g.rot = 0;
        op.O = R3; op.ldc = DM; op.o_bs = TPB * DM; return true;
    case 6 * 16 + 0:
        g.A = R3; g.a_rs = 1024; g.nM = NRT; g.Bt = (const bf16_t*)(ws + W_OUT0); g.b_rs = 1024; g.nN = 4; SETK(1024); op.O = (bf16_t*)(ws + WS_Y0); op.ldc = DM; return true;
    case 8 * 16 + 0: case 15 * 16 + 0:
        op.kind = 3; g.A = R2; g.a_rs = 1024; g.nM = (ph == 8 ? NRT : 128); g.skipctx = (ph != 8); g.Bt = (const bf16_t*)(ws + (ph == 8 ? W_GU0 : W_GU1)); g.b_rs = 1024; g.nN = 22; SETK(1024); op.O = R3; op.ldc = FF; return true;
    case 9 * 16 + 0: case 16 * 16 + 0:
        g.A = R3; g.a_rs = FF; g.nM = (ph == 9 ? NRT : 128); g.skipctx = (ph != 9); g.Bt = (const bf16_t*)(ws + (ph == 9 ? W_D0 : W_D1)); g.b_rs = FF; g.nN = 4; SETK(FF); op.O = R2; op.ldc = DM; return true;
    case 11 * 16 + 0:
        op.kind = 2; g.A = R2; g.a_rs = 1024; g.nM = NRT; g.Bt = (const bf16_t*)(ws + W_QK1); g.b_rs = 1024; g.nN = 8; SETK(1024);
        op.O = R3; op.ldc = 2048; op.scale = DIFF_QSCALE; op.q_tiles = 4; op.rope_from = 0; return true;
    case 11 * 16 + 1:
        g.A = (const bf16_t*)(ws + W_V1); g.a_rs = 1024; g.nM = 4; g.Bt = R2; g.b_rs = 1024; g.nN = NRT; SETK(1024); g.rot = 32;
        op.O = (bf16_t*)(ws + WS_VT1); op.ldc = ROWS; return true;
    case 13 * 16 + 0:
        g.A = R2; g.a_rs = 1024; g.nM = 128; g.skipctx = 1; g.Bt = (const bf16_t*)(ws + W_OUT1); g.b_rs = 1024; g.nN = 4; SETK(1024); op.O = R3; op.ldc = DM; return true;
    default: return false;
    }
#undef SETK
}

DI bool get_rowpass(int ph, const Args& a, RowPass& P) {
    unsigned char* ws = a.ws; const float* MOD0 = (const float*)(ws + WS_MOD); const float* MOD1 = MOD0 + 5 * 6144;
    float* XC = (float*)(ws + WS_XC); bf16_t* R2 = (bf16_t*)(ws + WS_R2);
    switch (ph) {
    case 1:  P = RowPass{a.in[I_X], a.in[I_CTX], nullptr, nullptr, nullptr, MOD0, 0, nullptr, nullptr, MOD0, 1024, 0, R2, 0}; return true;
    case 7:  P = RowPass{a.in[I_X], a.in[I_CTX], a.out, XC, (const bf16_t*)(ws + WS_Y0), MOD0, 2048, a.in[I0_LN1G], a.in[I0_LN1B], MOD0, 4096, 3072, R2, 0}; return true;
    case 10: P = RowPass{a.out, XC, a.out, XC, R2, MOD0, 5120, a.in[I0_LN2G], a.in[I0_LN2B], MOD1, 1024, 0, R2, 0}; return true;
    case 14: P = RowPass{a.out, XC, a.out, XC, (const bf16_t*)(ws + WS_R3), MOD1, 2048, a.in[I1_LN1G], a.in[I1_LN1B], MOD1, 4096, 3072, R2, 1}; return true;
    case 17: P = RowPass{a.out, XC, a.out, XC, R2, MOD1, 5120, a.in[I1_LN2G], a.in[I1_LN2B], MOD1, 0, 0, nullptr, 1}; return true;
    default: return false;
    }
}

__global__ void __launch_bounds__(512, 2) fwd_kernel(Args a) {
    extern __shared__ __attribute__((aligned(16))) unsigned char lds_raw[];
    LAS unsigned char* lds = (LAS unsigned char*)lds_raw;
    const int G = gridDim.x;
    volatile LAS unsigned* bst = (volatile LAS unsigned*)(lds + LDS_BYTES - 64);
    if (threadIdx.x < 2) bst[threadIdx.x] = 0u;
    __syncthreads();
    XcdBarrier xbar = xcd_barrier_post((unsigned*)(a.ws + WS_BAR), bst);
    for (int pos = a.ph_lo; pos < a.ph_hi; ++pos) {
        const int ph = pos <= 3 ? pos : (pos == 4 ? 18 : pos - 1);
        const int tid = otid(), lane = tid & 63, wave = __builtin_amdgcn_readfirstlane(tid >> 6);
        const int gw = blockIdx.x * 8 + wave, NGW = G * 8;
#ifndef NO_PRO
        if (ph == 0) prologue(a, lds);
#endif
        RowPass P;
        if (get_rowpass(ph, a, P)) { for (int m = gw; m < ROWS; m += NGW) row_pass(P, m, lane); }
        if (ph == 3) { for (int m = gw; m < ROWS; m += NGW) p3_row(a, m, lane); }
        if (ph == 18) fold_items(a, gw, NGW, lane);
#ifndef NO_MLA
        if (ph == 5) {
            mirror_items(a, gw, NGW, lane);
            for (int L = blockIdx.x; ; L += G) { int bh, qb; if (!attn_unit_map(L, 1024, bh, qb)) break; attn_mla_unit(a, lds, bh, qb); }
        }
#endif
#ifndef NO_DIFF
        if (ph == 12) {
            const float p1 = wave_sum(a.in[I1_LQ1][lane] * a.in[I1_LK1][lane]), p2 = wave_sum(a.in[I1_LQ2][lane] * a.in[I1_LK2][lane]);
            const float lam = expf(p1) - expf(p2) + LAMBDA_INIT;
            for (int L = blockIdx.x; L < 1024; L += G) { int bh, qb; attn_unit_map(L, 1024, bh, qb); attn_diff_unit(a, lds, bh, qb, lam); }
        }
#endif
#ifndef NO_GEMM
        for (int sub = 0; sub < 16; ++sub) {
            GOp op; if (!get_gemm(ph, sub, a, op)) break;
            pg8::StaticOrder S; S.init(op.g.nM, op.g.nN, op.g.nB, G, (int)blockIdx.x, op.g.rot, op.g.skipctx);
            if (op.kind == 0) { pg8::EpiStore E{op.O, op.ldc, op.o_bs, op.ai_extra, op.scale}; pg8::gemm_phase(lds, op.g, S, E); }
            else if (op.kind == 1) { pg8::EpiRope<8> E{op.O, op.ldc, op.scale, op.q_tiles, op.rope_from, (const f32x2*)(a.ws + WS_TAB8)}; pg8::gemm_phase(lds, op.g, S, E); }
            else if (op.kind == 2) { pg8::EpiRope<16> E{op.O, op.ldc, op.scale, op.q_tiles, op.rope_from, (const f32x2*)(a.ws + WS_TAB16)}; pg8::gemm_phase(lds, op.g, S, E); }
            else { pg8::EpiSwiglu E{op.O, op.ldc}; pg8::gemm_phase(lds, op.g, S, E); }
        }
#endif
        if (pos + 1 < a.ph_hi) { if (a.use_cg) { __threadfence(); cg::this_grid().sync(); } else xcd_barrier(xbar); }
    }
}

extern "C" void kernel_launch(void* const* d_in, const int* in_sizes, int n_in, void* d_out, int out_size, void* d_ws, size_t ws_size, hipStream_t stream) {
    static int grid = 0;
    if (grid == 0) {
        if (n_in != 35 || ws_size < WS_END) { fprintf(stderr, "kernel_launch: unexpected n_in %d / ws %zu (need %zu)\n", n_in, ws_size, (size_t)WS_END); grid = -1; return; }
        int dev = 0, cus = 0, per_cu = 0;
        hipGetDevice(&dev); hipDeviceGetAttribute(&cus, hipDeviceAttributeMultiprocessorCount, dev);
        hipFuncSetAttribute((const void*)fwd_kernel, hipFuncAttributeMaxDynamicSharedMemorySize, LDS_BYTES);
        hipOccupancyMaxActiveBlocksPerMultiprocessor(&per_cu, (const void*)fwd_kernel, 512, LDS_BYTES);
        if (per_cu < 1) { fprintf(stderr, "kernel_launch: occupancy query says %d blocks/CU\n", per_cu); per_cu = 1; }
        (void)hipGetLastError();
        grid = cus * 1;
    }
    if (grid < 0) return;
    Args a{};
    for (int i = 0; i < 35; ++i) a.in[i] = (const float*)d_in[i];
    a.out = (float*)d_out; a.ws = (unsigned char*)d_ws;
#if MK_MULTI
    for (int ph = 0; ph < NPHASES; ++ph) { a.ph_lo = ph; a.ph_hi = ph + 1; hipLaunchKernelGGL(fwd_kernel, dim3(grid), dim3(512), LDS_BYTES, stream, a); }
#else
    a.ph_lo = 0; a.ph_hi = NPHASES;
    hipMemsetAsync((char*)d_ws + WS_BAR, 0, 16384, stream);
    void* args[] = {&a};
    hipError_t e = hipLaunchCooperativeKernel((const void*)fwd_kernel, dim3(grid), dim3(512), args, LDS_BYTES, stream);
    if (e != hipSuccess) fprintf(stderr, "cooperative launch failed: %s (grid %d)\n", hipGetErrorString(e), grid);
#endif
}
```

```cpp
#include <hip/hip_runtime.h>
#include <hip/hip_cooperative_groups.h>
#include <cstdio>
#include <cstdint>
namespace cg = cooperative_groups;

#ifndef MK_MULTI
#define MK_MULTI 0
#endif

#define DI __device__ __forceinline__
#define LAS __attribute__((address_space(3)))
typedef unsigned short bf16_t;
typedef short bf16x8 __attribute__((ext_vector_type(8)));
typedef float f32x4 __attribute__((ext_vector_type(4)));
typedef float f32x2 __attribute__((ext_vector_type(2)));
typedef float f32x16 __attribute__((ext_vector_type(16)));
typedef unsigned u32x4 __attribute__((ext_vector_type(4)));
typedef unsigned u32x2 __attribute__((ext_vector_type(2)));
typedef __bf16 bf16x2_t __attribute__((ext_vector_type(2)));

constexpr int DM = 1024, NB = 4, SEQ = 8192, CTX = 256, TPB = SEQ + CTX  , ROWS = NB * TPB  , FF = 2816;
constexpr int NRT = ROWS / 256;
constexpr float LN_EPS = 1e-6f, RMS_EPS = 1e-6f;
constexpr float DN_ALPHA = 1.41421356237f;
constexpr float LOG2E = 1.4426950408889634f;
constexpr float MLA_QSCALE = 0.10206207261596577f * LOG2E;
constexpr float DIFF_QSCALE = 0.125f * LOG2E;
constexpr float LAMBDA_INIT = 0.35550906f;

constexpr size_t MiB = 1u << 20;
constexpr size_t WS_MOD = 0;
constexpr size_t WS_TAB16 = 256 * 1024;
constexpr size_t WS_TAB8 = WS_TAB16 + 16384;
constexpr size_t WS_BAR = 512 * 1024;
constexpr size_t WS_XC = 1 * MiB;
constexpr size_t WS_W = 5 * MiB;
constexpr size_t W_IN0 = WS_W;
constexpr size_t W_UQ = W_IN0 + 1280 * 1024 * 2;
constexpr size_t W_KN = W_UQ + 768 * 256 * 2;
constexpr size_t W_V0 = W_KN + 512 * 256 * 2;
constexpr size_t W_OUT0 = W_V0 + 512 * 256 * 2;
constexpr size_t W_GU0 = W_OUT0 + 1024 * 1024 * 2;
constexpr size_t W_D0 = W_GU0 + 5632 * 1024 * 2;
constexpr size_t W_QK1 = W_D0 + 1024 * 2816 * 2;
constexpr size_t W_V1 = W_QK1 + 2048 * 1024 * 2;
constexpr size_t W_OUT1 = W_V1 + 1024 * 1024 * 2;
constexpr size_t W_GU1 = W_OUT1 + 1024 * 1024 * 2;
constexpr size_t W_D1 = W_GU1 + 5632 * 1024 * 2;
constexpr size_t W_DC = W_D1 + 1024 * 2816 * 2;
constexpr size_t W_D256 = W_DC + 256 * 128 * 2;
constexpr size_t W_END = W_D256 + 256 * 512 * 2;
static_assert(W_END <= 56 * MiB, "weights region");
constexpr size_t WS_DN = 56 * MiB;
constexpr size_t WS_AT4 = 88 * MiB;
constexpr size_t WS_R2 = 184 * MiB;
constexpr size_t WS_R3 = 250 * MiB;
constexpr size_t WS_R4 = WS_R3 + (size_t)ROWS * 1280 * 2;
constexpr size_t WS_CQN = WS_R4, WS_CKVN = WS_R4 + (size_t)ROWS * 256 * 2;
constexpr size_t WS_R5 = WS_R4 + (size_t)ROWS * 512 * 2;
constexpr size_t WS_Q = WS_R5;
constexpr size_t WS_KN = WS_Q + (size_t)ROWS * 768 * 2;
constexpr size_t WS_KR = WS_KN + (size_t)ROWS * 512 * 2;
constexpr size_t WS_VT0 = WS_KR + (size_t)ROWS * 32 * 2;
constexpr size_t WS_END = WS_VT0 + (size_t)512 * ROWS * 2;
constexpr size_t WS_Y0 = WS_R5;
constexpr size_t WS_PS = WS_R3 + (size_t)ROWS * DM * 2;
static_assert(WS_PS + (size_t)4 * 4096 * 512 * 2 <= WS_R4, "ps");
constexpr size_t WS_VT1 = WS_R3 + (size_t)ROWS * 2048 * 2;
static_assert(WS_END <= 512 * MiB, "workspace");
static_assert(WS_VT1 + (size_t)1024 * ROWS * 2 <= WS_END, "vt1");
static_assert(WS_R3 + (size_t)ROWS * FF * 2 <= WS_END, "hid");

DI int otid() { int t = threadIdx.x; asm volatile("" : "+v"(t)); return t; }
DI float wave_sum(float v) {
#pragma unroll
    for (int o = 1; o < 64; o <<= 1) v += __shfl_xor(v, o);
    return v;
}
DI unsigned cvtpk(float lo, float hi) { f32x2 v = {lo, hi}; bf16x2_t b = __builtin_convertvector(v, bf16x2_t); return __builtin_bit_cast(unsigned, b); }
DI float bf2f(unsigned short b) { return __uint_as_float(((unsigned)b) << 16); }
DI float bflo(unsigned w) { return __uint_as_float(w << 16); }
DI float bfhi(unsigned w) { return __uint_as_float(w & 0xffff0000u); }

namespace pg8 {
constexpr int BM = 256, BK = 64, HALF = 128, HTB = HALF * BK * 2, STAGE_BYTES = 8 * HTB, NXCD = 8, WGM = 8;
__host__ __device__ __forceinline__ int lds_byte(int r, int c) { const int st = (r >> 4) * 2 + (c >> 5), rr = r & 15, cc = c & 31, ob = rr * 64 + cc * 2; return st * 1024 + (ob ^ (((ob >> 9) & 1) << 5)); }
__host__ __device__ __forceinline__ void stage_rc(int b, int& R, int& C) { const int st = b / 1024, sb = b % 1024, swz = sb ^ (((sb >> 9) & 1) << 5); R = (st >> 1) * 16 + swz / 64; C = (st & 1) * 32 + (swz % 64) / 2; }
__host__ __device__ __forceinline__ int perm32(int rho) { const int n = rho >> 4, i = rho & 15; return 8 * (i >> 2) + 4 * n + (i & 3); }

struct Unit { int pm, pn, pb; };
struct Gemm {
    const bf16_t* A; const bf16_t* Bt; int nM, nN, nB, K, kseg;
    int a_rs, b_rs, a_seg, b_seg, a_bs, b_bs;
    int rot, skipctx;
};
struct StaticOrder {
    int nM, nN, nwg, tot, G, c, skipctx;
    DI void init(int nM_, int nN_, int nB_, int G_, int c_, int rot, int skip) { skipctx = skip; nM = nM_; nN = nN_; nwg = nM * nN; tot = nwg * nB_; G = G_; c = (c_ + G_ - (rot % G_)) % G_; }
    DI bool next(int i, Unit& u) const {
        const long L = (long)i * G + c; if (L >= tot) return false;
        u.pb = (int)(L / nwg); int wgid = (int)(L % nwg);
        { const int q = nwg / NXCD, r = nwg % NXCD, xcd = wgid % NXCD, off = wgid / NXCD; wgid = (xcd < r ? xcd * (q + 1) : r * (q + 1) + (xcd - r) * q) + off; }
        const int nig = WGM * nN, gid = wgid / nig, fm = gid * WGM, gsz = (nM - fm) < WGM ? (nM - fm) : WGM;
        u.pm = fm + ((wgid % nig) % gsz); u.pn = (wgid % nig) / gsz; if (skipctx) u.pm += (u.pm >> 5) + 1; return true;
    }
};

struct EpiStore {
    static constexpr bool PERM = true;
    bf16_t* O; int ldc, o_bs, ai_extra; float scale;
    DI void operator()(const f32x4 (&acc)[2][2][4][2], const Unit& u, int wr, int wc, int fr, int fq) const {
        const int row0 = u.pm * BM + wr * 64 + fr, col0 = u.pn * BM + wc * 32 + 8 * fq;
        bf16_t* base = O + (size_t)u.pb * o_bs;
#pragma unroll
        for (int ai = 0; ai < 2; ++ai)
#pragma unroll
            for (int m = 0; m < 4; ++m) { bf16_t* rowp = base + (size_t)(row0 + ai * HALF + m * 16) * ldc + (size_t)ai * ai_extra + col0;
#pragma unroll
                for (int bj = 0; bj < 2; ++bj) { const f32x4 v0 = acc[ai][bj][m][0] * scale, v1 = acc[ai][bj][m][1] * scale;
                    u32x4 w; w.x = cvtpk(v0[0], v0[1]); w.y = cvtpk(v0[2], v0[3]); w.z = cvtpk(v1[0], v1[1]); w.w = cvtpk(v1[2], v1[3]);
                    *(u32x4*)(rowp + bj * HALF) = w; } }
    }
};
struct EpiSwiglu {
    static constexpr bool PERM = true;
    bf16_t* O; int ldc;
    DI void operator()(const f32x4 (&acc)[2][2][4][2], const Unit& u, int wr, int wc, int fr, int fq) const {
        const int row0 = u.pm * BM + wr * 64 + fr, col0 = u.pn * HALF + wc * 32 + 8 * fq;
#pragma unroll
        for (int ai = 0; ai < 2; ++ai)
#pragma unroll
            for (int m = 0; m < 4; ++m) { bf16_t* rowp = O + (size_t)(row0 + ai * HALF + m * 16) * ldc + col0; float h[8];
#pragma unroll
                for (int n = 0; n < 2; ++n)
#pragma unroll
                    for (int i = 0; i < 4; ++i) { const float g = acc[ai][0][m][n][i], up = acc[ai][1][m][n][i];
                        h[n * 4 + i] = g * __builtin_amdgcn_rcpf(1.0f + __builtin_amdgcn_exp2f(-g * LOG2E)) * up; }
                u32x4 w; w.x = cvtpk(h[0], h[1]); w.y = cvtpk(h[2], h[3]); w.z = cvtpk(h[4], h[5]); w.w = cvtpk(h[6], h[7]);
                *(u32x4*)rowp = w; }
    }
};
template <int MODE> struct EpiRope {
    static constexpr bool PERM = false;
    bf16_t* O; int ldc; float qscale; int q_tiles, rope_from; const f32x2* tab;
    DI void operator()(const f32x4 (&acc)[2][2][4][2], const Unit& u, int wr, int wc, int fr, int fq) const {
        const float sc = u.pn < q_tiles ? qscale : 1.0f; const bool rope_tile = u.pn >= rope_from;
        const int col0 = u.pn * BM + wc * 32 + 4 * fq;
#pragma unroll
        for (int ai = 0; ai < 2; ++ai)
#pragma unroll
            for (int m = 0; m < 4; ++m) {
                const int row = u.pm * BM + ai * HALF + wr * 64 + m * 16 + fr; const int j = row % TPB; const int t = j - CTX;
                f32x4 cs0 = {1.f, 0.f, 1.f, 0.f}, cs1 = {1.f, 0.f, 1.f, 0.f};
                if (rope_tile && t >= 0) {
                    int pos, f0;
                    if (MODE == 16) { pos = (wc & 1) ? (t & 63) : (t >> 6); f0 = 4 * fq; } else { pos = (fq >> 1) ? (t & 63) : (t >> 6); f0 = 4 * (fq & 1); }
                    const f32x4* tp = (const f32x4*)(tab + pos * MODE + f0); cs0 = tp[0]; cs1 = tp[1];
                }
                const float c[4] = {cs0[0], cs0[2], cs1[0], cs1[2]}, s[4] = {cs0[1], cs0[3], cs1[1], cs1[3]};
                bf16_t* rowp = O + (size_t)row * ldc + col0;
#pragma unroll
                for (int bj = 0; bj < 2; ++bj) { const f32x4 x1 = acc[ai][bj][m][0] * sc, x2 = acc[ai][bj][m][1] * sc; float o1[4], o2[4];
#pragma unroll
                    for (int i = 0; i < 4; ++i) { o1[i] = x1[i] * c[i] - x2[i] * s[i]; o2[i] = x1[i] * s[i] + x2[i] * c[i]; }
                    u32x2 w1, w2; w1.x = cvtpk(o1[0], o1[1]); w1.y = cvtpk(o1[2], o1[3]); w2.x = cvtpk(o2[0], o2[1]); w2.y = cvtpk(o2[2], o2[3]);
                    *(u32x2*)(rowp + bj * HALF) = w1; *(u32x2*)(rowp + bj * HALF + 16) = w2; }
            }
    }
};

template <class Epi>
DI void gemm_phase(LAS unsigned char* lds, const Gemm g, const StaticOrder& S, const Epi& E) {
    const int tid = otid(), wid = __builtin_amdgcn_readfirstlane(tid >> 6), lane = tid & 63, wr = wid >> 2, wc = wid & 3, fr = lane & 15, fq = lane >> 4;
    const int nt = g.K / BK, kseg = g.kseg;
    unsigned voffA[2], voffB[2];
#pragma unroll
    for (int i = 0; i < 2; ++i) { int R, C; stage_rc(tid * 16 + i * 8192, R, C); const int Rb = Epi::PERM ? ((R & ~31) + perm32(R & 31)) : R;
        voffA[i] = (unsigned)(R * g.a_rs + C) * 2u; voffB[i] = (unsigned)(Rb * g.b_rs + C) * 2u; }
    const int kstep = BK * 2;
    const unsigned hstepA = (unsigned)HALF * g.a_rs * 2, hstepB = (unsigned)HALF * g.b_rs * 2;
    const unsigned tstepA = 2 * hstepA, tstepB = 2 * hstepB;
    const int segA = (g.a_seg - kseg * BK) * 2, segB = (g.b_seg - kseg * BK) * 2;
#define OFFA(t) ((t) * kstep + ((t) >= kseg ? segA : 0))
#define OFFB(t) ((t) * kstep + ((t) >= kseg ? segB : 0))
    const unsigned ldsw = (unsigned)wid * 1024u;
    const int aoff = lds_byte(wr * 64 + fr, fq * 8), boff = lds_byte(wc * 32 + fr, fq * 8);
#define PG8_SA(b, h) (((b) * 2 + (h)) * HTB)
#define PG8_SB(b, h) ((4 + (b) * 2 + (h)) * HTB)
#define PG8_STAGE(bufoff, gbase, voff) do { _Pragma("unroll") for (int _i = 0; _i < 2; ++_i) \
        __builtin_amdgcn_global_load_lds((const unsigned*)((const char*)(gbase) + (voff)[_i]), (LAS unsigned*)(lds + (bufoff) + ldsw + _i * 8192), 16, 0, 0); } while (0)
#define PG8_LDA(dst, b, h) do { _Pragma("unroll") for (int m = 0; m < 4; ++m) _Pragma("unroll") for (int k = 0; k < 2; ++k) dst[m][k] = *(const LAS bf16x8*)(lds + PG8_SA(b, h) + aoff + m * 2048 + k * 1024); } while (0)
#define PG8_LDB(dst, b, h) do { _Pragma("unroll") for (int n = 0; n < 2; ++n) _Pragma("unroll") for (int k = 0; k < 2; ++k) dst[n][k] = *(const LAS bf16x8*)(lds + PG8_SB(b, h) + boff + n * 2048 + k * 1024); } while (0)
#define PG8_MMA(ai, bj, At, Bt) do { __builtin_amdgcn_s_setprio(1); _Pragma("unroll") for (int m = 0; m < 4; ++m) _Pragma("unroll") for (int n = 0; n < 2; ++n) _Pragma("unroll") for (int k = 0; k < 2; ++k) \
        acc[ai][bj][m][n] = __builtin_amdgcn_mfma_f32_16x16x32_bf16(Bt[n][k], At[m][k], acc[ai][bj][m][n], 0, 0, 0); __builtin_amdgcn_s_setprio(0); } while (0)
#define PG8_WAIT_V(n) asm volatile("s_waitcnt vmcnt(" #n ")" ::: "memory")
#define PG8_WAIT_L(n) asm volatile("s_waitcnt lgkmcnt(" #n ")" ::: "memory")
#define PG8_BAR __builtin_amdgcn_s_barrier()
#define PG8_SCHED __builtin_amdgcn_sched_barrier(0)
    Unit cur, nxt; int ui = 0;
    if (!S.next(0, cur)) return;
    f32x4 acc[2][2][4][2];
#pragma unroll
    for (int a = 0; a < 2; ++a)
#pragma unroll
        for (int b = 0; b < 2; ++b)
#pragma unroll
            for (int m = 0; m < 4; ++m)
#pragma unroll
                for (int n = 0; n < 2; ++n) acc[a][b][m][n] = (f32x4){0.f, 0.f, 0.f, 0.f};
    bf16x8 At[4][2], B0[2][2], B1[2][2];
    const char* cA = (const char*)g.A + ((size_t)cur.pb * g.a_bs) * 2 + (size_t)cur.pm * tstepA;
    const char* cB = (const char*)g.Bt + ((size_t)cur.pb * g.b_bs) * 2 + (size_t)cur.pn * tstepB;
    {
        PG8_STAGE(PG8_SB(0, 0), cB, voffB); PG8_STAGE(PG8_SB(0, 1), cB + hstepB, voffB); PG8_STAGE(PG8_SA(0, 0), cA, voffA); PG8_STAGE(PG8_SA(0, 1), cA + hstepA, voffA);
        if (wr == 1) PG8_BAR;
        PG8_WAIT_V(2); PG8_BAR;
        PG8_STAGE(PG8_SB(1, 0), cB + OFFB(1), voffB); PG8_STAGE(PG8_SA(1, 0), cA + OFFA(1), voffA); PG8_STAGE(PG8_SB(1, 1), cB + hstepB + OFFB(1), voffB);
        PG8_WAIT_V(6); PG8_BAR;
    }
    for (;;) {
        const bool has_next = S.next(ui + 1, nxt);
        const char* nA = has_next ? (const char*)g.A + ((size_t)nxt.pb * g.a_bs) * 2 + (size_t)nxt.pm * tstepA : cA;
        const char* nB = has_next ? (const char*)g.Bt + ((size_t)nxt.pb * g.b_bs) * 2 + (size_t)nxt.pn * tstepB : cB;
        for (int t = 0; t < nt; t += 2) {
            const bool last = (t == nt - 2);
            const char* a1 = cA + OFFA(t + 1);
            const char* a2 = last ? nA : cA + OFFA(t + 2); const char* b2 = last ? nB : cB + OFFB(t + 2);
            const char* a3 = last ? nA + OFFA(1) : cA + OFFA(t + 3); const char* b3 = last ? nB + OFFB(1) : cB + OFFB(t + 3);
            PG8_LDB(B0, 0, 0); PG8_LDB(B1, 0, 1); PG8_SCHED; PG8_LDA(At, 0, 0); PG8_STAGE(PG8_SA(1, 1), a1 + hstepA, voffA);
            PG8_WAIT_V(8); PG8_WAIT_L(0); PG8_BAR; PG8_MMA(0, 0, At, B0); PG8_MMA(0, 1, At, B1); PG8_BAR; PG8_SCHED;
            PG8_LDA(At, 0, 1); PG8_STAGE(PG8_SB(0, 0), b2, voffB); PG8_STAGE(PG8_SB(0, 1), b2 + hstepB, voffB); PG8_STAGE(PG8_SA(0, 0), a2, voffA);
            PG8_WAIT_V(8); PG8_WAIT_L(0); PG8_BAR; PG8_MMA(1, 0, At, B0); PG8_MMA(1, 1, At, B1); PG8_BAR; PG8_SCHED;
            PG8_LDB(B0, 1, 0); PG8_LDB(B1, 1, 1); PG8_SCHED; PG8_LDA(At, 1, 0); PG8_STAGE(PG8_SA(0, 1), a2 + hstepA, voffA);
            PG8_WAIT_V(8); PG8_WAIT_L(0); PG8_BAR; PG8_MMA(0, 0, At, B0); PG8_MMA(0, 1, At, B1); PG8_BAR; PG8_SCHED;
            PG8_LDA(At, 1, 1); PG8_STAGE(PG8_SB(1, 0), b3, voffB); PG8_STAGE(PG8_SB(1, 1), b3 + hstepB, voffB); PG8_STAGE(PG8_SA(1, 0), a3, voffA);
            PG8_WAIT_V(8); PG8_WAIT_L(0); PG8_BAR; PG8_MMA(1, 0, At, B0); PG8_MMA(1, 1, At, B1); PG8_BAR; PG8_SCHED;
        }
        if (wr == 0) PG8_BAR;
        E(acc, cur, wr, wc, fr, fq);
        if (!has_next) break;
#pragma unroll
        for (int a = 0; a < 2; ++a)
#pragma unroll
            for (int b = 0; b < 2; ++b)
#pragma unroll
                for (int m = 0; m < 4; ++m)
#pragma unroll
                    for (int n = 0; n < 2; ++n) acc[a][b][m][n] = (f32x4){0.f, 0.f, 0.f, 0.f};
        cur = nxt; cA = nA; cB = nB; ++ui;
        if (wr == 1) PG8_BAR;
    }
    PG8_WAIT_V(0);
    PG8_BAR;
#undef OFFA
#undef OFFB
#undef PG8_SA
#undef PG8_SB
#undef PG8_STAGE
#undef PG8_LDA
#undef PG8_LDB
#undef PG8_MMA
#undef PG8_WAIT_V
#undef PG8_WAIT_L
#undef PG8_BAR
#undef PG8_SCHED
}
}

#define MFMA32(a, b, c) __builtin_amdgcn_mfma_f32_32x32x16_bf16((a), (b), (c), 0, 0, 0)
template <int D1, int D2, int DV>
DI void attn_core(f32x16 (&o)[DV / 32], float& l_out, LAS unsigned char* lds, const bf16_t* q1, const bf16_t* q2,
                  const bf16_t* k1, long ldk1, const bf16_t* k2, long ldk2, const bf16_t* vt, long ldv, int ntiles) {
    constexpr int DQK = D1 + D2, KROW = DQK * 2 + 16, VROW = 144, KT = 64 * KROW, VT = DV * VROW, BUF = KT + VT;
    constexpr int KCH = DQK / 8, NKC = 64 * KCH, NVC = DV * 8, KPT = (NKC + 511) / 512, VPT = NVC / 512;
    const int tid = otid(), lane = tid & 63, r = lane & 31, h = lane >> 5;
    bf16x8 qf[DQK / 16];
#pragma unroll
    for (int d0 = 0; d0 < DQK / 16; ++d0) qf[d0] = (16 * d0 < D1) ? *(const bf16x8*)(q1 + 16 * d0 + 8 * h) : *(const bf16x8*)(q2 + (16 * d0 - D1) + 8 * h);
    u32x4 kreg[KPT], vreg[VPT];
    auto gload = [&](int t) {
#pragma unroll
        for (int i = 0; i < KPT; ++i) { const int c = tid + i * 512; if (c < NKC) { const int row = c / KCH, cc = (c % KCH) * 8;
            kreg[i] = (cc < D1) ? *(const u32x4*)(k1 + (size_t)(t * 64 + row) * ldk1 + cc) : *(const u32x4*)(k2 + (size_t)(t * 64 + row) * ldk2 + (cc - D1)); } }
#pragma unroll
        for (int i = 0; i < VPT; ++i) { const int c = tid + i * 512; const int d = c >> 3, cc = (c & 7) * 8; vreg[i] = *(const u32x4*)(vt + (size_t)d * ldv + t * 64 + cc); }
    };
    auto sstore = [&](int b) {
        LAS unsigned char* kb = lds + b * BUF; LAS unsigned char* vb = kb + KT;
#pragma unroll
        for (int i = 0; i < KPT; ++i) { const int c = tid + i * 512; if (c < NKC) { const int row = c / KCH, cc = (c % KCH) * 8; *(LAS u32x4*)(kb + row * KROW + cc * 2) = kreg[i]; } }
#pragma unroll
        for (int i = 0; i < VPT; ++i) { const int c = tid + i * 512; const int d = c >> 3, cc = (c & 7) * 8; *(LAS u32x4*)(vb + d * VROW + cc * 2) = vreg[i]; }
    };
    const int pr = (r & ~12) | ((r & 4) << 1) | ((r & 8) >> 1);
    float mrun = 0.f, lrun = 0.f;
    f32x16 negm;
#pragma unroll
    for (int i = 0; i < 16; ++i) negm[i] = 0.f;
#pragma unroll
    for (int b = 0; b < DV / 32; ++b)
#pragma unroll
        for (int i = 0; i < 16; ++i) o[b][i] = 0.f;
    gload(0); sstore(0); if (ntiles > 1) { gload(1); sstore(1); } __syncthreads();
    for (int t = 0; t < ntiles; ++t) {
        if (t + 2 < ntiles) gload(t + 2);
        const LAS unsigned char* kb = lds + (t & 3) * BUF; const LAS unsigned char* vb = kb + KT;
        f32x16 p[2];
        {
            bf16x8 kf[2][DQK / 16];
#pragma unroll
            for (int hf = 0; hf < 2; ++hf)
#pragma unroll
                for (int d0 = 0; d0 < DQK / 16; ++d0) kf[hf][d0] = *(const LAS bf16x8*)(kb + (32 * hf + pr) * KROW + (16 * d0 + 8 * h) * 2);
            __builtin_amdgcn_sched_barrier(0);
            __builtin_amdgcn_s_setprio(1);
#pragma unroll
            for (int d0 = 0; d0 < DQK / 16; ++d0)
#pragma unroll
                for (int hf = 0; hf < 2; ++hf) p[hf] = MFMA32(kf[hf][d0], qf[d0], d0 == 0 ? negm : p[hf]);
            __builtin_amdgcn_sched_barrier(0);
        }
        constexpr int NBLK = DV / 32;
        bf16x8 vk[2][NBLK];
#define LDVK(buf, ks) do { _Pragma("unroll") for (int b_ = 0; b_ < NBLK; ++b_) vk[buf][b_] = *(const LAS bf16x8*)(vb + (32 * b_ + r) * VROW + (16 * (ks) + 8 * h) * 2); } while (0)
        LDVK(0, 0);
        __builtin_amdgcn_sched_barrier(0);
        float ta = fmaxf(fmaxf(p[0][0], p[0][1]), p[1][0]), tb = fmaxf(fmaxf(p[0][2], p[0][3]), p[1][1]);
        ta = fmaxf(fmaxf(ta, p[1][2]), p[1][3]);
#pragma unroll
        for (int i = 4; i < 16; i += 4) { ta = fmaxf(fmaxf(ta, p[0][i]), p[0][i + 1]); tb = fmaxf(fmaxf(tb, p[0][i + 2]), p[0][i + 3]); ta = fmaxf(fmaxf(ta, p[1][i]), p[1][i + 1]); tb = fmaxf(fmaxf(tb, p[1][i + 2]), p[1][i + 3]); }
        float tm = fmaxf(ta, tb);
        if (__any(t == 0 || tm > 8.0f)) {
            tm = fmaxf(tm, __shfl_xor(tm, 32));
            const float dl = (t == 0 || tm > 0.f) ? tm : 0.f; mrun += dl;
            const float alpha = __builtin_amdgcn_exp2f(-dl); lrun *= alpha;
#pragma unroll
            for (int i = 0; i < 16; ++i) { p[0][i] -= dl; p[1][i] -= dl; negm[i] = -mrun; }
#pragma unroll
            for (int b = 0; b < DV / 32; ++b)
#pragma unroll
                for (int i = 0; i < 16; ++i) o[b][i] *= alpha;
        }
        bf16x8 pf[4]; float rs = 0.f; u32x4 wq;
#define EXPPART(ks, j) do { const int hf_ = (ks) >> 1, s8_ = ((ks) & 1) * 8; const float e0_ = __builtin_amdgcn_exp2f(p[hf_][s8_ + 2 * (j)]), e1_ = __builtin_amdgcn_exp2f(p[hf_][s8_ + 2 * (j) + 1]); \
        rs += e0_; rs += e1_; wq[j] = cvtpk(e0_, e1_); } while (0)
        EXPPART(0, 0); EXPPART(0, 1); EXPPART(0, 2); EXPPART(0, 3); pf[0] = __builtin_bit_cast(bf16x8, wq);
        __builtin_amdgcn_sched_barrier(0);
#pragma unroll
        for (int ks = 0; ks < 4; ++ks) {
            if (ks < 3) LDVK((ks + 1) & 1, ks + 1);
            __builtin_amdgcn_sched_barrier(0);
#pragma unroll
            for (int b = 0; b < NBLK; ++b) {
                o[b] = MFMA32(vk[ks & 1][b], pf[ks], o[b]);
                if (ks < 3) {
#pragma unroll
                    for (int j = b * (4 / NBLK); j < (b + 1) * (4 / NBLK); ++j) {
                        if (ks == 0) EXPPART(1, j); else if (ks == 1) EXPPART(2, j); else EXPPART(3, j);
                    }
                }
                __builtin_amdgcn_sched_barrier(0);
            }
            if (ks < 3) pf[ks + 1] = __builtin_bit_cast(bf16x8, wq);
        }
        __builtin_amdgcn_s_setprio(0);
        lrun += rs;
#undef LDVK
#undef EXPPART
        if (t + 2 < ntiles) sstore((t + 2) & 3);
        if (t & 1) __syncthreads();
    }
    l_out = lrun + __shfl_xor(lrun, 32);
}
constexpr int ATTN_LDS = 2 * (64 * (96 * 2 + 16) + 128 * 144);


#define XB_TMO      128
#define XB_XCNT(j)  (256  + 64 * (j))
#define XB_XSUB(j)  (1280 + 64 * (j))
#define XB_XGEN(j)  (2304 + 64 * (j))
#define XB_TOP      3328
#define XB_TOPGEN   3392
#define XCD_BAR_WORDS 3456
#define XB_SPIN_CAP (1u << 18)
DI unsigned xb_ld(unsigned* p)              { return __hip_atomic_load(p, __ATOMIC_RELAXED, __HIP_MEMORY_SCOPE_AGENT); }
DI unsigned xb_add(unsigned* p, unsigned v) { return __hip_atomic_fetch_add(p, v, __ATOMIC_RELAXED, __HIP_MEMORY_SCOPE_AGENT); }
DI unsigned xb_xcc_id() { return (unsigned)__builtin_amdgcn_s_getreg((3 << 11) | 20) & 0xFu; }
#define XB_SPIN(cond, bar) do { unsigned _sp = 0; while (cond) { __builtin_amdgcn_s_sleep(1); \
    if ((++_sp & 255u) == 0u) { if (xb_ld(&(bar)[XB_TMO])) break; if (_sp > XB_SPIN_CAP) { atomicAdd(&(bar)[XB_TMO], 1u); break; } } } } while (0)
struct XcdBarrier { unsigned* bar; unsigned x; volatile LAS unsigned* st; };
DI XcdBarrier xcd_barrier_post(unsigned* bar, volatile LAS unsigned* st) {
    XcdBarrier b; b.bar = bar; b.x = xb_xcc_id(); b.st = st;
    if (threadIdx.x == 0) (void)xb_add(&bar[XB_XCNT(b.x)], 1u);
    return b;
}
DI void xcd_barrier_complete(unsigned* bar, unsigned x, unsigned& nloc, unsigned& nx) {
    const unsigned G = gridDim.x * gridDim.y * gridDim.z;
    unsigned sum, cnt, mine, sp = 0u;
    for (;;) {
        sum = 0u; cnt = 0u; mine = 0u;
#pragma unroll
        for (unsigned j = 0; j < 16; ++j) { const unsigned c = xb_ld(&bar[XB_XCNT(j)]); sum += c; cnt += (c > 0u) ? 1u : 0u; mine = (j == x) ? c : mine; }
        if (sum == G) break;
        __builtin_amdgcn_s_sleep(1);
        if ((++sp & 255u) == 0u) { if (xb_ld(&bar[XB_TMO])) break; if (sp > XB_SPIN_CAP) { atomicAdd(&bar[XB_TMO], 1u); break; } }
    }
    nloc = mine > 0u ? mine : 1u; nx = cnt > 0u ? cnt : 1u;
}
DI void xcd_barrier(const XcdBarrier& b) {
    asm volatile("s_waitcnt vmcnt(0)" ::: "memory");
    __syncthreads();
    if (threadIdx.x == 0) {
        unsigned* bar = b.bar;
        __builtin_amdgcn_s_waitcnt(0);
        unsigned nloc = b.st[0], nx = b.st[1];
        if (nloc == 0u) { xcd_barrier_complete(bar, b.x, nloc, nx); b.st[0] = nloc; b.st[1] = nx; }
        const unsigned old = xb_add(&bar[XB_XSUB(b.x)], 1u);
        const unsigned gen = old / nloc;
        if (old + 1u == (gen + 1u) * nloc) {
            __builtin_amdgcn_fence(__ATOMIC_RELEASE, "agent");
            asm volatile("s_waitcnt vmcnt(0)" ::: "memory");
            const unsigned og = xb_add(&bar[XB_TOP], 1u);
            const unsigned tg = og / nx;
            if (og + 1u == (tg + 1u) * nx) xb_add(&bar[XB_TOPGEN], 1u);
            else XB_SPIN(xb_ld(&bar[XB_TOPGEN]) == tg, bar);
            __builtin_amdgcn_fence(__ATOMIC_ACQUIRE, "agent");
            xb_add(&bar[XB_XGEN(b.x)], 1u);
            asm volatile("s_waitcnt vmcnt(0)" ::: "memory");
        } else {
            XB_SPIN(xb_ld(&bar[XB_XGEN(b.x)]) == gen, bar);
            __builtin_amdgcn_fence(__ATOMIC_ACQUIRE, "agent");
            asm volatile("s_waitcnt vmcnt(0)" ::: "memory");
        }
    }
    __syncthreads();
}

struct Args {
    const float* in[35]; float* out; unsigned char* ws; int ph_lo, ph_hi, use_cg, pad;
};
enum { I_X = 0, I_C, I_CTX, I_CCTX,
       I0_WMOD, I0_BMOD, I0_WIN, I0_QN, I0_WUQ, I0_KVN, I0_WUKV, I0_WOUT, I0_LN1G, I0_LN1B, I0_WG, I0_WU, I0_WD, I0_LN2G, I0_LN2B,
       I1_WMOD, I1_BMOD, I1_WIN, I1_LQ1, I1_LK1, I1_LQ2, I1_LK2, I1_SUBLN, I1_WOUT, I1_LN1G, I1_LN1B, I1_WG, I1_WU, I1_WD, I1_LN2G, I1_LN2B };

DI bf16_t* tr_dst(int job, int n, unsigned char* ws) {
    switch (job) {
    case 0: return (bf16_t*)(ws + W_IN0) + (size_t)n * 1024;
    case 1: { const int hd = n / 96, d = n % 96; int row; if (d < 64) row = hd * 64 + d; else { const int e = d - 64, t = e >> 3, f = e & 7; row = 512 + hd * 32 + 16 * (t & 1) + 8 * (t >> 1) + f; }
              return (bf16_t*)(ws + W_UQ) + (size_t)row * 256; }
    case 2: { const int hd = n >> 7, d = n & 127; return d < 64 ? (bf16_t*)(ws + W_KN) + (size_t)(hd * 64 + d) * 256 : (bf16_t*)(ws + W_V0) + (size_t)(hd * 64 + d - 64) * 256; }
    case 3: return (bf16_t*)(ws + W_OUT0) + (size_t)n * 1024;
    case 4: return (bf16_t*)(ws + W_GU0) + (size_t)(256 * (n >> 7) + (n & 127)) * 1024;
    case 5: return (bf16_t*)(ws + W_GU0) + (size_t)(256 * (n >> 7) + 128 + (n & 127)) * 1024;
    case 6: return (bf16_t*)(ws + W_D0) + (size_t)n * 2816;
    case 7: return n < 2048 ? (bf16_t*)(ws + W_QK1) + (size_t)n * 1024 : (bf16_t*)(ws + W_V1) + (size_t)(n - 2048) * 1024;
    case 8: return (bf16_t*)(ws + W_OUT1) + (size_t)n * 1024;
    case 9: return (bf16_t*)(ws + W_GU1) + (size_t)(256 * (n >> 7) + (n & 127)) * 1024;
    case 10: return (bf16_t*)(ws + W_GU1) + (size_t)(256 * (n >> 7) + 128 + (n & 127)) * 1024;
    default: return (bf16_t*)(ws + W_D1) + (size_t)n * 2816;
    }
}
DI void transpose_item(const float* W, int K, int N, int job, unsigned char* ws, LAS float* scr, int item, int lane) {
    const int nblk = N / 32, kb = item / nblk, nb = item % nblk, k0 = 64 * kb, n0 = 32 * nb;
#pragma unroll 8
    for (int i = 0; i < 32; ++i) { const int kk = 2 * i + (lane >> 5); scr[kk * 33 + (lane & 31)] = W[(size_t)(k0 + kk) * N + n0 + (lane & 31)]; }
    asm volatile("s_waitcnt lgkmcnt(0)" ::: "memory");
    const int c = lane & 7;
#pragma unroll
    for (int j = 0; j < 4; ++j) { const int n = (lane >> 3) + 8 * j; const LAS float* s = scr + (8 * c) * 33 + n;
        u32x4 o; o.x = cvtpk(s[0 * 33], s[1 * 33]); o.y = cvtpk(s[2 * 33], s[3 * 33]); o.z = cvtpk(s[4 * 33], s[5 * 33]); o.w = cvtpk(s[6 * 33], s[7 * 33]);
        bf16_t* dst = tr_dst(job, n0 + n, ws); *(u32x4*)(dst + k0 + 8 * c) = o; }
    asm volatile("s_waitcnt lgkmcnt(0)" ::: "memory");
}

DI void prologue(const Args& a, LAS unsigned char* lds) {
    unsigned char* ws = a.ws;
    const int tid = otid(), lane = tid & 63, wave = tid >> 6;
    const int G = gridDim.x, gw = blockIdx.x * 8 + wave, NGW = G * 8;
    const long gt = (long)blockIdx.x * 512 + tid, NGT = (long)G * 512;
    {
        LAS float* scr = (LAS float*)(lds + wave * 16384);
        const int jin[12] = {I0_WIN, I0_WUQ, I0_WUKV, I0_WOUT, I0_WG, I0_WU, I0_WD, I1_WIN, I1_WOUT, I1_WG, I1_WU, I1_WD};
        const int jK[12] = {1024, 256, 256, 1024, 1024, 1024, 2816, 1024, 1024, 1024, 1024, 2816};
        const int jN[12] = {1056, 768, 1024, 1024, 2816, 2816, 1024, 3072, 1024, 2816, 2816, 1024};
        int base = 0;
#pragma unroll
        for (int j = 0; j < 12; ++j) { const int items = (jK[j] / 64) * (jN[j] / 32);
            for (int it = gw; it < items; it += NGW) transpose_item(a.in[jin[j]], jK[j], jN[j], j, ws, scr, it, lane);
            base += items; }
        u32x4 z = {0u, 0u, 0u, 0u};
        for (long i = gt; i < (1280 - 1056) * 1024 / 8; i += NGT) ((u32x4*)((bf16_t*)(ws + W_IN0) + (size_t)1056 * 1024))[i] = z;
    }
    {
        const float sc = 0.011048543456039806f;
        for (long i = gt; i < (long)4 * 2 * 1024 * 256; i += NGT) { const long idx = i * 8; const int n0 = (int)(idx & 2047), kq = (int)(idx >> 11) & 1023, part = (int)(idx >> 21) & 1, rr = (int)(idx >> 22); const int k = 4 * kq + rr; float v[8];
#pragma unroll
            for (int e = 0; e < 8; ++e) { const float ph = (float)((k * (n0 + e)) & 8191) * (1.0f / 8192.0f); v[e] = (part ? __builtin_amdgcn_sinf(ph) : __builtin_amdgcn_cosf(ph)) * ((part && rr == 3) ? -sc : sc); }
            u32x4 o; o.x = cvtpk(v[0], v[1]); o.y = cvtpk(v[2], v[3]); o.z = cvtpk(v[4], v[5]); o.w = cvtpk(v[6], v[7]);
            *(u32x4*)((bf16_t*)(ws + WS_DN) + idx) = o; }
        for (long i = gt; i < 256 * 512; i += NGT) { const int k = (int)(i >> 9), c = (int)(i & 511), part = c >> 8, n = c & 255; const float ph = (float)((k * n) & 255) * (1.0f / 256.0f);
            const float v = (part ? __builtin_amdgcn_sinf(ph) : __builtin_amdgcn_cosf(ph)) * 0.0625f; ((bf16_t*)(ws + W_D256))[i] = (bf16_t)(cvtpk(v, 0.f) & 0xffffu); }
        for (long i = gt; i < 256 * 128; i += NGT) { const int rr = (int)(i >> 7), c = (int)(i & 127), part = rr >> 7, l = rr & 127; const float ph = (float)((l * c) & 127) * (1.0f / 128.0f);
            const float v = (part ? -__builtin_amdgcn_sinf(ph) : __builtin_amdgcn_cosf(ph)) * 0.08838834764831845f; ((bf16_t*)(ws + W_DC))[i] = (bf16_t)(cvtpk(v, 0.f) & 0xffffu); }
        for (long i = gt; i < 128 * 16; i += NGT) { const int pos = (int)(i >> 4), f = (int)(i & 15); const float inv = 1.0f / powf(10000.0f, (float)f / 16.0f); const float ang = (float)pos * inv;
            ((f32x2*)(ws + WS_TAB16))[i] = (f32x2){cosf(ang), sinf(ang)}; }
        for (long i = gt; i < 128 * 8; i += NGT) { const int pos = (int)(i >> 3), f = (int)(i & 7); const float inv = 1.0f / powf(10000.0f, (float)f / 8.0f); const float ang = (float)pos * inv;
            ((f32x2*)(ws + WS_TAB8))[i] = (f32x2){cosf(ang), sinf(ang)}; }
    }
    {
        LAS float* red = (LAS float*)lds;
        LAS float* sl = (LAS float*)(lds + 16384);
        __syncthreads();
        if (blockIdx.x < 2 * 96) {
            for (int i = tid; i < 5 * 1024; i += 512) { const int cls = i >> 10, k = i & 1023; const float cv = cls < 4 ? a.in[I_C][cls * 1024 + k] : a.in[I_CCTX][k]; sl[i] = cv / (1.0f + __expf(-cv)); }
        }
        __syncthreads();
        for (int it = blockIdx.x; it < 2 * 96; it += G) {
            const int layer = it / 96, n = (it % 96) * 64 + lane; const float* w = a.in[layer ? I1_WMOD : I0_WMOD] + (size_t)(wave * 128) * 6144 + n; const float* bm = a.in[layer ? I1_BMOD : I0_BMOD];
            float acc[5] = {0.f, 0.f, 0.f, 0.f, 0.f};
            for (int k0 = 0; k0 < 128; k0 += 16) { float wv[16];
#pragma unroll
                for (int u = 0; u < 16; ++u) wv[u] = w[(size_t)(k0 + u) * 6144];
#pragma unroll
                for (int u = 0; u < 16; ++u)
#pragma unroll
                    for (int cls = 0; cls < 5; ++cls) acc[cls] += sl[cls * 1024 + wave * 128 + k0 + u] * wv[u]; }
#pragma unroll
            for (int cls = 0; cls < 5; ++cls) red[(wave * 5 + cls) * 64 + lane] = acc[cls];
            __syncthreads();
            if (tid < 320) { const int cls = tid >> 6, l = tid & 63; float s_ = 0.f;
#pragma unroll
                for (int w8 = 0; w8 < 8; ++w8) s_ += red[(w8 * 5 + cls) * 64 + l];
                const int nn = (it % 96) * 64 + l; ((float*)(ws + WS_MOD))[(size_t)(layer * 5 + cls) * 6144 + nn] = s_ + bm[nn]; }
            __syncthreads();
        }
    }
}

struct RowPass {
    const float* xl; const float* xc;
    float* ol; float* oc;
    const bf16_t* Y;
    const float* mod;
    int gate_off; const float* lng; const float* lnb;
    const float* mod2; int sc_off, sh_off;
    bf16_t* H;
    int skipctx;
};
DI void wave_sum2(float& a, float& b) {
#pragma unroll
    for (int o = 1; o < 64; o <<= 1) { const float ta = __shfl_xor(a, o), tb = __shfl_xor(b, o); a += ta; b += tb; }
}
struct RowRef { int m, cls; bool act; size_t xoff; const float* xs; float* xd; };
DI RowRef row_ref(const RowPass& P, int m, bool act) {
    RowRef R; const int b = m / TPB, j = m % TPB; const bool isctx = j < CTX; R.m = m; R.cls = isctx ? 4 : b; R.act = act && !(P.skipctx && isctx);
    R.xoff = isctx ? (size_t)(b * CTX + j) * DM : (size_t)(b * SEQ + j - CTX) * DM;
    const long dsrc = (const char*)P.xc - (const char*)P.xl, ddst = (char*)P.oc - (char*)P.ol;
    R.xs = (const float*)((const char*)P.xl + (isctx ? dsrc : 0L)) + R.xoff; R.xd = (float*)((char*)P.ol + (isctx ? ddst : 0L)); return R;
}
DI void rp_load(const RowRef& R, f32x4 (&v)[4], int lane) {
#pragma unroll
    for (int jj = 0; jj < 4; ++jj) v[jj] = *(const f32x4*)(R.xs + 4 * lane + 256 * jj);
}
DI void rp_loady(const RowPass& P, const RowRef& R, u32x2 (&yw)[4], int lane) {
#pragma unroll
    for (int jj = 0; jj < 4; ++jj) yw[jj] = *(const u32x2*)(P.Y + (size_t)R.m * DM + 4 * lane + 256 * jj);
}
DI void rp_mix(const RowPass& P, const RowRef& R, f32x4 (&v)[4], const u32x2 (&yw)[4], int lane) {
    const float* gate = P.mod + (size_t)R.cls * 6144 + P.gate_off;
#pragma unroll
    for (int jj = 0; jj < 4; ++jj) { const int c0 = 4 * lane + 256 * jj; const f32x4 g = *(const f32x4*)(gate + c0);
        v[jj][0] = DN_ALPHA * v[jj][0] + g[0] * bflo(yw[jj].x); v[jj][1] = DN_ALPHA * v[jj][1] + g[1] * bfhi(yw[jj].x);
        v[jj][2] = DN_ALPHA * v[jj][2] + g[2] * bflo(yw[jj].y); v[jj][3] = DN_ALPHA * v[jj][3] + g[3] * bfhi(yw[jj].y); }
}
DI void rp_stats2(const f32x4 (&va)[4], const f32x4 (&vb)[4], float& ma, float& ra, float& mb, float& rb) {
    float sa = 0.f, sb = 0.f;
#pragma unroll
    for (int j = 0; j < 4; ++j) { sa += (va[j][0] + va[j][1]) + (va[j][2] + va[j][3]); sb += (vb[j][0] + vb[j][1]) + (vb[j][2] + vb[j][3]); }
    wave_sum2(sa, sb); ma = sa * (1.0f / DM); mb = sb * (1.0f / DM);
    float qa = 0.f, qb = 0.f;
#pragma unroll
    for (int j = 0; j < 4; ++j) { const f32x4 da = va[j] - ma, db = vb[j] - mb; qa += (da[0] * da[0] + da[1] * da[1]) + (da[2] * da[2] + da[3] * da[3]); qb += (db[0] * db[0] + db[1] * db[1]) + (db[2] * db[2] + db[3] * db[3]); }
    wave_sum2(qa, qb); ra = 1.0f / sqrtf(qa * (1.0f / DM) + LN_EPS); rb = 1.0f / sqrtf(qb * (1.0f / DM) + LN_EPS);
}
DI void rp_ln_store(const RowPass& P, const RowRef& R, f32x4 (&v)[4], float mean, float rstd, int lane) {
#pragma unroll
    for (int jj = 0; jj < 4; ++jj) { const int c0 = 4 * lane + 256 * jj; const f32x4 g = *(const f32x4*)(P.lng + c0), bb = *(const f32x4*)(P.lnb + c0); v[jj] = (v[jj] - mean) * rstd * g + bb; }
    if (R.act && R.xd) {
#pragma unroll
        for (int jj = 0; jj < 4; ++jj) *(f32x4*)(R.xd + R.xoff + 4 * lane + 256 * jj) = v[jj];
    }
}
DI void rp_h_store(const RowPass& P, const RowRef& R, const f32x4 (&v)[4], float mean, float rstd, int lane) {
    if (!R.act) return;
    const float* sc = P.mod2 + (size_t)R.cls * 6144 + P.sc_off; const float* sh = P.mod2 + (size_t)R.cls * 6144 + P.sh_off;
#pragma unroll
    for (int jj = 0; jj < 4; ++jj) { const int c0 = 4 * lane + 256 * jj; const f32x4 s1 = *(const f32x4*)(sc + c0), s0 = *(const f32x4*)(sh + c0);
        const f32x4 hh = (v[jj] - mean) * rstd * (s1 + 1.0f) + s0; u32x2 w; w.x = cvtpk(hh[0], hh[1]); w.y = cvtpk(hh[2], hh[3]);
        *(u32x2*)(P.H + (size_t)R.m * DM + c0) = w; }
}
DI void row_pass2(const RowPass& P, int m0, int m1, bool act1, int lane) {
    const RowRef A = row_ref(P, m0, true), B = row_ref(P, m1, act1);
    if (!A.act && !B.act) return;
    f32x4 va[4], vb[4]; rp_load(A, va, lane); rp_load(B, vb, lane);
    if (P.Y) {
        u32x2 ya[4], yb[4]; rp_loady(P, A, ya, lane); rp_loady(P, B, yb, lane);
        rp_mix(P, A, va, ya, lane); rp_mix(P, B, vb, yb, lane);
        float ma, ra, mb, rb; rp_stats2(va, vb, ma, ra, mb, rb);
        rp_ln_store(P, A, va, ma, ra, lane); rp_ln_store(P, B, vb, mb, rb, lane);
    }
    if (P.H) {
        float ma, ra, mb, rb; rp_stats2(va, vb, ma, ra, mb, rb);
        rp_h_store(P, A, va, ma, ra, lane); rp_h_store(P, B, vb, mb, rb, lane);
    }
}
DI void p3_row(const Args& a, int m, int lane) {
    unsigned char* ws = a.ws; const bf16_t* U = (const bf16_t*)(ws + WS_R3) + (size_t)m * 1280;
    const u32x2 qw = *(const u32x2*)(U + 512 + 4 * lane), kw = *(const u32x2*)(U + 768 + 4 * lane);
    float q[4] = {bflo(qw.x), bfhi(qw.x), bflo(qw.y), bfhi(qw.y)}, k[4] = {bflo(kw.x), bfhi(kw.x), bflo(kw.y), bfhi(kw.y)};
    const float qs = wave_sum(q[0] * q[0] + q[1] * q[1] + q[2] * q[2] + q[3] * q[3]), ks = wave_sum(k[0] * k[0] + k[1] * k[1] + k[2] * k[2] + k[3] * k[3]);
    const float qr = 1.0f / sqrtf(qs * (1.0f / 256.0f) + RMS_EPS), kr_ = 1.0f / sqrtf(ks * (1.0f / 256.0f) + RMS_EPS);
    const f32x4 qg = *(const f32x4*)(a.in[I0_QN] + 4 * lane), kg = *(const f32x4*)(a.in[I0_KVN] + 4 * lane);
    u32x2 w; w.x = cvtpk(q[0] * qr * qg[0], q[1] * qr * qg[1]); w.y = cvtpk(q[2] * qr * qg[2], q[3] * qr * qg[3]);
    *(u32x2*)((bf16_t*)(ws + WS_CQN) + (size_t)m * 256 + 4 * lane) = w;
    w.x = cvtpk(k[0] * kr_ * kg[0], k[1] * kr_ * kg[1]); w.y = cvtpk(k[2] * kr_ * kg[2], k[3] * kr_ * kg[3]);
    *(u32x2*)((bf16_t*)(ws + WS_CKVN) + (size_t)m * 256 + 4 * lane) = w;
    const int d = lane & 31, t = d >> 3, f = d & 7; const float val = bf2f(U[1024 + d]); const float par = __shfl_xor(val, 8);
    const int j = m % TPB, tt = j - CTX; float outv = val;
    if (tt >= 0) { const int pos = (t < 2) ? (tt >> 6) : (tt & 63); const f32x2 cs = ((const f32x2*)(ws + WS_TAB8))[pos * 8 + f];
        outv = (t & 1) ? (par * cs[1] + val * cs[0]) : (val * cs[0] - par * cs[1]); }
    if (lane < 32) ((bf16_t*)(ws + WS_KR))[(size_t)m * 32 + 16 * (t & 1) + 8 * (t >> 1) + f] = (bf16_t)(cvtpk(outv, 0.f) & 0xffffu);
}

DI void fold_items(const Args& a, int gw, int NGW, int lane) {
    unsigned char* ws = a.ws; const bf16_t* At = (const bf16_t*)(ws + WS_R2); bf16_t* At4 = (bf16_t*)(ws + WS_AT4);
    for (int it = gw; it < 512 * NB; it += NGW) { const int gl = it >> 2, b = it & 3;
        const bf16_t* sx = At + (size_t)gl * ROWS + b * TPB + CTX; const bf16_t* sy = sx + (size_t)512 * ROWS;
        for (int i = 0; i < 4; ++i) { const int n = (i * 64 + lane) * 8; u32x4 xw[4], yw[4];
#pragma unroll
            for (int j = 0; j < 4; ++j) { xw[j] = *(const u32x4*)(sx + n + 2048 * j); yw[j] = *(const u32x4*)(sy + n + 2048 * j); }
            u32x4 o[4][2];
#pragma unroll
            for (int q = 0; q < 4; ++q) {
                float cr[4][2], ci[4][2];
#pragma unroll
                for (int e = 0; e < 2; ++e) { float x[4], y[4];
#pragma unroll
                    for (int j = 0; j < 4; ++j) { x[j] = e ? bfhi(xw[j][q]) : bflo(xw[j][q]); y[j] = e ? bfhi(yw[j][q]) : bflo(yw[j][q]); }
                    const float sx02 = x[0] + x[2], dx02 = x[0] - x[2], sx13 = x[1] + x[3], dx13 = x[1] - x[3];
                    const float sy02 = y[0] + y[2], dy02 = y[0] - y[2], sy13 = y[1] + y[3], dy13 = y[1] - y[3];
                    cr[0][e] = sx02 + sx13; ci[0][e] = sy02 + sy13;
                    cr[1][e] = dx02; ci[1][e] = -dx13;
                    cr[2][e] = sx02 - sx13; ci[2][e] = sy02 - sy13;
                    cr[3][e] = dy13; ci[3][e] = dy02; }
#pragma unroll
                for (int r = 0; r < 4; ++r) { o[r][0][q] = cvtpk(cr[r][0], cr[r][1]); o[r][1][q] = cvtpk(ci[r][0], ci[r][1]); }
            }
#pragma unroll
            for (int r = 0; r < 4; ++r)
#pragma unroll
                for (int p = 0; p < 2; ++p) *(u32x4*)(At4 + ((size_t)((r * 2 + p) * 512 + gl)) * 8192 + b * 2048 + n) = o[r][p];
        }
    }
}
DI void mirror_items(const Args& a, int gw, int NGW, int lane) {
    unsigned char* ws = a.ws; bf16_t* MIX = (bf16_t*)(ws + WS_R3); const bf16_t* At = (const bf16_t*)(ws + WS_R2);
    for (int it = gw; it < NB * 512; it += NGW) { const int b = it >> 9, ch = it & 511; const bf16_t* src = (const bf16_t*)(ws + WS_AT4) + (size_t)ch * 8192 + b * 2048; float s = 0.f;
        for (int i = 0; i < 4; ++i) { const u32x4 w = *(const u32x4*)(src + (i * 64 + lane) * 8);
            s += (bflo(w.x) - bfhi(w.x)) + (bflo(w.y) - bfhi(w.y)) + (bflo(w.z) - bfhi(w.z)) + (bflo(w.w) - bfhi(w.w)); }
        s = wave_sum(s) * 0.011048543456039806f;
        if (lane == 0) MIX[(size_t)(b * TPB + CTX + 4096) * DM + ch] = (bf16_t)(cvtpk(s, 0.f) & 0xffffu); }
    const bf16_t* PS = (const bf16_t*)(ws + WS_PS);
    for (int it = gw; it < NB * 4096; it += NGW) { const int b = it >> 12, k = it & 4095;
        bf16_t* src = MIX + (size_t)(b * TPB + CTX + k) * DM + 8 * lane; const u32x4 pc = *(const u32x4*)src; const u32x4 ps = *(const u32x4*)(PS + ((size_t)(b * 4096 + k)) * 512 + 8 * lane);
        u32x4 sm, df;
        sm.x = cvtpk(bflo(pc.x) + bflo(ps.x), bfhi(pc.x) + bfhi(ps.x)); df.x = cvtpk(bflo(pc.x) - bflo(ps.x), bfhi(pc.x) - bfhi(ps.x));
        sm.y = cvtpk(bflo(pc.y) + bflo(ps.y), bfhi(pc.y) + bfhi(ps.y)); df.y = cvtpk(bflo(pc.y) - bflo(ps.y), bfhi(pc.y) - bfhi(ps.y));
        sm.z = cvtpk(bflo(pc.z) + bflo(ps.z), bfhi(pc.z) + bfhi(ps.z)); df.z = cvtpk(bflo(pc.z) - bflo(ps.z), bfhi(pc.z) - bfhi(ps.z));
        sm.w = cvtpk(bflo(pc.w) + bflo(ps.w), bfhi(pc.w) + bfhi(ps.w)); df.w = cvtpk(bflo(pc.w) - bflo(ps.w), bfhi(pc.w) - bfhi(ps.w));
        *(u32x4*)src = sm;
        if (k >= 1) *(u32x4*)(MIX + (size_t)(b * TPB + CTX + 8192 - k) * DM + 8 * lane) = df; }
}

DI bool attn_unit_map(int L, int nunits_big, int& bh, int& qb) {
    if (L < nunits_big) { const int i = L >> 8, c = L & 255; bh = 4 * (c & 7) + i; qb = 1 + (c >> 3); return true; }
    bh = L - nunits_big; qb = 0; return bh < 32;
}
DI void attn_mla_unit(const Args& a, LAS unsigned char* lds, int bh, int qb) {
    unsigned char* ws = a.ws; const int tid = otid(), lane = tid & 63, wave = tid >> 6, r = lane & 31, h = lane >> 5;
    const int b = bh >> 3, hd = bh & 7; const int m = b * TPB + qb * 256 + wave * 32 + r;
    const bf16_t* Q = (const bf16_t*)(ws + WS_Q) + (size_t)m * 768;
    const bf16_t* KN = (const bf16_t*)(ws + WS_KN) + (size_t)(b * TPB) * 512 + hd * 64;
    const bf16_t* KR = (const bf16_t*)(ws + WS_KR) + (size_t)(b * TPB) * 32;
    const bf16_t* VT = (const bf16_t*)(ws + WS_VT0) + (size_t)(hd * 64) * ROWS + b * TPB;
    f32x16 o[2]; float l;
    attn_core<64, 32, 64>(o, l, lds, Q + hd * 64, Q + 512 + hd * 32, KN, 512, KR, 32, VT, ROWS, qb == 0 ? CTX / 64 : TPB / 64);
    const float il = 1.0f / l; bf16_t* dst = (bf16_t*)(ws + WS_R3) + (size_t)m * DM + 512 + hd * 64;
#pragma unroll
    for (int blk = 0; blk < 2; ++blk)
#pragma unroll
        for (int g = 0; g < 4; ++g) { u32x2 w; w.x = cvtpk(o[blk][4 * g] * il, o[blk][4 * g + 1] * il); w.y = cvtpk(o[blk][4 * g + 2] * il, o[blk][4 * g + 3] * il);
            *(u32x2*)(dst + 32 * blk + 8 * g + 4 * h) = w; }
}
DI void attn_diff_unit(const Args& a, LAS unsigned char* lds, int bh, int qb, float lam) {
    unsigned char* ws = a.ws; const int tid = otid(), lane = tid & 63, wave = tid >> 6, r = lane & 31, h = lane >> 5;
    const int b = bh >> 3, hd = bh & 7; const int m = b * TPB + qb * 256 + wave * 32 + r;
    const bf16_t* QK = (const bf16_t*)(ws + WS_R3);
    const bf16_t* VT = (const bf16_t*)(ws + WS_VT1) + (size_t)(hd * 128) * ROWS + b * TPB;
    bf16_t* dst = (bf16_t*)(ws + WS_R2) + (size_t)m * DM + hd * 128;
    f32x16 o[4]; float l;
    {
        const bf16_t* q = QK + (size_t)m * 2048 + (hd * 2) * 64; const bf16_t* k = QK + (size_t)(b * TPB) * 2048 + 1024 + (hd * 2) * 64;
        attn_core<64, 0, 128>(o, l, lds, q, q, k, 2048, k, 2048, VT, ROWS, TPB / 64);
        const float il = 1.0f / l;
#pragma unroll
        for (int blk = 0; blk < 4; ++blk)
#pragma unroll
            for (int g = 0; g < 4; ++g) { u32x2 w; w.x = cvtpk(o[blk][4 * g] * il, o[blk][4 * g + 1] * il); w.y = cvtpk(o[blk][4 * g + 2] * il, o[blk][4 * g + 3] * il); *(u32x2*)(dst + 32 * blk + 8 * g + 4 * h) = w; }
    }
    {
        const bf16_t* q = QK + (size_t)m * 2048 + (hd * 2 + 1) * 64; const bf16_t* k = QK + (size_t)(b * TPB) * 2048 + 1024 + (hd * 2 + 1) * 64;
        attn_core<64, 0, 128>(o, l, lds, q, q, k, 2048, k, 2048, VT, ROWS, TPB / 64);
    }
    const float il = lam / l; float ss = 0.f;
#pragma unroll
    for (int blk = 0; blk < 4; ++blk)
#pragma unroll
        for (int g = 0; g < 4; ++g) { const u32x2 aw = *(const u32x2*)(dst + 32 * blk + 8 * g + 4 * h);
            const float x0 = bflo(aw.x) - o[blk][4 * g] * il, x1 = bfhi(aw.x) - o[blk][4 * g + 1] * il, x2 = bflo(aw.y) - o[blk][4 * g + 2] * il, x3 = bfhi(aw.y) - o[blk][4 * g + 3] * il;
            o[blk][4 * g] = x0; o[blk][4 * g + 1] = x1; o[blk][4 * g + 2] = x2; o[blk][4 * g + 3] = x3; ss += (x0 * x0 + x1 * x1) + (x2 * x2 + x3 * x3); }
    ss += __shfl_xor(ss, 32);
    const float rn = (1.0f - LAMBDA_INIT) / sqrtf(ss * (1.0f / 128.0f) + RMS_EPS);
    const float* sub = a.in[I1_SUBLN];
#pragma unroll
    for (int blk = 0; blk < 4; ++blk)
#pragma unroll
        for (int g = 0; g < 4; ++g) { const int d0 = 32 * blk + 8 * g + 4 * h; const f32x4 sg = *(const f32x4*)(sub + d0);
            u32x2 w; w.x = cvtpk(o[blk][4 * g] * rn * sg[0], o[blk][4 * g + 1] * rn * sg[1]); w.y = cvtpk(o[blk][4 * g + 2] * rn * sg[2], o[blk][4 * g + 3] * rn * sg[3]);
            *(u32x2*)(dst + d0) = w; }
}

constexpr int NPHASES = 19;
constexpr int LDS_BYTES = 147456;
struct GOp { int kind; pg8::Gemm g; bf16_t* O; int ldc, o_bs, ai_extra; float scale; int q_tiles, rope_from; };

DI bool get_gemm(int ph, int sub, const Args& a, GOp& op) {
    unsigned char* ws = a.ws;
    bf16_t* R2 = (bf16_t*)(ws + WS_R2); bf16_t* R3 = (bf16_t*)(ws + WS_R3);
    op.kind = 0; op.o_bs = 0; op.ai_extra = 0; op.scale = 1.0f; op.q_tiles = 0; op.rope_from = 0;
    pg8::Gemm& g = op.g; g.nB = 1; g.a_bs = 0; g.b_bs = 0; g.rot = 0; g.a_seg = 0; g.b_seg = 0; g.skipctx = 0;
#define SETK(k_) do { g.K = (k_); g.kseg = (k_) / 64; g.a_seg = (k_); g.b_seg = (k_); } while (0)
    switch (ph * 16 + sub) {
    case 2 * 16 + 0:
        g.A = R2; g.a_rs = 1024; g.nM = NRT; g.Bt = (const bf16_t*)(ws + W_IN0); g.b_rs = 1024; g.nN = 5; SETK(1024); op.O = R3; op.ldc = 1280; return true;
    case 3 * 16 + 0:
        g.A = (const bf16_t*)(ws + W_DC); g.a_rs = 128; g.nM = 1; g.Bt = R3; g.b_rs = 1280; g.nN = NRT; g.nB = 4; g.b_bs = 128; SETK(128);
        op.O = R2; op.ldc = ROWS; op.o_bs = 128 * ROWS; op.ai_extra = 384 * ROWS; return true;
    case 4 * 16 + 0:
        op.kind = 1; g.A = (const bf16_t*)(ws + WS_CQN); g.a_rs = 256; g.nM = NRT; g.Bt = (const bf16_t*)(ws + W_UQ); g.b_rs = 256; g.nN = 3; SETK(256);
        op.O = (bf16_t*)(ws + WS_Q); op.ldc = 768; op.scale = MLA_QSCALE; op.q_tiles = 3; op.rope_from = 2; return true;
    case 4 * 16 + 1:
        g.A = (const bf16_t*)(ws + WS_CKVN); g.a_rs = 256; g.nM = NRT; g.Bt = (const bf16_t*)(ws + W_KN); g.b_rs = 256; g.nN = 2; SETK(256); g.rot = 140;
        op.O = (bf16_t*)(ws + WS_KN); op.ldc = 512; return true;
    case 4 * 16 + 2:
        g.A = (const bf16_t*)(ws + W_V0); g.a_rs = 256; g.nM = 2; g.Bt = (const bf16_t*)(ws + WS_CKVN); g.b_rs = 256; g.nN = NRT; SETK(256); g.rot = 148;
        op.O = (bf16_t*)(ws + WS_VT0); op.ldc = ROWS; return true;
    case 4 * 16 + 3: case 4 * 16 + 4: case 4 * 16 + 5: case 4 * 16 + 6: case 4 * 16 + 7: case 4 * 16 + 8: case 4 * 16 + 9: case 4 * 16 + 10: {
        const int rp = sub - 3, rr = rp >> 1, part = rp & 1;
        g.a_rs = 2048; g.nM = 4; g.b_rs = 8192; g.nN = 2; g.nB = 4; g.b_bs = 2048;
        if ((rr & 1) == 0) {
            g.A = (const bf16_t*)(ws + WS_DN) + (size_t)rp * 1024 * 2048; g.Bt = (const bf16_t*)(ws + WS_AT4) + (size_t)rp * 512 * 8192; SETK(2048);
        } else {
            g.A = (const bf16_t*)(ws + WS_DN) + (size_t)(rr * 2) * 1024 * 2048; g.Bt = (const bf16_t*)(ws + WS_AT4) + (size_t)((part ? 3 : 1) * 2) * 512 * 8192;
            g.K = 4096; g.kseg = 32; g.a_seg = 1024 * 2048; g.b_seg = 512 * 8192; if (rr == 3 && part == 1) op.scale = -1.0f;
        }
        g.rot = (152 + 32 * rp) & 255;
        if (part == 0) { op.O = R3 + (size_t)(CTX + rr) * DM; op.ldc = 4 * DM; op.o_bs = TPB * DM; }
        else { op.O = (bf16_t*)(ws + WS_PS) + rr * 512; op.ldc = 4 * 512; op.o_bs = 4096 * 512; }
        return true; }
    case 4 * 16 + 11:
        g.A = (const bf16_t*)(ws + W_D256); g.a_rs = 512; g.nM = 1; g.Bt = R2; g.b_rs = ROWS; g.nN = 2; g.nB = 4; g.b_bs = TPB; g.K = 512; g.kseg = 4; g.a_seg = 256; g.b_seg = 512 * ROWS; g.rot = 0;
        op.O = R3; op.ldc = DM; op.o_bs = TPB * DM; return true;
    case 6 * 16 + 0:
        g.A = R3; g.a_rs = 1024; g.nM = NRT; g.Bt = (const bf16_t*)(ws + W_OUT0); g.b_rs = 1024; g.nN = 4; SETK(1024); op.O = (bf16_t*)(ws + WS_Y0); op.ldc = DM; return true;
    case 8 * 16 + 0: case 15 * 16 + 0:
        op.kind = 3; g.A = R2; g.a_rs = 1024; g.nM = (ph == 8 ? NRT : 128); g.skipctx = (ph != 8); g.Bt = (const bf16_t*)(ws + (ph == 8 ? W_GU0 : W_GU1)); g.b_rs = 1024; g.nN = 22; SETK(1024); op.O = R3; op.ldc = FF; return true;
    case 9 * 16 + 0: case 16 * 16 + 0:
        g.A = R3; g.a_rs = FF; g.nM = (ph == 9 ? NRT : 128); g.skipctx = (ph != 9); g.Bt = (const bf16_t*)(ws + (ph == 9 ? W_D0 : W_D1)); g.b_rs = FF; g.nN = 4; SETK(FF); op.O = R2; op.ldc = DM; return true;
    case 11 * 16 + 0:
        op.kind = 2; g.A = R2; g.a_rs = 1024; g.nM = NRT; g.Bt = (const bf16_t*)(ws + W_QK1); g.b_rs = 1024; g.nN = 8; SETK(1024);
        op.O = R3; op.ldc = 2048; op.scale = DIFF_QSCALE; op.q_tiles = 4; op.rope_from = 0; return true;
    case 11 * 16 + 1:
        g.A = (const bf16_t*)(ws + W_V1); g.a_rs = 1024; g.nM = 4; g.Bt = R2; g.b_rs = 1024; g.nN = NRT; SETK(1024); g.rot = 32;
        op.O = (bf16_t*)(ws + WS_VT1); op.ldc = ROWS; return true;
    case 13 * 16 + 0:
        g.A = R2; g.a_rs = 1024; g.nM = 128; g.skipctx = 1; g.Bt = (const bf16_t*)(ws + W_OUT1); g.b_rs = 1024; g.nN = 4; SETK(1024); op.O = R3; op.ldc = DM; return true;
    default: return false;
    }
#undef SETK
}

DI bool get_rowpass(int ph, const Args& a, RowPass& P) {
    unsigned char* ws = a.ws; const float* MOD0 = (const float*)(ws + WS_MOD); const float* MOD1 = MOD0 + 5 * 6144;
    float* XC = (float*)(ws + WS_XC); bf16_t* R2 = (bf16_t*)(ws + WS_R2);
    switch (ph) {
    case 1:  P = RowPass{a.in[I_X], a.in[I_CTX], nullptr, nullptr, nullptr, MOD0, 0, nullptr, nullptr, MOD0, 1024, 0, R2, 0}; return true;
    case 7:  P = RowPass{a.in[I_X], a.in[I_CTX], a.out, XC, (const bf16_t*)(ws + WS_Y0), MOD0, 2048, a.in[I0_LN1G], a.in[I0_LN1B], MOD0, 4096, 3072, R2, 0}; return true;
    case 10: P = RowPass{a.out, XC, a.out, XC, R2, MOD0, 5120, a.in[I0_LN2G], a.in[I0_LN2B], MOD1, 1024, 0, R2, 0}; return true;
    case 14: P = RowPass{a.out, XC, a.out, XC, (const bf16_t*)(ws + WS_R3), MOD1, 2048, a.in[I1_LN1G], a.in[I1_LN1B], MOD1, 4096, 3072, R2, 1}; return true;
    case 17: P = RowPass{a.out, XC, a.out, XC, R2, MOD1, 5120, a.in[I1_LN2G], a.in[I1_LN2B], MOD1, 0, 0, nullptr, 1}; return true;
    default: return false;
    }
}

__global__ void __launch_bounds__(512, 2) fwd_kernel(Args a) {
    extern __shared__ __attribute__((aligned(16))) unsigned char lds_raw[];
    LAS unsigned char* lds = (LAS unsigned char*)lds_raw;
    const int G = gridDim.x;
    volatile LAS unsigned* bst = (volatile LAS unsigned*)(lds + LDS_BYTES - 64);
    if (threadIdx.x < 2) bst[threadIdx.x] = 0u;
    __syncthreads();
    XcdBarrier xbar = xcd_barrier_post((unsigned*)(a.ws + WS_BAR), bst);
    for (int pos = a.ph_lo; pos < a.ph_hi; ++pos) {
        const int ph = pos <= 3 ? pos : (pos == 4 ? 18 : pos - 1);
        const int tid = otid(), lane = tid & 63, wave = __builtin_amdgcn_readfirstlane(tid >> 6);
        const int gw = blockIdx.x * 8 + wave, NGW = G * 8;
#ifndef NO_PRO
        if (ph == 0) prologue(a, lds);
#endif
        RowPass P;
        if (get_rowpass(ph, a, P)) { for (int m = gw; m < ROWS; m += 2 * NGW) { const int m1 = m + NGW; const bool v1 = m1 < ROWS; row_pass2(P, m, v1 ? m1 : m, v1, lane); } }
        if (ph == 3) { for (int m = gw; m < ROWS; m += NGW) p3_row(a, m, lane); }
        if (ph == 18) fold_items(a, gw, NGW, lane);
#ifndef NO_MLA
        if (ph == 5) {
            mirror_items(a, gw, NGW, lane);
            for (int L = blockIdx.x; ; L += G) { int bh, qb; if (!attn_unit_map(L, 1024, bh, qb)) break; attn_mla_unit(a, lds, bh, qb); }
        }
#endif
#ifndef NO_DIFF
        if (ph == 12) {
            const float p1 = wave_sum(a.in[I1_LQ1][lane] * a.in[I1_LK1][lane]), p2 = wave_sum(a.in[I1_LQ2][lane] * a.in[I1_LK2][lane]);
            const float lam = expf(p1) - expf(p2) + LAMBDA_INIT;
            for (int L = blockIdx.x; L < 1024; L += G) { int bh, qb; attn_unit_map(L, 1024, bh, qb); attn_diff_unit(a, lds, bh, qb, lam); }
        }
#endif
#ifndef NO_GEMM
        for (int sub = 0; sub < 16; ++sub) {
            GOp op; if (!get_gemm(ph, sub, a, op)) break;
            pg8::StaticOrder S; S.init(op.g.nM, op.g.nN, op.g.nB, G, (int)blockIdx.x, op.g.rot, op.g.skipctx);
            if (op.kind == 0) { pg8::EpiStore E{op.O, op.ldc, op.o_bs, op.ai_extra, op.scale}; pg8::gemm_phase(lds, op.g, S, E); }
            else if (op.kind == 1) { pg8::EpiRope<8> E{op.O, op.ldc, op.scale, op.q_tiles, op.rope_from, (const f32x2*)(a.ws + WS_TAB8)}; pg8::gemm_phase(lds, op.g, S, E); }
            else if (op.kind == 2) { pg8::EpiRope<16> E{op.O, op.ldc, op.scale, op.q_tiles, op.rope_from, (const f32x2*)(a.ws + WS_TAB16)}; pg8::gemm_phase(lds, op.g, S, E); }
            else { pg8::EpiSwiglu E{op.O, op.ldc}; pg8::gemm_phase(lds, op.g, S, E); }
        }
#endif
        if (pos + 1 < a.ph_hi) { if (a.use_cg) { __threadfence(); cg::this_grid().sync(); } else xcd_barrier(xbar); }
    }
}

extern "C" void kernel_launch(void* const* d_in, const int* in_sizes, int n_in, void* d_out, int out_size, void* d_ws, size_t ws_size, hipStream_t stream) {
    static int grid = 0;
    if (grid == 0) {
        if (n_in != 35 || ws_size < WS_END) { fprintf(stderr, "kernel_launch: unexpected n_in %d / ws %zu (need %zu)\n", n_in, ws_size, (size_t)WS_END); grid = -1; return; }
        int dev = 0, cus = 0, per_cu = 0;
        hipGetDevice(&dev); hipDeviceGetAttribute(&cus, hipDeviceAttributeMultiprocessorCount, dev);
        hipFuncSetAttribute((const void*)fwd_kernel, hipFuncAttributeMaxDynamicSharedMemorySize, LDS_BYTES);
        hipOccupancyMaxActiveBlocksPerMultiprocessor(&per_cu, (const void*)fwd_kernel, 512, LDS_BYTES);
        if (per_cu < 1) { fprintf(stderr, "kernel_launch: occupancy query says %d blocks/CU\n", per_cu); per_cu = 1; }
        (void)hipGetLastError();
        grid = cus * 1;
    }
    if (grid < 0) return;
    Args a{};
    for (int i = 0; i < 35; ++i) a.in[i] = (const float*)d_in[i];
    a.out = (float*)d_out; a.ws = (unsigned char*)d_ws;
#if MK_MULTI
    for (int ph = 0; ph < NPHASES; ++ph) { a.ph_lo = ph; a.ph_hi = ph + 1; hipLaunchKernelGGL(fwd_kernel, dim3(grid), dim3(512), LDS_BYTES, stream, a); }
#else
    a.ph_lo = 0; a.ph_hi = NPHASES;
    hipMemsetAsync((char*)d_ws + WS_BAR, 0, 16384, stream);
    void* args[] = {&a};
    hipError_t e = hipLaunchCooperativeKernel((const void*)fwd_kernel, dim3(grid), dim3(512), args, LDS_BYTES, stream);
    if (e != hipSuccess) fprintf(stderr, "cooperative launch failed: %s (grid %d)\n", hipGetErrorString(e), grid);
#endif
}
```
